# Optimizing an MI355X kernel written in HIP

```python
import jax, jax.numpy as jnp
from jax import lax
import numpy as np

D_MODEL = 1024
BATCH = 16
SEQ = 256
DEPTH = 4
DEC_BATCH = 8
DEC_SEQ = 2048
PAST_LEN = 512

GRID_W = 64
GLA_H = 4
GLA_DK = 64
GLA_DV = 128
GLA_RANK = 16
GLA_GATE_NORM = 16.0
HG_H = 4
HG_DK = 128
HG_DV = 128
GM_G = 4
GM_CH = 128
GM_CHUNK = 128
SCAN_CHUNK = 64
D_FF = 4 * D_MODEL
EPS = 1e-6
GLA_QK = GLA_H * GLA_DK
GLA_V = GLA_H * GLA_DV
HG_K = HG_H * HG_DK
HG_V = HG_H * HG_DV
GM_W = GM_G * GM_CH
SPLIT_SIZES = (GLA_QK, GLA_QK, GLA_V, GLA_V, GLA_RANK, GLA_RANK,
               HG_K, HG_K, HG_K, HG_V, HG_V,
               GM_W, GM_W,
               D_MODEL, D_MODEL, D_MODEL)
SPLIT_POINTS = tuple(int(s) for s in np.cumsum(SPLIT_SIZES)[:-1])
D_IN = int(sum(SPLIT_SIZES))

kernel_name = "hybrid_gla_hgrn2_gmlp_diffusion_step"

F32 = jnp.float32


def rms_norm(x, g):
    xf = x.astype(F32)
    xf = xf * lax.rsqrt(jnp.mean(xf * xf, axis=-1, keepdims=True) + EPS)
    return xf.astype(x.dtype) * g


def split_heads(t, n):
    b, s, _ = t.shape
    return t.reshape(b, s, n, -1).transpose(0, 2, 1, 3)


def head_norm_gate(o, g, gate):
    b, h, s, dv = o.shape
    of = o.astype(F32)
    of = of * lax.rsqrt(jnp.mean(of * of, axis=-1, keepdims=True) + EPS)
    of = of.transpose(0, 2, 1, 3).reshape(b, s, h * dv).astype(gate.dtype)
    return of * g * jax.nn.silu(gate)


def chunked_gla(q, k, v, log_a, s0):
    b, h, s, _ = q.shape
    n = s // SCAN_CHUNK

    def to_chunks(t):
        return jnp.moveaxis(t.reshape(b, h, n, SCAN_CHUNK, t.shape[-1]), 2, 0)

    causal = jnp.tril(jnp.ones((SCAN_CHUNK, SCAN_CHUNK), dtype=bool))

    def step(st, inp):
        qc, kc, vc, ac = inp
        cum = jnp.cumsum(ac.astype(F32), axis=2)
        rel = cum[:, :, :, None, :] - cum[:, :, None, :, :]
        decay = jnp.exp(jnp.where(causal[:, :, None], rel, -jnp.inf))
        scores = jnp.einsum('bhid,bhjd,bhijd->bhij', qc, kc, decay)
        o = (jnp.einsum('bhij,bhjv->bhiv', scores, vc)
             + jnp.einsum('bhid,bhdv->bhiv', qc * jnp.exp(cum), st))
        last = cum[:, :, -1:, :]
        st_new = (jnp.exp(last[:, :, 0, :])[..., None] * st
                  + jnp.einsum('bhjd,bhjv->bhdv', kc * jnp.exp(last - cum), vc))
        return st_new.astype(st.dtype), o.astype(v.dtype)

    s_fin, o = lax.scan(step, s0, (to_chunks(q), to_chunks(k), to_chunks(v), to_chunks(log_a)))
    o = jnp.moveaxis(o, 0, 2).reshape(b, h, s, v.shape[-1])
    return o, s_fin


def bidir_scan(q, k_f, k_b, v, la_f, la_b, s0_f, s0_b):
    o_f, s_f = chunked_gla(q, k_f, v, la_f, s0_f)
    flip = lambda t: jnp.flip(t, axis=2)
    o_b, s_b = chunked_gla(flip(q), flip(k_b), flip(v), flip(la_b), s0_b)
    return o_f + flip(o_b), jnp.stack([s_f, s_b], axis=1)


def hgrn_lower_bounds(logits):
    p = jax.nn.softmax(logits.astype(F32), axis=1)
    cum = jnp.cumsum(p, axis=1)
    return cum - cum[:, :1]


def chunk_spatial_gate(u, v, g, ws, bs):
    b, s, _ = u.shape
    n = s // GM_CHUNK
    vf = v.astype(F32)
    mu = jnp.mean(vf, axis=-1, keepdims=True)
    var = jnp.mean(jnp.square(vf - mu), axis=-1, keepdims=True)
    vn = ((vf - mu) * lax.rsqrt(var + EPS)).astype(v.dtype) * g
    vc = vn.reshape(b, n, GM_CHUNK, GM_G, GM_CH)
    mixed = jnp.einsum('gpq,bnqgc->bnpgc', ws, vc) + bs.T[:, :, None]
    return u * mixed.reshape(b, s, GM_W)


def grid_posemb(n_tok, dtype):
    rows = n_tok // GRID_W
    r, col = jnp.meshgrid(jnp.arange(rows, dtype=F32), jnp.arange(GRID_W, dtype=F32), indexing='ij')
    r = r.reshape(-1)
    col = col.reshape(-1)
    nf = D_MODEL // 4
    omega = 1.0 / (10000.0 ** (jnp.arange(nf, dtype=F32) / nf))
    er = r[:, None] * omega
    ec = col[:, None] * omega
    return jnp.concatenate([jnp.sin(er), jnp.cos(er), jnp.sin(ec), jnp.cos(ec)], axis=-1).astype(dtype)


def token_mixers(h, s_gla, s_hg, p, lb_f, lb_b):
    proj = h @ p['w_in']
    (gq, gk, gv, go, gzf, gzb, hq, hff, hfb, hi, ho, mu, mv, a_gla, a_hg, a_gm) = jnp.split(
        proj, SPLIT_POINTS, axis=-1)
    q = split_heads(gq, GLA_H) * (GLA_DK ** -0.5)
    k = split_heads(gk, GLA_H)
    v = split_heads(gv, GLA_H)
    la_f = split_heads(jax.nn.log_sigmoid((gzf @ p['gla_lr_w'][0] + p['gla_lr_b'][0]).astype(F32)) / GLA_GATE_NORM, GLA_H)
    la_b = split_heads(jax.nn.log_sigmoid((gzb @ p['gla_lr_w'][1] + p['gla_lr_b'][1]).astype(F32)) / GLA_GATE_NORM, GLA_H)
    o, s_gla_new = bidir_scan(q, k, k, v, la_f, la_b, s_gla[:, 0], s_gla[:, 1])
    o_gla = head_norm_gate(o, p['gla_norm_g'], go)
    q = split_heads(hq, HG_H) * (HG_DK ** -0.5)
    hff32 = hff.astype(F32)
    hfb32 = hfb.astype(F32)
    lf_f = jnp.log(lb_f + (1.0 - lb_f) * jax.nn.sigmoid(hff32))
    lf_b = jnp.log(lb_b + (1.0 - lb_b) * jax.nn.sigmoid(hfb32))
    k_f = (1.0 - lb_f) * jax.nn.sigmoid(-hff32)
    k_b = (1.0 - lb_b) * jax.nn.sigmoid(-hfb32)
    v = split_heads(hi, HG_H)
    o, s_hg_new = bidir_scan(q, split_heads(k_f, HG_H), split_heads(k_b, HG_H), v,
                             split_heads(lf_f, HG_H), split_heads(lf_b, HG_H), s_hg[:, 0], s_hg[:, 1])
    o_hg = head_norm_gate(o, p['hg_norm_g'], ho)
    o_gm = chunk_spatial_gate(jax.nn.gelu(mu), jax.nn.gelu(mv), p['gm_norm_g'], p['gm_ws'], p['gm_bs'])
    merged = (jax.nn.sigmoid(a_gla) * (o_gla @ p['w_br_gla'])
              + jax.nn.sigmoid(a_hg) * (o_hg @ p['w_br_hg'])
              + jax.nn.sigmoid(a_gm) * (o_gm @ p['w_br_gm']))
    return merged @ p['w_out'], s_gla_new, s_hg_new


def trunk_layer(x, mod, s_gla, s_hg, lb_f, lb_b, p):
    sh1, sc1, gt1, sh2, sc2, gt2 = jnp.split(mod, 6, axis=-1)
    h = rms_norm(x, p['norm_mix_g']) * (1.0 + sc1) + sh1
    mix, s_gla_new, s_hg_new = token_mixers(h, s_gla, s_hg, p, lb_f, lb_b)
    x = x + gt1 * mix
    h = rms_norm(x, p['norm_ffn_g']) * (1.0 + sc2) + sh2
    x = x + gt2 * (jnp.square(jax.nn.relu(h @ p['w_ff1'])) @ p['w_ff2'])
    return x, s_gla_new, s_hg_new


def setup_inputs(seed: int = 0) -> dict:
    key = jax.random.key(seed)
    ks = jax.random.split(key, 26)
    nrm = lambda k, shape, scale: jax.random.normal(k, shape, F32) * scale
    gain = lambda k, shape: 1.0 + 0.02 * jax.random.normal(k, shape, F32)
    D = D_MODEL
    return {
        'x_prompt': nrm(ks[0], (BATCH, SEQ, D), 1.0),
        'x_sample': nrm(ks[1], (DEC_BATCH, DEC_SEQ, D), 1.0),
        'c': nrm(ks[2], (DEC_BATCH, D), 1.0),
        'state_gla': nrm(ks[3], (DEC_BATCH, DEPTH, 2, GLA_H, GLA_DK, GLA_DV), 0.3),
        'state_hgrn': nrm(ks[4], (DEC_BATCH, DEPTH, 2, HG_H, HG_DK, HG_DV), 0.3),
        'c_ctx': nrm(ks[5], (D,), 1.0),
        'ada_w': nrm(ks[6], (DEPTH, D, 6 * D), 0.5 * D ** -0.5),
        'ada_b': nrm(ks[7], (DEPTH, 6 * D), 0.02),
        'norm_mix_g': gain(ks[8], (DEPTH, D)),
        'norm_ffn_g': gain(ks[9], (DEPTH, D)),
        'w_in': nrm(ks[10], (DEPTH, D, D_IN), D ** -0.5),
        'gla_lr_w': nrm(ks[11], (DEPTH, 2, GLA_RANK, GLA_QK), GLA_RANK ** -0.5),
        'gla_lr_b': nrm(ks[12], (DEPTH, 2, GLA_QK), 0.1),
        'gla_norm_g': gain(ks[13], (DEPTH, GLA_V)),
        'hg_lb_logits': nrm(ks[14], (2, DEPTH, HG_K), 0.1),
        'hg_norm_g': gain(ks[15], (DEPTH, HG_V)),
        'gm_norm_g': gain(ks[16], (DEPTH, GM_W)),
        'gm_ws': nrm(ks[17], (DEPTH, GM_G, GM_CHUNK, GM_CHUNK), GM_CHUNK ** -0.5),
        'gm_bs': gain(ks[18], (DEPTH, GM_G, GM_CHUNK)),
        'w_br_gla': nrm(ks[19], (DEPTH, GLA_V, D), GLA_V ** -0.5),
        'w_br_hg': nrm(ks[20], (DEPTH, HG_V, D), HG_V ** -0.5),
        'w_br_gm': nrm(ks[21], (DEPTH, GM_W, D), GM_W ** -0.5),
        'w_out': nrm(ks[22], (DEPTH, D, D), D ** -0.5),
        'w_ff1': nrm(ks[23], (DEPTH, D, D_FF), D ** -0.5),
        'w_ff2': nrm(ks[24], (DEPTH, D_FF, D), D_FF ** -0.5),
        'final_norm_g': gain(ks[25], (D,)),
    }


def reference(x_prompt, x_sample, c, state_gla, state_hgrn, c_ctx, ada_w, ada_b, norm_mix_g, norm_ffn_g,
              w_in, gla_lr_w, gla_lr_b, gla_norm_g, hg_lb_logits, hg_norm_g, gm_norm_g, gm_ws, gm_bs,
              w_br_gla, w_br_hg, w_br_gm, w_out, w_ff1, w_ff2, final_norm_g):
    lbs = hgrn_lower_bounds(hg_lb_logits)
    b_ctx = x_prompt.shape[0]
    xc = x_prompt
    xl = x_sample + grid_posemb(x_sample.shape[1], x_sample.dtype)[None]
    zero_gla = jnp.zeros((b_ctx, 2, GLA_H, GLA_DK, GLA_DV), x_prompt.dtype)
    zero_hg = jnp.zeros((b_ctx, 2, HG_H, HG_DK, HG_DV), x_prompt.dtype)
    new_gla = []
    new_hg = []
    for l in range(DEPTH):
        p = {
            'norm_mix_g': norm_mix_g[l], 'norm_ffn_g': norm_ffn_g[l], 'w_in': w_in[l],
            'gla_lr_w': gla_lr_w[l], 'gla_lr_b': gla_lr_b[l], 'gla_norm_g': gla_norm_g[l],
            'hg_norm_g': hg_norm_g[l], 'gm_norm_g': gm_norm_g[l], 'gm_ws': gm_ws[l], 'gm_bs': gm_bs[l],
            'w_br_gla': w_br_gla[l], 'w_br_hg': w_br_hg[l], 'w_br_gm': w_br_gm[l], 'w_out': w_out[l],
            'w_ff1': w_ff1[l], 'w_ff2': w_ff2[l],
        }
        mod_c = (jax.nn.silu(c_ctx) @ ada_w[l] + ada_b[l])[None, None, :]
        mod_l = (jax.nn.silu(c) @ ada_w[l] + ada_b[l])[:, None, :]
        xc, sg, sh = trunk_layer(xc, mod_c, zero_gla, zero_hg, lbs[0, l], lbs[1, l], p)
        new_gla.append(sg)
        new_hg.append(sh)
        xl, _, _ = trunk_layer(xl, mod_l, state_gla[:, l], state_hgrn[:, l], lbs[0, l], lbs[1, l], p)
    y_prompt = rms_norm(xc, final_norm_g)
    y_sample = rms_norm(xl, final_norm_g)
    new_state_gla = jnp.stack(new_gla, axis=1)
    new_state_hgrn = jnp.stack(new_hg, axis=1)
    return (y_prompt, y_sample, new_state_gla, new_state_hgrn)
```

```cpp
#include <hip/hip_runtime.h>
#include <hip/hip_cooperative_groups.h>
#include <cstdio>
namespace cg = cooperative_groups;

#define LAS __attribute__((address_space(3)))
typedef unsigned short bf16_t;
typedef short bf16x8 __attribute__((ext_vector_type(8)));
typedef float f32x16 __attribute__((ext_vector_type(16)));
typedef float f32x4 __attribute__((ext_vector_type(4)));
typedef unsigned u32x4 __attribute__((ext_vector_type(4)));
typedef unsigned u32x2 __attribute__((ext_vector_type(2)));

constexpr int D = 1024, DEPTH = 4, NTOK = 20480, NCTX = 4096, DFF = 4096;
constexpr int DIN = 8224, NPROJ = 5152, NGATE = 3072;
constexpr int PJ_GQ = 0, PJ_GK = 256, PJ_GV = 512, PJ_GO = 1024, PJ_GZF = 1536, PJ_GZB = 1552, PJ_HQ = 1568, PJ_HFF = 2080,
              PJ_HFB = 2592, PJ_HI = 3104, PJ_HO = 3616, PJ_MU = 4128, PJ_MV = 4640;
constexpr int NCHUNK = NTOK / 64;
constexpr float EPS = 1e-6f;
constexpr int LDS_BYTES = 160 * 1024;
constexpr int NPHASE = 2 + DEPTH * 9;

constexpr size_t WS_PROJ = 0;
constexpr size_t WS_ST   = WS_PROJ + (size_t)NTOK * NPROJ * 2;
constexpr size_t ST_GLA_BYTES = (size_t)NCHUNK * 2 * 4 * 128 * 64 * 2, ST_HG_BYTES = (size_t)NCHUNK * 2 * 4 * 128 * 128 * 2;
constexpr size_t WS_OCAT = WS_ST + ST_GLA_BYTES + ST_HG_BYTES;
constexpr size_t WS_H    = WS_OCAT + (size_t)NTOK * 1536 * 2;
constexpr size_t WS_W    = WS_H + (size_t)NTOK * D * 2;
constexpr size_t W_IN = 0, W_G = W_IN + (size_t)NPROJ * D * 2, W_BR = W_G + (size_t)NGATE * D * 2, W_OUT = W_BR + (size_t)3 * D * 512 * 2,
                 W_FF1 = W_OUT + (size_t)D * D * 2, W_FF2 = W_FF1 + (size_t)DFF * D * 2, W_END = W_FF2 + (size_t)D * DFF * 2;
constexpr size_t WS_MOD  = WS_W + W_END;
constexpr size_t WS_LBS  = WS_MOD + (size_t)DEPTH * 9 * 6144 * 4;
constexpr size_t WS_CTR  = WS_LBS + 2 * 4 * 512 * 4;
constexpr size_t WS_END  = WS_CTR + 256;

struct Params {
    const float *x_prompt, *x_sample, *c, *state_gla, *state_hgrn, *c_ctx, *ada_w, *ada_b, *norm_mix_g, *norm_ffn_g, *w_in, *gla_lr_w,
        *gla_lr_b, *gla_norm_g, *hg_lb_logits, *hg_norm_g, *gm_norm_g, *gm_ws, *gm_bs, *w_br_gla, *w_br_hg, *w_br_gm, *w_out, *w_ff1, *w_ff2,
        *final_norm_g;
    float* out; unsigned char* ws; int ph_lo, ph_hi;
};

__device__ __forceinline__ unsigned pk2(float lo, float hi) { unsigned r; asm("v_cvt_pk_bf16_f32 %0, %1, %2" : "=v"(r) : "v"(lo), "v"(hi)); return r; }
__device__ __forceinline__ bf16_t f2bf(float f) { return (bf16_t)(pk2(f, 0.f) & 0xffffu); }
__device__ __forceinline__ float bf2f(bf16_t h) { return __uint_as_float(((unsigned)h) << 16); }
__device__ __forceinline__ float bflo(unsigned u) { return __uint_as_float(u << 16); }
__device__ __forceinline__ float bfhi(unsigned u) { return __uint_as_float(u & 0xffff0000u); }
__device__ __forceinline__ float sigmoidf_(float x) { return 1.0f / (1.0f + __expf(-x)); }
__device__ __forceinline__ float siluf_(float x) { return x * sigmoidf_(x); }
__device__ __forceinline__ float geluf_(float x) { const float y = 0.7978845608028654f * (x + 0.044715f * x * x * x); const float t = 1.0f - 2.0f / (1.0f + __expf(2.0f * y)); return 0.5f * x * (1.0f + t); }
__device__ __forceinline__ float logsigmoidf_(float x) { return fminf(x, 0.f) - log1pf(__expf(-fabsf(x))); }
__device__ __forceinline__ float wave_sum(float v) {
#pragma unroll
    for (int o = 1; o < 64; o <<= 1) v += __shfl_xor(v, o);
    return v;
}
__device__ __forceinline__ int mod_row(int tok) { return tok < NCTX ? 0 : 1 + ((tok - NCTX) >> 11); }
__device__ __forceinline__ int otid() { int t = (int)__builtin_amdgcn_workitem_id_x(); asm volatile("" : "+v"(t)); return t; }
#define LDS_WAIT() asm volatile("s_waitcnt lgkmcnt(0)" ::: "memory")

template <int MT, int NTL, int KS>
__device__ __forceinline__ void mma_lds(f32x16 (&acc)[MT][NTL], const LAS bf16_t* As, int lda, const LAS bf16_t* Bs, int ldb, int lane) {
    const int r = lane & 31, h = lane >> 5;
    const LAS bf16_t* ap = As + r * lda + h * 8;
    const LAS bf16_t* bp = Bs + r * ldb + h * 8;
#pragma unroll
    for (int ks = 0; ks < KS; ++ks) {
        bf16x8 a[MT], b[NTL];
#pragma unroll
        for (int m = 0; m < MT; ++m) a[m] = *(const LAS bf16x8*)(ap + m * 32 * lda + ks * 16);
#pragma unroll
        for (int n = 0; n < NTL; ++n) b[n] = *(const LAS bf16x8*)(bp + n * 32 * ldb + ks * 16);
#pragma unroll
        for (int m = 0; m < MT; ++m)
#pragma unroll
            for (int n = 0; n < NTL; ++n) acc[m][n] = __builtin_amdgcn_mfma_f32_32x32x16_bf16(a[m], b[n], acc[m][n], 0, 0, 0);
    }
}

template <int BM>
__device__ __forceinline__ void gemm_kloop(LAS unsigned char* lds, const bf16_t* __restrict__ Ag, int lda, const bf16_t* __restrict__ Bg, int ldb, int brows,
                                           int K, f32x16 (&acc)[2][(128 / (8 / (BM / 64))) / 32]) {
    constexpr int WM = BM / 64, WN = 8 / WM, WTN = 128 / WN, NTL = WTN / 32, AP = BM / 64, LDT = 72;
    LAS bf16_t* As = (LAS bf16_t*)lds;
    LAS bf16_t* Bs = As + 2 * BM * LDT;
    const int tid = otid(), lane = tid & 63, wid = tid >> 6, wm = wid / WN, wn = wid % WN;
    const int lrow = tid >> 3, lc = (tid & 7) * 8;
    const bf16_t* ap[AP]; const bf16_t* bp[2];
#pragma unroll
    for (int p = 0; p < AP; ++p) ap[p] = Ag + (size_t)(lrow + p * 64) * lda + lc;
#pragma unroll
    for (int p = 0; p < 2; ++p) { int br = lrow + p * 64; br = br < brows ? br : brows - 1; bp[p] = Bg + (size_t)br * ldb + lc; }
    u32x4 ra[AP], rb[2];
#pragma unroll
    for (int p = 0; p < AP; ++p) ra[p] = *(const u32x4*)(ap[p]);
#pragma unroll
    for (int p = 0; p < 2; ++p) rb[p] = *(const u32x4*)(bp[p]);
#pragma unroll
    for (int p = 0; p < AP; ++p) *(LAS u32x4*)(As + (lrow + p * 64) * LDT + lc) = ra[p];
#pragma unroll
    for (int p = 0; p < 2; ++p) *(LAS u32x4*)(Bs + (lrow + p * 64) * LDT + lc) = rb[p];
    __syncthreads();
    const int nk = K / 64;
    for (int kt = 0; kt < nk; ++kt) {
        const int cur = kt & 1;
        const bool more = kt + 1 < nk;
        if (more) {
#pragma unroll
            for (int p = 0; p < AP; ++p) ra[p] = *(const u32x4*)(ap[p] + (kt + 1) * 64);
#pragma unroll
            for (int p = 0; p < 2; ++p) rb[p] = *(const u32x4*)(bp[p] + (kt + 1) * 64);
        }
        mma_lds<2, NTL, 4>(acc, As + cur * BM * LDT + wm * 64 * LDT, LDT, Bs + cur * 128 * LDT + wn * WTN * LDT, LDT, lane);
        if (more) {
            const int nx = cur ^ 1;
#pragma unroll
            for (int p = 0; p < AP; ++p) *(LAS u32x4*)(As + nx * BM * LDT + (lrow + p * 64) * LDT + lc) = ra[p];
#pragma unroll
            for (int p = 0; p < 2; ++p) *(LAS u32x4*)(Bs + nx * 128 * LDT + (lrow + p * 64) * LDT + lc) = rb[p];
        }
        __syncthreads();
    }
}

template <int NTL>
__device__ __forceinline__ void acc_zero(f32x16 (&acc)[2][NTL]) {
#pragma unroll
    for (int m = 0; m < 2; ++m)
#pragma unroll
        for (int n = 0; n < NTL; ++n)
#pragma unroll
            for (int i = 0; i < 16; ++i) acc[m][n][i] = 0.f;
}

__device__ __forceinline__ void tile_coords(int t, int nN, int& tm, int& tn) { const int q = t >> 3; tn = q % nN; tm = (q / nN) * 8 + (t & 7); }

template <int BM, class Epi>
__device__ __forceinline__ void gemm_phase(LAS unsigned char* lds, const bf16_t* A, int lda, const bf16_t* Bt, int ldb, int M, int N, int K, const Epi& epi) {
    constexpr int WM = BM / 64, WN = 8 / WM, WTN = 128 / WN, NTL = WTN / 32;
    const int nM = M / BM, nN = (N + 127) / 128, ntiles = nM * nN;
    const int lane = otid() & 63, wid = otid() >> 6, wm = wid / WN, wn = wid % WN;
    for (int t = blockIdx.x; t < ntiles; t += gridDim.x) {
        int tm, tn; tile_coords(t, nN, tm, tn);
        const int row0 = tm * BM, col0 = tn * 128;
        f32x16 acc[2][NTL]; acc_zero<NTL>(acc);
        gemm_kloop<BM>(lds, A + (size_t)row0 * lda, lda, Bt + (size_t)col0 * ldb, ldb, min(128, N - col0), K, acc);
#pragma unroll
        for (int m = 0; m < 2; ++m)
#pragma unroll
            for (int n = 0; n < NTL; ++n) {
                const int col = col0 + wn * WTN + n * 32 + (lane & 31);
#pragma unroll
                for (int i = 0; i < 16; ++i) {
                    const int row = row0 + wm * 64 + m * 32 + (i & 3) + 8 * (i >> 2) + 4 * (lane >> 5);
                    epi(row, col, acc[m][n][i]);
                }
            }
    }
}

struct EpiBf16 { bf16_t* C; int ldc, N; __device__ __forceinline__ void operator()(int row, int col, float v) const { if (col < N) C[(size_t)row * ldc + col] = f2bf(v); } };
struct EpiRelu2 { bf16_t* C; int ldc; __device__ __forceinline__ void operator()(int row, int col, float v) const { v = fmaxf(v, 0.f); C[(size_t)row * ldc + col] = f2bf(v * v); } };
struct EpiResid { float* x; const float* gate;   __device__ __forceinline__ void operator()(int row, int col, float v) const {
    const float g = gate[mod_row(row) * 6144 + col]; float* p = x + (size_t)row * D + col; *p = *p + g * v; } };

__device__ __forceinline__ void transpose_item(const float* __restrict__ W, int N, int K, int k0, int n0, bf16_t* __restrict__ dst  , LAS float* scr, int lane) {
#pragma unroll 8
    for (int i = 0; i < 32; ++i) { const int kk = 2 * i + (lane >> 5); scr[kk * 33 + (lane & 31)] = W[(size_t)(k0 + kk) * N + n0 + (lane & 31)]; }
    LDS_WAIT();
    const int c = lane & 7;
#pragma unroll
    for (int j = 0; j < 4; ++j) {
        const int n = (lane >> 3) + 8 * j; const LAS float* s = scr + (8 * c) * 33 + n;
        u32x4 o; o.x = pk2(s[0 * 33], s[1 * 33]); o.y = pk2(s[2 * 33], s[3 * 33]); o.z = pk2(s[4 * 33], s[5 * 33]); o.w = pk2(s[6 * 33], s[7 * 33]);
        *(u32x4*)(dst + (size_t)n * K + k0 + 8 * c) = o;
    }
    LDS_WAIT();
}

__device__ __forceinline__ void convert_weights(const Params& p, int l, LAS unsigned char* lds) {
    const int lane = otid() & 63, wid = otid() >> 6;
    LAS float* scr = (LAS float*)(lds + wid * 16384);
    unsigned char* wb = p.ws + WS_W;
    constexpr int I_IN = 16 * 257, I_BR = 8 * 32, I_OUT = 16 * 32, I_FF1 = 16 * 128, I_FF2 = 64 * 32;
    constexpr int NIT = I_IN + 3 * I_BR + I_OUT + I_FF1 + I_FF2;
    for (int it = blockIdx.x * 8 + wid; it < NIT; it += gridDim.x * 8) {
        int r = it;
        if (r < I_IN) { const int kb = r / 257, nb = r % 257, n0 = nb * 32;
            bf16_t* dst = n0 < NPROJ ? (bf16_t*)(wb + W_IN) + (size_t)n0 * D : (bf16_t*)(wb + W_G) + (size_t)(n0 - NPROJ) * D;
            transpose_item(p.w_in + (size_t)l * D * DIN, DIN, D, kb * 64, n0, dst, scr, lane); continue; }
        r -= I_IN;
        if (r < 3 * I_BR) { const int b = r / I_BR, q = r % I_BR, kb = q / 32, nb = q % 32;
            const float* W = (b == 0 ? p.w_br_gla : b == 1 ? p.w_br_hg : p.w_br_gm) + (size_t)l * 512 * D;
            transpose_item(W, D, 512, kb * 64, nb * 32, (bf16_t*)(wb + W_BR) + (size_t)b * D * 512 + (size_t)nb * 32 * 512, scr, lane); continue; }
        r -= 3 * I_BR;
        if (r < I_OUT) { const int kb = r / 32, nb = r % 32;
            transpose_item(p.w_out + (size_t)l * D * D, D, D, kb * 64, nb * 32, (bf16_t*)(wb + W_OUT) + (size_t)nb * 32 * D, scr, lane); continue; }
        r -= I_OUT;
        if (r < I_FF1) { const int kb = r / 128, nb = r % 128;
            transpose_item(p.w_ff1 + (size_t)l * D * DFF, DFF, D, kb * 64, nb * 32, (bf16_t*)(wb + W_FF1) + (size_t)nb * 32 * D, scr, lane); continue; }
        r -= I_FF1;
        { const int kb = r / 32, nb = r % 32;
            transpose_item(p.w_ff2 + (size_t)l * DFF * D, D, DFF, kb * 64, nb * 32, (bf16_t*)(wb + W_FF2) + (size_t)nb * 32 * DFF, scr, lane); }
    }
}

__device__ __forceinline__ void phase0(const Params& p, LAS unsigned char* lds) {
    const int tid = otid();
    float* x = p.out;
    for (size_t i = (size_t)blockIdx.x * 512 + tid; i < (size_t)NTOK * (D / 4); i += (size_t)gridDim.x * 512) {
        const int tok = (int)(i >> 8), c4 = (int)(i & 255) * 4;
        f32x4 v;
        if (tok < NCTX) v = *(const f32x4*)(p.x_prompt + (size_t)tok * D + c4);
        else {
            const int lt = tok - NCTX; v = *(const f32x4*)(p.x_sample + (size_t)lt * D + c4);
            const int t = lt & 2047; const float rr = (float)(t >> 6), cc = (float)(t & 63);
            const int sec = c4 >> 8; const float pos = sec < 2 ? rr : cc;
#pragma unroll
            for (int j = 0; j < 4; ++j) {
                const int f = (c4 + j) & 255;
                const float omega = 1.0f / powf(10000.0f, (float)f * (1.0f / 256.0f));
                const float a = pos * omega;
                v[j] += (sec & 1) ? cosf(a) : sinf(a);
            }
        }
        *(f32x4*)(x + i * 4) = v;
    }
    if (blockIdx.x == 0) {
        float* lbs = (float*)(p.ws + WS_LBS);
        for (int i = tid; i < 1024; i += 512) {
            const int dir = i >> 9, ch = i & 511; float lg[4], mx = -1e30f;
            for (int l = 0; l < 4; ++l) { lg[l] = p.hg_lb_logits[(size_t)(dir * 4 + l) * 512 + ch]; mx = fmaxf(mx, lg[l]); }
            float s = 0.f; for (int l = 0; l < 4; ++l) { lg[l] = expf(lg[l] - mx); s += lg[l]; }
            float cum = 0.f, c0 = 0.f;
            for (int l = 0; l < 4; ++l) { cum += lg[l] / s; if (l == 0) c0 = cum; lbs[(size_t)(dir * 4 + l) * 512 + ch] = cum - c0; }
        }
        if (tid < 64) ((unsigned*)(p.ws + WS_CTR))[tid] = 0u;
    }
    LAS float* sc = (LAS float*)lds;
    LAS float* red = sc + 9 * 1024;
    for (int i = tid; i < 9 * 1024; i += 512) { const int r = i >> 10, k = i & 1023; const float v = r == 0 ? p.c_ctx[k] : p.c[(size_t)(r - 1) * D + k]; sc[i] = siluf_(v); }
    __syncthreads();
    float* mod = (float*)(p.ws + WS_MOD);
    for (int u = blockIdx.x; u < DEPTH * 48; u += gridDim.x) {
        const int l = u / 48, cb = u % 48, cl = tid & 127, kp = tid >> 7, n = cb * 128 + cl;
        const float* w = p.ada_w + (size_t)l * D * 6144 + n;
        float a[9];
#pragma unroll
        for (int r = 0; r < 9; ++r) a[r] = 0.f;
#pragma unroll 4
        for (int k = kp * 256; k < kp * 256 + 256; ++k) {
            const float wv = w[(size_t)k * 6144];
#pragma unroll
            for (int r = 0; r < 9; ++r) a[r] += sc[r * 1024 + k] * wv;
        }
#pragma unroll
        for (int r = 0; r < 9; ++r) red[(kp * 9 + r) * 128 + cl] = a[r];
        __syncthreads();
        for (int i = tid; i < 9 * 128; i += 512) {
            const int r = i >> 7, c2 = i & 127;
            const float s = red[(0 * 9 + r) * 128 + c2] + red[(1 * 9 + r) * 128 + c2] + red[(2 * 9 + r) * 128 + c2] + red[(3 * 9 + r) * 128 + c2];
            mod[((size_t)l * 9 + r) * 6144 + cb * 128 + c2] = s + p.ada_b[(size_t)l * 6144 + cb * 128 + c2];
        }
        __syncthreads();
    }
}

__device__ __forceinline__ void norm_phase(const Params& p, const float* g, const float* mod_l, int off_sh, int off_sc, bf16_t* hout, int mode) {
    const int lane = otid() & 63, wid = otid() >> 6;
    float* x = p.out;
    for (int row = blockIdx.x * 8 + wid; row < NTOK; row += gridDim.x * 8) {
        f32x4 v[4]; float s = 0.f;
        float* xr = x + (size_t)row * D;
#pragma unroll
        for (int j = 0; j < 4; ++j) { v[j] = *(const f32x4*)(xr + lane * 4 + 256 * j); s += v[j].x * v[j].x + v[j].y * v[j].y + v[j].z * v[j].z + v[j].w * v[j].w; }
        const float rstd = rsqrtf(wave_sum(s) * (1.0f / D) + EPS);
        if (mode == 0) {
            const float* mr = mod_l + (size_t)mod_row(row) * 6144;
#pragma unroll
            for (int j = 0; j < 4; ++j) {
                const int c = lane * 4 + 256 * j;
                const f32x4 gg = *(const f32x4*)(g + c), sh = *(const f32x4*)(mr + off_sh + c), scv = *(const f32x4*)(mr + off_sc + c);
                const f32x4 o = (v[j] * rstd) * gg * (scv + 1.0f) + sh;
                u32x2 w; w.x = pk2(o.x, o.y); w.y = pk2(o.z, o.w);
                *(u32x2*)(hout + (size_t)row * D + c) = w;
            }
        } else {
#pragma unroll
            for (int j = 0; j < 4; ++j) { const int c = lane * 4 + 256 * j; const f32x4 gg = *(const f32x4*)(g + c); *(f32x4*)(xr + c) = (v[j] * rstd) * gg; }
        }
    }
}

template <int MIX>
__device__ __forceinline__ void gate_eval(const bf16_t* row, int kcol, int zcol, const float (&lrw)[16], float lrb, float lb, float& gt, float& kt) {
    if (!MIX) {
        const bf16_t* zr = row + zcol;
        const u32x4 z0 = *(const u32x4*)zr, z1 = *(const u32x4*)(zr + 8);
        float z = lrb;
        z += bflo(z0.x) * lrw[0] + bfhi(z0.x) * lrw[1] + bflo(z0.y) * lrw[2] + bfhi(z0.y) * lrw[3] + bflo(z0.z) * lrw[4] + bfhi(z0.z) * lrw[5] + bflo(z0.w) * lrw[6] + bfhi(z0.w) * lrw[7];
        z += bflo(z1.x) * lrw[8] + bfhi(z1.x) * lrw[9] + bflo(z1.y) * lrw[10] + bfhi(z1.y) * lrw[11] + bflo(z1.z) * lrw[12] + bfhi(z1.z) * lrw[13] + bflo(z1.w) * lrw[14] + bfhi(z1.w) * lrw[15];
        gt = logsigmoidf_(z) * (1.0f / 16.0f);
        kt = bf2f(row[kcol]);
    } else {
        const float xf = bf2f(row[kcol]);
        const float sg = sigmoidf_(xf);
        gt = __logf(lb + (1.0f - lb) * sg);
        kt = (1.0f - lb) * (1.0f - sg);
    }
}

template <int MIX>
__device__ __forceinline__ void scan_job(const Params& p, int l, int s, int dir, int hd, LAS unsigned char* lds) {
    constexpr int DK = MIX ? 128 : 64, WM = DK / 32, WN = 8 / WM, WTN = 128 / WN, NTL = WTN / 32, LDT = 72, LDG = DK + 1;
    LAS bf16_t* At = (LAS bf16_t*)lds;
    LAS bf16_t* Bt = At + 128 * LDT;
    LAS float* dec = (LAS float*)(lds + 2 * 128 * LDT * 2);
    LAS float* G = dec + 128;
    LAS float* KK = G + 64 * 129;
    const int tid = otid(), lane = tid & 63, wid = tid >> 6, wm = wid / WN, wn = wid % WN;
    const bool ctx = s < 16;
    const int T = ctx ? 256 : 2048, tok0 = ctx ? s * 256 : NCTX + (s - 16) * 2048, nch = T / 64;
    const bf16_t* proj = (const bf16_t*)(p.ws + WS_PROJ);
    const float* lbs = (const float*)(p.ws + WS_LBS);
    bf16_t* sbuf = (bf16_t*)(p.ws + WS_ST + (MIX ? ST_GLA_BYTES : 0));
    f32x16 S[1][NTL];
    {
        const float* st0 = ctx ? nullptr : (MIX ? p.state_hgrn + ((((size_t)(s - 16) * DEPTH + l) * 2 + dir) * 4 + hd) * 128 * 128
                                                : p.state_gla + ((((size_t)(s - 16) * DEPTH + l) * 2 + dir) * 4 + hd) * 64 * 128);
#pragma unroll
        for (int n = 0; n < NTL; ++n)
#pragma unroll
            for (int i = 0; i < 16; ++i) {
                const int d = wm * 32 + (i & 3) + 8 * (i >> 2) + 4 * (lane >> 5), v = wn * WTN + n * 32 + (lane & 31);
                S[0][n][i] = ctx ? 0.f : st0[(size_t)d * 128 + v];
            }
    }
    const int sd = tid & (DK - 1), t0 = tid / DK; constexpr int TS = 512 / DK;
    float lrw[16]; float lrb = 0.f, lb = 0.f;
    if (!MIX) {
#pragma unroll
        for (int r = 0; r < 16; ++r) lrw[r] = p.gla_lr_w[(((size_t)l * 2 + dir) * 16 + r) * 256 + hd * 64 + sd];
        lrb = p.gla_lr_b[((size_t)l * 2 + dir) * 256 + hd * 64 + sd];
    } else {
#pragma unroll
        for (int r = 0; r < 16; ++r) lrw[r] = 0.f;
        lb = lbs[(size_t)(dir * 4 + l) * 512 + hd * 128 + sd];
    }
    const int kcol = MIX ? (dir ? PJ_HFB : PJ_HFF) + hd * 128 + sd : PJ_GK + hd * 64 + sd;
    const int zcol = dir ? PJ_GZB : PJ_GZF;
    const int vv = tid & 127, vq = tid >> 7;
    const int vcol = (MIX ? PJ_HI : PJ_GV) + hd * 128 + vv;
    const int kd = tid >> 2, kq = tid & 3;
    const bool k2 = tid < 4 * DK;

    for (int n = 0; n < nch; ++n) {
        const int cn = dir ? nch - 1 - n : n;
        const int gc = (tok0 >> 6) + cn;
        const bf16_t* pr = proj + (size_t)(tok0 + cn * 64) * NPROJ;
        {
            bf16_t* sb = sbuf + (((size_t)gc * 2 + dir) * 4 + hd) * 128 * DK;
#pragma unroll
            for (int nn = 0; nn < NTL; ++nn)
#pragma unroll
                for (int q = 0; q < 4; ++q) {
                    const int d0 = wm * 32 + 8 * q + 4 * (lane >> 5), v = wn * WTN + nn * 32 + (lane & 31);
                    u32x2 w; w.x = pk2(S[0][nn][4 * q + 0], S[0][nn][4 * q + 1]); w.y = pk2(S[0][nn][4 * q + 2], S[0][nn][4 * q + 3]);
                    *(u32x2*)(sb + (size_t)v * DK + d0) = w;
                }
        }
#pragma unroll 4
        for (int i = 0; i < 64 / TS; ++i) {
            const int t = t0 + TS * i; float gt, kt;
            gate_eval<MIX>(pr + (size_t)t * NPROJ, kcol, zcol, lrw, lrb, lb, gt, kt);
            G[t * LDG + sd] = gt; KK[t * LDG + sd] = kt;
        }
        {
            unsigned pkv[8];
#pragma unroll
            for (int t = 0; t < 16; t += 2) {
                const unsigned a = pr[(size_t)(vq * 16 + t) * NPROJ + vcol], b = pr[(size_t)(vq * 16 + t + 1) * NPROJ + vcol];
                pkv[t >> 1] = a | (b << 16);
            }
#pragma unroll
            for (int q = 0; q < 2; ++q) { u32x4 w; w.x = pkv[4 * q]; w.y = pkv[4 * q + 1]; w.z = pkv[4 * q + 2]; w.w = pkv[4 * q + 3]; *(LAS u32x4*)(Bt + vv * LDT + vq * 16 + q * 8) = w; }
        }
        __syncthreads();
        if (k2) {
            float g[16]; float qs = 0.f;
#pragma unroll
            for (int t = 0; t < 16; ++t) { g[t] = G[(kq * 16 + t) * LDG + kd]; qs += g[t]; }
            const int lb4 = lane & ~3;
            const float s0 = __shfl(qs, lb4), s1 = __shfl(qs, lb4 + 1), s2 = __shfl(qs, lb4 + 2), s3 = __shfl(qs, lb4 + 3);
            const float total = (s0 + s1) + (s2 + s3);
            float pref = (kq > 0 ? s0 : 0.f) + (kq > 1 ? s1 : 0.f) + (kq > 2 ? s2 : 0.f);
            unsigned pkv[8];
#pragma unroll
            for (int t = 0; t < 16; ++t) {
                const float pe = pref; pref += g[t];
                const float w = dir ? pe : total - pref;
                const float kv = KK[(kq * 16 + t) * LDG + kd] * __expf(w);
                if (t & 1) pkv[t >> 1] = pk2(__uint_as_float(pkv[t >> 1]), kv); else pkv[t >> 1] = __float_as_uint(kv);
            }
#pragma unroll
            for (int q = 0; q < 2; ++q) { u32x4 w; w.x = pkv[4 * q]; w.y = pkv[4 * q + 1]; w.z = pkv[4 * q + 2]; w.w = pkv[4 * q + 3]; *(LAS u32x4*)(At + kd * LDT + kq * 16 + q * 8) = w; }
            if (kq == 0) dec[kd] = __expf(total);
        }
        __syncthreads();
#pragma unroll
        for (int nn = 0; nn < NTL; ++nn)
#pragma unroll
            for (int i = 0; i < 16; ++i) S[0][nn][i] *= dec[wm * 32 + (i & 3) + 8 * (i >> 2) + 4 * (lane >> 5)];
        mma_lds<1, NTL, 4>(S, At + wm * 32 * LDT, LDT, Bt + wn * WTN * LDT, LDT, lane);
        __syncthreads();
    }
    if (ctx) {
        float* o = MIX ? p.out + (size_t)NTOK * D + (size_t)16 * DEPTH * 2 * 4 * 64 * 128 + ((((size_t)s * DEPTH + l) * 2 + dir) * 4 + hd) * 128 * 128
                       : p.out + (size_t)NTOK * D + ((((size_t)s * DEPTH + l) * 2 + dir) * 4 + hd) * 64 * 128;
#pragma unroll
        for (int nn = 0; nn < NTL; ++nn)
#pragma unroll
            for (int i = 0; i < 16; ++i) {
                const int d = wm * 32 + (i & 3) + 8 * (i >> 2) + 4 * (lane >> 5), v = wn * WTN + nn * 32 + (lane & 31);
                o[(size_t)d * 128 + v] = S[0][nn][i];
            }
    }
}


__device__ __forceinline__ void gmlp_item(const Params& p, int l, int c2, int g, LAS unsigned char* lds) {
    constexpr int LDT = 136;
    LAS bf16_t* Aw = (LAS bf16_t*)lds;
    LAS bf16_t* Bt = Aw + 128 * LDT;
    const int tid = otid(), lane = tid & 63, wid = tid >> 6, wm = wid >> 2, wn = wid & 3;
    const bf16_t* proj = (const bf16_t*)(p.ws + WS_PROJ);
    const int tokb = c2 * 128;
    {
        const float* wsrc = p.gm_ws + ((size_t)l * 4 + g) * 128 * 128;
#pragma unroll
        for (int i = 0; i < 8; ++i) {
            const int e = (i * 512 + tid) * 4, pp = e >> 7, q = e & 127;
            const f32x4 v = *(const f32x4*)(wsrc + e);
            u32x2 w; w.x = pk2(v.x, v.y); w.y = pk2(v.z, v.w);
            *(LAS u32x2*)(Aw + pp * LDT + q) = w;
        }
    }
    {
        const int q = tid >> 2, part = tid & 3;
        const bf16_t* mv = proj + (size_t)(tokb + q) * NPROJ + PJ_MV;
        float s = 0.f, s2 = 0.f;
#pragma unroll
        for (int i = 0; i < 16; ++i) {
            const u32x4 u = *(const u32x4*)(mv + (i * 4 + part) * 8);
            const unsigned uu[4] = {u.x, u.y, u.z, u.w};
#pragma unroll
            for (int j = 0; j < 4; ++j) { const float a = geluf_(bflo(uu[j])), b = geluf_(bfhi(uu[j])); s += a + b; s2 += a * a + b * b; }
        }
        s += __shfl_xor(s, 1); s += __shfl_xor(s, 2); s2 += __shfl_xor(s2, 1); s2 += __shfl_xor(s2, 2);
        const float mean = s * (1.0f / 512.0f), var = fmaxf(s2 * (1.0f / 512.0f) - mean * mean, 0.f), rstd = rsqrtf(var + EPS);
        const float* gg = p.gm_norm_g + (size_t)l * 512 + g * 128 + part * 32;
        const bf16_t* mvg = mv + g * 128 + part * 32;
#pragma unroll
        for (int i = 0; i < 4; ++i) {
            const u32x4 u = *(const u32x4*)(mvg + i * 8);
            const unsigned uu[4] = {u.x, u.y, u.z, u.w};
#pragma unroll
            for (int j = 0; j < 4; ++j) {
                const int c = part * 32 + i * 8 + j * 2;
                const float a = (geluf_(bflo(uu[j])) - mean) * rstd * gg[i * 8 + j * 2], b = (geluf_(bfhi(uu[j])) - mean) * rstd * gg[i * 8 + j * 2 + 1];
                Bt[c * LDT + q] = f2bf(a); Bt[(c + 1) * LDT + q] = f2bf(b);
            }
        }
    }
    __syncthreads();
    f32x16 acc[2][1]; acc_zero<1>(acc);
    mma_lds<2, 1, 8>(acc, Aw + wm * 64 * LDT, LDT, Bt + wn * 32 * LDT, LDT, lane);
    bf16_t* ocat = (bf16_t*)(p.ws + WS_OCAT);
    const float* bs = p.gm_bs + ((size_t)l * 4 + g) * 128;
#pragma unroll
    for (int m = 0; m < 2; ++m)
#pragma unroll
        for (int i = 0; i < 16; ++i) {
            const int pp = wm * 64 + m * 32 + (i & 3) + 8 * (i >> 2) + 4 * (lane >> 5), c = wn * 32 + (lane & 31);
            const float mu = bf2f(proj[(size_t)(tokb + pp) * NPROJ + PJ_MU + g * 128 + c]);
            ocat[(size_t)(tokb + pp) * 1536 + 1024 + g * 128 + c] = f2bf(geluf_(mu) * (acc[m][0][i] + bs[pp]));
        }
    __syncthreads();
}

__device__ __forceinline__ void phase_scan(const Params& p, int l, LAS unsigned char* lds) {
    LAS int* slot = (LAS int*)(lds + LDS_BYTES - 16);
    unsigned* ctr = (unsigned*)(p.ws + WS_CTR) + l;
    constexpr int NLAT = 8 * 2 * 4 * 2, NCX = 16 * 2 * 4 * 2, NGM = 160 * 4;
    for (;;) {
        if (otid() == 0) *slot = (int)atomicAdd(ctr, 1u);
        __syncthreads();
        const int j = *slot;
        __syncthreads();
        if (j >= NLAT + NCX + NGM) break;
        if (j < NLAT + NCX) {
            int r = j, s;
            if (r < NLAT) { s = 16 + (r >> 4); r &= 15; } else { r -= NLAT; s = r >> 4; r &= 15; }
            const int mix = r & 1, dir = (r >> 1) & 1, hd = r >> 2;
            if (mix) scan_job<1>(p, l, s, dir, hd, lds); else scan_job<0>(p, l, s, dir, hd, lds);
        } else { const int r = j - NLAT - NCX; gmlp_item(p, l, r >> 2, r & 3, lds); }
    }
}

template <int MIX>
__device__ __forceinline__ void out_item(const Params& p, int l, int gc, int hd, LAS unsigned char* lds) {
    constexpr int DK = MIX ? 128 : 64, LQ = DK + 8, LDV = 72, LDG = DK + 1;
    LAS bf16_t* QA = (LAS bf16_t*)lds;
    LAS bf16_t* KA = QA + 128 * LQ;
    LAS bf16_t* QS = KA + 128 * LQ;
    LAS bf16_t* VT = QS + 64 * LQ;
    LAS bf16_t* P = VT + 128 * LDV;
    LAS float* C = (LAS float*)(P + 64 * LDV);
    LAS float* BS = C + 64 * LDG;
    LAS bf16_t* ST = KA;
    LAS float* Of = (LAS float*)lds;
    const int tid = otid(), lane = tid & 63, wid = __builtin_amdgcn_readfirstlane(tid >> 6);
    const int tokb = gc * 64;
    const bf16_t* proj = (const bf16_t*)(p.ws + WS_PROJ);
    const bf16_t* pr = proj + (size_t)tokb * NPROJ;
    const float* lbs = (const float*)(p.ws + WS_LBS);
    const bf16_t* sbuf = (const bf16_t*)(p.ws + WS_ST + (MIX ? ST_GLA_BYTES : 0));
    {
        const int vv = tid & 127, qt = tid >> 7;
        const int vcol = (MIX ? PJ_HI : PJ_GV) + hd * 128 + vv;
        unsigned pkv[8];
#pragma unroll
        for (int t = 0; t < 16; t += 2) {
            const unsigned a = pr[(size_t)(qt * 16 + t) * NPROJ + vcol], b = pr[(size_t)(qt * 16 + t + 1) * NPROJ + vcol];
            pkv[t >> 1] = a | (b << 16);
        }
#pragma unroll
        for (int q = 0; q < 2; ++q) { u32x4 w; w.x = pkv[4 * q]; w.y = pkv[4 * q + 1]; w.z = pkv[4 * q + 2]; w.w = pkv[4 * q + 3]; *(LAS u32x4*)(VT + vv * LDV + qt * 16 + q * 8) = w; }
    }
    const int wm = wid >> 2, wn = wid & 3;
    f32x16 o[1][1];
#pragma unroll
    for (int i = 0; i < 16; ++i) o[0][0][i] = 0.f;

#pragma unroll 1
    for (int dir = 0; dir < 2; ++dir) {
        {
            const int sd = tid & (DK - 1), t0 = tid / DK; constexpr int TS = 512 / DK;
            float lrw[16]; float lrb = 0.f, lb = 0.f;
            if (!MIX) {
#pragma unroll
                for (int r = 0; r < 16; ++r) lrw[r] = p.gla_lr_w[(((size_t)l * 2 + dir) * 16 + r) * 256 + hd * 64 + sd];
                lrb = p.gla_lr_b[((size_t)l * 2 + dir) * 256 + hd * 64 + sd];
            } else {
#pragma unroll
                for (int r = 0; r < 16; ++r) lrw[r] = 0.f;
                lb = lbs[(size_t)(dir * 4 + l) * 512 + hd * 128 + sd];
            }
            const int kcol = MIX ? (dir ? PJ_HFB : PJ_HFF) + hd * 128 + sd : PJ_GK + hd * 64 + sd;
            const int zcol = dir ? PJ_GZB : PJ_GZF;
#pragma unroll 4
            for (int i = 0; i < 64 / TS; ++i) {
                const int t = t0 + TS * i; float gt, kt;
                gate_eval<MIX>(pr + (size_t)t * NPROJ, kcol, zcol, lrw, lrb, lb, gt, kt);
                C[(dir ? 63 - t : t) * LDG + sd] = gt;
            }
        }
        __syncthreads();
        const int kd = tid & (DK - 1), ba = tid / DK;
        float lp7 = 0.f, Ta = 0.f;
        if (ba < 4) {
#pragma unroll
            for (int u = 0; u < 16; ++u) { Ta += C[(ba * 16 + u) * LDG + kd]; if (u == 7) lp7 = Ta; }
            BS[ba * DK + kd] = Ta;
        }
        __syncthreads();
        if (ba < 4) {
            const float T0 = BS[kd], T1 = BS[DK + kd], T2 = BS[2 * DK + kd];
            const float base = ba == 0 ? 0.f : ba == 1 ? T0 : ba == 2 ? T0 + T1 : T0 + T1 + T2;
            const float c31 = T0 + T1;
            const float lb = MIX ? lbs[(size_t)(dir * 4 + l) * 512 + hd * 128 + kd] : 0.f;
            const int kcol = MIX ? (dir ? PJ_HFB : PJ_HFF) + hd * 128 + kd : PJ_GK + hd * 64 + kd;
            const int qcol = (MIX ? PJ_HQ + hd * 128 : PJ_GQ + hd * 64) + kd;
            const float qscale = MIX ? 0.08838834764831845f : 0.125f;
            LAS bf16_t* qz = QA + (64 + ba * 16) * LQ + kd;
            LAS bf16_t* kz = KA + (64 + ba * 16) * LQ + kd;
            LAS bf16_t* xrow = (ba < 2 ? KA + (ba * 16) * LQ : QA + (ba * 16 - 32) * LQ) + kd;
            LAS bf16_t* yrow = ((ba & 1) ? QA + (32 + (ba >> 1) * 16) * LQ : KA + (32 + (ba >> 1) * 16) * LQ) + kd;
            float lp = 0.f;
#pragma unroll 4
            for (int u = 0; u < 16; ++u) {
                const int pp = ba * 16 + u, t = dir ? 63 - pp : pp;
                lp += C[pp * LDG + kd];
                const float c = base + lp;
                const float qv = bf2f(pr[(size_t)t * NPROJ + qcol]) * qscale;
                float kt = bf2f(pr[(size_t)t * NPROJ + kcol]);
                if (MIX) kt = (1.0f - lb) * (1.0f - sigmoidf_(kt));
                QS[t * LQ + kd] = f2bf(qv * __expf(c));
                qz[u * LQ] = f2bf(qv * __expf(lp - lp7));
                kz[u * LQ] = f2bf(kt * __expf(lp7 - lp));
                xrow[u * LQ] = f2bf(ba < 2 ? kt * __expf(c31 - c) : qv * __expf(c - c31));
                yrow[u * LQ] = f2bf((ba & 1) ? qv * __expf(lp) : kt * __expf(Ta - lp));
            }
        }
        __syncthreads();
        if (wid < 4) {
            f32x16 sc[1][1];
#pragma unroll
            for (int i = 0; i < 16; ++i) sc[0][0][i] = 0.f;
            mma_lds<1, 1, DK / 16>(sc, KA + wid * 32 * LQ, LQ, QA + wid * 32 * LQ, LQ, lane);
            const int cc = lane & 31;
#pragma unroll
            for (int q = 0; q < 4; ++q) {
                const int r0 = 8 * q + 4 * (lane >> 5);
                int pi, pj0; bool wr = true, zero = false, tri = false;
                if (wid == 0) { pi = 32 + cc; pj0 = r0; }
                else if (wid == 1) { pi = cc < 16 ? 16 + cc : 32 + cc; pj0 = r0 < 16 ? r0 : r0 + 16; wr = (r0 < 16) == (cc < 16); }
                else { const int off = (wid - 2) * 32; pi = off + cc; pj0 = off + r0; const bool same = (r0 >> 4) == (cc >> 4); tri = same; zero = !same && r0 >= 16; wr = same || zero; }
                float v[4];
#pragma unroll
                for (int e = 0; e < 4; ++e) { float x = sc[0][0][4 * q + e]; if (tri && (r0 + e > cc)) x = 0.f; if (zero) x = 0.f; v[e] = x; }
                if (wr) {
                    u32x2 w;
                    if (dir == 0) { w.x = pk2(v[0], v[1]); w.y = pk2(v[2], v[3]); *(LAS u32x2*)(P + pi * LDV + pj0) = w; }
                    else { w.x = pk2(v[3], v[2]); w.y = pk2(v[1], v[0]); *(LAS u32x2*)(P + (63 - pi) * LDV + (60 - pj0)) = w; }
                }
            }
        } else if (wid == 4) {
#pragma unroll
            for (int k = 0; k < 2; ++k) {
                const int idx = lane * 2 + k, row = idx >> 2, piece = idx & 3;
                const int ti = dir ? 32 + row : row, tj = (dir ? 0 : 32) + piece * 8;
                u32x4 z; z.x = 0; z.y = 0; z.z = 0; z.w = 0;
                *(LAS u32x4*)(P + ti * LDV + tj) = z;
            }
        }
        __syncthreads();
        {
            const bf16_t* sb = sbuf + (((size_t)gc * 2 + dir) * 4 + hd) * 128 * DK;
            constexpr int PIECES = 128 * DK / 8;
            for (int e = tid; e < PIECES; e += 512) {
                const int v = e / (DK / 8), d0 = (e % (DK / 8)) * 8;
                *(LAS u32x4*)(ST + v * LQ + d0) = *(const u32x4*)(sb + (size_t)v * DK + d0);
            }
        }
        mma_lds<1, 1, 4>(o, P + wm * 32 * LDV, LDV, VT + wn * 32 * LDV, LDV, lane);
        __syncthreads();
        mma_lds<1, 1, DK / 16>(o, QS + wm * 32 * LQ, LQ, ST + wn * 32 * LQ, LQ, lane);
        __syncthreads();
    }
#pragma unroll
    for (int i = 0; i < 16; ++i) Of[(wm * 32 + (i & 3) + 8 * (i >> 2) + 4 * (lane >> 5)) * 132 + wn * 32 + (lane & 31)] = o[0][0][i];
    __syncthreads();
    {
        const int i_ = tid >> 3, seg = tid & 7;
        const LAS float* orow = Of + i_ * 132 + seg * 16;
        float v[16]; float ss = 0.f;
#pragma unroll
        for (int j = 0; j < 16; ++j) { v[j] = orow[j]; ss += v[j] * v[j]; }
        ss += __shfl_xor(ss, 1); ss += __shfl_xor(ss, 2); ss += __shfl_xor(ss, 4);
        const float r = rsqrtf(ss * (1.0f / 128.0f) + EPS);
        const float* gn = (MIX ? p.hg_norm_g : p.gla_norm_g) + (size_t)l * 512 + hd * 128 + seg * 16;
        const bf16_t* gate = pr + (size_t)i_ * NPROJ + (MIX ? PJ_HO : PJ_GO) + hd * 128 + seg * 16;
        const u32x4 g0 = *(const u32x4*)gate, g1 = *(const u32x4*)(gate + 8);
        const unsigned gu[8] = {g0.x, g0.y, g0.z, g0.w, g1.x, g1.y, g1.z, g1.w};
        unsigned ow[8];
#pragma unroll
        for (int j = 0; j < 8; ++j) {
            const float a = v[2 * j] * r * gn[2 * j] * siluf_(bflo(gu[j])), b = v[2 * j + 1] * r * gn[2 * j + 1] * siluf_(bfhi(gu[j]));
            ow[j] = pk2(a, b);
        }
        bf16_t* dst = (bf16_t*)(p.ws + WS_OCAT) + (size_t)(tokb + i_) * 1536 + (MIX ? 512 : 0) + hd * 128 + seg * 16;
        u32x4 w0, w1; w0.x = ow[0]; w0.y = ow[1]; w0.z = ow[2]; w0.w = ow[3]; w1.x = ow[4]; w1.y = ow[5]; w1.z = ow[6]; w1.w = ow[7];
        *(u32x4*)dst = w0; *(u32x4*)(dst + 8) = w1;
    }
    __syncthreads();
}


__device__ __forceinline__ void phase_out(const Params& p, int l, LAS unsigned char* lds) {
    constexpr int NIT = NCHUNK * 4 * 2;
    for (int it = blockIdx.x; it < NIT; it += gridDim.x) {
        const int mix = it & 1, hd = (it >> 1) & 3, gc = it >> 3;
        if (mix) out_item<1>(p, l, gc, hd, lds); else out_item<0>(p, l, gc, hd, lds);
    }
}

__device__ __forceinline__ void phase_merge(const Params& p, LAS unsigned char* lds) {
    const bf16_t* h = (const bf16_t*)(p.ws + WS_H);
    const bf16_t* ocat = (const bf16_t*)(p.ws + WS_OCAT);
    const bf16_t* WgT = (const bf16_t*)(p.ws + WS_W + W_G);
    const bf16_t* WbrT = (const bf16_t*)(p.ws + WS_W + W_BR);
    bf16_t* merged = (bf16_t*)(p.ws + WS_ST);
    const int lane = otid() & 63, wid = otid() >> 6, wm = wid >> 2, wn = wid & 3;
    constexpr int nM = NTOK / 128, nN = 8;
    for (int t = blockIdx.x; t < nM * nN; t += gridDim.x) {
        int tm, tn; tile_coords(t, nN, tm, tn);
        const int row0 = tm * 128, col0 = tn * 128;
        f32x16 tot[2][1]; acc_zero<1>(tot);
#pragma unroll 1
        for (int b = 0; b < 3; ++b) {
            f32x16 ga[2][1]; acc_zero<1>(ga);
            gemm_kloop<128>(lds, h + (size_t)row0 * D, D, WgT + (size_t)(b * 1024 + col0) * D, D, 128, D, ga);
#pragma unroll
            for (int m = 0; m < 2; ++m)
#pragma unroll
                for (int i = 0; i < 16; ++i) ga[m][0][i] = sigmoidf_(ga[m][0][i]);
            f32x16 ba[2][1]; acc_zero<1>(ba);
            gemm_kloop<128>(lds, ocat + (size_t)row0 * 1536 + b * 512, 1536, WbrT + ((size_t)b * D + col0) * 512, 512, 128, 512, ba);
#pragma unroll
            for (int m = 0; m < 2; ++m)
#pragma unroll
                for (int i = 0; i < 16; ++i) tot[m][0][i] += ga[m][0][i] * ba[m][0][i];
        }
#pragma unroll
        for (int m = 0; m < 2; ++m)
#pragma unroll
            for (int i = 0; i < 16; ++i) {
                const int row = row0 + wm * 64 + m * 32 + (i & 3) + 8 * (i >> 2) + 4 * (lane >> 5), col = col0 + wn * 32 + (lane & 31);
                merged[(size_t)row * D + col] = f2bf(tot[m][0][i]);
            }
    }
}

__device__ __forceinline__ void run_phase(const Params& p, int ph, LAS unsigned char* lds) {
    if (ph == 0) { phase0(p, lds); return; }
    if (ph == NPHASE - 1) { norm_phase(p, p.final_norm_g, nullptr, 0, 0, nullptr, 1); return; }
    const int l = (ph - 1) / 9, sp = (ph - 1) % 9;
    const float* mod_l = (const float*)(p.ws + WS_MOD) + (size_t)l * 9 * 6144;
    bf16_t* hbuf = (bf16_t*)(p.ws + WS_H);
    bf16_t* proj = (bf16_t*)(p.ws + WS_PROJ);
    switch (sp) {
        case 0: convert_weights(p, l, lds); norm_phase(p, p.norm_mix_g + (size_t)l * D, mod_l, 0, 1024, hbuf, 0); break;
        case 1: { EpiBf16 e{proj, NPROJ, NPROJ}; gemm_phase<256>(lds, hbuf, D, (const bf16_t*)(p.ws + WS_W + W_IN), D, NTOK, NPROJ, D, e); } break;
        case 2: phase_scan(p, l, lds); break;
        case 3: phase_out(p, l, lds); break;
        case 4: phase_merge(p, lds); break;
        case 5: { EpiResid e{p.out, mod_l + 2048}; gemm_phase<128>(lds, (const bf16_t*)(p.ws + WS_ST), D, (const bf16_t*)(p.ws + WS_W + W_OUT), D, NTOK, D, D, e); } break;
        case 6: norm_phase(p, p.norm_ffn_g + (size_t)l * D, mod_l, 3072, 4096, hbuf, 0); break;
        case 7: { EpiRelu2 e{proj, DFF}; gemm_phase<256>(lds, hbuf, D, (const bf16_t*)(p.ws + WS_W + W_FF1), D, NTOK, DFF, D, e); } break;
        case 8: { EpiResid e{p.out, mod_l + 5120}; gemm_phase<128>(lds, proj, DFF, (const bf16_t*)(p.ws + WS_W + W_FF2), DFF, NTOK, D, DFF, e); } break;
    }
}

__global__ void __launch_bounds__(512) fwd_megakernel(Params p) {
    extern __shared__ __attribute__((aligned(16))) unsigned char smem[];
    LAS unsigned char* lds = (LAS unsigned char*)smem;
    cg::grid_group grid = cg::this_grid();
    for (int ph = p.ph_lo; ph < p.ph_hi; ++ph) {
        run_phase(p, ph, lds);
        if (ph + 1 < p.ph_hi) grid.sync();
    }
}

extern "C" void kernel_launch(void* const* d_in, const int* in_sizes, int n_in, void* d_out, int out_size, void* d_ws, size_t ws_size, hipStream_t stream) {
    static int grid_blocks = 0;
    if (!grid_blocks) {
        int dev = 0, cus = 0, per_cu = 0;
        hipGetDevice(&dev);
        hipDeviceGetAttribute(&cus, hipDeviceAttributeMultiprocessorCount, dev);
        if (hipFuncSetAttribute((const void*)fwd_megakernel, hipFuncAttributeMaxDynamicSharedMemorySize, LDS_BYTES) != hipSuccess) fprintf(stderr, "hipFuncSetAttribute failed\n");
        hipOccupancyMaxActiveBlocksPerMultiprocessor(&per_cu, (const void*)fwd_megakernel, 512, LDS_BYTES);
        if (per_cu < 1) { fprintf(stderr, "occupancy query says %d blocks/CU\n", per_cu); per_cu = 1; }
        grid_blocks = cus * 1;
        (void)hipGetLastError();
        if (n_in != 26 || ws_size < WS_END) fprintf(stderr, "kernel_launch: unexpected n_in %d or ws_size %zu (need %zu)\n", n_in, ws_size, (size_t)WS_END);
    }
    Params p{};
    const float** pp = (const float**)&p;
    for (int i = 0; i < 26; ++i) pp[i] = (const float*)d_in[i];
    p.out = (float*)d_out; p.ws = (unsigned char*)d_ws; p.ph_lo = 0; p.ph_hi = NPHASE;
    void* args[] = {&p};
    hipError_t e = hipLaunchCooperativeKernel((const void*)fwd_megakernel, dim3(grid_blocks), dim3(512), args, LDS_BYTES, stream);
    if (e != hipSuccess) fprintf(stderr, "cooperative launch failed: %s (grid %d)\n", hipGetErrorString(e), grid_blocks);
}
```

```cpp
#include <hip/hip_runtime.h>
#include <hip/hip_cooperative_groups.h>
#include <cstdio>
namespace cg = cooperative_groups;

#define LAS __attribute__((address_space(3)))
typedef unsigned short bf16_t;
typedef short bf16x8 __attribute__((ext_vector_type(8)));
typedef float f32x16 __attribute__((ext_vector_type(16)));
typedef float f32x4 __attribute__((ext_vector_type(4)));
typedef unsigned u32x4 __attribute__((ext_vector_type(4)));
typedef unsigned u32x2 __attribute__((ext_vector_type(2)));

constexpr int D = 1024, DEPTH = 4, NTOK = 20480, NCTX = 4096, DFF = 4096;
constexpr int DIN = 8224, NPROJ = 5152, NGATE = 3072;
constexpr int PJ_GQ = 0, PJ_GK = 256, PJ_GV = 512, PJ_GO = 1024, PJ_GZF = 1536, PJ_GZB = 1552, PJ_HQ = 1568, PJ_HFF = 2080,
              PJ_HFB = 2592, PJ_HI = 3104, PJ_HO = 3616, PJ_MU = 4128, PJ_MV = 4640;
constexpr int NCHUNK = NTOK / 64;
constexpr float EPS = 1e-6f;
constexpr int LDS_BYTES = 160 * 1024;
constexpr int NPHASE = 2 + DEPTH * 10;

constexpr size_t WS_PROJ = 0;
constexpr size_t WS_ST   = WS_PROJ + (size_t)NTOK * NPROJ * 2;
constexpr size_t ST_GLA_BYTES = (size_t)NCHUNK * 2 * 4 * 128 * 64 * 2, ST_HG_BYTES = (size_t)NCHUNK * 2 * 4 * 128 * 128 * 2;
constexpr size_t WS_OCAT = WS_ST + ST_GLA_BYTES + ST_HG_BYTES;
constexpr size_t WS_H    = WS_OCAT + (size_t)NTOK * 1536 * 2;
constexpr size_t WS_W    = WS_H + (size_t)NTOK * D * 2;
constexpr size_t W_IN = 0, W_G = W_IN + (size_t)NPROJ * D * 2, W_BR = W_G + (size_t)NGATE * D * 2, W_OUT = W_BR + (size_t)3 * D * 512 * 2,
                 W_FF1 = W_OUT + (size_t)D * D * 2, W_FF2 = W_FF1 + (size_t)DFF * D * 2, W_END = W_FF2 + (size_t)D * DFF * 2;
constexpr size_t WS_MOD  = WS_W + 2 * W_END;
constexpr size_t WS_LBS  = WS_MOD + (size_t)DEPTH * 9 * 6144 * 4;
constexpr size_t WS_CTR  = WS_LBS + 2 * 4 * 512 * 4;
constexpr size_t WS_END  = WS_CTR + 4096;

struct Params {
    const float *x_prompt, *x_sample, *c, *state_gla, *state_hgrn, *c_ctx, *ada_w, *ada_b, *norm_mix_g, *norm_ffn_g, *w_in, *gla_lr_w,
        *gla_lr_b, *gla_norm_g, *hg_lb_logits, *hg_norm_g, *gm_norm_g, *gm_ws, *gm_bs, *w_br_gla, *w_br_hg, *w_br_gm, *w_out, *w_ff1, *w_ff2,
        *final_norm_g;
    float* out; unsigned char* ws; int ph_lo, ph_hi;
};

typedef __bf16 bf16x2_t __attribute__((ext_vector_type(2)));
__device__ __forceinline__ unsigned pk2(float lo, float hi) { bf16x2_t v; v.x = (__bf16)lo; v.y = (__bf16)hi; return __builtin_bit_cast(unsigned, v); }
__device__ __forceinline__ bf16_t f2bf(float f) { return (bf16_t)(pk2(f, 0.f) & 0xffffu); }
__device__ __forceinline__ float bf2f(bf16_t h) { return __uint_as_float(((unsigned)h) << 16); }
__device__ __forceinline__ float bflo(unsigned u) { return __uint_as_float(u << 16); }
__device__ __forceinline__ float bfhi(unsigned u) { return __uint_as_float(u & 0xffff0000u); }
__device__ __forceinline__ float fexp_(float x) { return __builtin_amdgcn_exp2f(x * 1.4426950408889634f); }
__device__ __forceinline__ float flog_(float x) { return __builtin_amdgcn_logf(x) * 0.6931471805599453f; }
__device__ __forceinline__ float sigmoidf_(float x) { return __builtin_amdgcn_rcpf(1.0f + fexp_(-x)); }
__device__ __forceinline__ float siluf_(float x) { return x * sigmoidf_(x); }
__device__ __forceinline__ float geluf_(float x) { const float y = 0.7978845608028654f * (x + 0.044715f * x * x * x); const float t = 1.0f - 2.0f * __builtin_amdgcn_rcpf(1.0f + fexp_(2.0f * y)); return 0.5f * x * (1.0f + t); }
__device__ __forceinline__ float logsigmoidf_(float x) { return fminf(x, 0.f) - flog_(1.0f + fexp_(-fabsf(x))); }
__device__ __forceinline__ float wave_sum(float v) {
#pragma unroll
    for (int o = 1; o < 64; o <<= 1) v += __shfl_xor(v, o);
    return v;
}
__device__ __forceinline__ int mod_row(int tok) { return tok < NCTX ? 0 : 1 + ((tok - NCTX) >> 11); }
__device__ __forceinline__ int otid() { int t = (int)__builtin_amdgcn_workitem_id_x(); asm volatile("" : "+v"(t)); return t; }
#define LDS_WAIT() asm volatile("s_waitcnt lgkmcnt(0)" ::: "memory")

template <int MT, int NTL, int KS>
__device__ __forceinline__ void mma_lds(f32x16 (&acc)[MT][NTL], const LAS bf16_t* As, int lda, const LAS bf16_t* Bs, int ldb, int lane) {
    const int r = lane & 31, h = lane >> 5;
    const LAS bf16_t* ap = As + r * lda + h * 8;
    const LAS bf16_t* bp = Bs + r * ldb + h * 8;
#pragma unroll
    for (int ks = 0; ks < KS; ++ks) {
        bf16x8 a[MT], b[NTL];
#pragma unroll
        for (int m = 0; m < MT; ++m) a[m] = *(const LAS bf16x8*)(ap + m * 32 * lda + ks * 16);
#pragma unroll
        for (int n = 0; n < NTL; ++n) b[n] = *(const LAS bf16x8*)(bp + n * 32 * ldb + ks * 16);
#pragma unroll
        for (int m = 0; m < MT; ++m)
#pragma unroll
            for (int n = 0; n < NTL; ++n) acc[m][n] = __builtin_amdgcn_mfma_f32_32x32x16_bf16(a[m], b[n], acc[m][n], 0, 0, 0);
    }
}

template <int BM>
__device__ __forceinline__ void gemm_kloop(LAS unsigned char* lds, const bf16_t* __restrict__ Ag, int lda, const bf16_t* __restrict__ Bg, int ldb, int brows,
                                           int K, f32x16 (&acc)[2][(128 / (8 / (BM / 64))) / 32]) {
    static_assert(BM == 128, "128-row tiles only");
    constexpr int WN = 4, WTN = 32, NTL = 1, LDT = 136, NP = 4;
    LAS bf16_t* As = (LAS bf16_t*)lds;
    LAS bf16_t* Bs = As + 2 * 128 * LDT;
    const int tid = otid(), lane = tid & 63, wid = tid >> 6, wm = wid / WN, wn = wid % WN;
    const int lrow = tid >> 4, lc = (tid & 15) * 8;
    const bf16_t* ap[NP]; const bf16_t* bp[NP];
#pragma unroll
    for (int p = 0; p < NP; ++p) ap[p] = Ag + (size_t)(lrow + p * 32) * lda + lc;
#pragma unroll
    for (int p = 0; p < NP; ++p) { int br = lrow + p * 32; br = br < brows ? br : brows - 1; bp[p] = Bg + (size_t)br * ldb + lc; }
    u32x4 ra[3][NP], rb[3][NP];
    const int nk = K / 128;
#define KL_ISSUE(S, step) do { _Pragma("unroll") for (int p = 0; p < NP; ++p) ra[S][p] = *(const u32x4*)(ap[p] + (step) * 128); \
                               _Pragma("unroll") for (int p = 0; p < NP; ++p) rb[S][p] = *(const u32x4*)(bp[p] + (step) * 128); } while (0)
#define KL_WRITE(S, stage) do { _Pragma("unroll") for (int p = 0; p < NP; ++p) *(LAS u32x4*)(As + (stage) * 128 * LDT + (lrow + p * 32) * LDT + lc) = ra[S][p]; \
                                _Pragma("unroll") for (int p = 0; p < NP; ++p) *(LAS u32x4*)(Bs + (stage) * 128 * LDT + (lrow + p * 32) * LDT + lc) = rb[S][p]; } while (0)
#define KL_STEP(J, JN) if (kt + J < nk) { const int s_ = kt + J; if (s_ + 3 < nk) KL_ISSUE(J, s_ + 3); \
        mma_lds<2, NTL, 8>(acc, As + (s_ & 1) * 128 * LDT + wm * 64 * LDT, LDT, Bs + (s_ & 1) * 128 * LDT + wn * WTN * LDT, LDT, lane); \
        if (s_ + 1 < nk) KL_WRITE(JN, (s_ + 1) & 1); __syncthreads(); }
    KL_ISSUE(0, 0); if (nk > 1) KL_ISSUE(1, 1); if (nk > 2) KL_ISSUE(2, 2);
    KL_WRITE(0, 0);
    __syncthreads();
    for (int kt = 0; kt < nk; kt += 3) { KL_STEP(0, 1) KL_STEP(1, 2) KL_STEP(2, 0) }
#undef KL_ISSUE
#undef KL_WRITE
#undef KL_STEP
}

template <int NTL>
__device__ __forceinline__ void acc_zero(f32x16 (&acc)[2][NTL]) {
#pragma unroll
    for (int m = 0; m < 2; ++m)
#pragma unroll
        for (int n = 0; n < NTL; ++n)
#pragma unroll
            for (int i = 0; i < 16; ++i) acc[m][n][i] = 0.f;
}

__device__ __forceinline__ void tile_coords(int t, int nN, int& tm, int& tn) { const int q = t >> 3; tn = q % nN; tm = (q / nN) * 8 + (t & 7); }

template <int BM, class Epi>
__device__ __forceinline__ void gemm_phase(LAS unsigned char* lds, const bf16_t* A, int lda, const bf16_t* Bt, int ldb, int M, int N, int K, const Epi& epi) {
    constexpr int WM = BM / 64, WN = 8 / WM, WTN = 128 / WN, NTL = WTN / 32;
    const int nM = M / BM, nN = (N + 127) / 128, ntiles = nM * nN;
    const int lane = otid() & 63, wid = otid() >> 6, wm = wid / WN, wn = wid % WN;
    for (int t = blockIdx.x; t < ntiles; t += gridDim.x) {
        int tm, tn; tile_coords(t, nN, tm, tn);
        const int row0 = tm * BM, col0 = tn * 128;
        f32x16 acc[2][NTL]; acc_zero<NTL>(acc);
        gemm_kloop<BM>(lds, A + (size_t)row0 * lda, lda, Bt + (size_t)col0 * ldb, ldb, min(128, N - col0), K, acc);
#pragma unroll
        for (int m = 0; m < 2; ++m)
#pragma unroll
            for (int n = 0; n < NTL; ++n) {
                const int col = col0 + wn * WTN + n * 32 + (lane & 31);
#pragma unroll
                for (int i = 0; i < 16; ++i) {
                    const int row = row0 + wm * 64 + m * 32 + (i & 3) + 8 * (i >> 2) + 4 * (lane >> 5);
                    epi(row, col, acc[m][n][i]);
                }
            }
    }
}

struct EpiBf16 { bf16_t* C; int ldc, N; __device__ __forceinline__ void operator()(int row, int col, float v) const { if (col < N) C[(size_t)row * ldc + col] = f2bf(v); } };
struct EpiRelu2 { bf16_t* C; int ldc; __device__ __forceinline__ void operator()(int row, int col, float v) const { v = fmaxf(v, 0.f); C[(size_t)row * ldc + col] = f2bf(v * v); } };
struct EpiResidOff { float* x; const float* gate; int roff; __device__ __forceinline__ void operator()(int row, int col, float v) const {
    const int r = row + roff; const float g = gate[mod_row(r) * 6144 + col]; float* p = x + (size_t)r * D + col; *p = *p + g * v; } };
struct EpiResid { float* x; const float* gate;   __device__ __forceinline__ void operator()(int row, int col, float v) const {
    const float g = gate[mod_row(row) * 6144 + col]; float* p = x + (size_t)row * D + col; *p = *p + g * v; } };

namespace pg8 {
#define PG8_LAS __attribute__((address_space(3)))
typedef unsigned short bf16_t;
typedef short bf16x8 __attribute__((ext_vector_type(8)));
typedef float f32x4 __attribute__((ext_vector_type(4)));
typedef unsigned u32x4 __attribute__((ext_vector_type(4)));
constexpr int BM = 256, BK = 64, HALF = 128, HTB = HALF * BK * 2  , STAGE_BYTES = 8 * HTB, NXCD = 8, WGM = 8;

__host__ __device__ __forceinline__ int lds_byte(int r, int c) { const int st = (r >> 4) * 2 + (c >> 5), rr = r & 15, cc = c & 31, ob = rr * 64 + cc * 2; return st * 1024 + (ob ^ (((ob >> 9) & 1) << 5)); }
__host__ __device__ __forceinline__ void stage_rc(int b, int& R, int& C) { const int st = b / 1024, sb = b % 1024, swz = sb ^ (((sb >> 9) & 1) << 5); R = (st >> 1) * 16 + swz / 64; C = (st & 1) * 32 + (swz % 64) / 2; }
__host__ __device__ __forceinline__ int perm32(int rho) { const int n = rho >> 4, i = rho & 15; return 8 * (i >> 2) + 4 * n + (i & 3); }

struct Unit { int pm, pn; };
struct Gemm { const bf16_t* A; const bf16_t* Bt; int M, N, K; size_t agrp; };

struct StaticOrder {
    int nM, nN, nwg, G, c;
    __host__ __device__ void init(int M, int N, int G_, int c_) { nM = M / BM; nN = N / BM; nwg = nM * nN; G = G_; c = c_; }
    __host__ __device__ bool next(int i, Unit& u) const {
        const long L = (long)i * G + c; if (L >= nwg) return false;
        int wgid = (int)L; { const int q = nwg / NXCD, r = nwg % NXCD, xcd = wgid % NXCD, off = wgid / NXCD; wgid = (xcd < r ? xcd * (q + 1) : r * (q + 1) + (xcd - r) * q) + off; }
        const int nig = WGM * nN, gid = wgid / nig, fm = gid * WGM, gsz = (nM - fm) < WGM ? (nM - fm) : WGM;
        u.pm = fm + ((wgid % nig) % gsz); u.pn = (wgid % nig) / gsz; return true;
    }
    __device__ __forceinline__ void a_ready(const Unit&) const {}
    __device__ __forceinline__ void done(const Unit&) const {}
};
__device__ __forceinline__ unsigned cvt_pk_bf16(float lo, float hi) { unsigned r; asm volatile("v_cvt_pk_bf16_f32 %0, %1, %2" : "=v"(r) : "v"(lo), "v"(hi)); return r; }
template <class Epi, class Sched, bool STAMP = false>
__device__ __forceinline__ void gemm_phase(PG8_LAS unsigned char* lds, const Gemm g, const Sched& S, const Epi& E, unsigned long long* stamps) {
    const int tid = otid(), wid = __builtin_amdgcn_readfirstlane(tid >> 6), lane = tid & 63, wr = wid >> 2, wc = wid & 3, fr = lane & 15, fq = lane >> 4;
    const int K = g.K, nt = K / BK;
    int ts_lo = 0, ts_hi = 0, nts = 0; const unsigned long long rt_entry = STAMP ? (unsigned long long)wall_clock64() : 0ull;
#define PG8_STAMP() do { if (STAMP && wid == 0 && nts < 64) { const unsigned long long _c = (unsigned long long)clock64(); \
        ts_lo = (lane == nts) ? (int)(unsigned)_c : ts_lo; ts_hi = (lane == nts) ? (int)(unsigned)(_c >> 32) : ts_hi; ++nts; } } while (0)
    PG8_STAMP();
    unsigned voffA[2], voffB[2];
#pragma unroll
    for (int i = 0; i < 2; ++i) { int R, C; stage_rc(tid * 16 + i * 8192, R, C); const int Rb = Epi::PERM ? ((R & ~31) + perm32(R & 31)) : R;
        voffA[i] = (unsigned)(R * K + C) * 2u; voffB[i] = (unsigned)(Rb * K + C) * 2u; }
    const size_t kstep = (size_t)(BK * 2);
    const size_t hstep = (size_t)HALF * K * 2;
    const size_t tstep = 2 * hstep;
    const unsigned ldsw = (unsigned)wid * 1024u;
    const int aoff = lds_byte(wr * 64 + fr, fq * 8), boff = lds_byte(wc * 32 + fr, fq * 8);
#define PG8_SA(b, h) (((b) * 2 + (h)) * HTB)
#define PG8_SB(b, h) ((4 + (b) * 2 + (h)) * HTB)
#define PG8_STAGE(bufoff, gbase, voff) do { _Pragma("unroll") for (int _i = 0; _i < 2; ++_i) \
        __builtin_amdgcn_global_load_lds((const unsigned*)((const char*)(gbase) + (voff)[_i]), (PG8_LAS unsigned*)(lds + (bufoff) + ldsw + _i * 8192), 16, 0, 0); } while (0)
#define PG8_LDA(dst, b, h) do { _Pragma("unroll") for (int m = 0; m < 4; ++m) _Pragma("unroll") for (int k = 0; k < 2; ++k) dst[m][k] = *(const PG8_LAS bf16x8*)(lds + PG8_SA(b, h) + aoff + m * 2048 + k * 1024); } while (0)
#define PG8_LDB(dst, b, h) do { _Pragma("unroll") for (int n = 0; n < 2; ++n) _Pragma("unroll") for (int k = 0; k < 2; ++k) dst[n][k] = *(const PG8_LAS bf16x8*)(lds + PG8_SB(b, h) + boff + n * 2048 + k * 1024); } while (0)
#define PG8_MMA(ai, bj, At, Bt) do { __builtin_amdgcn_s_setprio(1); _Pragma("unroll") for (int m = 0; m < 4; ++m) _Pragma("unroll") for (int n = 0; n < 2; ++n) _Pragma("unroll") for (int k = 0; k < 2; ++k) \
        acc[ai][bj][m][n] = __builtin_amdgcn_mfma_f32_16x16x32_bf16(Bt[n][k], At[m][k], acc[ai][bj][m][n], 0, 0, 0); __builtin_amdgcn_s_setprio(0); } while (0)
#define PG8_WAIT_V(n) asm volatile("s_waitcnt vmcnt(" #n ")" ::: "memory")
#define PG8_WAIT_L(n) asm volatile("s_waitcnt lgkmcnt(" #n ")" ::: "memory")
#define PG8_BAR __builtin_amdgcn_s_barrier()
#define PG8_SCHED __builtin_amdgcn_sched_barrier(0)
    Unit cur, nxt; int ui = 0;
    if (!S.next(0, cur)) return;
    f32x4 acc[2][2][4][2];
#pragma unroll
    for (int a = 0; a < 2; ++a)
#pragma unroll
        for (int b = 0; b < 2; ++b)
#pragma unroll
            for (int m = 0; m < 4; ++m)
#pragma unroll
                for (int n = 0; n < 2; ++n) acc[a][b][m][n] = (f32x4){0.f, 0.f, 0.f, 0.f};
    bf16x8 At[4][2], B0[2][2], B1[2][2];
    const char* cA = (const char*)g.A + (size_t)cur.pm * tstep + (size_t)(cur.pn >> 2) * g.agrp; const char* cB = (const char*)g.Bt + (size_t)cur.pn * tstep;
    S.a_ready(cur);
    PG8_STAGE(PG8_SB(0, 0), cB, voffB); PG8_STAGE(PG8_SA(0, 0), cA, voffA); PG8_STAGE(PG8_SB(0, 1), cB + hstep, voffB); PG8_STAGE(PG8_SA(0, 1), cA + hstep, voffA);
    if (wr == 1) PG8_BAR;
    PG8_WAIT_V(4); PG8_BAR;
    PG8_STAGE(PG8_SB(1, 0), cB + kstep, voffB); PG8_STAGE(PG8_SA(1, 0), cA + kstep, voffA); PG8_STAGE(PG8_SB(1, 1), cB + hstep + kstep, voffB);
    PG8_WAIT_V(6); PG8_BAR;
    PG8_STAMP();
    for (;;) {
        const bool has_next = S.next(ui + 1, nxt);
        const char* nA = has_next ? (const char*)g.A + (size_t)nxt.pm * tstep + (size_t)(nxt.pn >> 2) * g.agrp : cA; const char* nB = has_next ? (const char*)g.Bt + (size_t)nxt.pn * tstep : cB;
        for (int t = 0; t < nt; t += 2) {
            const bool last = (t == nt - 2);
            const char* a1 = cA + (size_t)(t + 1) * kstep;
            const char* a2 = last ? nA : cA + (size_t)(t + 2) * kstep; const char* b2 = last ? nB : cB + (size_t)(t + 2) * kstep;
            const char* a3 = a2 + kstep; const char* b3 = b2 + kstep;
            if (last && has_next) S.a_ready(nxt);
            PG8_LDB(B0, 0, 0); PG8_SCHED; PG8_LDA(At, 0, 0); PG8_STAGE(PG8_SA(1, 1), a1 + hstep, voffA);
            PG8_WAIT_L(8); PG8_BAR; PG8_WAIT_L(0); PG8_MMA(0, 0, At, B0); PG8_BAR; PG8_SCHED;
            PG8_LDB(B1, 0, 1); PG8_STAGE(PG8_SB(0, 0), b2, voffB);
            PG8_BAR; PG8_WAIT_L(0); PG8_MMA(0, 1, At, B1); PG8_BAR;
            PG8_LDA(At, 0, 1); PG8_STAGE(PG8_SA(0, 0), a2, voffA);
            PG8_BAR; PG8_WAIT_L(0); PG8_MMA(1, 0, At, B0); PG8_BAR; PG8_SCHED;
            PG8_STAGE(PG8_SB(0, 1), b2 + hstep, voffB);
            PG8_WAIT_V(6); PG8_BAR; PG8_MMA(1, 1, At, B1); PG8_BAR;
            PG8_LDB(B0, 1, 0); PG8_SCHED; PG8_LDA(At, 1, 0); PG8_STAGE(PG8_SA(0, 1), a2 + hstep, voffA);
            PG8_WAIT_L(8); PG8_BAR; PG8_WAIT_L(0); PG8_MMA(0, 0, At, B0); PG8_BAR; PG8_SCHED;
            PG8_LDB(B1, 1, 1); PG8_STAGE(PG8_SB(1, 0), b3, voffB);
            PG8_BAR; PG8_WAIT_L(0); PG8_MMA(0, 1, At, B1); PG8_BAR;
            PG8_LDA(At, 1, 1); PG8_STAGE(PG8_SA(1, 0), a3, voffA);
            PG8_BAR; PG8_WAIT_L(0); PG8_MMA(1, 0, At, B0); PG8_BAR; PG8_SCHED;
            PG8_STAGE(PG8_SB(1, 1), b3 + hstep, voffB);
            PG8_WAIT_V(6); PG8_BAR; PG8_MMA(1, 1, At, B1); PG8_BAR;
        }
        PG8_STAMP();
        if constexpr (!Epi::AFTER_DRAIN) { E(acc, cur, wr, wc, fr, fq); S.done(cur); }
        PG8_STAMP();
        if (!has_next) break;
#pragma unroll
        for (int a = 0; a < 2; ++a)
#pragma unroll
            for (int b = 0; b < 2; ++b)
#pragma unroll
                for (int m = 0; m < 4; ++m)
#pragma unroll
                    for (int n = 0; n < 2; ++n) acc[a][b][m][n] = (f32x4){0.f, 0.f, 0.f, 0.f};
        cur = nxt; cA = nA; cB = nB; ++ui;
    }
    PG8_WAIT_V(0);
    if (wr == 0) PG8_BAR;
    PG8_BAR;
    if constexpr (Epi::AFTER_DRAIN) { E.fused(acc, cur, wr, wc, fr, fq, lds, wid, lane); S.done(cur); }
    PG8_STAMP();
    if (STAMP && wid == 0) { stamps[lane] = lane < nts ? (((unsigned long long)(unsigned)ts_hi << 32) | (unsigned)ts_lo) : 0ull;
        if (lane == 62) stamps[62] = rt_entry; if (lane == 63) stamps[63] = (unsigned long long)wall_clock64(); }
#undef PG8_STAMP
#undef PG8_SA
#undef PG8_SB
#undef PG8_STAGE
#undef PG8_LDA
#undef PG8_LDB
#undef PG8_MMA
#undef PG8_WAIT_V
#undef PG8_WAIT_L
#undef PG8_BAR
#undef PG8_SCHED
}
}

struct PEpiBf16 {
    static constexpr bool PERM = true, AFTER_DRAIN = false;
    bf16_t* C; int ldc, N, act;
    __device__ __forceinline__ void operator()(const pg8::f32x4 (&acc)[2][2][4][2], const pg8::Unit& u, int wr, int wc, int fr, int fq) const {
        const int row0 = u.pm * 256 + wr * 64 + fr, col0 = u.pn * 256 + wc * 32 + 8 * fq;
#pragma unroll
        for (int ai = 0; ai < 2; ++ai)
#pragma unroll
            for (int m = 0; m < 4; ++m) {
                bf16_t* rowp = C + (size_t)(row0 + ai * 128 + m * 16) * ldc;
#pragma unroll
                for (int bj = 0; bj < 2; ++bj) {
                    const int col = col0 + bj * 128;
                    pg8::f32x4 v0 = acc[ai][bj][m][0], v1 = acc[ai][bj][m][1];
                    if (act == 1) { v0.x = fmaxf(v0.x, 0.f); v0.y = fmaxf(v0.y, 0.f); v0.z = fmaxf(v0.z, 0.f); v0.w = fmaxf(v0.w, 0.f); v0 = v0 * v0;
                                    v1.x = fmaxf(v1.x, 0.f); v1.y = fmaxf(v1.y, 0.f); v1.z = fmaxf(v1.z, 0.f); v1.w = fmaxf(v1.w, 0.f); v1 = v1 * v1; }
                    if (act == 2) { v0.x = sigmoidf_(v0.x); v0.y = sigmoidf_(v0.y); v0.z = sigmoidf_(v0.z); v0.w = sigmoidf_(v0.w);
                                    v1.x = sigmoidf_(v1.x); v1.y = sigmoidf_(v1.y); v1.z = sigmoidf_(v1.z); v1.w = sigmoidf_(v1.w); }
                    u32x4 w; w.x = pk2(v0.x, v0.y); w.y = pk2(v0.z, v0.w); w.z = pk2(v1.x, v1.y); w.w = pk2(v1.z, v1.w);
                    if (col < N) *(u32x4*)(rowp + col) = w;
                }
            }
    }
};
struct PEpiResid {
    static constexpr bool PERM = true, AFTER_DRAIN = false;
    float* x; const float* gate;
    __device__ __forceinline__ void operator()(const pg8::f32x4 (&acc)[2][2][4][2], const pg8::Unit& u, int wr, int wc, int fr, int fq) const {
        const int row0 = u.pm * 256 + wr * 64 + fr, col0 = u.pn * 256 + wc * 32 + 8 * fq;
#pragma unroll
        for (int ai = 0; ai < 2; ++ai)
#pragma unroll
            for (int m = 0; m < 4; ++m) {
                const int row = row0 + ai * 128 + m * 16;
                float* rowp = x + (size_t)row * D; const float* gp = gate + (size_t)mod_row(row) * 6144;
#pragma unroll
                for (int bj = 0; bj < 2; ++bj) {
                    const int col = col0 + bj * 128;
                    const f32x4 g0 = *(const f32x4*)(gp + col), g1 = *(const f32x4*)(gp + col + 4);
                    f32x4 x0 = *(const f32x4*)(rowp + col), x1 = *(const f32x4*)(rowp + col + 4);
                    x0 = x0 + g0 * acc[ai][bj][m][0]; x1 = x1 + g1 * acc[ai][bj][m][1];
                    *(f32x4*)(rowp + col) = x0; *(f32x4*)(rowp + col + 4) = x1;
                }
            }
    }
};
struct PEpiGate {
    static constexpr bool PERM = true, AFTER_DRAIN = false;
    bf16_t* G; int ldc;
    __device__ __forceinline__ void operator()(const pg8::f32x4 (&acc)[2][2][4][2], const pg8::Unit& u, int wr, int wc, int fr, int fq) const {
        const int row0 = u.pm * 256 + wr * 64 + fr, col0 = u.pn * 256 + wc * 32 + 8 * fq;
#pragma unroll
        for (int ai = 0; ai < 2; ++ai)
#pragma unroll
            for (int m = 0; m < 4; ++m) {
                bf16_t* rowp = G + (size_t)(row0 + ai * 128 + m * 16) * ldc;
#pragma unroll
                for (int bj = 0; bj < 2; ++bj) {
                    const int col = col0 + bj * 128;
                    const u32x4 g = *(const u32x4*)(rowp + col);
                    const pg8::f32x4 v0 = acc[ai][bj][m][0], v1 = acc[ai][bj][m][1];
                    u32x4 w; w.x = pk2(bflo(g.x) * v0.x, bfhi(g.x) * v0.y); w.y = pk2(bflo(g.y) * v0.z, bfhi(g.y) * v0.w);
                    w.z = pk2(bflo(g.z) * v1.x, bfhi(g.z) * v1.y); w.w = pk2(bflo(g.w) * v1.z, bfhi(g.w) * v1.w);
                    *(u32x4*)(rowp + col) = w;
                }
            }
    }
};
__device__ __forceinline__ void sum3_phase(const Params& p) {
    const bf16_t* Y = (const bf16_t*)(p.ws + WS_PROJ); bf16_t* merged = (bf16_t*)(p.ws + WS_ST);
    for (size_t i = (size_t)blockIdx.x * 512 + otid(); i < (size_t)NTOK * (D / 8); i += (size_t)gridDim.x * 512) {
        const size_t row = i >> 7; const int c8 = (int)(i & 127) * 8;
        const bf16_t* yr = Y + row * NGATE + c8;
        const u32x4 a = *(const u32x4*)yr, b = *(const u32x4*)(yr + 1024), c = *(const u32x4*)(yr + 2048);
        u32x4 w; w.x = pk2(bflo(a.x) + bflo(b.x) + bflo(c.x), bfhi(a.x) + bfhi(b.x) + bfhi(c.x)); w.y = pk2(bflo(a.y) + bflo(b.y) + bflo(c.y), bfhi(a.y) + bfhi(b.y) + bfhi(c.y));
        w.z = pk2(bflo(a.z) + bflo(b.z) + bflo(c.z), bfhi(a.z) + bfhi(b.z) + bfhi(c.z)); w.w = pk2(bflo(a.w) + bflo(b.w) + bflo(c.w), bfhi(a.w) + bfhi(b.w) + bfhi(c.w));
        *(u32x4*)(merged + row * D + c8) = w;
    }
}
template <class Epi>
__device__ __forceinline__ void pg8_gemm(LAS unsigned char* lds, const bf16_t* A, const bf16_t* Bt, int M, int N, int K, const Epi& e, size_t agrp = 0) {
    pg8::Gemm g{A, Bt, M, N, K, agrp};
    pg8::StaticOrder so; so.init(M, N, (int)gridDim.x, (int)blockIdx.x);
    pg8::gemm_phase<Epi, pg8::StaticOrder, false>(lds, g, so, e, nullptr);
    __syncthreads();
}

__device__ __forceinline__ void grid_barrier(unsigned* bar, unsigned k) {
    asm volatile("s_waitcnt vmcnt(0)" ::: "memory");
    __syncthreads();
    if (otid() == 0) {
        const unsigned g = blockIdx.x & 7u, ng = (gridDim.x + 7u - g) >> 3;
        __builtin_amdgcn_fence(__ATOMIC_RELEASE, "agent");
        asm volatile("s_waitcnt vmcnt(0)" ::: "memory");
        const unsigned c = __hip_atomic_fetch_add(bar + 16 * g, 1u, __ATOMIC_RELAXED, __HIP_MEMORY_SCOPE_AGENT);
        if (c == ng * k - 1u) {
            const unsigned ngroups = gridDim.x < 8u ? gridDim.x : 8u;
            const unsigned t = __hip_atomic_fetch_add(bar + 128, 1u, __ATOMIC_RELAXED, __HIP_MEMORY_SCOPE_AGENT);
            if (t == ngroups * k - 1u)
                for (unsigned j = 0; j < ngroups; ++j) __hip_atomic_store(bar + 144 + 16 * j, k, __ATOMIC_RELAXED, __HIP_MEMORY_SCOPE_AGENT);
        }
        unsigned spins = 0;
        while (__hip_atomic_load(bar + 144 + 16 * g, __ATOMIC_RELAXED, __HIP_MEMORY_SCOPE_AGENT) < k && ++spins < (1u << 28)) __builtin_amdgcn_s_sleep(1);
        __builtin_amdgcn_fence(__ATOMIC_ACQUIRE, "agent");
        asm volatile("s_waitcnt vmcnt(0)" ::: "memory");
    }
    __syncthreads();
}

__device__ __forceinline__ void transpose_item(const float* __restrict__ W, int N, int K, int k0, int n0, bf16_t* __restrict__ dst  , LAS float* scr, int lane) {
#pragma unroll 8
    for (int i = 0; i < 32; ++i) { const int kk = 2 * i + (lane >> 5); scr[kk * 33 + (lane & 31)] = W[(size_t)(k0 + kk) * N + n0 + (lane & 31)]; }
    LDS_WAIT();
    const int c = lane & 7;
#pragma unroll
    for (int j = 0; j < 4; ++j) {
        const int n = (lane >> 3) + 8 * j; const LAS float* s = scr + (8 * c) * 33 + n;
        u32x4 o; o.x = pk2(s[0 * 33], s[1 * 33]); o.y = pk2(s[2 * 33], s[3 * 33]); o.z = pk2(s[4 * 33], s[5 * 33]); o.w = pk2(s[6 * 33], s[7 * 33]);
        *(u32x4*)(dst + (size_t)n * K + k0 + 8 * c) = o;
    }
    LDS_WAIT();
}

constexpr int CONV_NIT = 16 * 257 + 3 * 8 * 32 + 16 * 32 + 16 * 128 + 64 * 32, CONV_BLOCK_ITEMS = (CONV_NIT + 7) / 8;
__device__ __forceinline__ void convert_weights(const Params& p, int l, LAS unsigned char* lds, int bitem = -1) {
    const int lane = otid() & 63, wid = otid() >> 6;
    LAS float* scr = (LAS float*)(lds + wid * 16384);
    unsigned char* wb = p.ws + WS_W + (size_t)(l & 1) * W_END;
    constexpr int I_IN = 16 * 257, I_BR = 8 * 32, I_OUT = 16 * 32, I_FF1 = 16 * 128, I_FF2 = 64 * 32;
    constexpr int NIT = I_IN + 3 * I_BR + I_OUT + I_FF1 + I_FF2;
    for (int it = (bitem < 0 ? blockIdx.x * 8 + wid : bitem * 8 + wid); it < NIT; it += (bitem < 0 ? gridDim.x * 8 : NIT)) {
        int r = it;
        if (r < I_IN) { const int kb = r / 257, nb = r % 257, n0 = nb * 32;
            bf16_t* dst = n0 < NPROJ ? (bf16_t*)(wb + W_IN) + (size_t)n0 * D : (bf16_t*)(wb + W_G) + (size_t)(n0 - NPROJ) * D;
            transpose_item(p.w_in + (size_t)l * D * DIN, DIN, D, kb * 64, n0, dst, scr, lane); continue; }
        r -= I_IN;
        if (r < 3 * I_BR) { const int b = r / I_BR, q = r % I_BR, kb = q / 32, nb = q % 32;
            const float* W = (b == 0 ? p.w_br_gla : b == 1 ? p.w_br_hg : p.w_br_gm) + (size_t)l * 512 * D;
            transpose_item(W, D, 512, kb * 64, nb * 32, (bf16_t*)(wb + W_BR) + (size_t)b * D * 512 + (size_t)nb * 32 * 512, scr, lane); continue; }
        r -= 3 * I_BR;
        if (r < I_OUT) { const int kb = r / 32, nb = r % 32;
            transpose_item(p.w_out + (size_t)l * D * D, D, D, kb * 64, nb * 32, (bf16_t*)(wb + W_OUT) + (size_t)nb * 32 * D, scr, lane); continue; }
        r -= I_OUT;
        if (r < I_FF1) { const int kb = r / 128, nb = r % 128;
            transpose_item(p.w_ff1 + (size_t)l * D * DFF, DFF, D, kb * 64, nb * 32, (bf16_t*)(wb + W_FF1) + (size_t)nb * 32 * D, scr, lane); continue; }
        r -= I_FF1;
        { const int kb = r / 32, nb = r % 32;
            transpose_item(p.w_ff2 + (size_t)l * DFF * D, D, DFF, kb * 64, nb * 32, (bf16_t*)(wb + W_FF2) + (size_t)nb * 32 * DFF, scr, lane); }
    }
}

__device__ __forceinline__ void phase0(const Params& p, LAS unsigned char* lds) {
    const int tid = otid();
    float* x = p.out;
    for (size_t i = (size_t)blockIdx.x * 512 + tid; i < (size_t)NTOK * (D / 4); i += (size_t)gridDim.x * 512) {
        const int tok = (int)(i >> 8), c4 = (int)(i & 255) * 4;
        f32x4 v;
        if (tok < NCTX) v = *(const f32x4*)(p.x_prompt + (size_t)tok * D + c4);
        else {
            const int lt = tok - NCTX; v = *(const f32x4*)(p.x_sample + (size_t)lt * D + c4);
            const int t = lt & 2047; const float rr = (float)(t >> 6), cc = (float)(t & 63);
            const int sec = c4 >> 8; const float pos = sec < 2 ? rr : cc;
#pragma unroll
            for (int j = 0; j < 4; ++j) {
                const int f = (c4 + j) & 255;
                const float omega = exp2f((float)f * (-13.287712379549449f / 256.0f));
                const float a = pos * omega;
                v[j] += (sec & 1) ? __cosf(a) : __sinf(a);
            }
        }
        *(f32x4*)(x + i * 4) = v;
    }
    if (blockIdx.x == 0) {
        float* lbs = (float*)(p.ws + WS_LBS);
        for (int i = tid; i < 1024; i += 512) {
            const int dir = i >> 9, ch = i & 511; float lg[4], mx = -1e30f;
            for (int l = 0; l < 4; ++l) { lg[l] = p.hg_lb_logits[(size_t)(dir * 4 + l) * 512 + ch]; mx = fmaxf(mx, lg[l]); }
            float s = 0.f; for (int l = 0; l < 4; ++l) { lg[l] = expf(lg[l] - mx); s += lg[l]; }
            float cum = 0.f, c0 = 0.f;
            for (int l = 0; l < 4; ++l) { cum += lg[l] / s; if (l == 0) c0 = cum; lbs[(size_t)(dir * 4 + l) * 512 + ch] = cum - c0; }
        }
        for (int i = tid; i < 1024; i += 512) ((unsigned*)(p.ws + WS_CTR))[i] = 0u;
    }
    LAS float* sc = (LAS float*)lds;
    LAS float* red = sc + 9 * 1024;
    for (int i = tid; i < 9 * 1024; i += 512) { const int r = i >> 10, k = i & 1023; const float v = r == 0 ? p.c_ctx[k] : p.c[(size_t)(r - 1) * D + k]; sc[i] = siluf_(v); }
    __syncthreads();
    float* mod = (float*)(p.ws + WS_MOD);
    for (int u = blockIdx.x; u < DEPTH * 48; u += gridDim.x) {
        const int l = u / 48, cb = u % 48, cl = tid & 127, kp = tid >> 7, n = cb * 128 + cl;
        const float* w = p.ada_w + (size_t)l * D * 6144 + n;
        float a[9];
#pragma unroll
        for (int r = 0; r < 9; ++r) a[r] = 0.f;
#pragma unroll 4
        for (int k = kp * 256; k < kp * 256 + 256; ++k) {
            const float wv = w[(size_t)k * 6144];
#pragma unroll
            for (int r = 0; r < 9; ++r) a[r] += sc[r * 1024 + k] * wv;
        }
#pragma unroll
        for (int r = 0; r < 9; ++r) red[(kp * 9 + r) * 128 + cl] = a[r];
        __syncthreads();
        for (int i = tid; i < 9 * 128; i += 512) {
            const int r = i >> 7, c2 = i & 127;
            const float s = red[(0 * 9 + r) * 128 + c2] + red[(1 * 9 + r) * 128 + c2] + red[(2 * 9 + r) * 128 + c2] + red[(3 * 9 + r) * 128 + c2];
            mod[((size_t)l * 9 + r) * 6144 + cb * 128 + c2] = s + p.ada_b[(size_t)l * 6144 + cb * 128 + c2];
        }
        __syncthreads();
    }
}

__device__ __forceinline__ void norm_phase(const Params& p, const float* g, const float* mod_l, int off_sh, int off_sc, bf16_t* hout, int mode) {
    const int lane = otid() & 63, wid = otid() >> 6;
    float* x = p.out;
    for (int row = blockIdx.x * 8 + wid; row < NTOK; row += gridDim.x * 8) {
        f32x4 v[4]; float s = 0.f;
        float* xr = x + (size_t)row * D;
#pragma unroll
        for (int j = 0; j < 4; ++j) { v[j] = *(const f32x4*)(xr + lane * 4 + 256 * j); s += v[j].x * v[j].x + v[j].y * v[j].y + v[j].z * v[j].z + v[j].w * v[j].w; }
        const float rstd = rsqrtf(wave_sum(s) * (1.0f / D) + EPS);
        if (mode == 0) {
            const float* mr = mod_l + (size_t)mod_row(row) * 6144;
#pragma unroll
            for (int j = 0; j < 4; ++j) {
                const int c = lane * 4 + 256 * j;
                const f32x4 gg = *(const f32x4*)(g + c), sh = *(const f32x4*)(mr + off_sh + c), scv = *(const f32x4*)(mr + off_sc + c);
                const f32x4 o = (v[j] * rstd) * gg * (scv + 1.0f) + sh;
                u32x2 w; w.x = pk2(o.x, o.y); w.y = pk2(o.z, o.w);
                *(u32x2*)(hout + (size_t)row * D + c) = w;
            }
        } else {
#pragma unroll
            for (int j = 0; j < 4; ++j) { const int c = lane * 4 + 256 * j; const f32x4 gg = *(const f32x4*)(g + c); *(f32x4*)(xr + c) = (v[j] * rstd) * gg; }
        }
    }
}

template <int MIX>
__device__ __forceinline__ void gate_eval(const bf16_t* row, int kcol, int zcol, const float (&lrw)[16], float lrb, float lb, float& gt, float& kt) {
    if (!MIX) {
        const bf16_t* zr = row + zcol;
        const u32x4 z0 = *(const u32x4*)zr, z1 = *(const u32x4*)(zr + 8);
        float z = lrb;
        z += bflo(z0.x) * lrw[0] + bfhi(z0.x) * lrw[1] + bflo(z0.y) * lrw[2] + bfhi(z0.y) * lrw[3] + bflo(z0.z) * lrw[4] + bfhi(z0.z) * lrw[5] + bflo(z0.w) * lrw[6] + bfhi(z0.w) * lrw[7];
        z += bflo(z1.x) * lrw[8] + bfhi(z1.x) * lrw[9] + bflo(z1.y) * lrw[10] + bfhi(z1.y) * lrw[11] + bflo(z1.z) * lrw[12] + bfhi(z1.z) * lrw[13] + bflo(z1.w) * lrw[14] + bfhi(z1.w) * lrw[15];
        gt = logsigmoidf_(z) * (1.0f / 16.0f);
        kt = bf2f(row[kcol]);
    } else {
        const float xf = bf2f(row[kcol]);
        const float sg = sigmoidf_(xf);
        gt = flog_(lb + (1.0f - lb) * sg);
        kt = (1.0f - lb) * (1.0f - sg);
    }
}

template <int MIX>
__device__ __forceinline__ void gate_raw(unsigned kraw, const u32x4& z0, const u32x4& z1, const float (&lrw)[16], float lrb, float lb, float& gt, float& kt) {
    if (!MIX) {
        float z = lrb;
        z += bflo(z0.x) * lrw[0] + bfhi(z0.x) * lrw[1] + bflo(z0.y) * lrw[2] + bfhi(z0.y) * lrw[3] + bflo(z0.z) * lrw[4] + bfhi(z0.z) * lrw[5] + bflo(z0.w) * lrw[6] + bfhi(z0.w) * lrw[7];
        z += bflo(z1.x) * lrw[8] + bfhi(z1.x) * lrw[9] + bflo(z1.y) * lrw[10] + bfhi(z1.y) * lrw[11] + bflo(z1.z) * lrw[12] + bfhi(z1.z) * lrw[13] + bflo(z1.w) * lrw[14] + bfhi(z1.w) * lrw[15];
        gt = logsigmoidf_(z) * (1.0f / 16.0f);
        kt = bflo(kraw);
    } else {
        const float xf = bflo(kraw);
        const float sg = sigmoidf_(xf);
        gt = flog_(lb + (1.0f - lb) * sg);
        kt = (1.0f - lb) * (1.0f - sg);
    }
}

template <int MIX>
__device__ __forceinline__ void scan_job(const Params& p, int l, int s, int dir, int hd, LAS unsigned char* lds) {
    constexpr int DK = MIX ? 128 : 64, WM = DK / 32, WN = 8 / WM, WTN = 128 / WN, NTL = WTN / 32, LDT = 72, LDG = DK + 1;
    LAS bf16_t* At = (LAS bf16_t*)lds;
    LAS bf16_t* Bt = At + 128 * LDT;
    LAS float* dec = (LAS float*)(lds + 2 * 128 * LDT * 2);
    LAS float* G = dec + 128;
    LAS float* KK = G + 64 * 129;
    const int tid = otid(), lane = tid & 63, wid = tid >> 6, wm = wid / WN, wn = wid % WN;
    const bool ctx = s < 16;
    const int T = ctx ? 256 : 2048, tok0 = ctx ? s * 256 : NCTX + (s - 16) * 2048, nch = T / 64;
    const bf16_t* proj = (const bf16_t*)(p.ws + WS_PROJ);
    const float* lbs = (const float*)(p.ws + WS_LBS);
    bf16_t* sbuf = (bf16_t*)(p.ws + WS_ST + (MIX ? ST_GLA_BYTES : 0));
    f32x16 S[1][NTL];
    {
        const float* st0 = ctx ? nullptr : (MIX ? p.state_hgrn + ((((size_t)(s - 16) * DEPTH + l) * 2 + dir) * 4 + hd) * 128 * 128
                                                : p.state_gla + ((((size_t)(s - 16) * DEPTH + l) * 2 + dir) * 4 + hd) * 64 * 128);
#pragma unroll
        for (int n = 0; n < NTL; ++n)
#pragma unroll
            for (int i = 0; i < 16; ++i) {
                const int d = wm * 32 + (i & 3) + 8 * (i >> 2) + 4 * (lane >> 5), v = wn * WTN + n * 32 + (lane & 31);
                S[0][n][i] = ctx ? 0.f : st0[(size_t)d * 128 + v];
            }
    }
    const int sd = tid & (DK - 1), t0 = tid / DK; constexpr int TS = 512 / DK;
    float lrw[16]; float lrb = 0.f, lb = 0.f;
    if (!MIX) {
#pragma unroll
        for (int r = 0; r < 16; ++r) lrw[r] = p.gla_lr_w[(((size_t)l * 2 + dir) * 16 + r) * 256 + hd * 64 + sd];
        lrb = p.gla_lr_b[((size_t)l * 2 + dir) * 256 + hd * 64 + sd];
    } else {
#pragma unroll
        for (int r = 0; r < 16; ++r) lrw[r] = 0.f;
        lb = lbs[(size_t)(dir * 4 + l) * 512 + hd * 128 + sd];
    }
    const int kcol = MIX ? (dir ? PJ_HFB : PJ_HFF) + hd * 128 + sd : PJ_GK + hd * 64 + sd;
    const int zcol = dir ? PJ_GZB : PJ_GZF;
    const int vv = tid & 127, vq = tid >> 7;
    const int vcol = (MIX ? PJ_HI : PJ_GV) + hd * 128 + vv;
    const int kd = tid >> 2, kq = tid & 3;
    const bool k2 = tid < 4 * DK;

    constexpr int NE = 64 / TS;
    unsigned kraw[NE]; u32x4 zr0[MIX ? 1 : NE], zr1[MIX ? 1 : NE]; unsigned vraw[8];
    auto load_chunk = [&](const bf16_t* prc) {
#pragma unroll
        for (int i = 0; i < NE; ++i) {
            const bf16_t* row = prc + (size_t)(t0 + TS * i) * NPROJ;
            kraw[i] = row[kcol];
            if (!MIX) { zr0[i] = *(const u32x4*)(row + zcol); zr1[i] = *(const u32x4*)(row + zcol + 8); }
        }
#pragma unroll
        for (int t = 0; t < 16; t += 2) {
            const unsigned a = prc[(size_t)(vq * 16 + t) * NPROJ + vcol], b = prc[(size_t)(vq * 16 + t + 1) * NPROJ + vcol];
            vraw[t >> 1] = a | (b << 16);
        }
    };
    auto store_state = [&](int gcs) {
        bf16_t* sb = sbuf + (((size_t)gcs * 2 + dir) * 4 + hd) * 128 * DK;
#pragma unroll
        for (int nn = 0; nn < NTL; ++nn)
#pragma unroll
            for (int q = 0; q < 4; ++q) {
                const int d0 = wm * 32 + 8 * q + 4 * (lane >> 5), v = wn * WTN + nn * 32 + (lane & 31);
                u32x2 w; w.x = pk2(S[0][nn][4 * q + 0], S[0][nn][4 * q + 1]); w.y = pk2(S[0][nn][4 * q + 2], S[0][nn][4 * q + 3]);
                *(u32x2*)(sb + (size_t)v * DK + d0) = w;
            }
    };
    load_chunk(proj + (size_t)(tok0 + (dir ? nch - 1 : 0) * 64) * NPROJ);
    store_state((tok0 >> 6) + (dir ? nch - 1 : 0));
    for (int n = 0; n < nch; ++n) {
#pragma unroll
        for (int i = 0; i < NE; ++i) {
            const int t = t0 + TS * i; float gt, kt;
            gate_raw<MIX>(kraw[i], zr0[MIX ? 0 : i], zr1[MIX ? 0 : i], lrw, lrb, lb, gt, kt);
            G[t * LDG + sd] = gt; KK[t * LDG + sd] = kt;
        }
#pragma unroll
        for (int q = 0; q < 2; ++q) { u32x4 w; w.x = vraw[4 * q]; w.y = vraw[4 * q + 1]; w.z = vraw[4 * q + 2]; w.w = vraw[4 * q + 3]; *(LAS u32x4*)(Bt + vv * LDT + vq * 16 + q * 8) = w; }
        if (n + 1 < nch) load_chunk(proj + (size_t)(tok0 + (dir ? nch - 2 - n : n + 1) * 64) * NPROJ);
        __syncthreads();
        if (k2) {
            float g[16]; float qs = 0.f;
#pragma unroll
            for (int t = 0; t < 16; ++t) { g[t] = G[(kq * 16 + t) * LDG + kd]; qs += g[t]; }
            const int lb4 = lane & ~3;
            const float s0 = __shfl(qs, lb4), s1 = __shfl(qs, lb4 + 1), s2 = __shfl(qs, lb4 + 2), s3 = __shfl(qs, lb4 + 3);
            const float total = (s0 + s1) + (s2 + s3);
            float pref = (kq > 0 ? s0 : 0.f) + (kq > 1 ? s1 : 0.f) + (kq > 2 ? s2 : 0.f);
            unsigned pkv[8];
#pragma unroll
            for (int t = 0; t < 16; ++t) {
                const float pe = pref; pref += g[t];
                const float w = dir ? pe : total - pref;
                const float kv = KK[(kq * 16 + t) * LDG + kd] * fexp_(w);
                if (t & 1) pkv[t >> 1] = pk2(__uint_as_float(pkv[t >> 1]), kv); else pkv[t >> 1] = __float_as_uint(kv);
            }
#pragma unroll
            for (int q = 0; q < 2; ++q) { u32x4 w; w.x = pkv[4 * q]; w.y = pkv[4 * q + 1]; w.z = pkv[4 * q + 2]; w.w = pkv[4 * q + 3]; *(LAS u32x4*)(At + kd * LDT + kq * 16 + q * 8) = w; }
            if (kq == 0) dec[kd] = fexp_(total);
        }
        __syncthreads();
#pragma unroll
        for (int nn = 0; nn < NTL; ++nn)
#pragma unroll
            for (int i = 0; i < 16; ++i) S[0][nn][i] *= dec[wm * 32 + (i & 3) + 8 * (i >> 2) + 4 * (lane >> 5)];
        mma_lds<1, NTL, 4>(S, At + wm * 32 * LDT, LDT, Bt + wn * WTN * LDT, LDT, lane);
        if (n + 1 < nch) store_state((tok0 >> 6) + (dir ? nch - 2 - n : n + 1));
        __syncthreads();
    }
    if (ctx) {
        float* o = MIX ? p.out + (size_t)NTOK * D + (size_t)16 * DEPTH * 2 * 4 * 64 * 128 + ((((size_t)s * DEPTH + l) * 2 + dir) * 4 + hd) * 128 * 128
                       : p.out + (size_t)NTOK * D + ((((size_t)s * DEPTH + l) * 2 + dir) * 4 + hd) * 64 * 128;
#pragma unroll
        for (int nn = 0; nn < NTL; ++nn)
#pragma unroll
            for (int i = 0; i < 16; ++i) {
                const int d = wm * 32 + (i & 3) + 8 * (i >> 2) + 4 * (lane >> 5), v = wn * WTN + nn * 32 + (lane & 31);
                o[(size_t)d * 128 + v] = S[0][nn][i];
            }
    }
}


__device__ __forceinline__ void gmlp_item(const Params& p, int l, int c2, int g, LAS unsigned char* lds) {
    constexpr int LDT = 136;
    LAS bf16_t* Aw = (LAS bf16_t*)lds;
    LAS bf16_t* Bt = Aw + 128 * LDT;
    const int tid = otid(), lane = tid & 63, wid = tid >> 6, wm = wid >> 2, wn = wid & 3;
    const bf16_t* proj = (const bf16_t*)(p.ws + WS_PROJ);
    const int tokb = c2 * 128;
    {
        const float* wsrc = p.gm_ws + ((size_t)l * 4 + g) * 128 * 128;
#pragma unroll
        for (int i = 0; i < 8; ++i) {
            const int e = (i * 512 + tid) * 4, pp = e >> 7, q = e & 127;
            const f32x4 v = *(const f32x4*)(wsrc + e);
            u32x2 w; w.x = pk2(v.x, v.y); w.y = pk2(v.z, v.w);
            *(LAS u32x2*)(Aw + pp * LDT + q) = w;
        }
    }
    {
        const int q = tid >> 2, part = tid & 3;
        const bf16_t* mv = proj + (size_t)(tokb + q) * NPROJ + PJ_MV;
        float s = 0.f, s2 = 0.f;
#pragma unroll
        for (int i = 0; i < 16; ++i) {
            const u32x4 u = *(const u32x4*)(mv + (i * 4 + part) * 8);
            const unsigned uu[4] = {u.x, u.y, u.z, u.w};
#pragma unroll
            for (int j = 0; j < 4; ++j) { const float a = geluf_(bflo(uu[j])), b = geluf_(bfhi(uu[j])); s += a + b; s2 += a * a + b * b; }
        }
        s += __shfl_xor(s, 1); s += __shfl_xor(s, 2); s2 += __shfl_xor(s2, 1); s2 += __shfl_xor(s2, 2);
        const float mean = s * (1.0f / 512.0f), var = fmaxf(s2 * (1.0f / 512.0f) - mean * mean, 0.f), rstd = rsqrtf(var + EPS);
        const float* gg = p.gm_norm_g + (size_t)l * 512 + g * 128 + part * 32;
        const bf16_t* mvg = mv + g * 128 + part * 32;
#pragma unroll
        for (int i = 0; i < 4; ++i) {
            const u32x4 u = *(const u32x4*)(mvg + i * 8);
            const unsigned uu[4] = {u.x, u.y, u.z, u.w};
#pragma unroll
            for (int j = 0; j < 4; ++j) {
                const int c = part * 32 + i * 8 + j * 2;
                const float a = (geluf_(bflo(uu[j])) - mean) * rstd * gg[i * 8 + j * 2], b = (geluf_(bfhi(uu[j])) - mean) * rstd * gg[i * 8 + j * 2 + 1];
                Bt[c * LDT + q] = f2bf(a); Bt[(c + 1) * LDT + q] = f2bf(b);
            }
        }
    }
    __syncthreads();
    f32x16 acc[2][1]; acc_zero<1>(acc);
    mma_lds<2, 1, 8>(acc, Aw + wm * 64 * LDT, LDT, Bt + wn * 32 * LDT, LDT, lane);
    bf16_t* ocat = (bf16_t*)(p.ws + WS_OCAT);
    const float* bs = p.gm_bs + ((size_t)l * 4 + g) * 128;
#pragma unroll
    for (int m = 0; m < 2; ++m)
#pragma unroll
        for (int i = 0; i < 16; ++i) {
            const int pp = wm * 64 + m * 32 + (i & 3) + 8 * (i >> 2) + 4 * (lane >> 5), c = wn * 32 + (lane & 31);
            const float mu = bf2f(proj[(size_t)(tokb + pp) * NPROJ + PJ_MU + g * 128 + c]);
            ocat[(size_t)2 * NTOK * 512 + (size_t)(tokb + pp) * 512 + g * 128 + c] = f2bf(geluf_(mu) * (acc[m][0][i] + bs[pp]));
        }
    __syncthreads();
}

__device__ __forceinline__ void phase_scan(const Params& p, int l, LAS unsigned char* lds) {
    LAS int* slot = (LAS int*)(lds + LDS_BYTES - 16);
    unsigned* ctr = (unsigned*)(p.ws + WS_CTR) + l;
    constexpr int NLAT = 8 * 2 * 4 * 2, NCX = 16 * 2 * 4 * 2, NGM = 160 * 4;
    for (;;) {
        if (otid() == 0) *slot = (int)atomicAdd(ctr, 1u);
        __syncthreads();
        const int j = *slot;
        __syncthreads();
        const int nconv = l + 1 < DEPTH ? CONV_BLOCK_ITEMS : 0;
        if (j >= NLAT + NCX + NGM + nconv) break;
        if (j >= NLAT + NCX + NGM) { convert_weights(p, l + 1, lds, j - (NLAT + NCX + NGM)); __syncthreads(); continue; }
        if (j < NLAT + NCX) {
            int r = j, s;
            if (r < NLAT) { s = 16 + (r >> 4); r &= 15; } else { r -= NLAT; s = r >> 4; r &= 15; }
            const int mix = r & 1, dir = (r >> 1) & 1, hd = r >> 2;
            if (mix) scan_job<1>(p, l, s, dir, hd, lds); else scan_job<0>(p, l, s, dir, hd, lds);
        } else { const int r = j - NLAT - NCX; gmlp_item(p, l, r >> 2, r & 3, lds); }
    }
}

template <int MIX>
__device__ __forceinline__ void out_item(const Params& p, int l, int gc, int hd, LAS unsigned char* lds) {
    constexpr int DK = MIX ? 128 : 64, LQ = DK + 8, LDV = 72, LDG = DK + 1;
    LAS bf16_t* QA = (LAS bf16_t*)lds;
    LAS bf16_t* KA = QA + 128 * LQ;
    LAS bf16_t* QS = KA + 128 * LQ;
    LAS bf16_t* VT = QS + 64 * LQ;
    LAS bf16_t* P = VT + 128 * LDV;
    LAS float* C = (LAS float*)(P + 64 * LDV);
    LAS float* BS = C + (MIX ? 64 : 128) * LDG;
    LAS bf16_t* ST = KA;
    LAS float* Of = (LAS float*)lds;
    const int tid = otid(), lane = tid & 63, wid = __builtin_amdgcn_readfirstlane(tid >> 6);
    const int tokb = gc * 64;
    const bf16_t* proj = (const bf16_t*)(p.ws + WS_PROJ);
    const bf16_t* pr = proj + (size_t)tokb * NPROJ;
    const float* lbs = (const float*)(p.ws + WS_LBS);
    const bf16_t* sbuf = (const bf16_t*)(p.ws + WS_ST + (MIX ? ST_GLA_BYTES : 0));
    constexpr int NPQ = 64 * (DK / 8), NRQ = NPQ / 512;
    u32x4 rq[NRQ], rk[NRQ];
    auto load_raw = [&](int dr) {
        const int kcol0 = MIX ? (dr ? PJ_HFB : PJ_HFF) + hd * 128 : PJ_GK + hd * 64;
        const int qcol0 = MIX ? PJ_HQ + hd * 128 : PJ_GQ + hd * 64;
#pragma unroll
        for (int k = 0; k < NRQ; ++k) { const int e = tid + 512 * k; const int t = e / (DK / 8), c8 = (e % (DK / 8)) * 8;
            rq[k] = *(const u32x4*)(pr + (size_t)t * NPROJ + qcol0 + c8); rk[k] = *(const u32x4*)(pr + (size_t)t * NPROJ + kcol0 + c8); }
    };
    load_raw(0);
    const int kdp = tid & (DK - 1);
    float gnv[16];
    {
        const float* gn = (MIX ? p.hg_norm_g : p.gla_norm_g) + (size_t)l * 512 + hd * 128 + (tid & 7) * 16;
#pragma unroll
        for (int j = 0; j < 16; j += 4) { const f32x4 t4 = *(const f32x4*)(gn + j); gnv[j] = t4.x; gnv[j + 1] = t4.y; gnv[j + 2] = t4.z; gnv[j + 3] = t4.w; }
    }
    const float lbd0 = MIX ? lbs[(size_t)(0 * 4 + l) * 512 + hd * 128 + kdp] : 0.f, lbd1 = MIX ? lbs[(size_t)(1 * 4 + l) * 512 + hd * 128 + kdp] : 0.f;
    if (!MIX) {
        const int gd = wid >> 2, mt = (wid >> 1) & 1, nt = wid & 1, r = lane & 31, h = lane >> 5;
        const bf16x8 afr = *(const bf16x8*)(pr + (size_t)(mt * 32 + r) * NPROJ + (gd ? PJ_GZB : PJ_GZF) + 8 * h);
        const float* lw = p.gla_lr_w + (((size_t)l * 2 + gd) * 16 + 8 * h) * 256 + hd * 64 + nt * 32 + r;
        float wv[8];
#pragma unroll
        for (int j = 0; j < 8; ++j) wv[j] = lw[(size_t)j * 256];
        const float bias = p.gla_lr_b[((size_t)l * 2 + gd) * 256 + hd * 64 + nt * 32 + r];
        u32x4 bw; bw.x = pk2(wv[0], wv[1]); bw.y = pk2(wv[2], wv[3]); bw.z = pk2(wv[4], wv[5]); bw.w = pk2(wv[6], wv[7]);
        f32x16 zacc;
#pragma unroll
        for (int i = 0; i < 16; ++i) zacc[i] = 0.f;
        zacc = __builtin_amdgcn_mfma_f32_32x32x16_bf16(afr, __builtin_bit_cast(bf16x8, bw), zacc, 0, 0, 0);
#pragma unroll
        for (int i = 0; i < 16; ++i) {
            const int t = mt * 32 + (i & 3) + 8 * (i >> 2) + 4 * h;
            C[(gd * 64 + (gd ? 63 - t : t)) * LDG + nt * 32 + r] = logsigmoidf_(zacc[i] + bias) * (1.0f / 16.0f);
        }
    }
    const bf16_t* gatep = pr + (size_t)(tid >> 3) * NPROJ + (MIX ? PJ_HO : PJ_GO) + hd * 128 + (tid & 7) * 16;
    const u32x4 g0 = *(const u32x4*)gatep, g1 = *(const u32x4*)(gatep + 8);
    {
        const int vv = tid & 127, qt = tid >> 7;
        const int vcol = (MIX ? PJ_HI : PJ_GV) + hd * 128 + vv;
        unsigned pkv[8];
#pragma unroll
        for (int t = 0; t < 16; t += 2) {
            const unsigned a = pr[(size_t)(qt * 16 + t) * NPROJ + vcol], b = pr[(size_t)(qt * 16 + t + 1) * NPROJ + vcol];
            pkv[t >> 1] = a | (b << 16);
        }
#pragma unroll
        for (int q = 0; q < 2; ++q) { u32x4 w; w.x = pkv[4 * q]; w.y = pkv[4 * q + 1]; w.z = pkv[4 * q + 2]; w.w = pkv[4 * q + 3]; *(LAS u32x4*)(VT + vv * LDV + qt * 16 + q * 8) = w; }
    }
    const int wm = wid >> 2, wn = wid & 3;
    f32x16 o[1][1];
#pragma unroll
    for (int i = 0; i < 16; ++i) o[0][0][i] = 0.f;

#pragma unroll 1
    for (int dir = 0; dir < 2; ++dir) {
        const int kd = tid & (DK - 1), ba = tid / DK;
#pragma unroll
        for (int k = 0; k < NRQ; ++k) { const int e = tid + 512 * k; const int t = e / (DK / 8), c8 = (e % (DK / 8)) * 8;
            *(LAS u32x4*)(QS + t * LQ + c8) = rq[k]; *(LAS u32x4*)(KA + (64 + (dir ? 63 - t : t)) * LQ + c8) = rk[k]; }
        __syncthreads();
        float gk[16], kk[16]; float lp7 = 0.f, Ta = 0.f;
        if (MIX) {
            const float lb = dir ? lbd1 : lbd0;
            const LAS bf16_t* kz0 = KA + (64 + ba * 16) * LQ + kd;
#pragma unroll
            for (int u = 0; u < 16; ++u) {
                const float sg = sigmoidf_(bf2f(kz0[u * LQ]));
                gk[u] = flog_(lb + (1.0f - lb) * sg); kk[u] = (1.0f - lb) * (1.0f - sg);
                Ta += gk[u]; if (u == 7) lp7 = Ta;
            }
            BS[ba * DK + kd] = Ta;
        } else {
            if (ba < 4) {
#pragma unroll
                for (int u = 0; u < 16; ++u) { gk[u] = C[(dir * 64 + ba * 16 + u) * LDG + kd]; Ta += gk[u]; if (u == 7) lp7 = Ta; }
                BS[ba * DK + kd] = Ta;
            }
        }
        __syncthreads();
        if (ba < 4) {
            const float T0 = BS[kd], T1 = BS[DK + kd], T2 = BS[2 * DK + kd];
            const float base = ba == 0 ? 0.f : ba == 1 ? T0 : ba == 2 ? T0 + T1 : T0 + T1 + T2;
            const float c31 = T0 + T1;
            const float qscale = MIX ? 0.08838834764831845f : 0.125f;
            LAS bf16_t* qz = QA + (64 + ba * 16) * LQ + kd;
            LAS bf16_t* kz = KA + (64 + ba * 16) * LQ + kd;
            LAS bf16_t* xrow = (ba < 2 ? KA + (ba * 16) * LQ : QA + (ba * 16 - 32) * LQ) + kd;
            LAS bf16_t* yrow = ((ba & 1) ? QA + (32 + (ba >> 1) * 16) * LQ : KA + (32 + (ba >> 1) * 16) * LQ) + kd;
            float lp = 0.f;
#pragma unroll
            for (int u = 0; u < 16; ++u) {
                const int pp = ba * 16 + u, t = dir ? 63 - pp : pp;
                lp += gk[u];
                const float c = base + lp;
                const float qv = bf2f(QS[t * LQ + kd]) * qscale;
                const float kt = MIX ? kk[u] : bf2f(kz[u * LQ]);
                QS[t * LQ + kd] = f2bf(qv * fexp_(c));
                qz[u * LQ] = f2bf(qv * fexp_(lp - lp7));
                kz[u * LQ] = f2bf(kt * fexp_(lp7 - lp));
                xrow[u * LQ] = f2bf(ba < 2 ? kt * fexp_(c31 - c) : qv * fexp_(c - c31));
                yrow[u * LQ] = f2bf((ba & 1) ? qv * fexp_(lp) : kt * fexp_(Ta - lp));
            }
        }
        __syncthreads();
        if (dir == 0) load_raw(1);
        constexpr int PIECES = 128 * DK / 8, NPC = PIECES / 512;
        u32x4 stv[NPC];
        {
            const bf16_t* sb = sbuf + (((size_t)gc * 2 + dir) * 4 + hd) * 128 * DK;
#pragma unroll
            for (int k = 0; k < NPC; ++k) { const int e = tid + 512 * k; const int v = e / (DK / 8), d0 = (e % (DK / 8)) * 8; stv[k] = *(const u32x4*)(sb + (size_t)v * DK + d0); }
        }
        if (wid < 4) {
            f32x16 sc[1][1];
#pragma unroll
            for (int i = 0; i < 16; ++i) sc[0][0][i] = 0.f;
            mma_lds<1, 1, DK / 16>(sc, KA + wid * 32 * LQ, LQ, QA + wid * 32 * LQ, LQ, lane);
            const int cc = lane & 31;
#pragma unroll
            for (int q = 0; q < 4; ++q) {
                const int r0 = 8 * q + 4 * (lane >> 5);
                int pi, pj0; bool wr = true, zero = false, tri = false;
                if (wid == 0) { pi = 32 + cc; pj0 = r0; }
                else if (wid == 1) { pi = cc < 16 ? 16 + cc : 32 + cc; pj0 = r0 < 16 ? r0 : r0 + 16; wr = (r0 < 16) == (cc < 16); }
                else { const int off = (wid - 2) * 32; pi = off + cc; pj0 = off + r0; const bool same = (r0 >> 4) == (cc >> 4); tri = same; zero = !same && r0 >= 16; wr = same || zero; }
                float v[4];
#pragma unroll
                for (int e = 0; e < 4; ++e) { float x = sc[0][0][4 * q + e]; if (tri && (r0 + e > cc)) x = 0.f; if (zero) x = 0.f; v[e] = x; }
                if (wr) {
                    u32x2 w;
                    if (dir == 0) { w.x = pk2(v[0], v[1]); w.y = pk2(v[2], v[3]); *(LAS u32x2*)(P + pi * LDV + pj0) = w; }
                    else { w.x = pk2(v[3], v[2]); w.y = pk2(v[1], v[0]); *(LAS u32x2*)(P + (63 - pi) * LDV + (60 - pj0)) = w; }
                }
            }
        } else if (wid == 4) {
#pragma unroll
            for (int k = 0; k < 2; ++k) {
                const int idx = lane * 2 + k, row = idx >> 2, piece = idx & 3;
                const int ti = dir ? 32 + row : row, tj = (dir ? 0 : 32) + piece * 8;
                u32x4 z; z.x = 0; z.y = 0; z.z = 0; z.w = 0;
                *(LAS u32x4*)(P + ti * LDV + tj) = z;
            }
        }
        __syncthreads();
#pragma unroll
        for (int k = 0; k < NPC; ++k) { const int e = tid + 512 * k; const int v = e / (DK / 8), d0 = (e % (DK / 8)) * 8; *(LAS u32x4*)(ST + v * LQ + d0) = stv[k]; }
        mma_lds<1, 1, 4>(o, P + wm * 32 * LDV, LDV, VT + wn * 32 * LDV, LDV, lane);
        __syncthreads();
        mma_lds<1, 1, DK / 16>(o, QS + wm * 32 * LQ, LQ, ST + wn * 32 * LQ, LQ, lane);
        __syncthreads();
    }
#pragma unroll
    for (int i = 0; i < 16; ++i) Of[(wm * 32 + (i & 3) + 8 * (i >> 2) + 4 * (lane >> 5)) * 132 + wn * 32 + (lane & 31)] = o[0][0][i];
    __syncthreads();
    {
        const int i_ = tid >> 3, seg = tid & 7;
        const LAS float* orow = Of + i_ * 132 + seg * 16;
        float v[16]; float ss = 0.f;
#pragma unroll
        for (int j = 0; j < 16; ++j) { v[j] = orow[j]; ss += v[j] * v[j]; }
        ss += __shfl_xor(ss, 1); ss += __shfl_xor(ss, 2); ss += __shfl_xor(ss, 4);
        const float r = rsqrtf(ss * (1.0f / 128.0f) + EPS);
        const unsigned gu[8] = {g0.x, g0.y, g0.z, g0.w, g1.x, g1.y, g1.z, g1.w};
        unsigned ow[8];
#pragma unroll
        for (int j = 0; j < 8; ++j) {
            const float a = v[2 * j] * r * gnv[2 * j] * siluf_(bflo(gu[j])), b = v[2 * j + 1] * r * gnv[2 * j + 1] * siluf_(bfhi(gu[j]));
            ow[j] = pk2(a, b);
        }
        bf16_t* dst = (bf16_t*)(p.ws + WS_OCAT) + (size_t)(MIX ? 1 : 0) * NTOK * 512 + (size_t)(tokb + i_) * 512 + hd * 128 + seg * 16;
        u32x4 w0, w1; w0.x = ow[0]; w0.y = ow[1]; w0.z = ow[2]; w0.w = ow[3]; w1.x = ow[4]; w1.y = ow[5]; w1.z = ow[6]; w1.w = ow[7];
        *(u32x4*)dst = w0; *(u32x4*)(dst + 8) = w1;
    }
    __syncthreads();
}


__device__ __forceinline__ void phase_out(const Params& p, int l, LAS unsigned char* lds) {
    constexpr int NIT = NCHUNK * 4 * 2;
    for (int it = blockIdx.x; it < NIT; it += gridDim.x) {
        const int mix = (it >> 8) & 1, rem = (it & 255) | ((it >> 9) << 8), hd = rem & 3, gc = rem >> 2;
        if (mix) out_item<1>(p, l, gc, hd, lds); else out_item<0>(p, l, gc, hd, lds);
    }
}

__device__ __forceinline__ void phase_merge(const Params& p, int l, LAS unsigned char* lds) {
    const bf16_t* ocat = (const bf16_t*)(p.ws + WS_OCAT);
    const bf16_t* G3 = (const bf16_t*)(p.ws + WS_PROJ);
    const bf16_t* WbrT = (const bf16_t*)(p.ws + WS_W + (size_t)(l & 1) * W_END + W_BR);
    bf16_t* merged = (bf16_t*)(p.ws + WS_ST);
    const int lane = otid() & 63, wid = otid() >> 6, wm = wid >> 2, wn = wid & 3;
    constexpr int nM = NTOK / 128, nN = 8;
    for (int t = blockIdx.x; t < nM * nN; t += gridDim.x) {
        int tm, tn; tile_coords(t, nN, tm, tn);
        const int row0 = tm * 128, col0 = tn * 128;
        f32x16 tot[2][1]; acc_zero<1>(tot);
#pragma unroll 1
        for (int b = 0; b < 3; ++b) {
            f32x16 ba[2][1]; acc_zero<1>(ba);
            gemm_kloop<128>(lds, ocat + (size_t)row0 * 1536 + b * 512, 1536, WbrT + ((size_t)b * D + col0) * 512, 512, 128, 512, ba);
#pragma unroll
            for (int m = 0; m < 2; ++m)
#pragma unroll
                for (int i = 0; i < 16; ++i) {
                    const int row = row0 + wm * 64 + m * 32 + (i & 3) + 8 * (i >> 2) + 4 * (lane >> 5), col = col0 + wn * 32 + (lane & 31);
                    tot[m][0][i] += bf2f(G3[(size_t)row * NGATE + b * 1024 + col]) * ba[m][0][i];
                }
        }
#pragma unroll
        for (int m = 0; m < 2; ++m)
#pragma unroll
            for (int i = 0; i < 16; ++i) {
                const int row = row0 + wm * 64 + m * 32 + (i & 3) + 8 * (i >> 2) + 4 * (lane >> 5), col = col0 + wn * 32 + (lane & 31);
                merged[(size_t)row * D + col] = f2bf(tot[m][0][i]);
            }
    }
}

__device__ __forceinline__ void run_phase(const Params& p, int ph, LAS unsigned char* lds) {
    if (ph == 0) { phase0(p, lds); return; }
    if (ph == NPHASE - 1) { norm_phase(p, p.final_norm_g, nullptr, 0, 0, nullptr, 1); return; }
    const int l = (ph - 1) / 10, sp = (ph - 1) % 10;
    const float* mod_l = (const float*)(p.ws + WS_MOD) + (size_t)l * 9 * 6144;
    bf16_t* hbuf = (bf16_t*)(p.ws + WS_H);
    bf16_t* proj = (bf16_t*)(p.ws + WS_PROJ);
    const unsigned char* wl = p.ws + WS_W + (size_t)(l & 1) * W_END;
    switch (sp) {
        case 0: if (l == 0) convert_weights(p, l, lds); norm_phase(p, p.norm_mix_g + (size_t)l * D, mod_l, 0, 1024, hbuf, 0); break;
        case 1: { PEpiBf16 e{proj, NPROJ, NPROJ, 0}; pg8_gemm(lds, hbuf, (const bf16_t*)(wl + W_IN), NTOK, 5376, D, e); } break;
        case 2: phase_scan(p, l, lds); break;
        case 3: phase_out(p, l, lds); break;
        case 4: {
            PEpiBf16 e{proj, NGATE, NGATE, 2}; pg8_gemm(lds, hbuf, (const bf16_t*)(wl + W_G), NTOK, NGATE, D, e);
            PEpiGate e2{proj, NGATE}; pg8_gemm(lds, (const bf16_t*)(p.ws + WS_OCAT), (const bf16_t*)(wl + W_BR), NTOK, NGATE, 512, e2, (size_t)NTOK * 512 * 2); } break;
        case 5: sum3_phase(p); break;
        case 6: {
            PEpiResid e{p.out, mod_l + 2048}; pg8_gemm(lds, (const bf16_t*)(p.ws + WS_ST), (const bf16_t*)(wl + W_OUT), 16384, D, D, e);
            EpiResidOff e2{p.out, mod_l + 2048, 16384}; gemm_phase<128>(lds, (const bf16_t*)(p.ws + WS_ST) + (size_t)16384 * D, D, (const bf16_t*)(wl + W_OUT), D, NTOK - 16384, D, D, e2); } break;
        case 7: norm_phase(p, p.norm_ffn_g + (size_t)l * D, mod_l, 3072, 4096, hbuf, 0); break;
        case 8: { PEpiBf16 e{proj, DFF, DFF, 1}; pg8_gemm(lds, hbuf, (const bf16_t*)(wl + W_FF1), NTOK, DFF, D, e); } break;
        case 9: { PEpiResid e{p.out, mod_l + 5120}; pg8_gemm(lds, proj, (const bf16_t*)(wl + W_FF2), 16384, D, DFF, e);
            EpiResidOff e2{p.out, mod_l + 5120, 16384}; gemm_phase<128>(lds, proj + (size_t)16384 * DFF, DFF, (const bf16_t*)(wl + W_FF2), DFF, NTOK - 16384, D, DFF, e2); } break;
    }
}

__global__ void __launch_bounds__(512) fwd_megakernel(Params p) {
    extern __shared__ __attribute__((aligned(16))) unsigned char smem[];
    LAS unsigned char* lds = (LAS unsigned char*)smem;
    cg::grid_group grid = cg::this_grid();
    unsigned nbar = 0;
    for (int ph = p.ph_lo; ph < p.ph_hi; ++ph) {
        run_phase(p, ph, lds);
        if (ph + 1 < p.ph_hi) {
            if (ph == 0) grid.sync();
            else { ++nbar; grid_barrier((unsigned*)(p.ws + WS_CTR) + 64, nbar); }
        }
    }
}

extern "C" void kernel_launch(void* const* d_in, const int* in_sizes, int n_in, void* d_out, int out_size, void* d_ws, size_t ws_size, hipStream_t stream) {
    static int grid_blocks = 0;
    if (!grid_blocks) {
        int dev = 0, cus = 0, per_cu = 0;
        hipGetDevice(&dev);
        hipDeviceGetAttribute(&cus, hipDeviceAttributeMultiprocessorCount, dev);
        if (hipFuncSetAttribute((const void*)fwd_megakernel, hipFuncAttributeMaxDynamicSharedMemorySize, LDS_BYTES) != hipSuccess) fprintf(stderr, "hipFuncSetAttribute failed\n");
        hipOccupancyMaxActiveBlocksPerMultiprocessor(&per_cu, (const void*)fwd_megakernel, 512, LDS_BYTES);
        if (per_cu < 1) { fprintf(stderr, "occupancy query says %d blocks/CU\n", per_cu); per_cu = 1; }
        grid_blocks = cus * 1;
        (void)hipGetLastError();
        if (n_in != 26 || ws_size < WS_END) fprintf(stderr, "kernel_launch: unexpected n_in %d or ws_size %zu (need %zu)\n", n_in, ws_size, (size_t)WS_END);
    }
    Params p{};
    const float** pp = (const float**)&p;
    for (int i = 0; i < 26; ++i) pp[i] = (const float*)d_in[i];
    p.out = (float*)d_out; p.ws = (unsigned char*)d_ws; p.ph_lo = 0; p.ph_hi = NPHASE;
    void* args[] = {&p};
    hipError_t e = hipLaunchCooperativeKernel((const void*)fwd_megakernel, dim3(grid_blocks), dim3(512), args, LDS_BYTES, stream);
    if (e != hipSuccess) fprintf(stderr, "cooperative launch failed: %s (grid %d)\n", hipGetErrorString(e), grid_blocks);
}
```

```cpp
#include <hip/hip_runtime.h>
#include <hip/hip_cooperative_groups.h>
#include <cstdio>
namespace cg = cooperative_groups;

#define LAS __attribute__((address_space(3)))
typedef unsigned short bf16_t;
typedef short bf16x8 __attribute__((ext_vector_type(8)));
typedef float f32x16 __attribute__((ext_vector_type(16)));
typedef float f32x4 __attribute__((ext_vector_type(4)));
typedef unsigned u32x4 __attribute__((ext_vector_type(4)));
typedef unsigned u32x2 __attribute__((ext_vector_type(2)));

constexpr int D = 1024, DEPTH = 4, NTOK = 20480, NCTX = 4096, DFF = 4096;
constexpr int DIN = 8224, NPROJ = 5152, NGATE = 3072;
constexpr int PJ_GQ = 0, PJ_GK = 256, PJ_GV = 512, PJ_GO = 1024, PJ_GZF = 1536, PJ_GZB = 1552, PJ_HQ = 1568, PJ_HFF = 2080,
              PJ_HFB = 2592, PJ_HI = 3104, PJ_HO = 3616, PJ_MU = 4128, PJ_MV = 4640;
constexpr int NCHUNK = NTOK / 64;
constexpr float EPS = 1e-6f;
constexpr int LDS_BYTES = 160 * 1024;
constexpr int NPHASE = 2 + DEPTH * 10;

constexpr size_t WS_PROJ = 0;
constexpr size_t WS_ST   = WS_PROJ + (size_t)NTOK * NPROJ * 2;
constexpr size_t ST_GLA_BYTES = (size_t)NCHUNK * 2 * 4 * 128 * 64 * 2, ST_HG_BYTES = (size_t)NCHUNK * 2 * 4 * 128 * 128 * 2;
constexpr size_t WS_OCAT = WS_ST + ST_GLA_BYTES + ST_HG_BYTES;
constexpr size_t WS_H    = WS_OCAT + (size_t)NTOK * 1536 * 2;
constexpr size_t WS_W    = WS_H + (size_t)NTOK * D * 2;
constexpr size_t W_IN = 0, W_G = W_IN + (size_t)NPROJ * D * 2, W_BR = W_G + (size_t)NGATE * D * 2, W_OUT = W_BR + (size_t)3 * D * 512 * 2,
                 W_FF1 = W_OUT + (size_t)D * D * 2, W_FF2 = W_FF1 + (size_t)DFF * D * 2, W_END = W_FF2 + (size_t)D * DFF * 2;
constexpr size_t WS_MOD  = WS_W + 2 * W_END;
constexpr size_t WS_LBS  = WS_MOD + (size_t)DEPTH * 9 * 6144 * 4;
constexpr size_t WS_CTR  = WS_LBS + 2 * 4 * 512 * 4;
constexpr size_t WS_END  = WS_CTR + 4096;

struct Params {
    const float *x_prompt, *x_sample, *c, *state_gla, *state_hgrn, *c_ctx, *ada_w, *ada_b, *norm_mix_g, *norm_ffn_g, *w_in, *gla_lr_w,
        *gla_lr_b, *gla_norm_g, *hg_lb_logits, *hg_norm_g, *gm_norm_g, *gm_ws, *gm_bs, *w_br_gla, *w_br_hg, *w_br_gm, *w_out, *w_ff1, *w_ff2,
        *final_norm_g;
    float* out; unsigned char* ws; int ph_lo, ph_hi;
};

typedef __bf16 bf16x2_t __attribute__((ext_vector_type(2)));
__device__ __forceinline__ unsigned pk2(float lo, float hi) { bf16x2_t v; v.x = (__bf16)lo; v.y = (__bf16)hi; return __builtin_bit_cast(unsigned, v); }
__device__ __forceinline__ bf16_t f2bf(float f) { return (bf16_t)(pk2(f, 0.f) & 0xffffu); }
__device__ __forceinline__ float bf2f(bf16_t h) { return __uint_as_float(((unsigned)h) << 16); }
__device__ __forceinline__ float bflo(unsigned u) { return __uint_as_float(u << 16); }
__device__ __forceinline__ float bfhi(unsigned u) { return __uint_as_float(u & 0xffff0000u); }
__device__ __forceinline__ float fexp_(float x) { return __builtin_amdgcn_exp2f(x * 1.4426950408889634f); }
__device__ __forceinline__ float flog_(float x) { return __builtin_amdgcn_logf(x) * 0.6931471805599453f; }
__device__ __forceinline__ float sigmoidf_(float x) { return __builtin_amdgcn_rcpf(1.0f + fexp_(-x)); }
__device__ __forceinline__ float siluf_(float x) { return x * sigmoidf_(x); }
__device__ __forceinline__ float geluf_(float x) { const float y = 0.7978845608028654f * (x + 0.044715f * x * x * x); const float t = 1.0f - 2.0f * __builtin_amdgcn_rcpf(1.0f + fexp_(2.0f * y)); return 0.5f * x * (1.0f + t); }
__device__ __forceinline__ float logsigmoidf_(float x) { return fminf(x, 0.f) - flog_(1.0f + fexp_(-fabsf(x))); }
__device__ __forceinline__ float wave_sum(float v) {
#pragma unroll
    for (int o = 1; o < 64; o <<= 1) v += __shfl_xor(v, o);
    return v;
}
__device__ __forceinline__ int mod_row(int tok) { return tok < NCTX ? 0 : 1 + ((tok - NCTX) >> 11); }
__device__ __forceinline__ int otid() { int t = (int)__builtin_amdgcn_workitem_id_x(); asm volatile("" : "+v"(t)); return t; }
#define LDS_WAIT() asm volatile("s_waitcnt lgkmcnt(0)" ::: "memory")

template <int MT, int NTL, int KS>
__device__ __forceinline__ void mma_lds(f32x16 (&acc)[MT][NTL], const LAS bf16_t* As, int lda, const LAS bf16_t* Bs, int ldb, int lane) {
    const int r = lane & 31, h = lane >> 5;
    const LAS bf16_t* ap = As + r * lda + h * 8;
    const LAS bf16_t* bp = Bs + r * ldb + h * 8;
#pragma unroll
    for (int ks = 0; ks < KS; ++ks) {
        bf16x8 a[MT], b[NTL];
#pragma unroll
        for (int m = 0; m < MT; ++m) a[m] = *(const LAS bf16x8*)(ap + m * 32 * lda + ks * 16);
#pragma unroll
        for (int n = 0; n < NTL; ++n) b[n] = *(const LAS bf16x8*)(bp + n * 32 * ldb + ks * 16);
#pragma unroll
        for (int m = 0; m < MT; ++m)
#pragma unroll
            for (int n = 0; n < NTL; ++n) acc[m][n] = __builtin_amdgcn_mfma_f32_32x32x16_bf16(a[m], b[n], acc[m][n], 0, 0, 0);
    }
}

template <int BM>
__device__ __forceinline__ void gemm_kloop(LAS unsigned char* lds, const bf16_t* __restrict__ Ag, int lda, const bf16_t* __restrict__ Bg, int ldb, int brows,
                                           int K, f32x16 (&acc)[2][(128 / (8 / (BM / 64))) / 32]) {
    static_assert(BM == 128, "128-row tiles only");
    constexpr int WN = 4, WTN = 32, NTL = 1, LDT = 136, NP = 4;
    LAS bf16_t* As = (LAS bf16_t*)lds;
    LAS bf16_t* Bs = As + 2 * 128 * LDT;
    const int tid = otid(), lane = tid & 63, wid = tid >> 6, wm = wid / WN, wn = wid % WN;
    const int lrow = tid >> 4, lc = (tid & 15) * 8;
    const bf16_t* ap[NP]; const bf16_t* bp[NP];
#pragma unroll
    for (int p = 0; p < NP; ++p) ap[p] = Ag + (size_t)(lrow + p * 32) * lda + lc;
#pragma unroll
    for (int p = 0; p < NP; ++p) { int br = lrow + p * 32; br = br < brows ? br : brows - 1; bp[p] = Bg + (size_t)br * ldb + lc; }
    u32x4 ra[3][NP], rb[3][NP];
    const int nk = K / 128;
#define KL_ISSUE(S, step) do { _Pragma("unroll") for (int p = 0; p < NP; ++p) ra[S][p] = *(const u32x4*)(ap[p] + (step) * 128); \
                               _Pragma("unroll") for (int p = 0; p < NP; ++p) rb[S][p] = *(const u32x4*)(bp[p] + (step) * 128); } while (0)
#define KL_WRITE(S, stage) do { _Pragma("unroll") for (int p = 0; p < NP; ++p) *(LAS u32x4*)(As + (stage) * 128 * LDT + (lrow + p * 32) * LDT + lc) = ra[S][p]; \
                                _Pragma("unroll") for (int p = 0; p < NP; ++p) *(LAS u32x4*)(Bs + (stage) * 128 * LDT + (lrow + p * 32) * LDT + lc) = rb[S][p]; } while (0)
#define KL_STEP(J, JN) if (kt + J < nk) { const int s_ = kt + J; if (s_ + 3 < nk) KL_ISSUE(J, s_ + 3); \
        mma_lds<2, NTL, 8>(acc, As + (s_ & 1) * 128 * LDT + wm * 64 * LDT, LDT, Bs + (s_ & 1) * 128 * LDT + wn * WTN * LDT, LDT, lane); \
        if (s_ + 1 < nk) KL_WRITE(JN, (s_ + 1) & 1); __syncthreads(); }
    KL_ISSUE(0, 0); if (nk > 1) KL_ISSUE(1, 1); if (nk > 2) KL_ISSUE(2, 2);
    KL_WRITE(0, 0);
    __syncthreads();
    for (int kt = 0; kt < nk; kt += 3) { KL_STEP(0, 1) KL_STEP(1, 2) KL_STEP(2, 0) }
#undef KL_ISSUE
#undef KL_WRITE
#undef KL_STEP
}

template <int NTL>
__device__ __forceinline__ void acc_zero(f32x16 (&acc)[2][NTL]) {
#pragma unroll
    for (int m = 0; m < 2; ++m)
#pragma unroll
        for (int n = 0; n < NTL; ++n)
#pragma unroll
            for (int i = 0; i < 16; ++i) acc[m][n][i] = 0.f;
}

__device__ __forceinline__ void tile_coords(int t, int nN, int& tm, int& tn) { const int q = t >> 3; tn = q % nN; tm = (q / nN) * 8 + (t & 7); }

template <int BM, class Epi>
__device__ __forceinline__ void gemm_phase(LAS unsigned char* lds, const bf16_t* A, int lda, const bf16_t* Bt, int ldb, int M, int N, int K, const Epi& epi) {
    constexpr int WM = BM / 64, WN = 8 / WM, WTN = 128 / WN, NTL = WTN / 32;
    const int nM = M / BM, nN = (N + 127) / 128, ntiles = nM * nN;
    const int lane = otid() & 63, wid = otid() >> 6, wm = wid / WN, wn = wid % WN;
    for (int t = blockIdx.x; t < ntiles; t += gridDim.x) {
        int tm, tn; tile_coords(t, nN, tm, tn);
        const int row0 = tm * BM, col0 = tn * 128;
        f32x16 acc[2][NTL]; acc_zero<NTL>(acc);
        gemm_kloop<BM>(lds, A + (size_t)row0 * lda, lda, Bt + (size_t)col0 * ldb, ldb, min(128, N - col0), K, acc);
#pragma unroll
        for (int m = 0; m < 2; ++m)
#pragma unroll
            for (int n = 0; n < NTL; ++n) {
                const int col = col0 + wn * WTN + n * 32 + (lane & 31);
#pragma unroll
                for (int i = 0; i < 16; ++i) {
                    const int row = row0 + wm * 64 + m * 32 + (i & 3) + 8 * (i >> 2) + 4 * (lane >> 5);
                    epi(row, col, acc[m][n][i]);
                }
            }
    }
}

struct EpiBf16 { bf16_t* C; int ldc, N; __device__ __forceinline__ void operator()(int row, int col, float v) const { if (col < N) C[(size_t)row * ldc + col] = f2bf(v); } };
struct EpiRelu2 { bf16_t* C; int ldc; __device__ __forceinline__ void operator()(int row, int col, float v) const { v = fmaxf(v, 0.f); C[(size_t)row * ldc + col] = f2bf(v * v); } };
struct EpiResidOff { float* x; const float* gate; int roff; __device__ __forceinline__ void operator()(int row, int col, float v) const {
    const int r = row + roff; const float g = gate[mod_row(r) * 6144 + col]; float* p = x + (size_t)r * D + col; *p = *p + g * v; } };
struct EpiResid { float* x; const float* gate;   __device__ __forceinline__ void operator()(int row, int col, float v) const {
    const float g = gate[mod_row(row) * 6144 + col]; float* p = x + (size_t)row * D + col; *p = *p + g * v; } };

namespace pg8 {
#define PG8_LAS __attribute__((address_space(3)))
typedef unsigned short bf16_t;
typedef short bf16x8 __attribute__((ext_vector_type(8)));
typedef float f32x4 __attribute__((ext_vector_type(4)));
typedef unsigned u32x4 __attribute__((ext_vector_type(4)));
constexpr int BM = 256, BK = 64, HALF = 128, HTB = HALF * BK * 2  , STAGE_BYTES = 8 * HTB, NXCD = 8, WGM = 8;

__host__ __device__ __forceinline__ int lds_byte(int r, int c) { const int st = (r >> 4) * 2 + (c >> 5), rr = r & 15, cc = c & 31, ob = rr * 64 + cc * 2; return st * 1024 + (ob ^ (((ob >> 9) & 1) << 5)); }
__host__ __device__ __forceinline__ void stage_rc(int b, int& R, int& C) { const int st = b / 1024, sb = b % 1024, swz = sb ^ (((sb >> 9) & 1) << 5); R = (st >> 1) * 16 + swz / 64; C = (st & 1) * 32 + (swz % 64) / 2; }
__host__ __device__ __forceinline__ int perm32(int rho) { const int n = rho >> 4, i = rho & 15; return 8 * (i >> 2) + 4 * n + (i & 3); }

struct Unit { int pm, pn; };
struct Gemm { const bf16_t* A; const bf16_t* Bt; int M, N, K; size_t agrp; };

struct StaticOrder {
    int nM, nN, nwg, G, c;
    __host__ __device__ void init(int M, int N, int G_, int c_) { nM = M / BM; nN = N / BM; nwg = nM * nN; G = G_; c = c_; }
    __host__ __device__ bool next(int i, Unit& u) const {
        const long L = (long)i * G + c; if (L >= nwg) return false;
        int wgid = (int)L; { const int q = nwg / NXCD, r = nwg % NXCD, xcd = wgid % NXCD, off = wgid / NXCD; wgid = (xcd < r ? xcd * (q + 1) : r * (q + 1) + (xcd - r) * q) + off; }
        const int nig = WGM * nN, gid = wgid / nig, fm = gid * WGM, gsz = (nM - fm) < WGM ? (nM - fm) : WGM;
        u.pm = fm + ((wgid % nig) % gsz); u.pn = (wgid % nig) / gsz; return true;
    }
    __device__ __forceinline__ void a_ready(const Unit&) const {}
    __device__ __forceinline__ void done(const Unit&) const {}
};
__device__ __forceinline__ unsigned cvt_pk_bf16(float lo, float hi) { unsigned r; asm volatile("v_cvt_pk_bf16_f32 %0, %1, %2" : "=v"(r) : "v"(lo), "v"(hi)); return r; }
template <class Epi, class Sched, bool STAMP = false>
__device__ __forceinline__ void gemm_phase(PG8_LAS unsigned char* lds, const Gemm g, const Sched& S, const Epi& E, unsigned long long* stamps) {
    const int tid = otid(), wid = __builtin_amdgcn_readfirstlane(tid >> 6), lane = tid & 63, wr = wid >> 2, wc = wid & 3, fr = lane & 15, fq = lane >> 4;
    const int K = g.K, nt = K / BK;
    int ts_lo = 0, ts_hi = 0, nts = 0; const unsigned long long rt_entry = STAMP ? (unsigned long long)wall_clock64() : 0ull;
#define PG8_STAMP() do { if (STAMP && wid == 0 && nts < 64) { const unsigned long long _c = (unsigned long long)clock64(); \
        ts_lo = (lane == nts) ? (int)(unsigned)_c : ts_lo; ts_hi = (lane == nts) ? (int)(unsigned)(_c >> 32) : ts_hi; ++nts; } } while (0)
    PG8_STAMP();
    unsigned voffA[2], voffB[2];
#pragma unroll
    for (int i = 0; i < 2; ++i) { int R, C; stage_rc(tid * 16 + i * 8192, R, C); const int Rb = Epi::PERM ? ((R & ~31) + perm32(R & 31)) : R;
        voffA[i] = (unsigned)(R * K + C) * 2u; voffB[i] = (unsigned)(Rb * K + C) * 2u; }
    const size_t kstep = (size_t)(BK * 2);
    const size_t hstep = (size_t)HALF * K * 2;
    const size_t tstep = 2 * hstep;
    const unsigned ldsw = (unsigned)wid * 1024u;
    const int aoff = lds_byte(wr * 64 + fr, fq * 8), boff = lds_byte(wc * 32 + fr, fq * 8);
#define PG8_SA(b, h) (((b) * 2 + (h)) * HTB)
#define PG8_SB(b, h) ((4 + (b) * 2 + (h)) * HTB)
#define PG8_STAGE(bufoff, gbase, voff) do { _Pragma("unroll") for (int _i = 0; _i < 2; ++_i) \
        __builtin_amdgcn_global_load_lds((const unsigned*)((const char*)(gbase) + (voff)[_i]), (PG8_LAS unsigned*)(lds + (bufoff) + ldsw + _i * 8192), 16, 0, 0); } while (0)
#define PG8_LDA(dst, b, h) do { _Pragma("unroll") for (int m = 0; m < 4; ++m) _Pragma("unroll") for (int k = 0; k < 2; ++k) dst[m][k] = *(const PG8_LAS bf16x8*)(lds + PG8_SA(b, h) + aoff + m * 2048 + k * 1024); } while (0)
#define PG8_LDB(dst, b, h) do { _Pragma("unroll") for (int n = 0; n < 2; ++n) _Pragma("unroll") for (int k = 0; k < 2; ++k) dst[n][k] = *(const PG8_LAS bf16x8*)(lds + PG8_SB(b, h) + boff + n * 2048 + k * 1024); } while (0)
#define PG8_MMA(ai, bj, At, Bt) do { __builtin_amdgcn_s_setprio(1); _Pragma("unroll") for (int m = 0; m < 4; ++m) _Pragma("unroll") for (int n = 0; n < 2; ++n) _Pragma("unroll") for (int k = 0; k < 2; ++k) \
        acc[ai][bj][m][n] = __builtin_amdgcn_mfma_f32_16x16x32_bf16(Bt[n][k], At[m][k], acc[ai][bj][m][n], 0, 0, 0); __builtin_amdgcn_s_setprio(0); } while (0)
#define PG8_WAIT_V(n) asm volatile("s_waitcnt vmcnt(" #n ")" ::: "memory")
#define PG8_WAIT_L(n) asm volatile("s_waitcnt lgkmcnt(" #n ")" ::: "memory")
#define PG8_BAR __builtin_amdgcn_s_barrier()
#define PG8_SCHED __builtin_amdgcn_sched_barrier(0)
    Unit cur, nxt; int ui = 0;
    if (!S.next(0, cur)) return;
    f32x4 acc[2][2][4][2];
#pragma unroll
    for (int a = 0; a < 2; ++a)
#pragma unroll
        for (int b = 0; b < 2; ++b)
#pragma unroll
            for (int m = 0; m < 4; ++m)
#pragma unroll
                for (int n = 0; n < 2; ++n) acc[a][b][m][n] = (f32x4){0.f, 0.f, 0.f, 0.f};
    bf16x8 At[4][2], B0[2][2], B1[2][2];
    const char* cA = (const char*)g.A + (size_t)cur.pm * tstep + (size_t)(cur.pn >> 2) * g.agrp; const char* cB = (const char*)g.Bt + (size_t)cur.pn * tstep;
    S.a_ready(cur);
    PG8_STAGE(PG8_SB(0, 0), cB, voffB); PG8_STAGE(PG8_SA(0, 0), cA, voffA); PG8_STAGE(PG8_SB(0, 1), cB + hstep, voffB); PG8_STAGE(PG8_SA(0, 1), cA + hstep, voffA);
    if (wr == 1) PG8_BAR;
    PG8_WAIT_V(4); PG8_BAR;
    PG8_STAGE(PG8_SB(1, 0), cB + kstep, voffB); PG8_STAGE(PG8_SA(1, 0), cA + kstep, voffA); PG8_STAGE(PG8_SB(1, 1), cB + hstep + kstep, voffB);
    PG8_WAIT_V(6); PG8_BAR;
    PG8_STAMP();
    for (;;) {
        const bool has_next = S.next(ui + 1, nxt);
        const char* nA = has_next ? (const char*)g.A + (size_t)nxt.pm * tstep + (size_t)(nxt.pn >> 2) * g.agrp : cA; const char* nB = has_next ? (const char*)g.Bt + (size_t)nxt.pn * tstep : cB;
        for (int t = 0; t < nt; t += 2) {
            const bool last = (t == nt - 2);
            const char* a1 = cA + (size_t)(t + 1) * kstep;
            const char* a2 = last ? nA : cA + (size_t)(t + 2) * kstep; const char* b2 = last ? nB : cB + (size_t)(t + 2) * kstep;
            const char* a3 = a2 + kstep; const char* b3 = b2 + kstep;
            if (last && has_next) S.a_ready(nxt);
            PG8_LDB(B0, 0, 0); PG8_SCHED; PG8_LDA(At, 0, 0); PG8_STAGE(PG8_SA(1, 1), a1 + hstep, voffA);
            PG8_WAIT_L(8); PG8_BAR; PG8_WAIT_L(0); PG8_MMA(0, 0, At, B0); PG8_BAR; PG8_SCHED;
            PG8_LDB(B1, 0, 1); PG8_STAGE(PG8_SB(0, 0), b2, voffB);
            PG8_BAR; PG8_WAIT_L(0); PG8_MMA(0, 1, At, B1); PG8_BAR;
            PG8_LDA(At, 0, 1); PG8_STAGE(PG8_SA(0, 0), a2, voffA);
            PG8_BAR; PG8_WAIT_L(0); PG8_MMA(1, 0, At, B0); PG8_BAR; PG8_SCHED;
            PG8_STAGE(PG8_SB(0, 1), b2 + hstep, voffB);
            PG8_WAIT_V(6); PG8_BAR; PG8_MMA(1, 1, At, B1); PG8_BAR;
            PG8_LDB(B0, 1, 0); PG8_SCHED; PG8_LDA(At, 1, 0); PG8_STAGE(PG8_SA(0, 1), a2 + hstep, voffA);
            PG8_WAIT_L(8); PG8_BAR; PG8_WAIT_L(0); PG8_MMA(0, 0, At, B0); PG8_BAR; PG8_SCHED;
            PG8_LDB(B1, 1, 1); PG8_STAGE(PG8_SB(1, 0), b3, voffB);
            PG8_BAR; PG8_WAIT_L(0); PG8_MMA(0, 1, At, B1); PG8_BAR;
            PG8_LDA(At, 1, 1); PG8_STAGE(PG8_SA(1, 0), a3, voffA);
            PG8_BAR; PG8_WAIT_L(0); PG8_MMA(1, 0, At, B0); PG8_BAR; PG8_SCHED;
            PG8_STAGE(PG8_SB(1, 1), b3 + hstep, voffB);
            PG8_WAIT_V(6); PG8_BAR; PG8_MMA(1, 1, At, B1); PG8_BAR;
        }
        PG8_STAMP();
        if constexpr (!Epi::AFTER_DRAIN) { E(acc, cur, wr, wc, fr, fq); S.done(cur); }
        PG8_STAMP();
        if (!has_next) break;
#pragma unroll
        for (int a = 0; a < 2; ++a)
#pragma unroll
            for (int b = 0; b < 2; ++b)
#pragma unroll
                for (int m = 0; m < 4; ++m)
#pragma unroll
                    for (int n = 0; n < 2; ++n) acc[a][b][m][n] = (f32x4){0.f, 0.f, 0.f, 0.f};
        cur = nxt; cA = nA; cB = nB; ++ui;
    }
    PG8_WAIT_V(0);
    if (wr == 0) PG8_BAR;
    PG8_BAR;
    if constexpr (Epi::AFTER_DRAIN) { E.fused(acc, cur, wr, wc, fr, fq, lds, wid, lane); S.done(cur); }
    PG8_STAMP();
    if (STAMP && wid == 0) { stamps[lane] = lane < nts ? (((unsigned long long)(unsigned)ts_hi << 32) | (unsigned)ts_lo) : 0ull;
        if (lane == 62) stamps[62] = rt_entry; if (lane == 63) stamps[63] = (unsigned long long)wall_clock64(); }
#undef PG8_STAMP
#undef PG8_SA
#undef PG8_SB
#undef PG8_STAGE
#undef PG8_LDA
#undef PG8_LDB
#undef PG8_MMA
#undef PG8_WAIT_V
#undef PG8_WAIT_L
#undef PG8_BAR
#undef PG8_SCHED
}
}

struct PEpiBf16 {
    static constexpr bool PERM = true, AFTER_DRAIN = false;
    bf16_t* C; int ldc, N, act;
    __device__ __forceinline__ void operator()(const pg8::f32x4 (&acc)[2][2][4][2], const pg8::Unit& u, int wr, int wc, int fr, int fq) const {
        const int row0 = u.pm * 256 + wr * 64 + fr, col0 = u.pn * 256 + wc * 32 + 8 * fq;
#pragma unroll
        for (int ai = 0; ai < 2; ++ai)
#pragma unroll
            for (int m = 0; m < 4; ++m) {
                bf16_t* rowp = C + (size_t)(row0 + ai * 128 + m * 16) * ldc;
#pragma unroll
                for (int bj = 0; bj < 2; ++bj) {
                    const int col = col0 + bj * 128;
                    pg8::f32x4 v0 = acc[ai][bj][m][0], v1 = acc[ai][bj][m][1];
                    if (act == 1) { v0.x = fmaxf(v0.x, 0.f); v0.y = fmaxf(v0.y, 0.f); v0.z = fmaxf(v0.z, 0.f); v0.w = fmaxf(v0.w, 0.f); v0 = v0 * v0;
                                    v1.x = fmaxf(v1.x, 0.f); v1.y = fmaxf(v1.y, 0.f); v1.z = fmaxf(v1.z, 0.f); v1.w = fmaxf(v1.w, 0.f); v1 = v1 * v1; }
                    if (act == 2) { v0.x = sigmoidf_(v0.x); v0.y = sigmoidf_(v0.y); v0.z = sigmoidf_(v0.z); v0.w = sigmoidf_(v0.w);
                                    v1.x = sigmoidf_(v1.x); v1.y = sigmoidf_(v1.y); v1.z = sigmoidf_(v1.z); v1.w = sigmoidf_(v1.w); }
                    u32x4 w; w.x = pk2(v0.x, v0.y); w.y = pk2(v0.z, v0.w); w.z = pk2(v1.x, v1.y); w.w = pk2(v1.z, v1.w);
                    if (col < N) *(u32x4*)(rowp + col) = w;
                }
            }
    }
};
struct PEpiResid {
    static constexpr bool PERM = true, AFTER_DRAIN = false;
    float* x; const float* gate;
    __device__ __forceinline__ void operator()(const pg8::f32x4 (&acc)[2][2][4][2], const pg8::Unit& u, int wr, int wc, int fr, int fq) const {
        const int row0 = u.pm * 256 + wr * 64 + fr, col0 = u.pn * 256 + wc * 32 + 8 * fq;
#pragma unroll
        for (int ai = 0; ai < 2; ++ai)
#pragma unroll
            for (int m = 0; m < 4; ++m) {
                const int row = row0 + ai * 128 + m * 16;
                float* rowp = x + (size_t)row * D; const float* gp = gate + (size_t)mod_row(row) * 6144;
#pragma unroll
                for (int bj = 0; bj < 2; ++bj) {
                    const int col = col0 + bj * 128;
                    const f32x4 g0 = *(const f32x4*)(gp + col), g1 = *(const f32x4*)(gp + col + 4);
                    f32x4 x0 = *(const f32x4*)(rowp + col), x1 = *(const f32x4*)(rowp + col + 4);
                    x0 = x0 + g0 * acc[ai][bj][m][0]; x1 = x1 + g1 * acc[ai][bj][m][1];
                    *(f32x4*)(rowp + col) = x0; *(f32x4*)(rowp + col + 4) = x1;
                }
            }
    }
};
struct PEpiGate {
    static constexpr bool PERM = true, AFTER_DRAIN = false;
    bf16_t* G; int ldc;
    __device__ __forceinline__ void operator()(const pg8::f32x4 (&acc)[2][2][4][2], const pg8::Unit& u, int wr, int wc, int fr, int fq) const {
        const int row0 = u.pm * 256 + wr * 64 + fr, col0 = u.pn * 256 + wc * 32 + 8 * fq;
#pragma unroll
        for (int ai = 0; ai < 2; ++ai)
#pragma unroll
            for (int m = 0; m < 4; ++m) {
                bf16_t* rowp = G + (size_t)(row0 + ai * 128 + m * 16) * ldc;
#pragma unroll
                for (int bj = 0; bj < 2; ++bj) {
                    const int col = col0 + bj * 128;
                    const u32x4 g = *(const u32x4*)(rowp + col);
                    const pg8::f32x4 v0 = acc[ai][bj][m][0], v1 = acc[ai][bj][m][1];
                    u32x4 w; w.x = pk2(bflo(g.x) * v0.x, bfhi(g.x) * v0.y); w.y = pk2(bflo(g.y) * v0.z, bfhi(g.y) * v0.w);
                    w.z = pk2(bflo(g.z) * v1.x, bfhi(g.z) * v1.y); w.w = pk2(bflo(g.w) * v1.z, bfhi(g.w) * v1.w);
                    *(u32x4*)(rowp + col) = w;
                }
            }
    }
};
__device__ __forceinline__ void sum3_phase(const Params& p) {
    const bf16_t* Y = (const bf16_t*)(p.ws + WS_PROJ); bf16_t* merged = (bf16_t*)(p.ws + WS_ST);
    for (size_t i = (size_t)blockIdx.x * 512 + otid(); i < (size_t)NTOK * (D / 8); i += (size_t)gridDim.x * 512) {
        const size_t row = i >> 7; const int c8 = (int)(i & 127) * 8;
        const bf16_t* yr = Y + row * NGATE + c8;
        const u32x4 a = *(const u32x4*)yr, b = *(const u32x4*)(yr + 1024), c = *(const u32x4*)(yr + 2048);
        u32x4 w; w.x = pk2(bflo(a.x) + bflo(b.x) + bflo(c.x), bfhi(a.x) + bfhi(b.x) + bfhi(c.x)); w.y = pk2(bflo(a.y) + bflo(b.y) + bflo(c.y), bfhi(a.y) + bfhi(b.y) + bfhi(c.y));
        w.z = pk2(bflo(a.z) + bflo(b.z) + bflo(c.z), bfhi(a.z) + bfhi(b.z) + bfhi(c.z)); w.w = pk2(bflo(a.w) + bflo(b.w) + bflo(c.w), bfhi(a.w) + bfhi(b.w) + bfhi(c.w));
        *(u32x4*)(merged + row * D + c8) = w;
    }
}
template <class Epi>
__device__ __forceinline__ void pg8_gemm(LAS unsigned char* lds, const bf16_t* A, const bf16_t* Bt, int M, int N, int K, const Epi& e, size_t agrp = 0) {
    pg8::Gemm g{A, Bt, M, N, K, agrp};
    pg8::StaticOrder so; so.init(M, N, (int)gridDim.x, (int)blockIdx.x);
    pg8::gemm_phase<Epi, pg8::StaticOrder, false>(lds, g, so, e, nullptr);
    __syncthreads();
}

__device__ __forceinline__ void grid_barrier(unsigned* bar, unsigned k) {
    asm volatile("s_waitcnt vmcnt(0)" ::: "memory");
    __syncthreads();
    if (otid() == 0) {
        const unsigned g = blockIdx.x & 7u, ng = (gridDim.x + 7u - g) >> 3;
        __builtin_amdgcn_fence(__ATOMIC_RELEASE, "agent");
        asm volatile("s_waitcnt vmcnt(0)" ::: "memory");
        const unsigned c = __hip_atomic_fetch_add(bar + 16 * g, 1u, __ATOMIC_RELAXED, __HIP_MEMORY_SCOPE_AGENT);
        if (c == ng * k - 1u) {
            const unsigned ngroups = gridDim.x < 8u ? gridDim.x : 8u;
            const unsigned t = __hip_atomic_fetch_add(bar + 128, 1u, __ATOMIC_RELAXED, __HIP_MEMORY_SCOPE_AGENT);
            if (t == ngroups * k - 1u)
                for (unsigned j = 0; j < ngroups; ++j) __hip_atomic_store(bar + 144 + 16 * j, k, __ATOMIC_RELAXED, __HIP_MEMORY_SCOPE_AGENT);
        }
        unsigned spins = 0;
        while (__hip_atomic_load(bar + 144 + 16 * g, __ATOMIC_RELAXED, __HIP_MEMORY_SCOPE_AGENT) < k && ++spins < (1u << 28)) __builtin_amdgcn_s_sleep(1);
        __builtin_amdgcn_fence(__ATOMIC_ACQUIRE, "agent");
        asm volatile("s_waitcnt vmcnt(0)" ::: "memory");
    }
    __syncthreads();
}

__device__ __forceinline__ void transpose_item(const float* __restrict__ W, int N, int K, int k0, int n0, bf16_t* __restrict__ dst  , LAS float* scr, int lane) {
#pragma unroll 8
    for (int i = 0; i < 32; ++i) { const int kk = 2 * i + (lane >> 5); scr[kk * 33 + (lane & 31)] = W[(size_t)(k0 + kk) * N + n0 + (lane & 31)]; }
    LDS_WAIT();
    const int c = lane & 7;
#pragma unroll
    for (int j = 0; j < 4; ++j) {
        const int n = (lane >> 3) + 8 * j; const LAS float* s = scr + (8 * c) * 33 + n;
        u32x4 o; o.x = pk2(s[0 * 33], s[1 * 33]); o.y = pk2(s[2 * 33], s[3 * 33]); o.z = pk2(s[4 * 33], s[5 * 33]); o.w = pk2(s[6 * 33], s[7 * 33]);
        *(u32x4*)(dst + (size_t)n * K + k0 + 8 * c) = o;
    }
    LDS_WAIT();
}

constexpr int CONV_NIT = 16 * 257 + 3 * 8 * 32 + 16 * 32 + 16 * 128 + 64 * 32, CONV_BLOCK_ITEMS = (CONV_NIT + 7) / 8;
__device__ __forceinline__ void convert_weights(const Params& p, int l, LAS unsigned char* lds, int bitem = -1) {
    const int lane = otid() & 63, wid = otid() >> 6;
    LAS float* scr = (LAS float*)(lds + wid * 16384);
    unsigned char* wb = p.ws + WS_W + (size_t)(l & 1) * W_END;
    constexpr int I_IN = 16 * 257, I_BR = 8 * 32, I_OUT = 16 * 32, I_FF1 = 16 * 128, I_FF2 = 64 * 32;
    constexpr int NIT = I_IN + 3 * I_BR + I_OUT + I_FF1 + I_FF2;
    for (int it = (bitem < 0 ? blockIdx.x * 8 + wid : bitem * 8 + wid); it < NIT; it += (bitem < 0 ? gridDim.x * 8 : NIT)) {
        int r = it;
        if (r < I_IN) { const int kb = r / 257, nb = r % 257, n0 = nb * 32;
            bf16_t* dst = n0 < NPROJ ? (bf16_t*)(wb + W_IN) + (size_t)n0 * D : (bf16_t*)(wb + W_G) + (size_t)(n0 - NPROJ) * D;
            transpose_item(p.w_in + (size_t)l * D * DIN, DIN, D, kb * 64, n0, dst, scr, lane); continue; }
        r -= I_IN;
        if (r < 3 * I_BR) { const int b = r / I_BR, q = r % I_BR, kb = q / 32, nb = q % 32;
            const float* W = (b == 0 ? p.w_br_gla : b == 1 ? p.w_br_hg : p.w_br_gm) + (size_t)l * 512 * D;
            transpose_item(W, D, 512, kb * 64, nb * 32, (bf16_t*)(wb + W_BR) + (size_t)b * D * 512 + (size_t)nb * 32 * 512, scr, lane); continue; }
        r -= 3 * I_BR;
        if (r < I_OUT) { const int kb = r / 32, nb = r % 32;
            transpose_item(p.w_out + (size_t)l * D * D, D, D, kb * 64, nb * 32, (bf16_t*)(wb + W_OUT) + (size_t)nb * 32 * D, scr, lane); continue; }
        r -= I_OUT;
        if (r < I_FF1) { const int kb = r / 128, nb = r % 128;
            transpose_item(p.w_ff1 + (size_t)l * D * DFF, DFF, D, kb * 64, nb * 32, (bf16_t*)(wb + W_FF1) + (size_t)nb * 32 * D, scr, lane); continue; }
        r -= I_FF1;
        { const int kb = r / 32, nb = r % 32;
            transpose_item(p.w_ff2 + (size_t)l * DFF * D, D, DFF, kb * 64, nb * 32, (bf16_t*)(wb + W_FF2) + (size_t)nb * 32 * DFF, scr, lane); }
    }
}

__device__ __forceinline__ void phase0(const Params& p, LAS unsigned char* lds) {
    const int tid = otid();
    float* x = p.out;
    for (size_t i = (size_t)blockIdx.x * 512 + tid; i < (size_t)NTOK * (D / 4); i += (size_t)gridDim.x * 512) {
        const int tok = (int)(i >> 8), c4 = (int)(i & 255) * 4;
        f32x4 v;
        if (tok < NCTX) v = *(const f32x4*)(p.x_prompt + (size_t)tok * D + c4);
        else {
            const int lt = tok - NCTX; v = *(const f32x4*)(p.x_sample + (size_t)lt * D + c4);
            const int t = lt & 2047; const float rr = (float)(t >> 6), cc = (float)(t & 63);
            const int sec = c4 >> 8; const float pos = sec < 2 ? rr : cc;
#pragma unroll
            for (int j = 0; j < 4; ++j) {
                const int f = (c4 + j) & 255;
                const float omega = exp2f((float)f * (-13.287712379549449f / 256.0f));
                const float a = pos * omega;
                v[j] += (sec & 1) ? __cosf(a) : __sinf(a);
            }
        }
        *(f32x4*)(x + i * 4) = v;
    }
    if (blockIdx.x == 0) {
        float* lbs = (float*)(p.ws + WS_LBS);
        for (int i = tid; i < 1024; i += 512) {
            const int dir = i >> 9, ch = i & 511; float lg[4], mx = -1e30f;
            for (int l = 0; l < 4; ++l) { lg[l] = p.hg_lb_logits[(size_t)(dir * 4 + l) * 512 + ch]; mx = fmaxf(mx, lg[l]); }
            float s = 0.f; for (int l = 0; l < 4; ++l) { lg[l] = expf(lg[l] - mx); s += lg[l]; }
            float cum = 0.f, c0 = 0.f;
            for (int l = 0; l < 4; ++l) { cum += lg[l] / s; if (l == 0) c0 = cum; lbs[(size_t)(dir * 4 + l) * 512 + ch] = cum - c0; }
        }
        for (int i = tid; i < 1024; i += 512) ((unsigned*)(p.ws + WS_CTR))[i] = 0u;
    }
    LAS float* sc = (LAS float*)lds;
    LAS float* red = sc + 9 * 1024;
    for (int i = tid; i < 9 * 1024; i += 512) { const int r = i >> 10, k = i & 1023; const float v = r == 0 ? p.c_ctx[k] : p.c[(size_t)(r - 1) * D + k]; sc[i] = siluf_(v); }
    __syncthreads();
    float* mod = (float*)(p.ws + WS_MOD);
    for (int u = blockIdx.x; u < DEPTH * 48; u += gridDim.x) {
        const int l = u / 48, cb = u % 48, cl = tid & 127, kp = tid >> 7, n = cb * 128 + cl;
        const float* w = p.ada_w + (size_t)l * D * 6144 + n;
        float a[9];
#pragma unroll
        for (int r = 0; r < 9; ++r) a[r] = 0.f;
#pragma unroll 4
        for (int k = kp * 256; k < kp * 256 + 256; ++k) {
            const float wv = w[(size_t)k * 6144];
#pragma unroll
            for (int r = 0; r < 9; ++r) a[r] += sc[r * 1024 + k] * wv;
        }
#pragma unroll
        for (int r = 0; r < 9; ++r) red[(kp * 9 + r) * 128 + cl] = a[r];
        __syncthreads();
        for (int i = tid; i < 9 * 128; i += 512) {
            const int r = i >> 7, c2 = i & 127;
            const float s = red[(0 * 9 + r) * 128 + c2] + red[(1 * 9 + r) * 128 + c2] + red[(2 * 9 + r) * 128 + c2] + red[(3 * 9 + r) * 128 + c2];
            mod[((size_t)l * 9 + r) * 6144 + cb * 128 + c2] = s + p.ada_b[(size_t)l * 6144 + cb * 128 + c2];
        }
        __syncthreads();
    }
}

__device__ __forceinline__ void norm_phase(const Params& p, const float* g, const float* mod_l, int off_sh, int off_sc, bf16_t* hout, int mode) {
    const int lane = otid() & 63, wid = otid() >> 6;
    float* x = p.out;
    for (int row = blockIdx.x * 8 + wid; row < NTOK; row += gridDim.x * 8) {
        f32x4 v[4]; float s = 0.f;
        float* xr = x + (size_t)row * D;
#pragma unroll
        for (int j = 0; j < 4; ++j) { v[j] = *(const f32x4*)(xr + lane * 4 + 256 * j); s += v[j].x * v[j].x + v[j].y * v[j].y + v[j].z * v[j].z + v[j].w * v[j].w; }
        const float rstd = rsqrtf(wave_sum(s) * (1.0f / D) + EPS);
        if (mode == 0) {
            const float* mr = mod_l + (size_t)mod_row(row) * 6144;
#pragma unroll
            for (int j = 0; j < 4; ++j) {
                const int c = lane * 4 + 256 * j;
                const f32x4 gg = *(const f32x4*)(g + c), sh = *(const f32x4*)(mr + off_sh + c), scv = *(const f32x4*)(mr + off_sc + c);
                const f32x4 o = (v[j] * rstd) * gg * (scv + 1.0f) + sh;
                u32x2 w; w.x = pk2(o.x, o.y); w.y = pk2(o.z, o.w);
                *(u32x2*)(hout + (size_t)row * D + c) = w;
            }
        } else {
#pragma unroll
            for (int j = 0; j < 4; ++j) { const int c = lane * 4 + 256 * j; const f32x4 gg = *(const f32x4*)(g + c); *(f32x4*)(xr + c) = (v[j] * rstd) * gg; }
        }
    }
}

template <int MIX>
__device__ __forceinline__ void gate_eval(const bf16_t* row, int kcol, int zcol, const float (&lrw)[16], float lrb, float lb, float& gt, float& kt) {
    if (!MIX) {
        const bf16_t* zr = row + zcol;
        const u32x4 z0 = *(const u32x4*)zr, z1 = *(const u32x4*)(zr + 8);
        float z = lrb;
        z += bflo(z0.x) * lrw[0] + bfhi(z0.x) * lrw[1] + bflo(z0.y) * lrw[2] + bfhi(z0.y) * lrw[3] + bflo(z0.z) * lrw[4] + bfhi(z0.z) * lrw[5] + bflo(z0.w) * lrw[6] + bfhi(z0.w) * lrw[7];
        z += bflo(z1.x) * lrw[8] + bfhi(z1.x) * lrw[9] + bflo(z1.y) * lrw[10] + bfhi(z1.y) * lrw[11] + bflo(z1.z) * lrw[12] + bfhi(z1.z) * lrw[13] + bflo(z1.w) * lrw[14] + bfhi(z1.w) * lrw[15];
        gt = logsigmoidf_(z) * (1.0f / 16.0f);
        kt = bf2f(row[kcol]);
    } else {
        const float xf = bf2f(row[kcol]);
        const float sg = sigmoidf_(xf);
        gt = flog_(lb + (1.0f - lb) * sg);
        kt = (1.0f - lb) * (1.0f - sg);
    }
}

template <int MIX>
__device__ __forceinline__ void gate_raw(unsigned kraw, const u32x4& z0, const u32x4& z1, const float (&lrw)[16], float lrb, float lb, float& gt, float& kt) {
    if (!MIX) {
        float z = lrb;
        z += bflo(z0.x) * lrw[0] + bfhi(z0.x) * lrw[1] + bflo(z0.y) * lrw[2] + bfhi(z0.y) * lrw[3] + bflo(z0.z) * lrw[4] + bfhi(z0.z) * lrw[5] + bflo(z0.w) * lrw[6] + bfhi(z0.w) * lrw[7];
        z += bflo(z1.x) * lrw[8] + bfhi(z1.x) * lrw[9] + bflo(z1.y) * lrw[10] + bfhi(z1.y) * lrw[11] + bflo(z1.z) * lrw[12] + bfhi(z1.z) * lrw[13] + bflo(z1.w) * lrw[14] + bfhi(z1.w) * lrw[15];
        gt = logsigmoidf_(z) * (1.0f / 16.0f);
        kt = bflo(kraw);
    } else {
        const float xf = bflo(kraw);
        const float sg = sigmoidf_(xf);
        gt = flog_(lb + (1.0f - lb) * sg);
        kt = (1.0f - lb) * (1.0f - sg);
    }
}

template <int MIX>
__device__ __forceinline__ void scan_job(const Params& p, int l, int s, int dir, int hd, LAS unsigned char* lds) {
    constexpr int DK = MIX ? 128 : 64, WM = DK / 32, WN = 8 / WM, WTN = 128 / WN, NTL = WTN / 32, LDT = 72, LDG = DK + 1;
    LAS bf16_t* At = (LAS bf16_t*)lds;
    LAS bf16_t* Bt = At + 128 * LDT;
    LAS float* dec = (LAS float*)(lds + 2 * 128 * LDT * 2);
    LAS float* G = dec + 128;
    LAS float* KK = G + 64 * 129;
    const int tid = otid(), lane = tid & 63, wid = tid >> 6, wm = wid / WN, wn = wid % WN;
    const bool ctx = s < 16;
    const int T = ctx ? 256 : 2048, tok0 = ctx ? s * 256 : NCTX + (s - 16) * 2048, nch = T / 64;
    const bf16_t* proj = (const bf16_t*)(p.ws + WS_PROJ);
    const float* lbs = (const float*)(p.ws + WS_LBS);
    bf16_t* sbuf = (bf16_t*)(p.ws + WS_ST + (MIX ? ST_GLA_BYTES : 0));
    f32x16 S[1][NTL];
    {
        const float* st0 = ctx ? nullptr : (MIX ? p.state_hgrn + ((((size_t)(s - 16) * DEPTH + l) * 2 + dir) * 4 + hd) * 128 * 128
                                                : p.state_gla + ((((size_t)(s - 16) * DEPTH + l) * 2 + dir) * 4 + hd) * 64 * 128);
#pragma unroll
        for (int n = 0; n < NTL; ++n)
#pragma unroll
            for (int i = 0; i < 16; ++i) {
                const int d = wm * 32 + (i & 3) + 8 * (i >> 2) + 4 * (lane >> 5), v = wn * WTN + n * 32 + (lane & 31);
                S[0][n][i] = ctx ? 0.f : st0[(size_t)d * 128 + v];
            }
    }
    const int sd = tid & (DK - 1), t0 = tid / DK; constexpr int TS = 512 / DK;
    float lrw[16]; float lrb = 0.f, lb = 0.f;
    if (!MIX) {
#pragma unroll
        for (int r = 0; r < 16; ++r) lrw[r] = p.gla_lr_w[(((size_t)l * 2 + dir) * 16 + r) * 256 + hd * 64 + sd];
        lrb = p.gla_lr_b[((size_t)l * 2 + dir) * 256 + hd * 64 + sd];
    } else {
#pragma unroll
        for (int r = 0; r < 16; ++r) lrw[r] = 0.f;
        lb = lbs[(size_t)(dir * 4 + l) * 512 + hd * 128 + sd];
    }
    const int kcol = MIX ? (dir ? PJ_HFB : PJ_HFF) + hd * 128 + sd : PJ_GK + hd * 64 + sd;
    const int zcol = dir ? PJ_GZB : PJ_GZF;
    const int vv = tid & 127, vq = tid >> 7;
    const int vcol = (MIX ? PJ_HI : PJ_GV) + hd * 128 + vv;
    const int kd = tid >> 2, kq = tid & 3;
    const bool k2 = tid < 4 * DK;

    constexpr int NE = 64 / TS;
    unsigned kraw[NE]; unsigned vraw[8];
    const int widu = __builtin_amdgcn_readfirstlane(tid >> 6), gmt = (widu >> 1) & 1, gnt = widu & 1;
    bf16x8 gafr = {0, 0, 0, 0, 0, 0, 0, 0}; u32x4 gbw = {0u, 0u, 0u, 0u}; float gbias = 0.f;
    if (!MIX && widu < 4) {
        const float* lw = p.gla_lr_w + (((size_t)l * 2 + dir) * 16 + 8 * (lane >> 5)) * 256 + hd * 64 + gnt * 32 + (lane & 31);
        float wv[8];
#pragma unroll
        for (int j = 0; j < 8; ++j) wv[j] = lw[(size_t)j * 256];
        gbw.x = pk2(wv[0], wv[1]); gbw.y = pk2(wv[2], wv[3]); gbw.z = pk2(wv[4], wv[5]); gbw.w = pk2(wv[6], wv[7]);
        gbias = p.gla_lr_b[((size_t)l * 2 + dir) * 256 + hd * 64 + gnt * 32 + (lane & 31)];
    }
    auto load_chunk = [&](const bf16_t* prc) {
#pragma unroll
        for (int i = 0; i < NE; ++i) {
            const bf16_t* row = prc + (size_t)(t0 + TS * i) * NPROJ;
            kraw[i] = row[kcol];
        }
        if (!MIX && widu < 4) gafr = *(const bf16x8*)(prc + (size_t)(gmt * 32 + (lane & 31)) * NPROJ + zcol + 8 * (lane >> 5));
#pragma unroll
        for (int t = 0; t < 16; t += 2) {
            const unsigned a = prc[(size_t)(vq * 16 + t) * NPROJ + vcol], b = prc[(size_t)(vq * 16 + t + 1) * NPROJ + vcol];
            vraw[t >> 1] = a | (b << 16);
        }
    };
    auto store_state = [&](int gcs) {
        bf16_t* sb = sbuf + (((size_t)gcs * 2 + dir) * 4 + hd) * 128 * DK;
#pragma unroll
        for (int nn = 0; nn < NTL; ++nn)
#pragma unroll
            for (int q = 0; q < 4; ++q) {
                const int d0 = wm * 32 + 8 * q + 4 * (lane >> 5), v = wn * WTN + nn * 32 + (lane & 31);
                u32x2 w; w.x = pk2(S[0][nn][4 * q + 0], S[0][nn][4 * q + 1]); w.y = pk2(S[0][nn][4 * q + 2], S[0][nn][4 * q + 3]);
                *(u32x2*)(sb + (size_t)v * DK + d0) = w;
            }
    };
    load_chunk(proj + (size_t)(tok0 + (dir ? nch - 1 : 0) * 64) * NPROJ);
    store_state((tok0 >> 6) + (dir ? nch - 1 : 0));
    for (int n = 0; n < nch; ++n) {
        if (MIX) {
#pragma unroll
            for (int i = 0; i < NE; ++i) {
                const int t = t0 + TS * i; float gt, kt; const u32x4 zz = {0u, 0u, 0u, 0u};
                gate_raw<MIX>(kraw[i], zz, zz, lrw, lrb, lb, gt, kt);
                G[t * LDG + sd] = gt; KK[t * LDG + sd] = kt;
            }
        } else {
#pragma unroll
            for (int i = 0; i < NE; ++i) KK[(t0 + TS * i) * LDG + sd] = bflo(kraw[i]);
            if (widu < 4) {
                f32x16 zacc;
#pragma unroll
                for (int i = 0; i < 16; ++i) zacc[i] = 0.f;
                zacc = __builtin_amdgcn_mfma_f32_32x32x16_bf16(gafr, __builtin_bit_cast(bf16x8, gbw), zacc, 0, 0, 0);
#pragma unroll
                for (int i = 0; i < 16; ++i)
                    G[(gmt * 32 + (i & 3) + 8 * (i >> 2) + 4 * (lane >> 5)) * LDG + gnt * 32 + (lane & 31)] = logsigmoidf_(zacc[i] + gbias) * (1.0f / 16.0f);
            }
        }
#pragma unroll
        for (int q = 0; q < 2; ++q) { u32x4 w; w.x = vraw[4 * q]; w.y = vraw[4 * q + 1]; w.z = vraw[4 * q + 2]; w.w = vraw[4 * q + 3]; *(LAS u32x4*)(Bt + vv * LDT + vq * 16 + q * 8) = w; }
        if (n + 1 < nch) load_chunk(proj + (size_t)(tok0 + (dir ? nch - 2 - n : n + 1) * 64) * NPROJ);
        __syncthreads();
        if (k2) {
            float g[16]; float qs = 0.f;
#pragma unroll
            for (int t = 0; t < 16; ++t) { g[t] = G[(kq * 16 + t) * LDG + kd]; qs += g[t]; }
            const int lb4 = lane & ~3;
            const float s0 = __shfl(qs, lb4), s1 = __shfl(qs, lb4 + 1), s2 = __shfl(qs, lb4 + 2), s3 = __shfl(qs, lb4 + 3);
            const float total = (s0 + s1) + (s2 + s3);
            float pref = (kq > 0 ? s0 : 0.f) + (kq > 1 ? s1 : 0.f) + (kq > 2 ? s2 : 0.f);
            unsigned pkv[8];
#pragma unroll
            for (int t = 0; t < 16; ++t) {
                const float pe = pref; pref += g[t];
                const float w = dir ? pe : total - pref;
                const float kv = KK[(kq * 16 + t) * LDG + kd] * fexp_(w);
                if (t & 1) pkv[t >> 1] = pk2(__uint_as_float(pkv[t >> 1]), kv); else pkv[t >> 1] = __float_as_uint(kv);
            }
#pragma unroll
            for (int q = 0; q < 2; ++q) { u32x4 w; w.x = pkv[4 * q]; w.y = pkv[4 * q + 1]; w.z = pkv[4 * q + 2]; w.w = pkv[4 * q + 3]; *(LAS u32x4*)(At + kd * LDT + kq * 16 + q * 8) = w; }
            if (kq == 0) dec[kd] = fexp_(total);
        }
        __syncthreads();
#pragma unroll
        for (int nn = 0; nn < NTL; ++nn)
#pragma unroll
            for (int i = 0; i < 16; ++i) S[0][nn][i] *= dec[wm * 32 + (i & 3) + 8 * (i >> 2) + 4 * (lane >> 5)];
        mma_lds<1, NTL, 4>(S, At + wm * 32 * LDT, LDT, Bt + wn * WTN * LDT, LDT, lane);
        if (n + 1 < nch) store_state((tok0 >> 6) + (dir ? nch - 2 - n : n + 1));
        __syncthreads();
    }
    if (ctx) {
        float* o = MIX ? p.out + (size_t)NTOK * D + (size_t)16 * DEPTH * 2 * 4 * 64 * 128 + ((((size_t)s * DEPTH + l) * 2 + dir) * 4 + hd) * 128 * 128
                       : p.out + (size_t)NTOK * D + ((((size_t)s * DEPTH + l) * 2 + dir) * 4 + hd) * 64 * 128;
#pragma unroll
        for (int nn = 0; nn < NTL; ++nn)
#pragma unroll
            for (int i = 0; i < 16; ++i) {
                const int d = wm * 32 + (i & 3) + 8 * (i >> 2) + 4 * (lane >> 5), v = wn * WTN + nn * 32 + (lane & 31);
                o[(size_t)d * 128 + v] = S[0][nn][i];
            }
    }
}


__device__ __forceinline__ void gmlp_item(const Params& p, int l, int c2, int g, LAS unsigned char* lds) {
    constexpr int LDT = 136;
    LAS bf16_t* Aw = (LAS bf16_t*)lds;
    LAS bf16_t* Bt = Aw + 128 * LDT;
    const int tid = otid(), lane = tid & 63, wid = tid >> 6, wm = wid >> 2, wn = wid & 3;
    const bf16_t* proj = (const bf16_t*)(p.ws + WS_PROJ);
    const int tokb = c2 * 128;
    {
        const float* wsrc = p.gm_ws + ((size_t)l * 4 + g) * 128 * 128;
#pragma unroll
        for (int i = 0; i < 8; ++i) {
            const int e = (i * 512 + tid) * 4, pp = e >> 7, q = e & 127;
            const f32x4 v = *(const f32x4*)(wsrc + e);
            u32x2 w; w.x = pk2(v.x, v.y); w.y = pk2(v.z, v.w);
            *(LAS u32x2*)(Aw + pp * LDT + q) = w;
        }
    }
    {
        const int q = tid >> 2, part = tid & 3;
        const bf16_t* mv = proj + (size_t)(tokb + q) * NPROJ + PJ_MV;
        float s = 0.f, s2 = 0.f;
#pragma unroll
        for (int i = 0; i < 16; ++i) {
            const u32x4 u = *(const u32x4*)(mv + (i * 4 + part) * 8);
            const unsigned uu[4] = {u.x, u.y, u.z, u.w};
#pragma unroll
            for (int j = 0; j < 4; ++j) { const float a = geluf_(bflo(uu[j])), b = geluf_(bfhi(uu[j])); s += a + b; s2 += a * a + b * b; }
        }
        s += __shfl_xor(s, 1); s += __shfl_xor(s, 2); s2 += __shfl_xor(s2, 1); s2 += __shfl_xor(s2, 2);
        const float mean = s * (1.0f / 512.0f), var = fmaxf(s2 * (1.0f / 512.0f) - mean * mean, 0.f), rstd = rsqrtf(var + EPS);
        const float* gg = p.gm_norm_g + (size_t)l * 512 + g * 128 + part * 32;
        const bf16_t* mvg = mv + g * 128 + part * 32;
#pragma unroll
        for (int i = 0; i < 4; ++i) {
            const u32x4 u = *(const u32x4*)(mvg + i * 8);
            const unsigned uu[4] = {u.x, u.y, u.z, u.w};
#pragma unroll
            for (int j = 0; j < 4; ++j) {
                const int c = part * 32 + i * 8 + j * 2;
                const float a = (geluf_(bflo(uu[j])) - mean) * rstd * gg[i * 8 + j * 2], b = (geluf_(bfhi(uu[j])) - mean) * rstd * gg[i * 8 + j * 2 + 1];
                Bt[c * LDT + q] = f2bf(a); Bt[(c + 1) * LDT + q] = f2bf(b);
            }
        }
    }
    __syncthreads();
    f32x16 acc[2][1]; acc_zero<1>(acc);
    mma_lds<2, 1, 8>(acc, Aw + wm * 64 * LDT, LDT, Bt + wn * 32 * LDT, LDT, lane);
    bf16_t* ocat = (bf16_t*)(p.ws + WS_OCAT);
    const float* bs = p.gm_bs + ((size_t)l * 4 + g) * 128;
#pragma unroll
    for (int m = 0; m < 2; ++m)
#pragma unroll
        for (int i = 0; i < 16; ++i) {
            const int pp = wm * 64 + m * 32 + (i & 3) + 8 * (i >> 2) + 4 * (lane >> 5), c = wn * 32 + (lane & 31);
            const float mu = bf2f(proj[(size_t)(tokb + pp) * NPROJ + PJ_MU + g * 128 + c]);
            ocat[(size_t)2 * NTOK * 512 + (size_t)(tokb + pp) * 512 + g * 128 + c] = f2bf(geluf_(mu) * (acc[m][0][i] + bs[pp]));
        }
    __syncthreads();
}

__device__ __forceinline__ void phase_scan(const Params& p, int l, LAS unsigned char* lds) {
    LAS int* slot = (LAS int*)(lds + LDS_BYTES - 16);
    unsigned* ctr = (unsigned*)(p.ws + WS_CTR) + l;
    constexpr int NLAT = 8 * 2 * 4 * 2, NCX = 16 * 2 * 4 * 2, NGM = 160 * 4;
    for (;;) {
        if (otid() == 0) *slot = (int)atomicAdd(ctr, 1u);
        __syncthreads();
        const int j = *slot;
        __syncthreads();
        const int nconv = l + 1 < DEPTH ? CONV_BLOCK_ITEMS : 0;
        if (j >= NLAT + NCX + NGM + nconv) break;
        if (j >= NLAT + NCX + NGM) { convert_weights(p, l + 1, lds, j - (NLAT + NCX + NGM)); __syncthreads(); continue; }
        if (j < NLAT + NCX) {
            int r = j, s;
            if (r < NLAT) { s = 16 + (r >> 4); r &= 15; } else { r -= NLAT; s = r >> 4; r &= 15; }
            const int mix = r & 1, dir = (r >> 1) & 1, hd = r >> 2;
            if (mix) scan_job<1>(p, l, s, dir, hd, lds); else scan_job<0>(p, l, s, dir, hd, lds);
        } else { const int r = j - NLAT - NCX; gmlp_item(p, l, r >> 2, r & 3, lds); }
    }
}

template <int MIX>
__device__ __forceinline__ void out_item(const Params& p, int l, int gc, int hd, LAS unsigned char* lds) {
    constexpr int DK = MIX ? 128 : 64, LQ = DK + 8, LDV = 72, LDG = DK + 1;
    LAS bf16_t* QA = (LAS bf16_t*)lds;
    LAS bf16_t* KA = QA + 128 * LQ;
    LAS bf16_t* QS = KA + 128 * LQ;
    LAS bf16_t* VT = QS + 64 * LQ;
    LAS bf16_t* P = VT + 128 * LDV;
    LAS float* C = (LAS float*)(P + 64 * LDV);
    LAS float* BS = C + (MIX ? 64 : 128) * LDG;
    LAS bf16_t* ST = KA;
    LAS float* Of = (LAS float*)lds;
    const int tid = otid(), lane = tid & 63, wid = __builtin_amdgcn_readfirstlane(tid >> 6);
    const int tokb = gc * 64;
    const bf16_t* proj = (const bf16_t*)(p.ws + WS_PROJ);
    const bf16_t* pr = proj + (size_t)tokb * NPROJ;
    const float* lbs = (const float*)(p.ws + WS_LBS);
    const bf16_t* sbuf = (const bf16_t*)(p.ws + WS_ST + (MIX ? ST_GLA_BYTES : 0));
    constexpr int NPQ = 64 * (DK / 8), NRQ = NPQ / 512;
    u32x4 rq[NRQ], rk[NRQ];
    auto load_raw = [&](int dr) {
        const int kcol0 = MIX ? (dr ? PJ_HFB : PJ_HFF) + hd * 128 : PJ_GK + hd * 64;
        const int qcol0 = MIX ? PJ_HQ + hd * 128 : PJ_GQ + hd * 64;
#pragma unroll
        for (int k = 0; k < NRQ; ++k) { const int e = tid + 512 * k; const int t = e / (DK / 8), c8 = (e % (DK / 8)) * 8;
            rq[k] = *(const u32x4*)(pr + (size_t)t * NPROJ + qcol0 + c8); rk[k] = *(const u32x4*)(pr + (size_t)t * NPROJ + kcol0 + c8); }
    };
    load_raw(0);
    const int kdp = tid & (DK - 1);
    float gnv[16];
    {
        const float* gn = (MIX ? p.hg_norm_g : p.gla_norm_g) + (size_t)l * 512 + hd * 128 + (tid & 7) * 16;
#pragma unroll
        for (int j = 0; j < 16; j += 4) { const f32x4 t4 = *(const f32x4*)(gn + j); gnv[j] = t4.x; gnv[j + 1] = t4.y; gnv[j + 2] = t4.z; gnv[j + 3] = t4.w; }
    }
    const float lbd0 = MIX ? lbs[(size_t)(0 * 4 + l) * 512 + hd * 128 + kdp] : 0.f, lbd1 = MIX ? lbs[(size_t)(1 * 4 + l) * 512 + hd * 128 + kdp] : 0.f;
    if (!MIX) {
        const int gd = wid >> 2, mt = (wid >> 1) & 1, nt = wid & 1, r = lane & 31, h = lane >> 5;
        const bf16x8 afr = *(const bf16x8*)(pr + (size_t)(mt * 32 + r) * NPROJ + (gd ? PJ_GZB : PJ_GZF) + 8 * h);
        const float* lw = p.gla_lr_w + (((size_t)l * 2 + gd) * 16 + 8 * h) * 256 + hd * 64 + nt * 32 + r;
        float wv[8];
#pragma unroll
        for (int j = 0; j < 8; ++j) wv[j] = lw[(size_t)j * 256];
        const float bias = p.gla_lr_b[((size_t)l * 2 + gd) * 256 + hd * 64 + nt * 32 + r];
        u32x4 bw; bw.x = pk2(wv[0], wv[1]); bw.y = pk2(wv[2], wv[3]); bw.z = pk2(wv[4], wv[5]); bw.w = pk2(wv[6], wv[7]);
        f32x16 zacc;
#pragma unroll
        for (int i = 0; i < 16; ++i) zacc[i] = 0.f;
        zacc = __builtin_amdgcn_mfma_f32_32x32x16_bf16(afr, __builtin_bit_cast(bf16x8, bw), zacc, 0, 0, 0);
#pragma unroll
        for (int i = 0; i < 16; ++i) {
            const int t = mt * 32 + (i & 3) + 8 * (i >> 2) + 4 * h;
            C[(gd * 64 + (gd ? 63 - t : t)) * LDG + nt * 32 + r] = logsigmoidf_(zacc[i] + bias) * (1.0f / 16.0f);
        }
    }
    const bf16_t* gatep = pr + (size_t)(tid >> 3) * NPROJ + (MIX ? PJ_HO : PJ_GO) + hd * 128 + (tid & 7) * 16;
    const u32x4 g0 = *(const u32x4*)gatep, g1 = *(const u32x4*)(gatep + 8);
    {
        const int vv = tid & 127, qt = tid >> 7;
        const int vcol = (MIX ? PJ_HI : PJ_GV) + hd * 128 + vv;
        unsigned pkv[8];
#pragma unroll
        for (int t = 0; t < 16; t += 2) {
            const unsigned a = pr[(size_t)(qt * 16 + t) * NPROJ + vcol], b = pr[(size_t)(qt * 16 + t + 1) * NPROJ + vcol];
            pkv[t >> 1] = a | (b << 16);
        }
#pragma unroll
        for (int q = 0; q < 2; ++q) { u32x4 w; w.x = pkv[4 * q]; w.y = pkv[4 * q + 1]; w.z = pkv[4 * q + 2]; w.w = pkv[4 * q + 3]; *(LAS u32x4*)(VT + vv * LDV + qt * 16 + q * 8) = w; }
    }
    const int wm = wid >> 2, wn = wid & 3;
    f32x16 o[1][1];
#pragma unroll
    for (int i = 0; i < 16; ++i) o[0][0][i] = 0.f;

#pragma unroll 1
    for (int dir = 0; dir < 2; ++dir) {
        const int kd = tid & (DK - 1), ba = tid / DK;
#pragma unroll
        for (int k = 0; k < NRQ; ++k) { const int e = tid + 512 * k; const int t = e / (DK / 8), c8 = (e % (DK / 8)) * 8;
            *(LAS u32x4*)(QS + t * LQ + c8) = rq[k]; *(LAS u32x4*)(KA + (64 + (dir ? 63 - t : t)) * LQ + c8) = rk[k]; }
        __syncthreads();
        float gk[16], kk[16]; float lp7 = 0.f, Ta = 0.f;
        if (MIX) {
            const float lb = dir ? lbd1 : lbd0;
            const LAS bf16_t* kz0 = KA + (64 + ba * 16) * LQ + kd;
#pragma unroll
            for (int u = 0; u < 16; ++u) {
                const float sg = sigmoidf_(bf2f(kz0[u * LQ]));
                gk[u] = flog_(lb + (1.0f - lb) * sg); kk[u] = (1.0f - lb) * (1.0f - sg);
                Ta += gk[u]; if (u == 7) lp7 = Ta;
            }
            BS[ba * DK + kd] = Ta;
        } else {
            if (ba < 4) {
#pragma unroll
                for (int u = 0; u < 16; ++u) { gk[u] = C[(dir * 64 + ba * 16 + u) * LDG + kd]; Ta += gk[u]; if (u == 7) lp7 = Ta; }
                BS[ba * DK + kd] = Ta;
            }
        }
        __syncthreads();
        if (ba < 4) {
            const float T0 = BS[kd], T1 = BS[DK + kd], T2 = BS[2 * DK + kd];
            const float base = ba == 0 ? 0.f : ba == 1 ? T0 : ba == 2 ? T0 + T1 : T0 + T1 + T2;
            const float c31 = T0 + T1;
            const float qscale = MIX ? 0.08838834764831845f : 0.125f;
            LAS bf16_t* qz = QA + (64 + ba * 16) * LQ + kd;
            LAS bf16_t* kz = KA + (64 + ba * 16) * LQ + kd;
            LAS bf16_t* xrow = (ba < 2 ? KA + (ba * 16) * LQ : QA + (ba * 16 - 32) * LQ) + kd;
            LAS bf16_t* yrow = ((ba & 1) ? QA + (32 + (ba >> 1) * 16) * LQ : KA + (32 + (ba >> 1) * 16) * LQ) + kd;
            float lp = 0.f;
#pragma unroll
            for (int u = 0; u < 16; ++u) {
                const int pp = ba * 16 + u, t = dir ? 63 - pp : pp;
                lp += gk[u];
                const float c = base + lp;
                const float qv = bf2f(QS[t * LQ + kd]) * qscale;
                const float kt = MIX ? kk[u] : bf2f(kz[u * LQ]);
                QS[t * LQ + kd] = f2bf(qv * fexp_(c));
                qz[u * LQ] = f2bf(qv * fexp_(lp - lp7));
                kz[u * LQ] = f2bf(kt * fexp_(lp7 - lp));
                xrow[u * LQ] = f2bf(ba < 2 ? kt * fexp_(c31 - c) : qv * fexp_(c - c31));
                yrow[u * LQ] = f2bf((ba & 1) ? qv * fexp_(lp) : kt * fexp_(Ta - lp));
            }
        }
        __syncthreads();
        if (dir == 0) load_raw(1);
        constexpr int PIECES = 128 * DK / 8, NPC = PIECES / 512;
        u32x4 stv[NPC];
        {
            const bf16_t* sb = sbuf + (((size_t)gc * 2 + dir) * 4 + hd) * 128 * DK;
#pragma unroll
            for (int k = 0; k < NPC; ++k) { const int e = tid + 512 * k; const int v = e / (DK / 8), d0 = (e % (DK / 8)) * 8; stv[k] = *(const u32x4*)(sb + (size_t)v * DK + d0); }
        }
        if (wid < 4) {
            f32x16 sc[1][1];
#pragma unroll
            for (int i = 0; i < 16; ++i) sc[0][0][i] = 0.f;
            mma_lds<1, 1, DK / 16>(sc, KA + wid * 32 * LQ, LQ, QA + wid * 32 * LQ, LQ, lane);
            const int cc = lane & 31;
#pragma unroll
            for (int q = 0; q < 4; ++q) {
                const int r0 = 8 * q + 4 * (lane >> 5);
                int pi, pj0; bool wr = true, zero = false, tri = false;
                if (wid == 0) { pi = 32 + cc; pj0 = r0; }
                else if (wid == 1) { pi = cc < 16 ? 16 + cc : 32 + cc; pj0 = r0 < 16 ? r0 : r0 + 16; wr = (r0 < 16) == (cc < 16); }
                else { const int off = (wid - 2) * 32; pi = off + cc; pj0 = off + r0; const bool same = (r0 >> 4) == (cc >> 4); tri = same; zero = !same && r0 >= 16; wr = same || zero; }
                float v[4];
#pragma unroll
                for (int e = 0; e < 4; ++e) { float x = sc[0][0][4 * q + e]; if (tri && (r0 + e > cc)) x = 0.f; if (zero) x = 0.f; v[e] = x; }
                if (wr) {
                    u32x2 w;
                    if (dir == 0) { w.x = pk2(v[0], v[1]); w.y = pk2(v[2], v[3]); *(LAS u32x2*)(P + pi * LDV + pj0) = w; }
                    else { w.x = pk2(v[3], v[2]); w.y = pk2(v[1], v[0]); *(LAS u32x2*)(P + (63 - pi) * LDV + (60 - pj0)) = w; }
                }
            }
        } else if (wid == 4) {
#pragma unroll
            for (int k = 0; k < 2; ++k) {
                const int idx = lane * 2 + k, row = idx >> 2, piece = idx & 3;
                const int ti = dir ? 32 + row : row, tj = (dir ? 0 : 32) + piece * 8;
                u32x4 z; z.x = 0; z.y = 0; z.z = 0; z.w = 0;
                *(LAS u32x4*)(P + ti * LDV + tj) = z;
            }
        }
        __syncthreads();
#pragma unroll
        for (int k = 0; k < NPC; ++k) { const int e = tid + 512 * k; const int v = e / (DK / 8), d0 = (e % (DK / 8)) * 8; *(LAS u32x4*)(ST + v * LQ + d0) = stv[k]; }
        mma_lds<1, 1, 4>(o, P + wm * 32 * LDV, LDV, VT + wn * 32 * LDV, LDV, lane);
        __syncthreads();
        mma_lds<1, 1, DK / 16>(o, QS + wm * 32 * LQ, LQ, ST + wn * 32 * LQ, LQ, lane);
        __syncthreads();
    }
#pragma unroll
    for (int i = 0; i < 16; ++i) Of[(wm * 32 + (i & 3) + 8 * (i >> 2) + 4 * (lane >> 5)) * 132 + wn * 32 + (lane & 31)] = o[0][0][i];
    __syncthreads();
    {
        const int i_ = tid >> 3, seg = tid & 7;
        const LAS float* orow = Of + i_ * 132 + seg * 16;
        float v[16]; float ss = 0.f;
#pragma unroll
        for (int j = 0; j < 16; ++j) { v[j] = orow[j]; ss += v[j] * v[j]; }
        ss += __shfl_xor(ss, 1); ss += __shfl_xor(ss, 2); ss += __shfl_xor(ss, 4);
        const float r = rsqrtf(ss * (1.0f / 128.0f) + EPS);
        const unsigned gu[8] = {g0.x, g0.y, g0.z, g0.w, g1.x, g1.y, g1.z, g1.w};
        unsigned ow[8];
#pragma unroll
        for (int j = 0; j < 8; ++j) {
            const float a = v[2 * j] * r * gnv[2 * j] * siluf_(bflo(gu[j])), b = v[2 * j + 1] * r * gnv[2 * j + 1] * siluf_(bfhi(gu[j]));
            ow[j] = pk2(a, b);
        }
        bf16_t* dst = (bf16_t*)(p.ws + WS_OCAT) + (size_t)(MIX ? 1 : 0) * NTOK * 512 + (size_t)(tokb + i_) * 512 + hd * 128 + seg * 16;
        u32x4 w0, w1; w0.x = ow[0]; w0.y = ow[1]; w0.z = ow[2]; w0.w = ow[3]; w1.x = ow[4]; w1.y = ow[5]; w1.z = ow[6]; w1.w = ow[7];
        *(u32x4*)dst = w0; *(u32x4*)(dst + 8) = w1;
    }
    __syncthreads();
}


__device__ __forceinline__ void phase_out(const Params& p, int l, LAS unsigned char* lds) {
    constexpr int NIT = NCHUNK * 4 * 2;
    for (int it = blockIdx.x; it < NIT; it += gridDim.x) {
        const int mix = (it >> 8) & 1, rem = (it & 255) | ((it >> 9) << 8), hd = rem & 3, gc = rem >> 2;
        if (mix) out_item<1>(p, l, gc, hd, lds); else out_item<0>(p, l, gc, hd, lds);
    }
}

__device__ __forceinline__ void phase_merge(const Params& p, int l, LAS unsigned char* lds) {
    const bf16_t* ocat = (const bf16_t*)(p.ws + WS_OCAT);
    const bf16_t* G3 = (const bf16_t*)(p.ws + WS_PROJ);
    const bf16_t* WbrT = (const bf16_t*)(p.ws + WS_W + (size_t)(l & 1) * W_END + W_BR);
    bf16_t* merged = (bf16_t*)(p.ws + WS_ST);
    const int lane = otid() & 63, wid = otid() >> 6, wm = wid >> 2, wn = wid & 3;
    constexpr int nM = NTOK / 128, nN = 8;
    for (int t = blockIdx.x; t < nM * nN; t += gridDim.x) {
        int tm, tn; tile_coords(t, nN, tm, tn);
        const int row0 = tm * 128, col0 = tn * 128;
        f32x16 tot[2][1]; acc_zero<1>(tot);
#pragma unroll 1
        for (int b = 0; b < 3; ++b) {
            f32x16 ba[2][1]; acc_zero<1>(ba);
            gemm_kloop<128>(lds, ocat + (size_t)row0 * 1536 + b * 512, 1536, WbrT + ((size_t)b * D + col0) * 512, 512, 128, 512, ba);
#pragma unroll
            for (int m = 0; m < 2; ++m)
#pragma unroll
                for (int i = 0; i < 16; ++i) {
                    const int row = row0 + wm * 64 + m * 32 + (i & 3) + 8 * (i >> 2) + 4 * (lane >> 5), col = col0 + wn * 32 + (lane & 31);
                    tot[m][0][i] += bf2f(G3[(size_t)row * NGATE + b * 1024 + col]) * ba[m][0][i];
                }
        }
#pragma unroll
        for (int m = 0; m < 2; ++m)
#pragma unroll
            for (int i = 0; i < 16; ++i) {
                const int row = row0 + wm * 64 + m * 32 + (i & 3) + 8 * (i >> 2) + 4 * (lane >> 5), col = col0 + wn * 32 + (lane & 31);
                merged[(size_t)row * D + col] = f2bf(tot[m][0][i]);
            }
    }
}

__device__ __forceinline__ void run_phase(const Params& p, int ph, LAS unsigned char* lds) {
    if (ph == 0) { phase0(p, lds); return; }
    if (ph == NPHASE - 1) { norm_phase(p, p.final_norm_g, nullptr, 0, 0, nullptr, 1); return; }
    const int l = (ph - 1) / 10, sp = (ph - 1) % 10;
    const float* mod_l = (const float*)(p.ws + WS_MOD) + (size_t)l * 9 * 6144;
    bf16_t* hbuf = (bf16_t*)(p.ws + WS_H);
    bf16_t* proj = (bf16_t*)(p.ws + WS_PROJ);
    const unsigned char* wl = p.ws + WS_W + (size_t)(l & 1) * W_END;
    switch (sp) {
        case 0: if (l == 0) convert_weights(p, l, lds); norm_phase(p, p.norm_mix_g + (size_t)l * D, mod_l, 0, 1024, hbuf, 0); break;
        case 1: { PEpiBf16 e{proj, NPROJ, NPROJ, 0}; pg8_gemm(lds, hbuf, (const bf16_t*)(wl + W_IN), NTOK, 5376, D, e); } break;
        case 2: phase_scan(p, l, lds); break;
        case 3: phase_out(p, l, lds); break;
        case 4: {
            PEpiBf16 e{proj, NGATE, NGATE, 2}; pg8_gemm(lds, hbuf, (const bf16_t*)(wl + W_G), NTOK, NGATE, D, e);
            PEpiGate e2{proj, NGATE}; pg8_gemm(lds, (const bf16_t*)(p.ws + WS_OCAT), (const bf16_t*)(wl + W_BR), NTOK, NGATE, 512, e2, (size_t)NTOK * 512 * 2); } break;
        case 5: sum3_phase(p); break;
        case 6: {
            PEpiResid e{p.out, mod_l + 2048}; pg8_gemm(lds, (const bf16_t*)(p.ws + WS_ST), (const bf16_t*)(wl + W_OUT), 16384, D, D, e);
            EpiResidOff e2{p.out, mod_l + 2048, 16384}; gemm_phase<128>(lds, (const bf16_t*)(p.ws + WS_ST) + (size_t)16384 * D, D, (const bf16_t*)(wl + W_OUT), D, NTOK - 16384, D, D, e2); } break;
        case 7: norm_phase(p, p.norm_ffn_g + (size_t)l * D, mod_l, 3072, 4096, hbuf, 0); break;
        case 8: { PEpiBf16 e{proj, DFF, DFF, 1}; pg8_gemm(lds, hbuf, (const bf16_t*)(wl + W_FF1), NTOK, DFF, D, e); } break;
        case 9: { PEpiResid e{p.out, mod_l + 5120}; pg8_gemm(lds, proj, (const bf16_t*)(wl + W_FF2), 16384, D, DFF, e);
            EpiResidOff e2{p.out, mod_l + 5120, 16384}; gemm_phase<128>(lds, proj + (size_t)16384 * DFF, DFF, (const bf16_t*)(wl + W_FF2), DFF, NTOK - 16384, D, DFF, e2); } break;
    }
}

__global__ void __launch_bounds__(512) fwd_megakernel(Params p) {
    extern __shared__ __attribute__((aligned(16))) unsigned char smem[];
    LAS unsigned char* lds = (LAS unsigned char*)smem;
    cg::grid_group grid = cg::this_grid();
    unsigned nbar = 0;
    for (int ph = p.ph_lo; ph < p.ph_hi; ++ph) {
        run_phase(p, ph, lds);
        if (ph + 1 < p.ph_hi) {
            if (ph == 0) grid.sync();
            else { ++nbar; grid_barrier((unsigned*)(p.ws + WS_CTR) + 64, nbar); }
        }
    }
}

extern "C" void kernel_launch(void* const* d_in, const int* in_sizes, int n_in, void* d_out, int out_size, void* d_ws, size_t ws_size, hipStream_t stream) {
    static int grid_blocks = 0;
    if (!grid_blocks) {
        int dev = 0, cus = 0, per_cu = 0;
        hipGetDevice(&dev);
        hipDeviceGetAttribute(&cus, hipDeviceAttributeMultiprocessorCount, dev);
        if (hipFuncSetAttribute((const void*)fwd_megakernel, hipFuncAttributeMaxDynamicSharedMemorySize, LDS_BYTES) != hipSuccess) fprintf(stderr, "hipFuncSetAttribute failed\n");
        hipOccupancyMaxActiveBlocksPerMultiprocessor(&per_cu, (const void*)fwd_megakernel, 512, LDS_BYTES);
        if (per_cu < 1) { fprintf(stderr, "occupancy query says %d blocks/CU\n", per_cu); per_cu = 1; }
        grid_blocks = cus * 1;
        (void)hipGetLastError();
        if (n_in != 26 || ws_size < WS_END) fprintf(stderr, "kernel_launch: unexpected n_in %d or ws_size %zu (need %zu)\n", n_in, ws_size, (size_t)WS_END);
    }
    Params p{};
    const float** pp = (const float**)&p;
    for (int i = 0; i < 26; ++i) pp[i] = (const float*)d_in[i];
    p.out = (float*)d_out; p.ws = (unsigned char*)d_ws; p.ph_lo = 0; p.ph_hi = NPHASE;
    void* args[] = {&p};
    hipError_t e = hipLaunchCooperativeKernel((const void*)fwd_megakernel, dim3(grid_blocks), dim3(512), args, LDS_BYTES, stream);
    if (e != hipSuccess) fprintf(stderr, "cooperative launch failed: %s (grid %d)\n", hipGetErrorString(e), grid_blocks);
}
```

```cpp
#include <hip/hip_runtime.h>
#include <hip/hip_cooperative_groups.h>
#include <cstdio>
namespace cg = cooperative_groups;

#define LAS __attribute__((address_space(3)))
typedef unsigned short bf16_t;
typedef short bf16x8 __attribute__((ext_vector_type(8)));
typedef float f32x16 __attribute__((ext_vector_type(16)));
typedef float f32x4 __attribute__((ext_vector_type(4)));
typedef unsigned u32x4 __attribute__((ext_vector_type(4)));
typedef unsigned u32x2 __attribute__((ext_vector_type(2)));

constexpr int D = 1024, DEPTH = 4, NTOK = 20480, NCTX = 4096, DFF = 4096;
constexpr int DIN = 8224, NPROJ = 5152, NGATE = 3072;
constexpr int PJ_GQ = 0, PJ_GK = 256, PJ_GV = 512, PJ_GO = 1024, PJ_GZF = 1536, PJ_GZB = 1552, PJ_HQ = 1568, PJ_HFF = 2080,
              PJ_HFB = 2592, PJ_HI = 3104, PJ_HO = 3616, PJ_MU = 4128, PJ_MV = 4640;
constexpr int NCHUNK = NTOK / 64;
constexpr float EPS = 1e-6f;
constexpr int LDS_BYTES = 160 * 1024;
constexpr int NPHASE = 2 + DEPTH * 10;

constexpr size_t WS_PROJ = 0;
constexpr size_t WS_ST   = WS_PROJ + (size_t)NTOK * NPROJ * 2;
constexpr size_t ST_GLA_BYTES = (size_t)NCHUNK * 2 * 4 * 128 * 64 * 2, ST_HG_BYTES = (size_t)NCHUNK * 2 * 4 * 128 * 128 * 2;
constexpr size_t WS_OCAT = WS_ST + ST_GLA_BYTES + ST_HG_BYTES;
constexpr size_t WS_H    = WS_OCAT + (size_t)NTOK * 1536 * 2;
constexpr size_t WS_W    = WS_H + (size_t)NTOK * D * 2;
constexpr size_t W_IN = 0, W_G = W_IN + (size_t)NPROJ * D * 2, W_BR = W_G + (size_t)NGATE * D * 2, W_OUT = W_BR + (size_t)3 * D * 512 * 2,
                 W_FF1 = W_OUT + (size_t)D * D * 2, W_FF2 = W_FF1 + (size_t)DFF * D * 2, W_END = W_FF2 + (size_t)D * DFF * 2;
constexpr size_t WS_MOD  = WS_W + 2 * W_END;
constexpr size_t WS_LBS  = WS_MOD + (size_t)DEPTH * 9 * 6144 * 4;
constexpr size_t WS_CTR  = WS_LBS + 2 * 4 * 512 * 4;
constexpr size_t WS_END  = WS_CTR + 4096;

struct Params {
    const float *x_prompt, *x_sample, *c, *state_gla, *state_hgrn, *c_ctx, *ada_w, *ada_b, *norm_mix_g, *norm_ffn_g, *w_in, *gla_lr_w,
        *gla_lr_b, *gla_norm_g, *hg_lb_logits, *hg_norm_g, *gm_norm_g, *gm_ws, *gm_bs, *w_br_gla, *w_br_hg, *w_br_gm, *w_out, *w_ff1, *w_ff2,
        *final_norm_g;
    float* out; unsigned char* ws; int ph_lo, ph_hi;
};

typedef __bf16 bf16x2_t __attribute__((ext_vector_type(2)));
__device__ __forceinline__ unsigned pk2(float lo, float hi) { bf16x2_t v; v.x = (__bf16)lo; v.y = (__bf16)hi; return __builtin_bit_cast(unsigned, v); }
__device__ __forceinline__ bf16_t f2bf(float f) { return (bf16_t)(pk2(f, 0.f) & 0xffffu); }
__device__ __forceinline__ float bf2f(bf16_t h) { return __uint_as_float(((unsigned)h) << 16); }
__device__ __forceinline__ float bflo(unsigned u) { return __uint_as_float(u << 16); }
__device__ __forceinline__ float bfhi(unsigned u) { return __uint_as_float(u & 0xffff0000u); }
__device__ __forceinline__ float fexp_(float x) { return __builtin_amdgcn_exp2f(x * 1.4426950408889634f); }
__device__ __forceinline__ float flog_(float x) { return __builtin_amdgcn_logf(x) * 0.6931471805599453f; }
__device__ __forceinline__ float sigmoidf_(float x) { return __builtin_amdgcn_rcpf(1.0f + fexp_(-x)); }
__device__ __forceinline__ float siluf_(float x) { return x * sigmoidf_(x); }
__device__ __forceinline__ float geluf_(float x) { const float y = 0.7978845608028654f * (x + 0.044715f * x * x * x); const float t = 1.0f - 2.0f * __builtin_amdgcn_rcpf(1.0f + fexp_(2.0f * y)); return 0.5f * x * (1.0f + t); }
__device__ __forceinline__ float logsigmoidf_(float x) { return fminf(x, 0.f) - flog_(1.0f + fexp_(-fabsf(x))); }
__device__ __forceinline__ float wave_sum(float v) {
#pragma unroll
    for (int o = 1; o < 64; o <<= 1) v += __shfl_xor(v, o);
    return v;
}
__device__ __forceinline__ int mod_row(int tok) { return tok < NCTX ? 0 : 1 + ((tok - NCTX) >> 11); }
__device__ __forceinline__ int otid() { int t = (int)__builtin_amdgcn_workitem_id_x(); asm volatile("" : "+v"(t)); return t; }
#define LDS_WAIT() asm volatile("s_waitcnt lgkmcnt(0)" ::: "memory")

template <int MT, int NTL, int KS>
__device__ __forceinline__ void mma_lds(f32x16 (&acc)[MT][NTL], const LAS bf16_t* As, int lda, const LAS bf16_t* Bs, int ldb, int lane) {
    const int r = lane & 31, h = lane >> 5;
    const LAS bf16_t* ap = As + r * lda + h * 8;
    const LAS bf16_t* bp = Bs + r * ldb + h * 8;
#pragma unroll
    for (int ks = 0; ks < KS; ++ks) {
        bf16x8 a[MT], b[NTL];
#pragma unroll
        for (int m = 0; m < MT; ++m) a[m] = *(const LAS bf16x8*)(ap + m * 32 * lda + ks * 16);
#pragma unroll
        for (int n = 0; n < NTL; ++n) b[n] = *(const LAS bf16x8*)(bp + n * 32 * ldb + ks * 16);
#pragma unroll
        for (int m = 0; m < MT; ++m)
#pragma unroll
            for (int n = 0; n < NTL; ++n) acc[m][n] = __builtin_amdgcn_mfma_f32_32x32x16_bf16(a[m], b[n], acc[m][n], 0, 0, 0);
    }
}

template <int BM>
__device__ __forceinline__ void gemm_kloop(LAS unsigned char* lds, const bf16_t* __restrict__ Ag, int lda, const bf16_t* __restrict__ Bg, int ldb, int brows,
                                           int K, f32x16 (&acc)[2][(128 / (8 / (BM / 64))) / 32]) {
    static_assert(BM == 128, "128-row tiles only");
    constexpr int WN = 4, WTN = 32, NTL = 1, LDT = 136, NP = 4;
    LAS bf16_t* As = (LAS bf16_t*)lds;
    LAS bf16_t* Bs = As + 2 * 128 * LDT;
    const int tid = otid(), lane = tid & 63, wid = tid >> 6, wm = wid / WN, wn = wid % WN;
    const int lrow = tid >> 4, lc = (tid & 15) * 8;
    const bf16_t* ap[NP]; const bf16_t* bp[NP];
#pragma unroll
    for (int p = 0; p < NP; ++p) ap[p] = Ag + (size_t)(lrow + p * 32) * lda + lc;
#pragma unroll
    for (int p = 0; p < NP; ++p) { int br = lrow + p * 32; br = br < brows ? br : brows - 1; bp[p] = Bg + (size_t)br * ldb + lc; }
    u32x4 ra[3][NP], rb[3][NP];
    const int nk = K / 128;
#define KL_ISSUE(S, step) do { _Pragma("unroll") for (int p = 0; p < NP; ++p) ra[S][p] = *(const u32x4*)(ap[p] + (step) * 128); \
                               _Pragma("unroll") for (int p = 0; p < NP; ++p) rb[S][p] = *(const u32x4*)(bp[p] + (step) * 128); } while (0)
#define KL_WRITE(S, stage) do { _Pragma("unroll") for (int p = 0; p < NP; ++p) *(LAS u32x4*)(As + (stage) * 128 * LDT + (lrow + p * 32) * LDT + lc) = ra[S][p]; \
                                _Pragma("unroll") for (int p = 0; p < NP; ++p) *(LAS u32x4*)(Bs + (stage) * 128 * LDT + (lrow + p * 32) * LDT + lc) = rb[S][p]; } while (0)
#define KL_STEP(J, JN) if (kt + J < nk) { const int s_ = kt + J; if (s_ + 3 < nk) KL_ISSUE(J, s_ + 3); \
        mma_lds<2, NTL, 8>(acc, As + (s_ & 1) * 128 * LDT + wm * 64 * LDT, LDT, Bs + (s_ & 1) * 128 * LDT + wn * WTN * LDT, LDT, lane); \
        if (s_ + 1 < nk) KL_WRITE(JN, (s_ + 1) & 1); __syncthreads(); }
    KL_ISSUE(0, 0); if (nk > 1) KL_ISSUE(1, 1); if (nk > 2) KL_ISSUE(2, 2);
    KL_WRITE(0, 0);
    __syncthreads();
    for (int kt = 0; kt < nk; kt += 3) { KL_STEP(0, 1) KL_STEP(1, 2) KL_STEP(2, 0) }
#undef KL_ISSUE
#undef KL_WRITE
#undef KL_STEP
}

template <int NTL>
__device__ __forceinline__ void acc_zero(f32x16 (&acc)[2][NTL]) {
#pragma unroll
    for (int m = 0; m < 2; ++m)
#pragma unroll
        for (int n = 0; n < NTL; ++n)
#pragma unroll
            for (int i = 0; i < 16; ++i) acc[m][n][i] = 0.f;
}

__device__ __forceinline__ void tile_coords(int t, int nN, int& tm, int& tn) { const int q = t >> 3; tn = q % nN; tm = (q / nN) * 8 + (t & 7); }

template <int BM, class Epi>
__device__ __forceinline__ void gemm_phase(LAS unsigned char* lds, const bf16_t* A, int lda, const bf16_t* Bt, int ldb, int M, int N, int K, const Epi& epi) {
    constexpr int WM = BM / 64, WN = 8 / WM, WTN = 128 / WN, NTL = WTN / 32;
    const int nM = M / BM, nN = (N + 127) / 128, ntiles = nM * nN;
    const int lane = otid() & 63, wid = otid() >> 6, wm = wid / WN, wn = wid % WN;
    for (int t = blockIdx.x; t < ntiles; t += gridDim.x) {
        int tm, tn; tile_coords(t, nN, tm, tn);
        const int row0 = tm * BM, col0 = tn * 128;
        f32x16 acc[2][NTL]; acc_zero<NTL>(acc);
        gemm_kloop<BM>(lds, A + (size_t)row0 * lda, lda, Bt + (size_t)col0 * ldb, ldb, min(128, N - col0), K, acc);
#pragma unroll
        for (int m = 0; m < 2; ++m)
#pragma unroll
            for (int n = 0; n < NTL; ++n) {
                const int col = col0 + wn * WTN + n * 32 + (lane & 31);
#pragma unroll
                for (int i = 0; i < 16; ++i) {
                    const int row = row0 + wm * 64 + m * 32 + (i & 3) + 8 * (i >> 2) + 4 * (lane >> 5);
                    epi(row, col, acc[m][n][i]);
                }
            }
    }
}

struct EpiBf16 { bf16_t* C; int ldc, N; __device__ __forceinline__ void operator()(int row, int col, float v) const { if (col < N) C[(size_t)row * ldc + col] = f2bf(v); } };
struct EpiRelu2 { bf16_t* C; int ldc; __device__ __forceinline__ void operator()(int row, int col, float v) const { v = fmaxf(v, 0.f); C[(size_t)row * ldc + col] = f2bf(v * v); } };
struct EpiResidOff { float* x; const float* gate; int roff; __device__ __forceinline__ void operator()(int row, int col, float v) const {
    const int r = row + roff; const float g = gate[mod_row(r) * 6144 + col]; float* p = x + (size_t)r * D + col; *p = *p + g * v; } };
struct EpiResid { float* x; const float* gate;   __device__ __forceinline__ void operator()(int row, int col, float v) const {
    const float g = gate[mod_row(row) * 6144 + col]; float* p = x + (size_t)row * D + col; *p = *p + g * v; } };

namespace pg8 {
#define PG8_LAS __attribute__((address_space(3)))
typedef unsigned short bf16_t;
typedef short bf16x8 __attribute__((ext_vector_type(8)));
typedef float f32x4 __attribute__((ext_vector_type(4)));
typedef unsigned u32x4 __attribute__((ext_vector_type(4)));
constexpr int BM = 256, BK = 64, HALF = 128, HTB = HALF * BK * 2  , STAGE_BYTES = 8 * HTB, NXCD = 8, WGM = 8;

__host__ __device__ __forceinline__ int lds_byte(int r, int c) { const int st = (r >> 4) * 2 + (c >> 5), rr = r & 15, cc = c & 31, ob = rr * 64 + cc * 2; return st * 1024 + (ob ^ (((ob >> 9) & 1) << 5)); }
__host__ __device__ __forceinline__ void stage_rc(int b, int& R, int& C) { const int st = b / 1024, sb = b % 1024, swz = sb ^ (((sb >> 9) & 1) << 5); R = (st >> 1) * 16 + swz / 64; C = (st & 1) * 32 + (swz % 64) / 2; }
__host__ __device__ __forceinline__ int perm32(int rho) { const int n = rho >> 4, i = rho & 15; return 8 * (i >> 2) + 4 * n + (i & 3); }

struct Unit { int pm, pn; };
struct Gemm { const bf16_t* A; const bf16_t* Bt; int M, N, K; size_t agrp; };

struct StaticOrder {
    int nM, nN, nwg, G, c;
    __host__ __device__ void init(int M, int N, int G_, int c_) { nM = M / BM; nN = N / BM; nwg = nM * nN; G = G_; c = c_; }
    __host__ __device__ bool next(int i, Unit& u) const {
        const long L = (long)i * G + c; if (L >= nwg) return false;
        int wgid = (int)L; { const int q = nwg / NXCD, r = nwg % NXCD, xcd = wgid % NXCD, off = wgid / NXCD; wgid = (xcd < r ? xcd * (q + 1) : r * (q + 1) + (xcd - r) * q) + off; }
        const int nig = WGM * nN, gid = wgid / nig, fm = gid * WGM, gsz = (nM - fm) < WGM ? (nM - fm) : WGM;
        u.pm = fm + ((wgid % nig) % gsz); u.pn = (wgid % nig) / gsz; return true;
    }
    __device__ __forceinline__ void a_ready(const Unit&) const {}
    __device__ __forceinline__ void done(const Unit&) const {}
};
__device__ __forceinline__ unsigned cvt_pk_bf16(float lo, float hi) { unsigned r; asm volatile("v_cvt_pk_bf16_f32 %0, %1, %2" : "=v"(r) : "v"(lo), "v"(hi)); return r; }
template <class Epi, class Sched, bool STAMP = false>
__device__ __forceinline__ void gemm_phase(PG8_LAS unsigned char* lds, const Gemm g, const Sched& S, const Epi& E, unsigned long long* stamps) {
    const int tid = otid(), wid = __builtin_amdgcn_readfirstlane(tid >> 6), lane = tid & 63, wr = wid >> 2, wc = wid & 3, fr = lane & 15, fq = lane >> 4;
    const int K = g.K, nt = K / BK;
    int ts_lo = 0, ts_hi = 0, nts = 0; const unsigned long long rt_entry = STAMP ? (unsigned long long)wall_clock64() : 0ull;
#define PG8_STAMP() do { if (STAMP && wid == 0 && nts < 64) { const unsigned long long _c = (unsigned long long)clock64(); \
        ts_lo = (lane == nts) ? (int)(unsigned)_c : ts_lo; ts_hi = (lane == nts) ? (int)(unsigned)(_c >> 32) : ts_hi; ++nts; } } while (0)
    PG8_STAMP();
    unsigned voffA[2], voffB[2];
#pragma unroll
    for (int i = 0; i < 2; ++i) { int R, C; stage_rc(tid * 16 + i * 8192, R, C); const int Rb = Epi::PERM ? ((R & ~31) + perm32(R & 31)) : R;
        voffA[i] = (unsigned)(R * K + C) * 2u; voffB[i] = (unsigned)(Rb * K + C) * 2u; }
    const size_t kstep = (size_t)(BK * 2);
    const size_t hstep = (size_t)HALF * K * 2;
    const size_t tstep = 2 * hstep;
    const unsigned ldsw = (unsigned)wid * 1024u;
    const int aoff = lds_byte(wr * 64 + fr, fq * 8), boff = lds_byte(wc * 32 + fr, fq * 8);
#define PG8_SA(b, h) (((b) * 2 + (h)) * HTB)
#define PG8_SB(b, h) ((4 + (b) * 2 + (h)) * HTB)
#define PG8_STAGE(bufoff, gbase, voff) do { _Pragma("unroll") for (int _i = 0; _i < 2; ++_i) \
        __builtin_amdgcn_global_load_lds((const unsigned*)((const char*)(gbase) + (voff)[_i]), (PG8_LAS unsigned*)(lds + (bufoff) + ldsw + _i * 8192), 16, 0, 0); } while (0)
#define PG8_LDA(dst, b, h) do { _Pragma("unroll") for (int m = 0; m < 4; ++m) _Pragma("unroll") for (int k = 0; k < 2; ++k) dst[m][k] = *(const PG8_LAS bf16x8*)(lds + PG8_SA(b, h) + aoff + m * 2048 + k * 1024); } while (0)
#define PG8_LDB(dst, b, h) do { _Pragma("unroll") for (int n = 0; n < 2; ++n) _Pragma("unroll") for (int k = 0; k < 2; ++k) dst[n][k] = *(const PG8_LAS bf16x8*)(lds + PG8_SB(b, h) + boff + n * 2048 + k * 1024); } while (0)
#define PG8_MMA(ai, bj, At, Bt) do { __builtin_amdgcn_s_setprio(1); _Pragma("unroll") for (int m = 0; m < 4; ++m) _Pragma("unroll") for (int n = 0; n < 2; ++n) _Pragma("unroll") for (int k = 0; k < 2; ++k) \
        acc[ai][bj][m][n] = __builtin_amdgcn_mfma_f32_16x16x32_bf16(Bt[n][k], At[m][k], acc[ai][bj][m][n], 0, 0, 0); __builtin_amdgcn_s_setprio(0); } while (0)
#define PG8_WAIT_V(n) asm volatile("s_waitcnt vmcnt(" #n ")" ::: "memory")
#define PG8_WAIT_L(n) asm volatile("s_waitcnt lgkmcnt(" #n ")" ::: "memory")
#define PG8_BAR __builtin_amdgcn_s_barrier()
#define PG8_SCHED __builtin_amdgcn_sched_barrier(0)
    Unit cur, nxt; int ui = 0;
    if (!S.next(0, cur)) return;
    f32x4 acc[2][2][4][2];
#pragma unroll
    for (int a = 0; a < 2; ++a)
#pragma unroll
        for (int b = 0; b < 2; ++b)
#pragma unroll
            for (int m = 0; m < 4; ++m)
#pragma unroll
                for (int n = 0; n < 2; ++n) acc[a][b][m][n] = (f32x4){0.f, 0.f, 0.f, 0.f};
    bf16x8 At[4][2], B0[2][2], B1[2][2];
    const char* cA = (const char*)g.A + (size_t)cur.pm * tstep + (size_t)(cur.pn >> 2) * g.agrp; const char* cB = (const char*)g.Bt + (size_t)cur.pn * tstep;
    S.a_ready(cur);
    PG8_STAGE(PG8_SB(0, 0), cB, voffB); PG8_STAGE(PG8_SA(0, 0), cA, voffA); PG8_STAGE(PG8_SB(0, 1), cB + hstep, voffB); PG8_STAGE(PG8_SA(0, 1), cA + hstep, voffA);
    if (wr == 1) PG8_BAR;
    PG8_WAIT_V(4); PG8_BAR;
    PG8_STAGE(PG8_SB(1, 0), cB + kstep, voffB); PG8_STAGE(PG8_SA(1, 0), cA + kstep, voffA); PG8_STAGE(PG8_SB(1, 1), cB + hstep + kstep, voffB);
    PG8_WAIT_V(6); PG8_BAR;
    PG8_STAMP();
    for (;;) {
        const bool has_next = S.next(ui + 1, nxt);
        const char* nA = has_next ? (const char*)g.A + (size_t)nxt.pm * tstep + (size_t)(nxt.pn >> 2) * g.agrp : cA; const char* nB = has_next ? (const char*)g.Bt + (size_t)nxt.pn * tstep : cB;
        for (int t = 0; t < nt; t += 2) {
            const bool last = (t == nt - 2);
            const char* a1 = cA + (size_t)(t + 1) * kstep;
            const char* a2 = last ? nA : cA + (size_t)(t + 2) * kstep; const char* b2 = last ? nB : cB + (size_t)(t + 2) * kstep;
            const char* a3 = a2 + kstep; const char* b3 = b2 + kstep;
            if (last && has_next) S.a_ready(nxt);
            PG8_LDB(B0, 0, 0); PG8_SCHED; PG8_LDA(At, 0, 0); PG8_STAGE(PG8_SA(1, 1), a1 + hstep, voffA);
            PG8_WAIT_L(8); PG8_BAR; PG8_WAIT_L(0); PG8_MMA(0, 0, At, B0); PG8_BAR; PG8_SCHED;
            PG8_LDB(B1, 0, 1); PG8_STAGE(PG8_SB(0, 0), b2, voffB);
            PG8_BAR; PG8_WAIT_L(0); PG8_MMA(0, 1, At, B1); PG8_BAR;
            PG8_LDA(At, 0, 1); PG8_STAGE(PG8_SA(0, 0), a2, voffA);
            PG8_BAR; PG8_WAIT_L(0); PG8_MMA(1, 0, At, B0); PG8_BAR; PG8_SCHED;
            PG8_STAGE(PG8_SB(0, 1), b2 + hstep, voffB);
            PG8_WAIT_V(6); PG8_BAR; PG8_MMA(1, 1, At, B1); PG8_BAR;
            PG8_LDB(B0, 1, 0); PG8_SCHED; PG8_LDA(At, 1, 0); PG8_STAGE(PG8_SA(0, 1), a2 + hstep, voffA);
            PG8_WAIT_L(8); PG8_BAR; PG8_WAIT_L(0); PG8_MMA(0, 0, At, B0); PG8_BAR; PG8_SCHED;
            PG8_LDB(B1, 1, 1); PG8_STAGE(PG8_SB(1, 0), b3, voffB);
            PG8_BAR; PG8_WAIT_L(0); PG8_MMA(0, 1, At, B1); PG8_BAR;
            PG8_LDA(At, 1, 1); PG8_STAGE(PG8_SA(1, 0), a3, voffA);
            PG8_BAR; PG8_WAIT_L(0); PG8_MMA(1, 0, At, B0); PG8_BAR; PG8_SCHED;
            PG8_STAGE(PG8_SB(1, 1), b3 + hstep, voffB);
            PG8_WAIT_V(6); PG8_BAR; PG8_MMA(1, 1, At, B1); PG8_BAR;
        }
        PG8_STAMP();
        if constexpr (!Epi::AFTER_DRAIN) { E(acc, cur, wr, wc, fr, fq); S.done(cur); }
        PG8_STAMP();
        if (!has_next) break;
#pragma unroll
        for (int a = 0; a < 2; ++a)
#pragma unroll
            for (int b = 0; b < 2; ++b)
#pragma unroll
                for (int m = 0; m < 4; ++m)
#pragma unroll
                    for (int n = 0; n < 2; ++n) acc[a][b][m][n] = (f32x4){0.f, 0.f, 0.f, 0.f};
        cur = nxt; cA = nA; cB = nB; ++ui;
    }
    PG8_WAIT_V(0);
    if (wr == 0) PG8_BAR;
    PG8_BAR;
    if constexpr (Epi::AFTER_DRAIN) { E.fused(acc, cur, wr, wc, fr, fq, lds, wid, lane); S.done(cur); }
    PG8_STAMP();
    if (STAMP && wid == 0) { stamps[lane] = lane < nts ? (((unsigned long long)(unsigned)ts_hi << 32) | (unsigned)ts_lo) : 0ull;
        if (lane == 62) stamps[62] = rt_entry; if (lane == 63) stamps[63] = (unsigned long long)wall_clock64(); }
#undef PG8_STAMP
#undef PG8_SA
#undef PG8_SB
#undef PG8_STAGE
#undef PG8_LDA
#undef PG8_LDB
#undef PG8_MMA
#undef PG8_WAIT_V
#undef PG8_WAIT_L
#undef PG8_BAR
#undef PG8_SCHED
}
}

struct PEpiBf16 {
    static constexpr bool PERM = true, AFTER_DRAIN = false;
    bf16_t* C; int ldc, N, act;
    __device__ __forceinline__ void operator()(const pg8::f32x4 (&acc)[2][2][4][2], const pg8::Unit& u, int wr, int wc, int fr, int fq) const {
        const int row0 = u.pm * 256 + wr * 64 + fr, col0 = u.pn * 256 + wc * 32 + 8 * fq;
#pragma unroll
        for (int ai = 0; ai < 2; ++ai)
#pragma unroll
            for (int m = 0; m < 4; ++m) {
                bf16_t* rowp = C + (size_t)(row0 + ai * 128 + m * 16) * ldc;
#pragma unroll
                for (int bj = 0; bj < 2; ++bj) {
                    const int col = col0 + bj * 128;
                    pg8::f32x4 v0 = acc[ai][bj][m][0], v1 = acc[ai][bj][m][1];
                    if (act == 1) { v0.x = fmaxf(v0.x, 0.f); v0.y = fmaxf(v0.y, 0.f); v0.z = fmaxf(v0.z, 0.f); v0.w = fmaxf(v0.w, 0.f); v0 = v0 * v0;
                                    v1.x = fmaxf(v1.x, 0.f); v1.y = fmaxf(v1.y, 0.f); v1.z = fmaxf(v1.z, 0.f); v1.w = fmaxf(v1.w, 0.f); v1 = v1 * v1; }
                    if (act == 2) { v0.x = sigmoidf_(v0.x); v0.y = sigmoidf_(v0.y); v0.z = sigmoidf_(v0.z); v0.w = sigmoidf_(v0.w);
                                    v1.x = sigmoidf_(v1.x); v1.y = sigmoidf_(v1.y); v1.z = sigmoidf_(v1.z); v1.w = sigmoidf_(v1.w); }
                    u32x4 w; w.x = pk2(v0.x, v0.y); w.y = pk2(v0.z, v0.w); w.z = pk2(v1.x, v1.y); w.w = pk2(v1.z, v1.w);
                    if (col < N) *(u32x4*)(rowp + col) = w;
                }
            }
    }
};
struct PEpiResid {
    static constexpr bool PERM = true, AFTER_DRAIN = false;
    float* x; const float* gate;
    __device__ __forceinline__ void operator()(const pg8::f32x4 (&acc)[2][2][4][2], const pg8::Unit& u, int wr, int wc, int fr, int fq) const {
        const int row0 = u.pm * 256 + wr * 64 + fr, col0 = u.pn * 256 + wc * 32 + 8 * fq;
#pragma unroll
        for (int ai = 0; ai < 2; ++ai)
#pragma unroll
            for (int m = 0; m < 4; ++m) {
                const int row = row0 + ai * 128 + m * 16;
                float* rowp = x + (size_t)row * D; const float* gp = gate + (size_t)mod_row(row) * 6144;
#pragma unroll
                for (int bj = 0; bj < 2; ++bj) {
                    const int col = col0 + bj * 128;
                    const f32x4 g0 = *(const f32x4*)(gp + col), g1 = *(const f32x4*)(gp + col + 4);
                    f32x4 x0 = *(const f32x4*)(rowp + col), x1 = *(const f32x4*)(rowp + col + 4);
                    x0 = x0 + g0 * acc[ai][bj][m][0]; x1 = x1 + g1 * acc[ai][bj][m][1];
                    *(f32x4*)(rowp + col) = x0; *(f32x4*)(rowp + col + 4) = x1;
                }
            }
    }
};
struct PEpiGate {
    static constexpr bool PERM = true, AFTER_DRAIN = false;
    bf16_t* G; int ldc;
    __device__ __forceinline__ void operator()(const pg8::f32x4 (&acc)[2][2][4][2], const pg8::Unit& u, int wr, int wc, int fr, int fq) const {
        const int row0 = u.pm * 256 + wr * 64 + fr, col0 = u.pn * 256 + wc * 32 + 8 * fq;
#pragma unroll
        for (int ai = 0; ai < 2; ++ai)
#pragma unroll
            for (int m = 0; m < 4; ++m) {
                bf16_t* rowp = G + (size_t)(row0 + ai * 128 + m * 16) * ldc;
#pragma unroll
                for (int bj = 0; bj < 2; ++bj) {
                    const int col = col0 + bj * 128;
                    const u32x4 g = *(const u32x4*)(rowp + col);
                    const pg8::f32x4 v0 = acc[ai][bj][m][0], v1 = acc[ai][bj][m][1];
                    u32x4 w; w.x = pk2(bflo(g.x) * v0.x, bfhi(g.x) * v0.y); w.y = pk2(bflo(g.y) * v0.z, bfhi(g.y) * v0.w);
                    w.z = pk2(bflo(g.z) * v1.x, bfhi(g.z) * v1.y); w.w = pk2(bflo(g.w) * v1.z, bfhi(g.w) * v1.w);
                    *(u32x4*)(rowp + col) = w;
                }
            }
    }
};
__device__ __forceinline__ void sum3_phase(const Params& p) {
    const bf16_t* Y = (const bf16_t*)(p.ws + WS_PROJ); bf16_t* merged = (bf16_t*)(p.ws + WS_ST);
    for (size_t i = (size_t)blockIdx.x * 512 + otid(); i < (size_t)NTOK * (D / 8); i += (size_t)gridDim.x * 512) {
        const size_t row = i >> 7; const int c8 = (int)(i & 127) * 8;
        const bf16_t* yr = Y + row * NGATE + c8;
        const u32x4 a = *(const u32x4*)yr, b = *(const u32x4*)(yr + 1024), c = *(const u32x4*)(yr + 2048);
        u32x4 w; w.x = pk2(bflo(a.x) + bflo(b.x) + bflo(c.x), bfhi(a.x) + bfhi(b.x) + bfhi(c.x)); w.y = pk2(bflo(a.y) + bflo(b.y) + bflo(c.y), bfhi(a.y) + bfhi(b.y) + bfhi(c.y));
        w.z = pk2(bflo(a.z) + bflo(b.z) + bflo(c.z), bfhi(a.z) + bfhi(b.z) + bfhi(c.z)); w.w = pk2(bflo(a.w) + bflo(b.w) + bflo(c.w), bfhi(a.w) + bfhi(b.w) + bfhi(c.w));
        *(u32x4*)(merged + row * D + c8) = w;
    }
}
template <class Epi>
__device__ __forceinline__ void pg8_gemm(LAS unsigned char* lds, const bf16_t* A, const bf16_t* Bt, int M, int N, int K, const Epi& e, size_t agrp = 0) {
    pg8::Gemm g{A, Bt, M, N, K, agrp};
    pg8::StaticOrder so; so.init(M, N, (int)gridDim.x, (int)blockIdx.x);
    pg8::gemm_phase<Epi, pg8::StaticOrder, false>(lds, g, so, e, nullptr);
    __syncthreads();
}

__device__ __forceinline__ void grid_barrier(unsigned* bar, unsigned k) {
    asm volatile("s_waitcnt vmcnt(0)" ::: "memory");
    __syncthreads();
    if (otid() == 0) {
        const unsigned g = blockIdx.x & 7u, ng = (gridDim.x + 7u - g) >> 3;
        __builtin_amdgcn_fence(__ATOMIC_RELEASE, "agent");
        asm volatile("s_waitcnt vmcnt(0)" ::: "memory");
        const unsigned c = __hip_atomic_fetch_add(bar + 16 * g, 1u, __ATOMIC_RELAXED, __HIP_MEMORY_SCOPE_AGENT);
        if (c == ng * k - 1u) {
            const unsigned ngroups = gridDim.x < 8u ? gridDim.x : 8u;
            const unsigned t = __hip_atomic_fetch_add(bar + 128, 1u, __ATOMIC_RELAXED, __HIP_MEMORY_SCOPE_AGENT);
            if (t == ngroups * k - 1u)
                for (unsigned j = 0; j < ngroups; ++j) __hip_atomic_store(bar + 144 + 16 * j, k, __ATOMIC_RELAXED, __HIP_MEMORY_SCOPE_AGENT);
        }
        unsigned spins = 0;
        while (__hip_atomic_load(bar + 144 + 16 * g, __ATOMIC_RELAXED, __HIP_MEMORY_SCOPE_AGENT) < k && ++spins < (1u << 28)) __builtin_amdgcn_s_sleep(1);
        __builtin_amdgcn_fence(__ATOMIC_ACQUIRE, "agent");
        asm volatile("s_waitcnt vmcnt(0)" ::: "memory");
    }
    __syncthreads();
}

__device__ __forceinline__ void transpose_item(const float* __restrict__ W, int N, int K, int k0, int n0, bf16_t* __restrict__ dst  , LAS float* scr, int lane) {
#pragma unroll 8
    for (int i = 0; i < 32; ++i) { const int kk = 2 * i + (lane >> 5); scr[kk * 33 + (lane & 31)] = W[(size_t)(k0 + kk) * N + n0 + (lane & 31)]; }
    LDS_WAIT();
    const int c = lane & 7;
#pragma unroll
    for (int j = 0; j < 4; ++j) {
        const int n = (lane >> 3) + 8 * j; const LAS float* s = scr + (8 * c) * 33 + n;
        u32x4 o; o.x = pk2(s[0 * 33], s[1 * 33]); o.y = pk2(s[2 * 33], s[3 * 33]); o.z = pk2(s[4 * 33], s[5 * 33]); o.w = pk2(s[6 * 33], s[7 * 33]);
        *(u32x4*)(dst + (size_t)n * K + k0 + 8 * c) = o;
    }
    LDS_WAIT();
}

constexpr int CONV_NIT = 16 * 257 + 3 * 8 * 32 + 16 * 32 + 16 * 128 + 64 * 32, CONV_BLOCK_ITEMS = (CONV_NIT + 7) / 8;
__device__ __forceinline__ void convert_weights(const Params& p, int l, LAS unsigned char* lds, int bitem = -1) {
    const int lane = otid() & 63, wid = otid() >> 6;
    LAS float* scr = (LAS float*)(lds + wid * 16384);
    unsigned char* wb = p.ws + WS_W + (size_t)(l & 1) * W_END;
    constexpr int I_IN = 16 * 257, I_BR = 8 * 32, I_OUT = 16 * 32, I_FF1 = 16 * 128, I_FF2 = 64 * 32;
    constexpr int NIT = I_IN + 3 * I_BR + I_OUT + I_FF1 + I_FF2;
    for (int it = (bitem < 0 ? blockIdx.x * 8 + wid : bitem * 8 + wid); it < NIT; it += (bitem < 0 ? gridDim.x * 8 : NIT)) {
        int r = it;
        if (r < I_IN) { const int kb = r / 257, nb = r % 257, n0 = nb * 32;
            bf16_t* dst = n0 < NPROJ ? (bf16_t*)(wb + W_IN) + (size_t)n0 * D : (bf16_t*)(wb + W_G) + (size_t)(n0 - NPROJ) * D;
            transpose_item(p.w_in + (size_t)l * D * DIN, DIN, D, kb * 64, n0, dst, scr, lane); continue; }
        r -= I_IN;
        if (r < 3 * I_BR) { const int b = r / I_BR, q = r % I_BR, kb = q / 32, nb = q % 32;
            const float* W = (b == 0 ? p.w_br_gla : b == 1 ? p.w_br_hg : p.w_br_gm) + (size_t)l * 512 * D;
            transpose_item(W, D, 512, kb * 64, nb * 32, (bf16_t*)(wb + W_BR) + (size_t)b * D * 512 + (size_t)nb * 32 * 512, scr, lane); continue; }
        r -= 3 * I_BR;
        if (r < I_OUT) { const int kb = r / 32, nb = r % 32;
            transpose_item(p.w_out + (size_t)l * D * D, D, D, kb * 64, nb * 32, (bf16_t*)(wb + W_OUT) + (size_t)nb * 32 * D, scr, lane); continue; }
        r -= I_OUT;
        if (r < I_FF1) { const int kb = r / 128, nb = r % 128;
            transpose_item(p.w_ff1 + (size_t)l * D * DFF, DFF, D, kb * 64, nb * 32, (bf16_t*)(wb + W_FF1) + (size_t)nb * 32 * D, scr, lane); continue; }
        r -= I_FF1;
        { const int kb = r / 32, nb = r % 32;
            transpose_item(p.w_ff2 + (size_t)l * DFF * D, D, DFF, kb * 64, nb * 32, (bf16_t*)(wb + W_FF2) + (size_t)nb * 32 * DFF, scr, lane); }
    }
}

__device__ __forceinline__ void phase0(const Params& p, LAS unsigned char* lds) {
    const int tid = otid();
    float* x = p.out;
    for (size_t i = (size_t)blockIdx.x * 512 + tid; i < (size_t)NTOK * (D / 4); i += (size_t)gridDim.x * 512) {
        const int tok = (int)(i >> 8), c4 = (int)(i & 255) * 4;
        f32x4 v;
        if (tok < NCTX) v = *(const f32x4*)(p.x_prompt + (size_t)tok * D + c4);
        else {
            const int lt = tok - NCTX; v = *(const f32x4*)(p.x_sample + (size_t)lt * D + c4);
            const int t = lt & 2047; const float rr = (float)(t >> 6), cc = (float)(t & 63);
            const int sec = c4 >> 8; const float pos = sec < 2 ? rr : cc;
#pragma unroll
            for (int j = 0; j < 4; ++j) {
                const int f = (c4 + j) & 255;
                const float omega = exp2f((float)f * (-13.287712379549449f / 256.0f));
                const float a = pos * omega;
                v[j] += (sec & 1) ? __cosf(a) : __sinf(a);
            }
        }
        *(f32x4*)(x + i * 4) = v;
    }
    if (blockIdx.x == 0) {
        float* lbs = (float*)(p.ws + WS_LBS);
        for (int i = tid; i < 1024; i += 512) {
            const int dir = i >> 9, ch = i & 511; float lg[4], mx = -1e30f;
            for (int l = 0; l < 4; ++l) { lg[l] = p.hg_lb_logits[(size_t)(dir * 4 + l) * 512 + ch]; mx = fmaxf(mx, lg[l]); }
            float s = 0.f; for (int l = 0; l < 4; ++l) { lg[l] = expf(lg[l] - mx); s += lg[l]; }
            float cum = 0.f, c0 = 0.f;
            for (int l = 0; l < 4; ++l) { cum += lg[l] / s; if (l == 0) c0 = cum; lbs[(size_t)(dir * 4 + l) * 512 + ch] = cum - c0; }
        }
        for (int i = tid; i < 1024; i += 512) ((unsigned*)(p.ws + WS_CTR))[i] = 0u;
    }
    LAS float* sc = (LAS float*)lds;
    LAS float* red = sc + 9 * 1024;
    for (int i = tid; i < 9 * 1024; i += 512) { const int r = i >> 10, k = i & 1023; const float v = r == 0 ? p.c_ctx[k] : p.c[(size_t)(r - 1) * D + k]; sc[i] = siluf_(v); }
    __syncthreads();
    float* mod = (float*)(p.ws + WS_MOD);
    for (int u = blockIdx.x; u < DEPTH * 48; u += gridDim.x) {
        const int l = u / 48, cb = u % 48, cl = tid & 127, kp = tid >> 7, n = cb * 128 + cl;
        const float* w = p.ada_w + (size_t)l * D * 6144 + n;
        float a[9];
#pragma unroll
        for (int r = 0; r < 9; ++r) a[r] = 0.f;
#pragma unroll 4
        for (int k = kp * 256; k < kp * 256 + 256; ++k) {
            const float wv = w[(size_t)k * 6144];
#pragma unroll
            for (int r = 0; r < 9; ++r) a[r] += sc[r * 1024 + k] * wv;
        }
#pragma unroll
        for (int r = 0; r < 9; ++r) red[(kp * 9 + r) * 128 + cl] = a[r];
        __syncthreads();
        for (int i = tid; i < 9 * 128; i += 512) {
            const int r = i >> 7, c2 = i & 127;
            const float s = red[(0 * 9 + r) * 128 + c2] + red[(1 * 9 + r) * 128 + c2] + red[(2 * 9 + r) * 128 + c2] + red[(3 * 9 + r) * 128 + c2];
            mod[((size_t)l * 9 + r) * 6144 + cb * 128 + c2] = s + p.ada_b[(size_t)l * 6144 + cb * 128 + c2];
        }
        __syncthreads();
    }
}

__device__ __forceinline__ void norm_phase(const Params& p, const float* g, const float* mod_l, int off_sh, int off_sc, bf16_t* hout, int mode) {
    const int lane = otid() & 63, wid = otid() >> 6;
    float* x = p.out;
    for (int row = blockIdx.x * 8 + wid; row < NTOK; row += gridDim.x * 8) {
        f32x4 v[4]; float s = 0.f;
        float* xr = x + (size_t)row * D;
#pragma unroll
        for (int j = 0; j < 4; ++j) { v[j] = *(const f32x4*)(xr + lane * 4 + 256 * j); s += v[j].x * v[j].x + v[j].y * v[j].y + v[j].z * v[j].z + v[j].w * v[j].w; }
        const float rstd = rsqrtf(wave_sum(s) * (1.0f / D) + EPS);
        if (mode == 0) {
            const float* mr = mod_l + (size_t)mod_row(row) * 6144;
#pragma unroll
            for (int j = 0; j < 4; ++j) {
                const int c = lane * 4 + 256 * j;
                const f32x4 gg = *(const f32x4*)(g + c), sh = *(const f32x4*)(mr + off_sh + c), scv = *(const f32x4*)(mr + off_sc + c);
                const f32x4 o = (v[j] * rstd) * gg * (scv + 1.0f) + sh;
                u32x2 w; w.x = pk2(o.x, o.y); w.y = pk2(o.z, o.w);
                *(u32x2*)(hout + (size_t)row * D + c) = w;
            }
        } else {
#pragma unroll
            for (int j = 0; j < 4; ++j) { const int c = lane * 4 + 256 * j; const f32x4 gg = *(const f32x4*)(g + c); *(f32x4*)(xr + c) = (v[j] * rstd) * gg; }
        }
    }
}

template <int MIX>
__device__ __forceinline__ void gate_eval(const bf16_t* row, int kcol, int zcol, const float (&lrw)[16], float lrb, float lb, float& gt, float& kt) {
    if (!MIX) {
        const bf16_t* zr = row + zcol;
        const u32x4 z0 = *(const u32x4*)zr, z1 = *(const u32x4*)(zr + 8);
        float z = lrb;
        z += bflo(z0.x) * lrw[0] + bfhi(z0.x) * lrw[1] + bflo(z0.y) * lrw[2] + bfhi(z0.y) * lrw[3] + bflo(z0.z) * lrw[4] + bfhi(z0.z) * lrw[5] + bflo(z0.w) * lrw[6] + bfhi(z0.w) * lrw[7];
        z += bflo(z1.x) * lrw[8] + bfhi(z1.x) * lrw[9] + bflo(z1.y) * lrw[10] + bfhi(z1.y) * lrw[11] + bflo(z1.z) * lrw[12] + bfhi(z1.z) * lrw[13] + bflo(z1.w) * lrw[14] + bfhi(z1.w) * lrw[15];
        gt = logsigmoidf_(z) * (1.0f / 16.0f);
        kt = bf2f(row[kcol]);
    } else {
        const float xf = bf2f(row[kcol]);
        const float sg = sigmoidf_(xf);
        gt = flog_(lb + (1.0f - lb) * sg);
        kt = (1.0f - lb) * (1.0f - sg);
    }
}

template <int MIX>
__device__ __forceinline__ void gate_raw(unsigned kraw, const u32x4& z0, const u32x4& z1, const float (&lrw)[16], float lrb, float lb, float& gt, float& kt) {
    if (!MIX) {
        float z = lrb;
        z += bflo(z0.x) * lrw[0] + bfhi(z0.x) * lrw[1] + bflo(z0.y) * lrw[2] + bfhi(z0.y) * lrw[3] + bflo(z0.z) * lrw[4] + bfhi(z0.z) * lrw[5] + bflo(z0.w) * lrw[6] + bfhi(z0.w) * lrw[7];
        z += bflo(z1.x) * lrw[8] + bfhi(z1.x) * lrw[9] + bflo(z1.y) * lrw[10] + bfhi(z1.y) * lrw[11] + bflo(z1.z) * lrw[12] + bfhi(z1.z) * lrw[13] + bflo(z1.w) * lrw[14] + bfhi(z1.w) * lrw[15];
        gt = logsigmoidf_(z) * (1.0f / 16.0f);
        kt = bflo(kraw);
    } else {
        const float xf = bflo(kraw);
        const float sg = sigmoidf_(xf);
        gt = flog_(lb + (1.0f - lb) * sg);
        kt = (1.0f - lb) * (1.0f - sg);
    }
}

template <int MIX>
__device__ __forceinline__ void scan_job(const Params& p, int l, int s, int dir, int hd, LAS unsigned char* lds) {
    constexpr int DK = MIX ? 128 : 64, WM = DK / 32, WN = 8 / WM, WTN = 128 / WN, NTL = WTN / 32, LDT = 72, LDG = DK + 1;
    LAS bf16_t* At = (LAS bf16_t*)lds;
    LAS bf16_t* Bt = At + 128 * LDT;
    LAS float* dec = (LAS float*)(lds + 2 * 128 * LDT * 2);
    LAS float* G = dec + 128;
    LAS float* KK = G + 64 * 129;
    const int tid = otid(), lane = tid & 63, wid = tid >> 6, wm = wid / WN, wn = wid % WN;
    const bool ctx = s < 16;
    const int T = ctx ? 256 : 2048, tok0 = ctx ? s * 256 : NCTX + (s - 16) * 2048, nch = T / 64;
    const bf16_t* proj = (const bf16_t*)(p.ws + WS_PROJ);
    const float* lbs = (const float*)(p.ws + WS_LBS);
    bf16_t* sbuf = (bf16_t*)(p.ws + WS_ST + (MIX ? ST_GLA_BYTES : 0));
    f32x16 S[1][NTL];
    {
        const float* st0 = ctx ? nullptr : (MIX ? p.state_hgrn + ((((size_t)(s - 16) * DEPTH + l) * 2 + dir) * 4 + hd) * 128 * 128
                                                : p.state_gla + ((((size_t)(s - 16) * DEPTH + l) * 2 + dir) * 4 + hd) * 64 * 128);
#pragma unroll
        for (int n = 0; n < NTL; ++n)
#pragma unroll
            for (int i = 0; i < 16; ++i) {
                const int d = wm * 32 + (i & 3) + 8 * (i >> 2) + 4 * (lane >> 5), v = wn * WTN + n * 32 + (lane & 31);
                S[0][n][i] = ctx ? 0.f : st0[(size_t)d * 128 + v];
            }
    }
    const int sd = tid & (DK - 1), t0 = tid / DK; constexpr int TS = 512 / DK;
    float lrw[16]; float lrb = 0.f, lb = 0.f;
    if (!MIX) {
#pragma unroll
        for (int r = 0; r < 16; ++r) lrw[r] = p.gla_lr_w[(((size_t)l * 2 + dir) * 16 + r) * 256 + hd * 64 + sd];
        lrb = p.gla_lr_b[((size_t)l * 2 + dir) * 256 + hd * 64 + sd];
    } else {
#pragma unroll
        for (int r = 0; r < 16; ++r) lrw[r] = 0.f;
        lb = lbs[(size_t)(dir * 4 + l) * 512 + hd * 128 + sd];
    }
    const int kcol = MIX ? (dir ? PJ_HFB : PJ_HFF) + hd * 128 + sd : PJ_GK + hd * 64 + sd;
    const int zcol = dir ? PJ_GZB : PJ_GZF;
    const int vv = tid & 127, vq = tid >> 7;
    const int vcol = (MIX ? PJ_HI : PJ_GV) + hd * 128 + vv;
    const int kd = tid >> 2, kq = tid & 3;
    const bool k2 = tid < 4 * DK;

    constexpr int NE = 64 / TS;
    unsigned kraw[NE]; unsigned vraw[8];
    const int widu = __builtin_amdgcn_readfirstlane(tid >> 6), gmt = (widu >> 1) & 1, gnt = widu & 1;
    bf16x8 gafr = {0, 0, 0, 0, 0, 0, 0, 0}; u32x4 gbw = {0u, 0u, 0u, 0u}; float gbias = 0.f;
    if (!MIX && widu < 4) {
        const float* lw = p.gla_lr_w + (((size_t)l * 2 + dir) * 16 + 8 * (lane >> 5)) * 256 + hd * 64 + gnt * 32 + (lane & 31);
        float wv[8];
#pragma unroll
        for (int j = 0; j < 8; ++j) wv[j] = lw[(size_t)j * 256];
        gbw.x = pk2(wv[0], wv[1]); gbw.y = pk2(wv[2], wv[3]); gbw.z = pk2(wv[4], wv[5]); gbw.w = pk2(wv[6], wv[7]);
        gbias = p.gla_lr_b[((size_t)l * 2 + dir) * 256 + hd * 64 + gnt * 32 + (lane & 31)];
    }
    auto load_chunk = [&](const bf16_t* prc) {
#pragma unroll
        for (int i = 0; i < NE; ++i) {
            const bf16_t* row = prc + (size_t)(t0 + TS * i) * NPROJ;
            kraw[i] = row[kcol];
        }
        if (!MIX && widu < 4) gafr = *(const bf16x8*)(prc + (size_t)(gmt * 32 + (lane & 31)) * NPROJ + zcol + 8 * (lane >> 5));
#pragma unroll
        for (int t = 0; t < 16; t += 2) {
            const unsigned a = prc[(size_t)(vq * 16 + t) * NPROJ + vcol], b = prc[(size_t)(vq * 16 + t + 1) * NPROJ + vcol];
            vraw[t >> 1] = a | (b << 16);
        }
    };
    auto store_state = [&](int gcs) {
        bf16_t* sb = sbuf + (((size_t)gcs * 2 + dir) * 4 + hd) * 128 * DK;
#pragma unroll
        for (int nn = 0; nn < NTL; ++nn)
#pragma unroll
            for (int q = 0; q < 4; ++q) {
                const int d0 = wm * 32 + 8 * q + 4 * (lane >> 5), v = wn * WTN + nn * 32 + (lane & 31);
                u32x2 w; w.x = pk2(S[0][nn][4 * q + 0], S[0][nn][4 * q + 1]); w.y = pk2(S[0][nn][4 * q + 2], S[0][nn][4 * q + 3]);
                *(u32x2*)(sb + (size_t)v * DK + d0) = w;
            }
    };
    load_chunk(proj + (size_t)(tok0 + (dir ? nch - 1 : 0) * 64) * NPROJ);
    store_state((tok0 >> 6) + (dir ? nch - 1 : 0));
    for (int n = 0; n < nch; ++n) {
        if (MIX) {
#pragma unroll
            for (int i = 0; i < NE; ++i) {
                const int t = t0 + TS * i; float gt, kt; const u32x4 zz = {0u, 0u, 0u, 0u};
                gate_raw<MIX>(kraw[i], zz, zz, lrw, lrb, lb, gt, kt);
                G[t * LDG + sd] = gt; KK[t * LDG + sd] = kt;
            }
        } else {
#pragma unroll
            for (int i = 0; i < NE; ++i) KK[(t0 + TS * i) * LDG + sd] = bflo(kraw[i]);
            if (widu < 4) {
                f32x16 zacc;
#pragma unroll
                for (int i = 0; i < 16; ++i) zacc[i] = 0.f;
                zacc = __builtin_amdgcn_mfma_f32_32x32x16_bf16(gafr, __builtin_bit_cast(bf16x8, gbw), zacc, 0, 0, 0);
#pragma unroll
                for (int i = 0; i < 16; ++i)
                    G[(gmt * 32 + (i & 3) + 8 * (i >> 2) + 4 * (lane >> 5)) * LDG + gnt * 32 + (lane & 31)] = logsigmoidf_(zacc[i] + gbias) * (1.0f / 16.0f);
            }
        }
#pragma unroll
        for (int q = 0; q < 2; ++q) { u32x4 w; w.x = vraw[4 * q]; w.y = vraw[4 * q + 1]; w.z = vraw[4 * q + 2]; w.w = vraw[4 * q + 3]; *(LAS u32x4*)(Bt + vv * LDT + vq * 16 + q * 8) = w; }
        if (n + 1 < nch) load_chunk(proj + (size_t)(tok0 + (dir ? nch - 2 - n : n + 1) * 64) * NPROJ);
        __syncthreads();
        if (k2) {
            float g[16]; float qs = 0.f;
#pragma unroll
            for (int t = 0; t < 16; ++t) { g[t] = G[(kq * 16 + t) * LDG + kd]; qs += g[t]; }
            const int lb4 = lane & ~3;
            const float s0 = __shfl(qs, lb4), s1 = __shfl(qs, lb4 + 1), s2 = __shfl(qs, lb4 + 2), s3 = __shfl(qs, lb4 + 3);
            const float total = (s0 + s1) + (s2 + s3);
            float pref = (kq > 0 ? s0 : 0.f) + (kq > 1 ? s1 : 0.f) + (kq > 2 ? s2 : 0.f);
            unsigned pkv[8];
#pragma unroll
            for (int t = 0; t < 16; ++t) {
                const float pe = pref; pref += g[t];
                const float w = dir ? pe : total - pref;
                const float kv = KK[(kq * 16 + t) * LDG + kd] * fexp_(w);
                if (t & 1) pkv[t >> 1] = pk2(__uint_as_float(pkv[t >> 1]), kv); else pkv[t >> 1] = __float_as_uint(kv);
            }
#pragma unroll
            for (int q = 0; q < 2; ++q) { u32x4 w; w.x = pkv[4 * q]; w.y = pkv[4 * q + 1]; w.z = pkv[4 * q + 2]; w.w = pkv[4 * q + 3]; *(LAS u32x4*)(At + kd * LDT + kq * 16 + q * 8) = w; }
            if (kq == 0) dec[kd] = fexp_(total);
        }
        __syncthreads();
#pragma unroll
        for (int nn = 0; nn < NTL; ++nn)
#pragma unroll
            for (int i = 0; i < 16; ++i) S[0][nn][i] *= dec[wm * 32 + (i & 3) + 8 * (i >> 2) + 4 * (lane >> 5)];
        mma_lds<1, NTL, 4>(S, At + wm * 32 * LDT, LDT, Bt + wn * WTN * LDT, LDT, lane);
        if (n + 1 < nch) store_state((tok0 >> 6) + (dir ? nch - 2 - n : n + 1));
        __syncthreads();
    }
    if (ctx) {
        float* o = MIX ? p.out + (size_t)NTOK * D + (size_t)16 * DEPTH * 2 * 4 * 64 * 128 + ((((size_t)s * DEPTH + l) * 2 + dir) * 4 + hd) * 128 * 128
                       : p.out + (size_t)NTOK * D + ((((size_t)s * DEPTH + l) * 2 + dir) * 4 + hd) * 64 * 128;
#pragma unroll
        for (int nn = 0; nn < NTL; ++nn)
#pragma unroll
            for (int i = 0; i < 16; ++i) {
                const int d = wm * 32 + (i & 3) + 8 * (i >> 2) + 4 * (lane >> 5), v = wn * WTN + nn * 32 + (lane & 31);
                o[(size_t)d * 128 + v] = S[0][nn][i];
            }
    }
}


__device__ __forceinline__ void gmlp_item(const Params& p, int l, int c2, int g, LAS unsigned char* lds) {
    constexpr int LDT = 136;
    LAS bf16_t* Aw = (LAS bf16_t*)lds;
    LAS bf16_t* Bt = Aw + 128 * LDT;
    const int tid = otid(), lane = tid & 63, wid = tid >> 6, wm = wid >> 2, wn = wid & 3;
    const bf16_t* proj = (const bf16_t*)(p.ws + WS_PROJ);
    const int tokb = c2 * 128;
    {
        const float* wsrc = p.gm_ws + ((size_t)l * 4 + g) * 128 * 128;
#pragma unroll
        for (int i = 0; i < 8; ++i) {
            const int e = (i * 512 + tid) * 4, pp = e >> 7, q = e & 127;
            const f32x4 v = *(const f32x4*)(wsrc + e);
            u32x2 w; w.x = pk2(v.x, v.y); w.y = pk2(v.z, v.w);
            *(LAS u32x2*)(Aw + pp * LDT + q) = w;
        }
    }
    {
        const int q = tid >> 2, part = tid & 3;
        const bf16_t* mv = proj + (size_t)(tokb + q) * NPROJ + PJ_MV;
        float s = 0.f, s2 = 0.f;
#pragma unroll
        for (int i = 0; i < 16; ++i) {
            const u32x4 u = *(const u32x4*)(mv + (i * 4 + part) * 8);
            const unsigned uu[4] = {u.x, u.y, u.z, u.w};
#pragma unroll
            for (int j = 0; j < 4; ++j) { const float a = geluf_(bflo(uu[j])), b = geluf_(bfhi(uu[j])); s += a + b; s2 += a * a + b * b; }
        }
        s += __shfl_xor(s, 1); s += __shfl_xor(s, 2); s2 += __shfl_xor(s2, 1); s2 += __shfl_xor(s2, 2);
        const float mean = s * (1.0f / 512.0f), var = fmaxf(s2 * (1.0f / 512.0f) - mean * mean, 0.f), rstd = rsqrtf(var + EPS);
        const float* gg = p.gm_norm_g + (size_t)l * 512 + g * 128 + part * 32;
        const bf16_t* mvg = mv + g * 128 + part * 32;
#pragma unroll
        for (int i = 0; i < 4; ++i) {
            const u32x4 u = *(const u32x4*)(mvg + i * 8);
            const unsigned uu[4] = {u.x, u.y, u.z, u.w};
#pragma unroll
            for (int j = 0; j < 4; ++j) {
                const int c = part * 32 + i * 8 + j * 2;
                const float a = (geluf_(bflo(uu[j])) - mean) * rstd * gg[i * 8 + j * 2], b = (geluf_(bfhi(uu[j])) - mean) * rstd * gg[i * 8 + j * 2 + 1];
                Bt[c * LDT + q] = f2bf(a); Bt[(c + 1) * LDT + q] = f2bf(b);
            }
        }
    }
    __syncthreads();
    f32x16 acc[2][1]; acc_zero<1>(acc);
    mma_lds<2, 1, 8>(acc, Aw + wm * 64 * LDT, LDT, Bt + wn * 32 * LDT, LDT, lane);
    bf16_t* ocat = (bf16_t*)(p.ws + WS_OCAT);
    const float* bs = p.gm_bs + ((size_t)l * 4 + g) * 128;
#pragma unroll
    for (int m = 0; m < 2; ++m)
#pragma unroll
        for (int i = 0; i < 16; ++i) {
            const int pp = wm * 64 + m * 32 + (i & 3) + 8 * (i >> 2) + 4 * (lane >> 5), c = wn * 32 + (lane & 31);
            const float mu = bf2f(proj[(size_t)(tokb + pp) * NPROJ + PJ_MU + g * 128 + c]);
            ocat[(size_t)2 * NTOK * 512 + (size_t)(tokb + pp) * 512 + g * 128 + c] = f2bf(geluf_(mu) * (acc[m][0][i] + bs[pp]));
        }
    __syncthreads();
}

__device__ __forceinline__ void phase_scan(const Params& p, int l, LAS unsigned char* lds) {
    LAS int* slot = (LAS int*)(lds + LDS_BYTES - 16);
    unsigned* ctr = (unsigned*)(p.ws + WS_CTR) + l;
    constexpr int NLAT = 8 * 2 * 4 * 2, NCX = 16 * 2 * 4 * 2, NGM = 160 * 4;
    for (;;) {
        if (otid() == 0) *slot = (int)atomicAdd(ctr, 1u);
        __syncthreads();
        const int j = *slot;
        __syncthreads();
        const int nconv = l + 1 < DEPTH ? CONV_BLOCK_ITEMS : 0;
        if (j >= NLAT + NCX + NGM + nconv) break;
        if (j >= NLAT + NCX + NGM) { convert_weights(p, l + 1, lds, j - (NLAT + NCX + NGM)); __syncthreads(); continue; }
        if (j < NLAT + NCX) {
            int r = j, s;
            if (r < NLAT) { s = 16 + (r >> 4); r &= 15; } else { r -= NLAT; s = r >> 4; r &= 15; }
            const int mix = r & 1, dir = (r >> 1) & 1, hd = r >> 2;
            if (mix) scan_job<1>(p, l, s, dir, hd, lds); else scan_job<0>(p, l, s, dir, hd, lds);
        } else { const int r = j - NLAT - NCX; gmlp_item(p, l, r >> 2, r & 3, lds); }
    }
}

template <int MIX>
__device__ __forceinline__ void out_item(const Params& p, int l, int gc, int hd, LAS unsigned char* lds) {
    constexpr int DK = MIX ? 128 : 64, LQ = DK + 8, LDV = 72, LDG = DK + 1;
    LAS bf16_t* QA = (LAS bf16_t*)lds;
    LAS bf16_t* KA = QA + 128 * LQ;
    LAS bf16_t* QS = KA + 128 * LQ;
    LAS bf16_t* VT = QS + 64 * LQ;
    LAS bf16_t* P = VT + 128 * LDV;
    LAS float* C = (LAS float*)(P + 64 * LDV);
    LAS float* BS = C + (MIX ? 64 : 128) * LDG;
    LAS bf16_t* ST = KA;
    LAS float* Of = (LAS float*)lds;
    const int tid = otid(), lane = tid & 63, wid = __builtin_amdgcn_readfirstlane(tid >> 6);
    const int tokb = gc * 64;
    const bf16_t* proj = (const bf16_t*)(p.ws + WS_PROJ);
    const bf16_t* pr = proj + (size_t)tokb * NPROJ;
    const float* lbs = (const float*)(p.ws + WS_LBS);
    const bf16_t* sbuf = (const bf16_t*)(p.ws + WS_ST + (MIX ? ST_GLA_BYTES : 0));
    constexpr int NPQ = 64 * (DK / 8), NRQ = NPQ / 512;
    u32x4 rq[NRQ], rk[NRQ];
    auto load_raw = [&](int dr) {
        const int kcol0 = MIX ? (dr ? PJ_HFB : PJ_HFF) + hd * 128 : PJ_GK + hd * 64;
        const int qcol0 = MIX ? PJ_HQ + hd * 128 : PJ_GQ + hd * 64;
#pragma unroll
        for (int k = 0; k < NRQ; ++k) { const int e = tid + 512 * k; const int t = e / (DK / 8), c8 = (e % (DK / 8)) * 8;
            rq[k] = *(const u32x4*)(pr + (size_t)t * NPROJ + qcol0 + c8); rk[k] = *(const u32x4*)(pr + (size_t)t * NPROJ + kcol0 + c8); }
    };
    load_raw(0);
    const int kdp = tid & (DK - 1);
    float gnv[16];
    {
        const float* gn = (MIX ? p.hg_norm_g : p.gla_norm_g) + (size_t)l * 512 + hd * 128 + (tid & 7) * 16;
#pragma unroll
        for (int j = 0; j < 16; j += 4) { const f32x4 t4 = *(const f32x4*)(gn + j); gnv[j] = t4.x; gnv[j + 1] = t4.y; gnv[j + 2] = t4.z; gnv[j + 3] = t4.w; }
    }
    const float lbd0 = MIX ? lbs[(size_t)(0 * 4 + l) * 512 + hd * 128 + kdp] : 0.f, lbd1 = MIX ? lbs[(size_t)(1 * 4 + l) * 512 + hd * 128 + kdp] : 0.f;
    typedef float f32x2p_t __attribute__((ext_vector_type(2)));
    const f32x2p_t zz2 = {0.f, 0.f};
    const f32x2p_t lbp0 = MIX ? *(const f32x2p_t*)(lbs + (size_t)(0 * 4 + l) * 512 + hd * 128 + 2 * (tid & 63)) : zz2, lbp1 = MIX ? *(const f32x2p_t*)(lbs + (size_t)(1 * 4 + l) * 512 + hd * 128 + 2 * (tid & 63)) : zz2;
    if (!MIX) {
        const int gd = wid >> 2, mt = (wid >> 1) & 1, nt = wid & 1, r = lane & 31, h = lane >> 5;
        const bf16x8 afr = *(const bf16x8*)(pr + (size_t)(mt * 32 + r) * NPROJ + (gd ? PJ_GZB : PJ_GZF) + 8 * h);
        const float* lw = p.gla_lr_w + (((size_t)l * 2 + gd) * 16 + 8 * h) * 256 + hd * 64 + nt * 32 + r;
        float wv[8];
#pragma unroll
        for (int j = 0; j < 8; ++j) wv[j] = lw[(size_t)j * 256];
        const float bias = p.gla_lr_b[((size_t)l * 2 + gd) * 256 + hd * 64 + nt * 32 + r];
        u32x4 bw; bw.x = pk2(wv[0], wv[1]); bw.y = pk2(wv[2], wv[3]); bw.z = pk2(wv[4], wv[5]); bw.w = pk2(wv[6], wv[7]);
        f32x16 zacc;
#pragma unroll
        for (int i = 0; i < 16; ++i) zacc[i] = 0.f;
        zacc = __builtin_amdgcn_mfma_f32_32x32x16_bf16(afr, __builtin_bit_cast(bf16x8, bw), zacc, 0, 0, 0);
#pragma unroll
        for (int i = 0; i < 16; ++i) {
            const int t = mt * 32 + (i & 3) + 8 * (i >> 2) + 4 * h;
            C[(gd * 64 + (gd ? 63 - t : t)) * LDG + nt * 32 + r] = logsigmoidf_(zacc[i] + bias) * (1.0f / 16.0f);
        }
    }
    const bf16_t* gatep = pr + (size_t)(tid >> 3) * NPROJ + (MIX ? PJ_HO : PJ_GO) + hd * 128 + (tid & 7) * 16;
    const u32x4 g0 = *(const u32x4*)gatep, g1 = *(const u32x4*)(gatep + 8);
    {
        const int vv = tid & 127, qt = tid >> 7;
        const int vcol = (MIX ? PJ_HI : PJ_GV) + hd * 128 + vv;
        unsigned pkv[8];
#pragma unroll
        for (int t = 0; t < 16; t += 2) {
            const unsigned a = pr[(size_t)(qt * 16 + t) * NPROJ + vcol], b = pr[(size_t)(qt * 16 + t + 1) * NPROJ + vcol];
            pkv[t >> 1] = a | (b << 16);
        }
#pragma unroll
        for (int q = 0; q < 2; ++q) { u32x4 w; w.x = pkv[4 * q]; w.y = pkv[4 * q + 1]; w.z = pkv[4 * q + 2]; w.w = pkv[4 * q + 3]; *(LAS u32x4*)(VT + vv * LDV + qt * 16 + q * 8) = w; }
    }
    const int wm = wid >> 2, wn = wid & 3;
    f32x16 o[1][1];
#pragma unroll
    for (int i = 0; i < 16; ++i) o[0][0][i] = 0.f;

#pragma unroll 1
    for (int dir = 0; dir < 2; ++dir) {
        const int kd = tid & (DK - 1), ba = tid / DK;
#pragma unroll
        for (int k = 0; k < NRQ; ++k) { const int e = tid + 512 * k; const int t = e / (DK / 8), c8 = (e % (DK / 8)) * 8;
            *(LAS u32x4*)(QS + t * LQ + c8) = rq[k]; *(LAS u32x4*)(KA + (64 + (dir ? 63 - t : t)) * LQ + c8) = rk[k]; }
        __syncthreads();
        if (MIX) {
            const int cp = tid & 63, bh = tid >> 6, bah = bh >> 1, u0 = (bh & 1) * 8;
            const float lbA = dir ? lbp1.x : lbp0.x, lbB = dir ? lbp1.y : lbp0.y;
            float gA[8], gB[8], kA[8], kB[8]; float thA = 0.f, thB = 0.f;
            {
                const LAS bf16_t* kzr = KA + (64 + bah * 16 + u0) * LQ + 2 * cp;
#pragma unroll
                for (int u = 0; u < 8; ++u) {
                    const unsigned raw = *(const LAS unsigned*)(kzr + u * LQ);
                    const float sa = sigmoidf_(bflo(raw)), sb = sigmoidf_(bfhi(raw));
                    gA[u] = flog_(lbA + (1.0f - lbA) * sa); kA[u] = (1.0f - lbA) * (1.0f - sa); thA += gA[u];
                    gB[u] = flog_(lbB + (1.0f - lbB) * sb); kB[u] = (1.0f - lbB) * (1.0f - sb); thB += gB[u];
                }
                typedef float f32x2_t __attribute__((ext_vector_type(2)));
                f32x2_t th; th.x = thA; th.y = thB;
                *(LAS f32x2_t*)(BS + bh * DK + 2 * cp) = th;
            }
            __syncthreads();
            {
                typedef float f32x2_t __attribute__((ext_vector_type(2)));
                f32x2_t hh[8];
#pragma unroll
                for (int j = 0; j < 8; ++j) hh[j] = *(const LAS f32x2_t*)(BS + j * DK + 2 * cp);
                const f32x2_t T0 = hh[0] + hh[1], T1 = hh[2] + hh[3], T2 = hh[4] + hh[5], T3 = hh[6] + hh[7];
                const f32x2_t Tb = bah == 0 ? T0 : bah == 1 ? T1 : bah == 2 ? T2 : T3;
                const f32x2_t l7 = bah == 0 ? hh[0] : bah == 1 ? hh[2] : bah == 2 ? hh[4] : hh[6];
                const f32x2_t zero2 = {0.f, 0.f};
                const f32x2_t base = bah == 0 ? zero2 : bah == 1 ? T0 : bah == 2 ? T0 + T1 : T0 + T1 + T2;
                const f32x2_t c31 = T0 + T1;
                float lpA = u0 ? l7.x : 0.f, lpB = u0 ? l7.y : 0.f;
                const float qscale = 0.08838834764831845f;
                LAS bf16_t* qz = QA + (64 + bah * 16 + u0) * LQ + 2 * cp;
                LAS bf16_t* kz = KA + (64 + bah * 16 + u0) * LQ + 2 * cp;
                LAS bf16_t* xrow = (bah < 2 ? KA + (bah * 16 + u0) * LQ : QA + (bah * 16 + u0 - 32) * LQ) + 2 * cp;
                LAS bf16_t* yrow = ((bah & 1) ? QA + (32 + (bah >> 1) * 16 + u0) * LQ : KA + (32 + (bah >> 1) * 16 + u0) * LQ) + 2 * cp;
                const bool xk = bah < 2, yq = (bah & 1) != 0;
#pragma unroll
                for (int u = 0; u < 8; ++u) {
                    const int pp = bah * 16 + u0 + u, t = dir ? 63 - pp : pp;
                    lpA += gA[u]; lpB += gB[u];
                    const float cA = base.x + lpA, cB = base.y + lpB;
                    const unsigned qraw = *(const LAS unsigned*)(QS + t * LQ + 2 * cp);
                    const float qa = bflo(qraw) * qscale, qb = bfhi(qraw) * qscale;
                    *(LAS unsigned*)(QS + t * LQ + 2 * cp) = pk2(qa * fexp_(cA), qb * fexp_(cB));
                    *(LAS unsigned*)(qz + u * LQ) = pk2(qa * fexp_(lpA - l7.x), qb * fexp_(lpB - l7.y));
                    *(LAS unsigned*)(kz + u * LQ) = pk2(kA[u] * fexp_(l7.x - lpA), kB[u] * fexp_(l7.y - lpB));
                    *(LAS unsigned*)(xrow + u * LQ) = pk2((xk ? kA[u] : qa) * fexp_(xk ? c31.x - cA : cA - c31.x), (xk ? kB[u] : qb) * fexp_(xk ? c31.y - cB : cB - c31.y));
                    *(LAS unsigned*)(yrow + u * LQ) = pk2((yq ? qa : kA[u]) * fexp_(yq ? lpA : Tb.x - lpA), (yq ? qb : kB[u]) * fexp_(yq ? lpB : Tb.y - lpB));
                }
            }
            __syncthreads();
        } else {
        float gk[16], kk[16]; float lp7 = 0.f, Ta = 0.f;
        if (MIX) {
            const float lb = dir ? lbd1 : lbd0;
            const LAS bf16_t* kz0 = KA + (64 + ba * 16) * LQ + kd;
#pragma unroll
            for (int u = 0; u < 16; ++u) {
                const float sg = sigmoidf_(bf2f(kz0[u * LQ]));
                gk[u] = flog_(lb + (1.0f - lb) * sg); kk[u] = (1.0f - lb) * (1.0f - sg);
                Ta += gk[u]; if (u == 7) lp7 = Ta;
            }
            BS[ba * DK + kd] = Ta;
        } else {
            if (ba < 4) {
#pragma unroll
                for (int u = 0; u < 16; ++u) { gk[u] = C[(dir * 64 + ba * 16 + u) * LDG + kd]; Ta += gk[u]; if (u == 7) lp7 = Ta; }
                BS[ba * DK + kd] = Ta;
            }
        }
        __syncthreads();
        if (ba < 4) {
            const float T0 = BS[kd], T1 = BS[DK + kd], T2 = BS[2 * DK + kd];
            const float base = ba == 0 ? 0.f : ba == 1 ? T0 : ba == 2 ? T0 + T1 : T0 + T1 + T2;
            const float c31 = T0 + T1;
            const float qscale = MIX ? 0.08838834764831845f : 0.125f;
            LAS bf16_t* qz = QA + (64 + ba * 16) * LQ + kd;
            LAS bf16_t* kz = KA + (64 + ba * 16) * LQ + kd;
            LAS bf16_t* xrow = (ba < 2 ? KA + (ba * 16) * LQ : QA + (ba * 16 - 32) * LQ) + kd;
            LAS bf16_t* yrow = ((ba & 1) ? QA + (32 + (ba >> 1) * 16) * LQ : KA + (32 + (ba >> 1) * 16) * LQ) + kd;
            float lp = 0.f;
#pragma unroll
            for (int u = 0; u < 16; ++u) {
                const int pp = ba * 16 + u, t = dir ? 63 - pp : pp;
                lp += gk[u];
                const float c = base + lp;
                const float qv = bf2f(QS[t * LQ + kd]) * qscale;
                const float kt = MIX ? kk[u] : bf2f(kz[u * LQ]);
                QS[t * LQ + kd] = f2bf(qv * fexp_(c));
                qz[u * LQ] = f2bf(qv * fexp_(lp - lp7));
                kz[u * LQ] = f2bf(kt * fexp_(lp7 - lp));
                xrow[u * LQ] = f2bf(ba < 2 ? kt * fexp_(c31 - c) : qv * fexp_(c - c31));
                yrow[u * LQ] = f2bf((ba & 1) ? qv * fexp_(lp) : kt * fexp_(Ta - lp));
            }
        }
        __syncthreads();
        }
        if (dir == 0) load_raw(1);
        constexpr int PIECES = 128 * DK / 8, NPC = PIECES / 512;
        u32x4 stv[NPC];
        {
            const bf16_t* sb = sbuf + (((size_t)gc * 2 + dir) * 4 + hd) * 128 * DK;
#pragma unroll
            for (int k = 0; k < NPC; ++k) { const int e = tid + 512 * k; const int v = e / (DK / 8), d0 = (e % (DK / 8)) * 8; stv[k] = *(const u32x4*)(sb + (size_t)v * DK + d0); }
        }
        if (wid < 4) {
            f32x16 sc[1][1];
#pragma unroll
            for (int i = 0; i < 16; ++i) sc[0][0][i] = 0.f;
            mma_lds<1, 1, DK / 16>(sc, KA + wid * 32 * LQ, LQ, QA + wid * 32 * LQ, LQ, lane);
            const int cc = lane & 31;
#pragma unroll
            for (int q = 0; q < 4; ++q) {
                const int r0 = 8 * q + 4 * (lane >> 5);
                int pi, pj0; bool wr = true, zero = false, tri = false;
                if (wid == 0) { pi = 32 + cc; pj0 = r0; }
                else if (wid == 1) { pi = cc < 16 ? 16 + cc : 32 + cc; pj0 = r0 < 16 ? r0 : r0 + 16; wr = (r0 < 16) == (cc < 16); }
                else { const int off = (wid - 2) * 32; pi = off + cc; pj0 = off + r0; const bool same = (r0 >> 4) == (cc >> 4); tri = same; zero = !same && r0 >= 16; wr = same || zero; }
                float v[4];
#pragma unroll
                for (int e = 0; e < 4; ++e) { float x = sc[0][0][4 * q + e]; if (tri && (r0 + e > cc)) x = 0.f; if (zero) x = 0.f; v[e] = x; }
                if (wr) {
                    u32x2 w;
                    if (dir == 0) { w.x = pk2(v[0], v[1]); w.y = pk2(v[2], v[3]); *(LAS u32x2*)(P + pi * LDV + pj0) = w; }
                    else { w.x = pk2(v[3], v[2]); w.y = pk2(v[1], v[0]); *(LAS u32x2*)(P + (63 - pi) * LDV + (60 - pj0)) = w; }
                }
            }
        } else if (wid == 4) {
#pragma unroll
            for (int k = 0; k < 2; ++k) {
                const int idx = lane * 2 + k, row = idx >> 2, piece = idx & 3;
                const int ti = dir ? 32 + row : row, tj = (dir ? 0 : 32) + piece * 8;
                u32x4 z; z.x = 0; z.y = 0; z.z = 0; z.w = 0;
                *(LAS u32x4*)(P + ti * LDV + tj) = z;
            }
        }
        __syncthreads();
#pragma unroll
        for (int k = 0; k < NPC; ++k) { const int e = tid + 512 * k; const int v = e / (DK / 8), d0 = (e % (DK / 8)) * 8; *(LAS u32x4*)(ST + v * LQ + d0) = stv[k]; }
        mma_lds<1, 1, 4>(o, P + wm * 32 * LDV, LDV, VT + wn * 32 * LDV, LDV, lane);
        __syncthreads();
        mma_lds<1, 1, DK / 16>(o, QS + wm * 32 * LQ, LQ, ST + wn * 32 * LQ, LQ, lane);
        __syncthreads();
    }
#pragma unroll
    for (int i = 0; i < 16; ++i) Of[(wm * 32 + (i & 3) + 8 * (i >> 2) + 4 * (lane >> 5)) * 132 + wn * 32 + (lane & 31)] = o[0][0][i];
    __syncthreads();
    {
        const int i_ = tid >> 3, seg = tid & 7;
        const LAS float* orow = Of + i_ * 132 + seg * 16;
        float v[16]; float ss = 0.f;
#pragma unroll
        for (int j = 0; j < 16; ++j) { v[j] = orow[j]; ss += v[j] * v[j]; }
        ss += __shfl_xor(ss, 1); ss += __shfl_xor(ss, 2); ss += __shfl_xor(ss, 4);
        const float r = rsqrtf(ss * (1.0f / 128.0f) + EPS);
        const unsigned gu[8] = {g0.x, g0.y, g0.z, g0.w, g1.x, g1.y, g1.z, g1.w};
        unsigned ow[8];
#pragma unroll
        for (int j = 0; j < 8; ++j) {
            const float a = v[2 * j] * r * gnv[2 * j] * siluf_(bflo(gu[j])), b = v[2 * j + 1] * r * gnv[2 * j + 1] * siluf_(bfhi(gu[j]));
            ow[j] = pk2(a, b);
        }
        bf16_t* dst = (bf16_t*)(p.ws + WS_OCAT) + (size_t)(MIX ? 1 : 0) * NTOK * 512 + (size_t)(tokb + i_) * 512 + hd * 128 + seg * 16;
        u32x4 w0, w1; w0.x = ow[0]; w0.y = ow[1]; w0.z = ow[2]; w0.w = ow[3]; w1.x = ow[4]; w1.y = ow[5]; w1.z = ow[6]; w1.w = ow[7];
        *(u32x4*)dst = w0; *(u32x4*)(dst + 8) = w1;
    }
    __syncthreads();
}


__device__ __forceinline__ void phase_out(const Params& p, int l, LAS unsigned char* lds) {
    constexpr int NIT = NCHUNK * 4 * 2;
    for (int it = blockIdx.x; it < NIT; it += gridDim.x) {
        const int mix = (it >> 8) & 1, rem = (it & 255) | ((it >> 9) << 8), hd = rem & 3, gc = rem >> 2;
        if (mix) out_item<1>(p, l, gc, hd, lds); else out_item<0>(p, l, gc, hd, lds);
    }
}

__device__ __forceinline__ void phase_merge(const Params& p, int l, LAS unsigned char* lds) {
    const bf16_t* ocat = (const bf16_t*)(p.ws + WS_OCAT);
    const bf16_t* G3 = (const bf16_t*)(p.ws + WS_PROJ);
    const bf16_t* WbrT = (const bf16_t*)(p.ws + WS_W + (size_t)(l & 1) * W_END + W_BR);
    bf16_t* merged = (bf16_t*)(p.ws + WS_ST);
    const int lane = otid() & 63, wid = otid() >> 6, wm = wid >> 2, wn = wid & 3;
    constexpr int nM = NTOK / 128, nN = 8;
    for (int t = blockIdx.x; t < nM * nN; t += gridDim.x) {
        int tm, tn; tile_coords(t, nN, tm, tn);
        const int row0 = tm * 128, col0 = tn * 128;
        f32x16 tot[2][1]; acc_zero<1>(tot);
#pragma unroll 1
        for (int b = 0; b < 3; ++b) {
            f32x16 ba[2][1]; acc_zero<1>(ba);
            gemm_kloop<128>(lds, ocat + (size_t)row0 * 1536 + b * 512, 1536, WbrT + ((size_t)b * D + col0) * 512, 512, 128, 512, ba);
#pragma unroll
            for (int m = 0; m < 2; ++m)
#pragma unroll
                for (int i = 0; i < 16; ++i) {
                    const int row = row0 + wm * 64 + m * 32 + (i & 3) + 8 * (i >> 2) + 4 * (lane >> 5), col = col0 + wn * 32 + (lane & 31);
                    tot[m][0][i] += bf2f(G3[(size_t)row * NGATE + b * 1024 + col]) * ba[m][0][i];
                }
        }
#pragma unroll
        for (int m = 0; m < 2; ++m)
#pragma unroll
            for (int i = 0; i < 16; ++i) {
                const int row = row0 + wm * 64 + m * 32 + (i & 3) + 8 * (i >> 2) + 4 * (lane >> 5), col = col0 + wn * 32 + (lane & 31);
                merged[(size_t)row * D + col] = f2bf(tot[m][0][i]);
            }
    }
}

__device__ __forceinline__ void run_phase(const Params& p, int ph, LAS unsigned char* lds) {
    if (ph == 0) { phase0(p, lds); return; }
    if (ph == NPHASE - 1) { norm_phase(p, p.final_norm_g, nullptr, 0, 0, nullptr, 1); return; }
    const int l = (ph - 1) / 10, sp = (ph - 1) % 10;
    const float* mod_l = (const float*)(p.ws + WS_MOD) + (size_t)l * 9 * 6144;
    bf16_t* hbuf = (bf16_t*)(p.ws + WS_H);
    bf16_t* proj = (bf16_t*)(p.ws + WS_PROJ);
    const unsigned char* wl = p.ws + WS_W + (size_t)(l & 1) * W_END;
    switch (sp) {
        case 0: if (l == 0) convert_weights(p, l, lds); norm_phase(p, p.norm_mix_g + (size_t)l * D, mod_l, 0, 1024, hbuf, 0); break;
        case 1: { PEpiBf16 e{proj, NPROJ, NPROJ, 0}; pg8_gemm(lds, hbuf, (const bf16_t*)(wl + W_IN), NTOK, 5376, D, e); } break;
        case 2: phase_scan(p, l, lds); break;
        case 3: phase_out(p, l, lds); break;
        case 4: {
            PEpiBf16 e{proj, NGATE, NGATE, 2}; pg8_gemm(lds, hbuf, (const bf16_t*)(wl + W_G), NTOK, NGATE, D, e);
            PEpiGate e2{proj, NGATE}; pg8_gemm(lds, (const bf16_t*)(p.ws + WS_OCAT), (const bf16_t*)(wl + W_BR), NTOK, NGATE, 512, e2, (size_t)NTOK * 512 * 2); } break;
        case 5: sum3_phase(p); break;
        case 6: {
            PEpiResid e{p.out, mod_l + 2048}; pg8_gemm(lds, (const bf16_t*)(p.ws + WS_ST), (const bf16_t*)(wl + W_OUT), 16384, D, D, e);
            EpiResidOff e2{p.out, mod_l + 2048, 16384}; gemm_phase<128>(lds, (const bf16_t*)(p.ws + WS_ST) + (size_t)16384 * D, D, (const bf16_t*)(wl + W_OUT), D, NTOK - 16384, D, D, e2); } break;
        case 7: norm_phase(p, p.norm_ffn_g + (size_t)l * D, mod_l, 3072, 4096, hbuf, 0); break;
        case 8: { PEpiBf16 e{proj, DFF, DFF, 1}; pg8_gemm(lds, hbuf, (const bf16_t*)(wl + W_FF1), NTOK, DFF, D, e); } break;
        case 9: { PEpiResid e{p.out, mod_l + 5120}; pg8_gemm(lds, proj, (const bf16_t*)(wl + W_FF2), 16384, D, DFF, e);
            EpiResidOff e2{p.out, mod_l + 5120, 16384}; gemm_phase<128>(lds, proj + (size_t)16384 * DFF, DFF, (const bf16_t*)(wl + W_FF2), DFF, NTOK - 16384, D, DFF, e2); } break;
    }
}

__global__ void __launch_bounds__(512) fwd_megakernel(Params p) {
    extern __shared__ __attribute__((aligned(16))) unsigned char smem[];
    LAS unsigned char* lds = (LAS unsigned char*)smem;
    cg::grid_group grid = cg::this_grid();
    unsigned nbar = 0;
    for (int ph = p.ph_lo; ph < p.ph_hi; ++ph) {
        run_phase(p, ph, lds);
        if (ph + 1 < p.ph_hi) {
            if (ph == 0) grid.sync();
            else { ++nbar; grid_barrier((unsigned*)(p.ws + WS_CTR) + 64, nbar); }
        }
    }
}

extern "C" void kernel_launch(void* const* d_in, const int* in_sizes, int n_in, void* d_out, int out_size, void* d_ws, size_t ws_size, hipStream_t stream) {
    static int grid_blocks = 0;
    if (!grid_blocks) {
        int dev = 0, cus = 0, per_cu = 0;
        hipGetDevice(&dev);
        hipDeviceGetAttribute(&cus, hipDeviceAttributeMultiprocessorCount, dev);
        if (hipFuncSetAttribute((const void*)fwd_megakernel, hipFuncAttributeMaxDynamicSharedMemorySize, LDS_BYTES) != hipSuccess) fprintf(stderr, "hipFuncSetAttribute failed\n");
        hipOccupancyMaxActiveBlocksPerMultiprocessor(&per_cu, (const void*)fwd_megakernel, 512, LDS_BYTES);
        if (per_cu < 1) { fprintf(stderr, "occupancy query says %d blocks/CU\n", per_cu); per_cu = 1; }
        grid_blocks = cus * 1;
        (void)hipGetLastError();
        if (n_in != 26 || ws_size < WS_END) fprintf(stderr, "kernel_launch: unexpected n_in %d or ws_size %zu (need %zu)\n", n_in, ws_size, (size_t)WS_END);
    }
    Params p{};
    const float** pp = (const float**)&p;
    for (int i = 0; i < 26; ++i) pp[i] = (const float*)d_in[i];
    p.out = (float*)d_out; p.ws = (unsigned char*)d_ws; p.ph_lo = 0; p.ph_hi = NPHASE;
    void* args[] = {&p};
    hipError_t e = hipLaunchCooperativeKernel((const void*)fwd_megakernel, dim3(grid_blocks), dim3(512), args, LDS_BYTES, stream);
    if (e != hipSuccess) fprintf(stderr, "cooperative launch failed: %s (grid %d)\n", hipGetErrorString(e), grid_blocks);
}
```

```cpp
#include <hip/hip_runtime.h>
#include <hip/hip_cooperative_groups.h>
#include <cstdio>
namespace cg = cooperative_groups;

#define LAS __attribute__((address_space(3)))
typedef unsigned short bf16_t;
typedef short bf16x8 __attribute__((ext_vector_type(8)));
typedef float f32x16 __attribute__((ext_vector_type(16)));
typedef float f32x4 __attribute__((ext_vector_type(4)));
typedef unsigned u32x4 __attribute__((ext_vector_type(4)));
typedef unsigned u32x2 __attribute__((ext_vector_type(2)));

constexpr int D = 1024, DEPTH = 4, NTOK = 20480, NCTX = 4096, DFF = 4096;
constexpr int DIN = 8224, NPROJ = 5152, NGATE = 3072;
constexpr int PJ_GQ = 0, PJ_GK = 256, PJ_GV = 512, PJ_GO = 1024, PJ_GZF = 1536, PJ_GZB = 1552, PJ_HQ = 1568, PJ_HFF = 2080,
              PJ_HFB = 2592, PJ_HI = 3104, PJ_HO = 3616, PJ_MU = 4128, PJ_MV = 4640;
constexpr int NCHUNK = NTOK / 64;
constexpr float EPS = 1e-6f;
constexpr int LDS_BYTES = 160 * 1024;
constexpr int NPHASE = 2 + DEPTH * 10;

constexpr size_t WS_PROJ = 0;
constexpr size_t WS_ST   = WS_PROJ + (size_t)NTOK * NPROJ * 2;
constexpr size_t ST_GLA_BYTES = (size_t)NCHUNK * 2 * 4 * 128 * 64 * 2, ST_HG_BYTES = (size_t)NCHUNK * 2 * 4 * 128 * 128 * 2;
constexpr size_t WS_OCAT = WS_ST + ST_GLA_BYTES + ST_HG_BYTES;
constexpr size_t WS_H    = WS_OCAT + (size_t)NTOK * 1536 * 2;
constexpr size_t WS_W    = WS_H + (size_t)NTOK * D * 2;
constexpr size_t W_IN = 0, W_G = W_IN + (size_t)NPROJ * D * 2, W_BR = W_G + (size_t)NGATE * D * 2, W_OUT = W_BR + (size_t)3 * D * 512 * 2,
                 W_FF1 = W_OUT + (size_t)D * D * 2, W_FF2 = W_FF1 + (size_t)DFF * D * 2, W_END = W_FF2 + (size_t)D * DFF * 2;
constexpr size_t WS_MOD  = WS_W + 2 * W_END;
constexpr size_t WS_LBS  = WS_MOD + (size_t)DEPTH * 9 * 6144 * 4;
constexpr size_t WS_CTR  = WS_LBS + 2 * 4 * 512 * 4;
constexpr size_t WS_END  = WS_CTR + 4096;

struct Params {
    const float *x_prompt, *x_sample, *c, *state_gla, *state_hgrn, *c_ctx, *ada_w, *ada_b, *norm_mix_g, *norm_ffn_g, *w_in, *gla_lr_w,
        *gla_lr_b, *gla_norm_g, *hg_lb_logits, *hg_norm_g, *gm_norm_g, *gm_ws, *gm_bs, *w_br_gla, *w_br_hg, *w_br_gm, *w_out, *w_ff1, *w_ff2,
        *final_norm_g;
    float* out; unsigned char* ws; int ph_lo, ph_hi;
};

typedef __bf16 bf16x2_t __attribute__((ext_vector_type(2)));
__device__ __forceinline__ unsigned pk2(float lo, float hi) { bf16x2_t v; v.x = (__bf16)lo; v.y = (__bf16)hi; return __builtin_bit_cast(unsigned, v); }
__device__ __forceinline__ bf16_t f2bf(float f) { return (bf16_t)(pk2(f, 0.f) & 0xffffu); }
__device__ __forceinline__ float bf2f(bf16_t h) { return __uint_as_float(((unsigned)h) << 16); }
__device__ __forceinline__ float bflo(unsigned u) { return __uint_as_float(u << 16); }
__device__ __forceinline__ float bfhi(unsigned u) { return __uint_as_float(u & 0xffff0000u); }
__device__ __forceinline__ float fexp_(float x) { return __builtin_amdgcn_exp2f(x * 1.4426950408889634f); }
__device__ __forceinline__ float flog_(float x) { return __builtin_amdgcn_logf(x) * 0.6931471805599453f; }
__device__ __forceinline__ float sigmoidf_(float x) { return __builtin_amdgcn_rcpf(1.0f + fexp_(-x)); }
__device__ __forceinline__ float siluf_(float x) { return x * sigmoidf_(x); }
__device__ __forceinline__ float geluf_(float x) { const float y = 0.7978845608028654f * (x + 0.044715f * x * x * x); const float t = 1.0f - 2.0f * __builtin_amdgcn_rcpf(1.0f + fexp_(2.0f * y)); return 0.5f * x * (1.0f + t); }
__device__ __forceinline__ float logsigmoidf_(float x) { return fminf(x, 0.f) - flog_(1.0f + fexp_(-fabsf(x))); }
__device__ __forceinline__ float wave_sum(float v) {
#pragma unroll
    for (int o = 1; o < 64; o <<= 1) v += __shfl_xor(v, o);
    return v;
}
__device__ __forceinline__ int mod_row(int tok) { return tok < NCTX ? 0 : 1 + ((tok - NCTX) >> 11); }
__device__ __forceinline__ int otid() { int t = (int)__builtin_amdgcn_workitem_id_x(); asm volatile("" : "+v"(t)); return t; }
#define LDS_WAIT() asm volatile("s_waitcnt lgkmcnt(0)" ::: "memory")

template <int MT, int NTL, int KS>
__device__ __forceinline__ void mma_lds(f32x16 (&acc)[MT][NTL], const LAS bf16_t* As, int lda, const LAS bf16_t* Bs, int ldb, int lane) {
    const int r = lane & 31, h = lane >> 5;
    const LAS bf16_t* ap = As + r * lda + h * 8;
    const LAS bf16_t* bp = Bs + r * ldb + h * 8;
#pragma unroll
    for (int ks = 0; ks < KS; ++ks) {
        bf16x8 a[MT], b[NTL];
#pragma unroll
        for (int m = 0; m < MT; ++m) a[m] = *(const LAS bf16x8*)(ap + m * 32 * lda + ks * 16);
#pragma unroll
        for (int n = 0; n < NTL; ++n) b[n] = *(const LAS bf16x8*)(bp + n * 32 * ldb + ks * 16);
#pragma unroll
        for (int m = 0; m < MT; ++m)
#pragma unroll
            for (int n = 0; n < NTL; ++n) acc[m][n] = __builtin_amdgcn_mfma_f32_32x32x16_bf16(a[m], b[n], acc[m][n], 0, 0, 0);
    }
}

template <int BM>
__device__ __forceinline__ void gemm_kloop(LAS unsigned char* lds, const bf16_t* __restrict__ Ag, int lda, const bf16_t* __restrict__ Bg, int ldb, int brows,
                                           int K, f32x16 (&acc)[2][(128 / (8 / (BM / 64))) / 32]) {
    static_assert(BM == 128, "128-row tiles only");
    constexpr int WN = 4, WTN = 32, NTL = 1, LDT = 136, NP = 4;
    LAS bf16_t* As = (LAS bf16_t*)lds;
    LAS bf16_t* Bs = As + 2 * 128 * LDT;
    const int tid = otid(), lane = tid & 63, wid = tid >> 6, wm = wid / WN, wn = wid % WN;
    const int lrow = tid >> 4, lc = (tid & 15) * 8;
    const bf16_t* ap[NP]; const bf16_t* bp[NP];
#pragma unroll
    for (int p = 0; p < NP; ++p) ap[p] = Ag + (size_t)(lrow + p * 32) * lda + lc;
#pragma unroll
    for (int p = 0; p < NP; ++p) { int br = lrow + p * 32; br = br < brows ? br : brows - 1; bp[p] = Bg + (size_t)br * ldb + lc; }
    u32x4 ra[3][NP], rb[3][NP];
    const int nk = K / 128;
#define KL_ISSUE(S, step) do { _Pragma("unroll") for (int p = 0; p < NP; ++p) ra[S][p] = *(const u32x4*)(ap[p] + (step) * 128); \
                               _Pragma("unroll") for (int p = 0; p < NP; ++p) rb[S][p] = *(const u32x4*)(bp[p] + (step) * 128); } while (0)
#define KL_WRITE(S, stage) do { _Pragma("unroll") for (int p = 0; p < NP; ++p) *(LAS u32x4*)(As + (stage) * 128 * LDT + (lrow + p * 32) * LDT + lc) = ra[S][p]; \
                                _Pragma("unroll") for (int p = 0; p < NP; ++p) *(LAS u32x4*)(Bs + (stage) * 128 * LDT + (lrow + p * 32) * LDT + lc) = rb[S][p]; } while (0)
#define KL_STEP(J, JN) if (kt + J < nk) { const int s_ = kt + J; if (s_ + 3 < nk) KL_ISSUE(J, s_ + 3); \
        mma_lds<2, NTL, 8>(acc, As + (s_ & 1) * 128 * LDT + wm * 64 * LDT, LDT, Bs + (s_ & 1) * 128 * LDT + wn * WTN * LDT, LDT, lane); \
        if (s_ + 1 < nk) KL_WRITE(JN, (s_ + 1) & 1); __syncthreads(); }
    KL_ISSUE(0, 0); if (nk > 1) KL_ISSUE(1, 1); if (nk > 2) KL_ISSUE(2, 2);
    KL_WRITE(0, 0);
    __syncthreads();
    for (int kt = 0; kt < nk; kt += 3) { KL_STEP(0, 1) KL_STEP(1, 2) KL_STEP(2, 0) }
#undef KL_ISSUE
#undef KL_WRITE
#undef KL_STEP
}

template <int NTL>
__device__ __forceinline__ void acc_zero(f32x16 (&acc)[2][NTL]) {
#pragma unroll
    for (int m = 0; m < 2; ++m)
#pragma unroll
        for (int n = 0; n < NTL; ++n)
#pragma unroll
            for (int i = 0; i < 16; ++i) acc[m][n][i] = 0.f;
}

__device__ __forceinline__ void tile_coords(int t, int nN, int& tm, int& tn) { const int q = t >> 3; tn = q % nN; tm = (q / nN) * 8 + (t & 7); }

template <int BM, class Epi>
__device__ __forceinline__ void gemm_phase(LAS unsigned char* lds, const bf16_t* A, int lda, const bf16_t* Bt, int ldb, int M, int N, int K, const Epi& epi) {
    constexpr int WM = BM / 64, WN = 8 / WM, WTN = 128 / WN, NTL = WTN / 32;
    const int nM = M / BM, nN = (N + 127) / 128, ntiles = nM * nN;
    const int lane = otid() & 63, wid = otid() >> 6, wm = wid / WN, wn = wid % WN;
    for (int t = blockIdx.x; t < ntiles; t += gridDim.x) {
        int tm, tn; tile_coords(t, nN, tm, tn);
        const int row0 = tm * BM, col0 = tn * 128;
        f32x16 acc[2][NTL]; acc_zero<NTL>(acc);
        gemm_kloop<BM>(lds, A + (size_t)row0 * lda, lda, Bt + (size_t)col0 * ldb, ldb, min(128, N - col0), K, acc);
#pragma unroll
        for (int m = 0; m < 2; ++m)
#pragma unroll
            for (int n = 0; n < NTL; ++n) {
                const int col = col0 + wn * WTN + n * 32 + (lane & 31);
#pragma unroll
                for (int i = 0; i < 16; ++i) {
                    const int row = row0 + wm * 64 + m * 32 + (i & 3) + 8 * (i >> 2) + 4 * (lane >> 5);
                    epi(row, col, acc[m][n][i]);
                }
            }
    }
}

struct EpiBf16 { bf16_t* C; int ldc, N; __device__ __forceinline__ void operator()(int row, int col, float v) const { if (col < N) C[(size_t)row * ldc + col] = f2bf(v); } };
struct EpiRelu2 { bf16_t* C; int ldc; __device__ __forceinline__ void operator()(int row, int col, float v) const { v = fmaxf(v, 0.f); C[(size_t)row * ldc + col] = f2bf(v * v); } };
struct EpiResidOff { float* x; const float* gate; int roff; __device__ __forceinline__ void operator()(int row, int col, float v) const {
    const int r = row + roff; const float g = gate[mod_row(r) * 6144 + col]; float* p = x + (size_t)r * D + col; *p = *p + g * v; } };
struct EpiResid { float* x; const float* gate;   __device__ __forceinline__ void operator()(int row, int col, float v) const {
    const float g = gate[mod_row(row) * 6144 + col]; float* p = x + (size_t)row * D + col; *p = *p + g * v; } };

namespace pg8 {
#define PG8_LAS __attribute__((address_space(3)))
typedef unsigned short bf16_t;
typedef short bf16x8 __attribute__((ext_vector_type(8)));
typedef float f32x4 __attribute__((ext_vector_type(4)));
typedef unsigned u32x4 __attribute__((ext_vector_type(4)));
constexpr int BM = 256, BK = 64, HALF = 128, HTB = HALF * BK * 2  , STAGE_BYTES = 8 * HTB, NXCD = 8, WGM = 8;

__host__ __device__ __forceinline__ int lds_byte(int r, int c) { const int st = (r >> 4) * 2 + (c >> 5), rr = r & 15, cc = c & 31, ob = rr * 64 + cc * 2; return st * 1024 + (ob ^ (((ob >> 9) & 1) << 5)); }
__host__ __device__ __forceinline__ void stage_rc(int b, int& R, int& C) { const int st = b / 1024, sb = b % 1024, swz = sb ^ (((sb >> 9) & 1) << 5); R = (st >> 1) * 16 + swz / 64; C = (st & 1) * 32 + (swz % 64) / 2; }
__host__ __device__ __forceinline__ int perm32(int rho) { const int n = rho >> 4, i = rho & 15; return 8 * (i >> 2) + 4 * n + (i & 3); }

struct Unit { int pm, pn; };
struct Gemm { const bf16_t* A; const bf16_t* Bt; int M, N, K; size_t agrp; };

struct StaticOrder {
    int nM, nN, nwg, G, c;
    __host__ __device__ void init(int M, int N, int G_, int c_) { nM = M / BM; nN = N / BM; nwg = nM * nN; G = G_; c = c_; }
    __host__ __device__ bool next(int i, Unit& u) const {
        const long L = (long)i * G + c; if (L >= nwg) return false;
        int wgid = (int)L; { const int q = nwg / NXCD, r = nwg % NXCD, xcd = wgid % NXCD, off = wgid / NXCD; wgid = (xcd < r ? xcd * (q + 1) : r * (q + 1) + (xcd - r) * q) + off; }
        const int nig = WGM * nN, gid = wgid / nig, fm = gid * WGM, gsz = (nM - fm) < WGM ? (nM - fm) : WGM;
        u.pm = fm + ((wgid % nig) % gsz); u.pn = (wgid % nig) / gsz; return true;
    }
    __device__ __forceinline__ void a_ready(const Unit&) const {}
    __device__ __forceinline__ void done(const Unit&) const {}
};
__device__ __forceinline__ unsigned cvt_pk_bf16(float lo, float hi) { unsigned r; asm volatile("v_cvt_pk_bf16_f32 %0, %1, %2" : "=v"(r) : "v"(lo), "v"(hi)); return r; }
template <class Epi, class Sched, bool STAMP = false>
__device__ __forceinline__ void gemm_phase(PG8_LAS unsigned char* lds, const Gemm g, const Sched& S, const Epi& E, unsigned long long* stamps) {
    const int tid = otid(), wid = __builtin_amdgcn_readfirstlane(tid >> 6), lane = tid & 63, wr = wid >> 2, wc = wid & 3, fr = lane & 15, fq = lane >> 4;
    const int K = g.K, nt = K / BK;
    int ts_lo = 0, ts_hi = 0, nts = 0; const unsigned long long rt_entry = STAMP ? (unsigned long long)wall_clock64() : 0ull;
#define PG8_STAMP() do { if (STAMP && wid == 0 && nts < 64) { const unsigned long long _c = (unsigned long long)clock64(); \
        ts_lo = (lane == nts) ? (int)(unsigned)_c : ts_lo; ts_hi = (lane == nts) ? (int)(unsigned)(_c >> 32) : ts_hi; ++nts; } } while (0)
    PG8_STAMP();
    unsigned voffA[2], voffB[2];
#pragma unroll
    for (int i = 0; i < 2; ++i) { int R, C; stage_rc(tid * 16 + i * 8192, R, C); const int Rb = Epi::PERM ? ((R & ~31) + perm32(R & 31)) : R;
        voffA[i] = (unsigned)(R * K + C) * 2u; voffB[i] = (unsigned)(Rb * K + C) * 2u; }
    const size_t kstep = (size_t)(BK * 2);
    const size_t hstep = (size_t)HALF * K * 2;
    const size_t tstep = 2 * hstep;
    const unsigned ldsw = (unsigned)wid * 1024u;
    const int aoff = lds_byte(wr * 64 + fr, fq * 8), boff = lds_byte(wc * 32 + fr, fq * 8);
#define PG8_SA(b, h) (((b) * 2 + (h)) * HTB)
#define PG8_SB(b, h) ((4 + (b) * 2 + (h)) * HTB)
#define PG8_STAGE(bufoff, gbase, voff) do { _Pragma("unroll") for (int _i = 0; _i < 2; ++_i) \
        __builtin_amdgcn_global_load_lds((const unsigned*)((const char*)(gbase) + (voff)[_i]), (PG8_LAS unsigned*)(lds + (bufoff) + ldsw + _i * 8192), 16, 0, 0); } while (0)
#define PG8_LDA(dst, b, h) do { _Pragma("unroll") for (int m = 0; m < 4; ++m) _Pragma("unroll") for (int k = 0; k < 2; ++k) dst[m][k] = *(const PG8_LAS bf16x8*)(lds + PG8_SA(b, h) + aoff + m * 2048 + k * 1024); } while (0)
#define PG8_LDB(dst, b, h) do { _Pragma("unroll") for (int n = 0; n < 2; ++n) _Pragma("unroll") for (int k = 0; k < 2; ++k) dst[n][k] = *(const PG8_LAS bf16x8*)(lds + PG8_SB(b, h) + boff + n * 2048 + k * 1024); } while (0)
#define PG8_MMA(ai, bj, At, Bt) do { __builtin_amdgcn_s_setprio(1); _Pragma("unroll") for (int m = 0; m < 4; ++m) _Pragma("unroll") for (int n = 0; n < 2; ++n) _Pragma("unroll") for (int k = 0; k < 2; ++k) \
        acc[ai][bj][m][n] = __builtin_amdgcn_mfma_f32_16x16x32_bf16(Bt[n][k], At[m][k], acc[ai][bj][m][n], 0, 0, 0); __builtin_amdgcn_s_setprio(0); } while (0)
#define PG8_WAIT_V(n) asm volatile("s_waitcnt vmcnt(" #n ")" ::: "memory")
#define PG8_WAIT_L(n) asm volatile("s_waitcnt lgkmcnt(" #n ")" ::: "memory")
#define PG8_BAR __builtin_amdgcn_s_barrier()
#define PG8_SCHED __builtin_amdgcn_sched_barrier(0)
    Unit cur, nxt; int ui = 0;
    if (!S.next(0, cur)) return;
    f32x4 acc[2][2][4][2];
#pragma unroll
    for (int a = 0; a < 2; ++a)
#pragma unroll
        for (int b = 0; b < 2; ++b)
#pragma unroll
            for (int m = 0; m < 4; ++m)
#pragma unroll
                for (int n = 0; n < 2; ++n) acc[a][b][m][n] = (f32x4){0.f, 0.f, 0.f, 0.f};
    bf16x8 At[4][2], B0[2][2], B1[2][2];
    const char* cA = (const char*)g.A + (size_t)cur.pm * tstep + (size_t)(cur.pn >> 2) * g.agrp; const char* cB = (const char*)g.Bt + (size_t)cur.pn * tstep;
    S.a_ready(cur);
    PG8_STAGE(PG8_SB(0, 0), cB, voffB); PG8_STAGE(PG8_SA(0, 0), cA, voffA); PG8_STAGE(PG8_SB(0, 1), cB + hstep, voffB); PG8_STAGE(PG8_SA(0, 1), cA + hstep, voffA);
    if (wr == 1) PG8_BAR;
    PG8_WAIT_V(4); PG8_BAR;
    PG8_STAGE(PG8_SB(1, 0), cB + kstep, voffB); PG8_STAGE(PG8_SA(1, 0), cA + kstep, voffA); PG8_STAGE(PG8_SB(1, 1), cB + hstep + kstep, voffB);
    PG8_WAIT_V(6); PG8_BAR;
    PG8_STAMP();
    for (;;) {
        const bool has_next = S.next(ui + 1, nxt);
        const char* nA = has_next ? (const char*)g.A + (size_t)nxt.pm * tstep + (size_t)(nxt.pn >> 2) * g.agrp : cA; const char* nB = has_next ? (const char*)g.Bt + (size_t)nxt.pn * tstep : cB;
        for (int t = 0; t < nt; t += 2) {
            const bool last = (t == nt - 2);
            const char* a1 = cA + (size_t)(t + 1) * kstep;
            const char* a2 = last ? nA : cA + (size_t)(t + 2) * kstep; const char* b2 = last ? nB : cB + (size_t)(t + 2) * kstep;
            const char* a3 = a2 + kstep; const char* b3 = b2 + kstep;
            if (last && has_next) S.a_ready(nxt);
            PG8_LDB(B0, 0, 0); PG8_SCHED; PG8_LDA(At, 0, 0); PG8_STAGE(PG8_SA(1, 1), a1 + hstep, voffA);
            PG8_WAIT_L(8); PG8_BAR; PG8_WAIT_L(0); PG8_MMA(0, 0, At, B0); PG8_BAR; PG8_SCHED;
            PG8_LDB(B1, 0, 1); PG8_STAGE(PG8_SB(0, 0), b2, voffB);
            PG8_BAR; PG8_WAIT_L(0); PG8_MMA(0, 1, At, B1); PG8_BAR;
            PG8_LDA(At, 0, 1); PG8_STAGE(PG8_SA(0, 0), a2, voffA);
            PG8_BAR; PG8_WAIT_L(0); PG8_MMA(1, 0, At, B0); PG8_BAR; PG8_SCHED;
            PG8_STAGE(PG8_SB(0, 1), b2 + hstep, voffB);
            PG8_WAIT_V(6); PG8_BAR; PG8_MMA(1, 1, At, B1); PG8_BAR;
            PG8_LDB(B0, 1, 0); PG8_SCHED; PG8_LDA(At, 1, 0); PG8_STAGE(PG8_SA(0, 1), a2 + hstep, voffA);
            PG8_WAIT_L(8); PG8_BAR; PG8_WAIT_L(0); PG8_MMA(0, 0, At, B0); PG8_BAR; PG8_SCHED;
            PG8_LDB(B1, 1, 1); PG8_STAGE(PG8_SB(1, 0), b3, voffB);
            PG8_BAR; PG8_WAIT_L(0); PG8_MMA(0, 1, At, B1); PG8_BAR;
            PG8_LDA(At, 1, 1); PG8_STAGE(PG8_SA(1, 0), a3, voffA);
            PG8_BAR; PG8_WAIT_L(0); PG8_MMA(1, 0, At, B0); PG8_BAR; PG8_SCHED;
            PG8_STAGE(PG8_SB(1, 1), b3 + hstep, voffB);
            PG8_WAIT_V(6); PG8_BAR; PG8_MMA(1, 1, At, B1); PG8_BAR;
        }
        PG8_STAMP();
        if constexpr (!Epi::AFTER_DRAIN) { E(acc, cur, wr, wc, fr, fq); S.done(cur); }
        PG8_STAMP();
        if (!has_next) break;
#pragma unroll
        for (int a = 0; a < 2; ++a)
#pragma unroll
            for (int b = 0; b < 2; ++b)
#pragma unroll
                for (int m = 0; m < 4; ++m)
#pragma unroll
                    for (int n = 0; n < 2; ++n) acc[a][b][m][n] = (f32x4){0.f, 0.f, 0.f, 0.f};
        cur = nxt; cA = nA; cB = nB; ++ui;
    }
    PG8_WAIT_V(0);
    if (wr == 0) PG8_BAR;
    PG8_BAR;
    if constexpr (Epi::AFTER_DRAIN) { E.fused(acc, cur, wr, wc, fr, fq, lds, wid, lane); S.done(cur); }
    PG8_STAMP();
    if (STAMP && wid == 0) { stamps[lane] = lane < nts ? (((unsigned long long)(unsigned)ts_hi << 32) | (unsigned)ts_lo) : 0ull;
        if (lane == 62) stamps[62] = rt_entry; if (lane == 63) stamps[63] = (unsigned long long)wall_clock64(); }
#undef PG8_STAMP
#undef PG8_SA
#undef PG8_SB
#undef PG8_STAGE
#undef PG8_LDA
#undef PG8_LDB
#undef PG8_MMA
#undef PG8_WAIT_V
#undef PG8_WAIT_L
#undef PG8_BAR
#undef PG8_SCHED
}
}

struct PEpiBf16 {
    static constexpr bool PERM = true, AFTER_DRAIN = false;
    bf16_t* C; int ldc, N, act;
    __device__ __forceinline__ void operator()(const pg8::f32x4 (&acc)[2][2][4][2], const pg8::Unit& u, int wr, int wc, int fr, int fq) const {
        const int row0 = u.pm * 256 + wr * 64 + fr, col0 = u.pn * 256 + wc * 32 + 8 * fq;
#pragma unroll
        for (int ai = 0; ai < 2; ++ai)
#pragma unroll
            for (int m = 0; m < 4; ++m) {
                bf16_t* rowp = C + (size_t)(row0 + ai * 128 + m * 16) * ldc;
#pragma unroll
                for (int bj = 0; bj < 2; ++bj) {
                    const int col = col0 + bj * 128;
                    pg8::f32x4 v0 = acc[ai][bj][m][0], v1 = acc[ai][bj][m][1];
                    if (act == 1) { v0.x = fmaxf(v0.x, 0.f); v0.y = fmaxf(v0.y, 0.f); v0.z = fmaxf(v0.z, 0.f); v0.w = fmaxf(v0.w, 0.f); v0 = v0 * v0;
                                    v1.x = fmaxf(v1.x, 0.f); v1.y = fmaxf(v1.y, 0.f); v1.z = fmaxf(v1.z, 0.f); v1.w = fmaxf(v1.w, 0.f); v1 = v1 * v1; }
                    if (act == 2) { v0.x = sigmoidf_(v0.x); v0.y = sigmoidf_(v0.y); v0.z = sigmoidf_(v0.z); v0.w = sigmoidf_(v0.w);
                                    v1.x = sigmoidf_(v1.x); v1.y = sigmoidf_(v1.y); v1.z = sigmoidf_(v1.z); v1.w = sigmoidf_(v1.w); }
                    u32x4 w; w.x = pk2(v0.x, v0.y); w.y = pk2(v0.z, v0.w); w.z = pk2(v1.x, v1.y); w.w = pk2(v1.z, v1.w);
                    if (col < N) *(u32x4*)(rowp + col) = w;
                }
            }
    }
};
struct PEpiResid {
    static constexpr bool PERM = true, AFTER_DRAIN = false;
    float* x; const float* gate;
    __device__ __forceinline__ void operator()(const pg8::f32x4 (&acc)[2][2][4][2], const pg8::Unit& u, int wr, int wc, int fr, int fq) const {
        const int row0 = u.pm * 256 + wr * 64 + fr, col0 = u.pn * 256 + wc * 32 + 8 * fq;
#pragma unroll
        for (int ai = 0; ai < 2; ++ai)
#pragma unroll
            for (int m = 0; m < 4; ++m) {
                const int row = row0 + ai * 128 + m * 16;
                float* rowp = x + (size_t)row * D; const float* gp = gate + (size_t)mod_row(row) * 6144;
#pragma unroll
                for (int bj = 0; bj < 2; ++bj) {
                    const int col = col0 + bj * 128;
                    const f32x4 g0 = *(const f32x4*)(gp + col), g1 = *(const f32x4*)(gp + col + 4);
                    f32x4 x0 = *(const f32x4*)(rowp + col), x1 = *(const f32x4*)(rowp + col + 4);
                    x0 = x0 + g0 * acc[ai][bj][m][0]; x1 = x1 + g1 * acc[ai][bj][m][1];
                    *(f32x4*)(rowp + col) = x0; *(f32x4*)(rowp + col + 4) = x1;
                }
            }
    }
};
struct PEpiGate {
    static constexpr bool PERM = true, AFTER_DRAIN = false;
    bf16_t* G; int ldc;
    __device__ __forceinline__ void operator()(const pg8::f32x4 (&acc)[2][2][4][2], const pg8::Unit& u, int wr, int wc, int fr, int fq) const {
        const int row0 = u.pm * 256 + wr * 64 + fr, col0 = u.pn * 256 + wc * 32 + 8 * fq;
#pragma unroll
        for (int ai = 0; ai < 2; ++ai)
#pragma unroll
            for (int m = 0; m < 4; ++m) {
                bf16_t* rowp = G + (size_t)(row0 + ai * 128 + m * 16) * ldc;
#pragma unroll
                for (int bj = 0; bj < 2; ++bj) {
                    const int col = col0 + bj * 128;
                    const u32x4 g = *(const u32x4*)(rowp + col);
                    const pg8::f32x4 v0 = acc[ai][bj][m][0], v1 = acc[ai][bj][m][1];
                    u32x4 w; w.x = pk2(bflo(g.x) * v0.x, bfhi(g.x) * v0.y); w.y = pk2(bflo(g.y) * v0.z, bfhi(g.y) * v0.w);
                    w.z = pk2(bflo(g.z) * v1.x, bfhi(g.z) * v1.y); w.w = pk2(bflo(g.w) * v1.z, bfhi(g.w) * v1.w);
                    *(u32x4*)(rowp + col) = w;
                }
            }
    }
};
__device__ __forceinline__ void sum3_phase(const Params& p) {
    const bf16_t* Y = (const bf16_t*)(p.ws + WS_PROJ); bf16_t* merged = (bf16_t*)(p.ws + WS_ST);
    for (size_t i = (size_t)blockIdx.x * 512 + otid(); i < (size_t)NTOK * (D / 8); i += (size_t)gridDim.x * 512) {
        const size_t row = i >> 7; const int c8 = (int)(i & 127) * 8;
        const bf16_t* yr = Y + row * NGATE + c8;
        const u32x4 a = *(const u32x4*)yr, b = *(const u32x4*)(yr + 1024), c = *(const u32x4*)(yr + 2048);
        u32x4 w; w.x = pk2(bflo(a.x) + bflo(b.x) + bflo(c.x), bfhi(a.x) + bfhi(b.x) + bfhi(c.x)); w.y = pk2(bflo(a.y) + bflo(b.y) + bflo(c.y), bfhi(a.y) + bfhi(b.y) + bfhi(c.y));
        w.z = pk2(bflo(a.z) + bflo(b.z) + bflo(c.z), bfhi(a.z) + bfhi(b.z) + bfhi(c.z)); w.w = pk2(bflo(a.w) + bflo(b.w) + bflo(c.w), bfhi(a.w) + bfhi(b.w) + bfhi(c.w));
        *(u32x4*)(merged + row * D + c8) = w;
    }
}
template <class Epi>
__device__ __forceinline__ void pg8_gemm(LAS unsigned char* lds, const bf16_t* A, const bf16_t* Bt, int M, int N, int K, const Epi& e, size_t agrp = 0) {
    pg8::Gemm g{A, Bt, M, N, K, agrp};
    pg8::StaticOrder so; so.init(M, N, (int)gridDim.x, (int)blockIdx.x);
    pg8::gemm_phase<Epi, pg8::StaticOrder, false>(lds, g, so, e, nullptr);
    __syncthreads();
}

__device__ __forceinline__ void grid_barrier(unsigned* bar, unsigned k) {
    asm volatile("s_waitcnt vmcnt(0)" ::: "memory");
    __syncthreads();
    if (otid() == 0) {
        const unsigned g = blockIdx.x & 7u, ng = (gridDim.x + 7u - g) >> 3;
        __builtin_amdgcn_fence(__ATOMIC_RELEASE, "agent");
        asm volatile("s_waitcnt vmcnt(0)" ::: "memory");
        const unsigned c = __hip_atomic_fetch_add(bar + 16 * g, 1u, __ATOMIC_RELAXED, __HIP_MEMORY_SCOPE_AGENT);
        if (c == ng * k - 1u) {
            const unsigned ngroups = gridDim.x < 8u ? gridDim.x : 8u;
            const unsigned t = __hip_atomic_fetch_add(bar + 128, 1u, __ATOMIC_RELAXED, __HIP_MEMORY_SCOPE_AGENT);
            if (t == ngroups * k - 1u)
                for (unsigned j = 0; j < ngroups; ++j) __hip_atomic_store(bar + 144 + 16 * j, k, __ATOMIC_RELAXED, __HIP_MEMORY_SCOPE_AGENT);
        }
        unsigned spins = 0;
        while (__hip_atomic_load(bar + 144 + 16 * g, __ATOMIC_RELAXED, __HIP_MEMORY_SCOPE_AGENT) < k && ++spins < (1u << 28)) __builtin_amdgcn_s_sleep(1);
        __builtin_amdgcn_fence(__ATOMIC_ACQUIRE, "agent");
        asm volatile("s_waitcnt vmcnt(0)" ::: "memory");
    }
    __syncthreads();
}

__device__ __forceinline__ void transpose_item(const float* __restrict__ W, int N, int K, int k0, int n0, bf16_t* __restrict__ dst  , LAS float* scr, int lane) {
#pragma unroll 8
    for (int i = 0; i < 32; ++i) { const int kk = 2 * i + (lane >> 5); scr[kk * 33 + (lane & 31)] = W[(size_t)(k0 + kk) * N + n0 + (lane & 31)]; }
    LDS_WAIT();
    const int c = lane & 7;
#pragma unroll
    for (int j = 0; j < 4; ++j) {
        const int n = (lane >> 3) + 8 * j; const LAS float* s = scr + (8 * c) * 33 + n;
        u32x4 o; o.x = pk2(s[0 * 33], s[1 * 33]); o.y = pk2(s[2 * 33], s[3 * 33]); o.z = pk2(s[4 * 33], s[5 * 33]); o.w = pk2(s[6 * 33], s[7 * 33]);
        *(u32x4*)(dst + (size_t)n * K + k0 + 8 * c) = o;
    }
    LDS_WAIT();
}

constexpr int CONV_NIT = 16 * 257 + 3 * 8 * 32 + 16 * 32 + 16 * 128 + 64 * 32, CONV_BLOCK_ITEMS = (CONV_NIT + 7) / 8;
constexpr int CONV_IN_P2 = 112 * 2, CONV_IN_P4 = 64 * 4, CONV_IN_GEMM = CONV_IN_P2 + CONV_IN_P4;
__device__ __forceinline__ void convert_weights(const Params& p, int l, LAS unsigned char* lds, int bitem = -1) {
    const int lane = otid() & 63, wid = otid() >> 6;
    LAS float* scr = (LAS float*)(lds + wid * 16384);
    unsigned char* wb = p.ws + WS_W + (size_t)(l & 1) * W_END;
    constexpr int I_IN = 16 * 257, I_BR = 8 * 32, I_OUT = 16 * 32, I_FF1 = 16 * 128, I_FF2 = 64 * 32;
    constexpr int NIT = I_IN + 3 * I_BR + I_OUT + I_FF1 + I_FF2;
    for (int it = (bitem < 0 ? blockIdx.x * 8 + wid : bitem * 8 + wid); it < NIT; it += (bitem < 0 ? gridDim.x * 8 : NIT)) {
        int r = it;
        if (r < I_IN) { const int kb = r / 257, nb = r % 257, n0 = nb * 32;
            bf16_t* dst = n0 < NPROJ ? (bf16_t*)(wb + W_IN) + (size_t)n0 * D : (bf16_t*)(wb + W_G) + (size_t)(n0 - NPROJ) * D;
            transpose_item(p.w_in + (size_t)l * D * DIN, DIN, D, kb * 64, n0, dst, scr, lane); continue; }
        r -= I_IN;
        if (r < 3 * I_BR) { const int b = r / I_BR, q = r % I_BR, kb = q / 32, nb = q % 32;
            const float* W = (b == 0 ? p.w_br_gla : b == 1 ? p.w_br_hg : p.w_br_gm) + (size_t)l * 512 * D;
            transpose_item(W, D, 512, kb * 64, nb * 32, (bf16_t*)(wb + W_BR) + (size_t)b * D * 512 + (size_t)nb * 32 * 512, scr, lane); continue; }
        r -= 3 * I_BR;
        if (r < I_OUT) { const int kb = r / 32, nb = r % 32;
            transpose_item(p.w_out + (size_t)l * D * D, D, D, kb * 64, nb * 32, (bf16_t*)(wb + W_OUT) + (size_t)nb * 32 * D, scr, lane); continue; }
        r -= I_OUT;
        if (r < I_FF1) { const int kb = r / 128, nb = r % 128;
            transpose_item(p.w_ff1 + (size_t)l * D * DFF, DFF, D, kb * 64, nb * 32, (bf16_t*)(wb + W_FF1) + (size_t)nb * 32 * D, scr, lane); continue; }
        r -= I_FF1;
        { const int kb = r / 32, nb = r % 32;
            transpose_item(p.w_ff2 + (size_t)l * DFF * D, D, DFF, kb * 64, nb * 32, (bf16_t*)(wb + W_FF2) + (size_t)nb * 32 * DFF, scr, lane); }
    }
}

__device__ __forceinline__ void phase0(const Params& p, LAS unsigned char* lds) {
    const int tid = otid();
    float* x = p.out;
    for (size_t i = (size_t)blockIdx.x * 512 + tid; i < (size_t)NTOK * (D / 4); i += (size_t)gridDim.x * 512) {
        const int tok = (int)(i >> 8), c4 = (int)(i & 255) * 4;
        f32x4 v;
        if (tok < NCTX) v = *(const f32x4*)(p.x_prompt + (size_t)tok * D + c4);
        else {
            const int lt = tok - NCTX; v = *(const f32x4*)(p.x_sample + (size_t)lt * D + c4);
            const int t = lt & 2047; const float rr = (float)(t >> 6), cc = (float)(t & 63);
            const int sec = c4 >> 8; const float pos = sec < 2 ? rr : cc;
#pragma unroll
            for (int j = 0; j < 4; ++j) {
                const int f = (c4 + j) & 255;
                const float omega = exp2f((float)f * (-13.287712379549449f / 256.0f));
                const float a = pos * omega;
                v[j] += (sec & 1) ? __cosf(a) : __sinf(a);
            }
        }
        *(f32x4*)(x + i * 4) = v;
    }
    if (blockIdx.x == 0) {
        float* lbs = (float*)(p.ws + WS_LBS);
        for (int i = tid; i < 1024; i += 512) {
            const int dir = i >> 9, ch = i & 511; float lg[4], mx = -1e30f;
            for (int l = 0; l < 4; ++l) { lg[l] = p.hg_lb_logits[(size_t)(dir * 4 + l) * 512 + ch]; mx = fmaxf(mx, lg[l]); }
            float s = 0.f; for (int l = 0; l < 4; ++l) { lg[l] = expf(lg[l] - mx); s += lg[l]; }
            float cum = 0.f, c0 = 0.f;
            for (int l = 0; l < 4; ++l) { cum += lg[l] / s; if (l == 0) c0 = cum; lbs[(size_t)(dir * 4 + l) * 512 + ch] = cum - c0; }
        }
        for (int i = tid; i < 1024; i += 512) ((unsigned*)(p.ws + WS_CTR))[i] = 0u;
    }
    LAS float* sc = (LAS float*)lds;
    LAS float* red = sc + 9 * 1024;
    for (int i = tid; i < 9 * 1024; i += 512) { const int r = i >> 10, k = i & 1023; const float v = r == 0 ? p.c_ctx[k] : p.c[(size_t)(r - 1) * D + k]; sc[i] = siluf_(v); }
    __syncthreads();
    float* mod = (float*)(p.ws + WS_MOD);
    for (int u = blockIdx.x; u < DEPTH * 48; u += gridDim.x) {
        const int l = u / 48, cb = u % 48, cl = tid & 127, kp = tid >> 7, n = cb * 128 + cl;
        const float* w = p.ada_w + (size_t)l * D * 6144 + n;
        float a[9];
#pragma unroll
        for (int r = 0; r < 9; ++r) a[r] = 0.f;
#pragma unroll 4
        for (int k = kp * 256; k < kp * 256 + 256; ++k) {
            const float wv = w[(size_t)k * 6144];
#pragma unroll
            for (int r = 0; r < 9; ++r) a[r] += sc[r * 1024 + k] * wv;
        }
#pragma unroll
        for (int r = 0; r < 9; ++r) red[(kp * 9 + r) * 128 + cl] = a[r];
        __syncthreads();
        for (int i = tid; i < 9 * 128; i += 512) {
            const int r = i >> 7, c2 = i & 127;
            const float s = red[(0 * 9 + r) * 128 + c2] + red[(1 * 9 + r) * 128 + c2] + red[(2 * 9 + r) * 128 + c2] + red[(3 * 9 + r) * 128 + c2];
            mod[((size_t)l * 9 + r) * 6144 + cb * 128 + c2] = s + p.ada_b[(size_t)l * 6144 + cb * 128 + c2];
        }
        __syncthreads();
    }
}

__device__ __forceinline__ void norm_phase(const Params& p, const float* g, const float* mod_l, int off_sh, int off_sc, bf16_t* hout, int mode) {
    const int lane = otid() & 63, wid = otid() >> 6;
    float* x = p.out;
    for (int row = blockIdx.x * 8 + wid; row < NTOK; row += gridDim.x * 8) {
        f32x4 v[4]; float s = 0.f;
        float* xr = x + (size_t)row * D;
#pragma unroll
        for (int j = 0; j < 4; ++j) { v[j] = *(const f32x4*)(xr + lane * 4 + 256 * j); s += v[j].x * v[j].x + v[j].y * v[j].y + v[j].z * v[j].z + v[j].w * v[j].w; }
        const float rstd = rsqrtf(wave_sum(s) * (1.0f / D) + EPS);
        if (mode == 0) {
            const float* mr = mod_l + (size_t)mod_row(row) * 6144;
#pragma unroll
            for (int j = 0; j < 4; ++j) {
                const int c = lane * 4 + 256 * j;
                const f32x4 gg = *(const f32x4*)(g + c), sh = *(const f32x4*)(mr + off_sh + c), scv = *(const f32x4*)(mr + off_sc + c);
                const f32x4 o = (v[j] * rstd) * gg * (scv + 1.0f) + sh;
                u32x2 w; w.x = pk2(o.x, o.y); w.y = pk2(o.z, o.w);
                *(u32x2*)(hout + (size_t)row * D + c) = w;
            }
        } else {
#pragma unroll
            for (int j = 0; j < 4; ++j) { const int c = lane * 4 + 256 * j; const f32x4 gg = *(const f32x4*)(g + c); *(f32x4*)(xr + c) = (v[j] * rstd) * gg; }
        }
    }
}

template <int MIX>
__device__ __forceinline__ void gate_eval(const bf16_t* row, int kcol, int zcol, const float (&lrw)[16], float lrb, float lb, float& gt, float& kt) {
    if (!MIX) {
        const bf16_t* zr = row + zcol;
        const u32x4 z0 = *(const u32x4*)zr, z1 = *(const u32x4*)(zr + 8);
        float z = lrb;
        z += bflo(z0.x) * lrw[0] + bfhi(z0.x) * lrw[1] + bflo(z0.y) * lrw[2] + bfhi(z0.y) * lrw[3] + bflo(z0.z) * lrw[4] + bfhi(z0.z) * lrw[5] + bflo(z0.w) * lrw[6] + bfhi(z0.w) * lrw[7];
        z += bflo(z1.x) * lrw[8] + bfhi(z1.x) * lrw[9] + bflo(z1.y) * lrw[10] + bfhi(z1.y) * lrw[11] + bflo(z1.z) * lrw[12] + bfhi(z1.z) * lrw[13] + bflo(z1.w) * lrw[14] + bfhi(z1.w) * lrw[15];
        gt = logsigmoidf_(z) * (1.0f / 16.0f);
        kt = bf2f(row[kcol]);
    } else {
        const float xf = bf2f(row[kcol]);
        const float sg = sigmoidf_(xf);
        gt = flog_(lb + (1.0f - lb) * sg);
        kt = (1.0f - lb) * (1.0f - sg);
    }
}

template <int MIX>
__device__ __forceinline__ void gate_raw(unsigned kraw, const u32x4& z0, const u32x4& z1, const float (&lrw)[16], float lrb, float lb, float& gt, float& kt) {
    if (!MIX) {
        float z = lrb;
        z += bflo(z0.x) * lrw[0] + bfhi(z0.x) * lrw[1] + bflo(z0.y) * lrw[2] + bfhi(z0.y) * lrw[3] + bflo(z0.z) * lrw[4] + bfhi(z0.z) * lrw[5] + bflo(z0.w) * lrw[6] + bfhi(z0.w) * lrw[7];
        z += bflo(z1.x) * lrw[8] + bfhi(z1.x) * lrw[9] + bflo(z1.y) * lrw[10] + bfhi(z1.y) * lrw[11] + bflo(z1.z) * lrw[12] + bfhi(z1.z) * lrw[13] + bflo(z1.w) * lrw[14] + bfhi(z1.w) * lrw[15];
        gt = logsigmoidf_(z) * (1.0f / 16.0f);
        kt = bflo(kraw);
    } else {
        const float xf = bflo(kraw);
        const float sg = sigmoidf_(xf);
        gt = flog_(lb + (1.0f - lb) * sg);
        kt = (1.0f - lb) * (1.0f - sg);
    }
}

template <int MIX>
__device__ __forceinline__ void scan_job(const Params& p, int l, int s, int dir, int hd, LAS unsigned char* lds) {
    constexpr int DK = MIX ? 128 : 64, WM = DK / 32, WN = 8 / WM, WTN = 128 / WN, NTL = WTN / 32, LDT = 72, LDG = DK + 1;
    LAS bf16_t* At = (LAS bf16_t*)lds;
    LAS bf16_t* Bt = At + 128 * LDT;
    LAS float* dec = (LAS float*)(lds + 2 * 128 * LDT * 2);
    LAS float* G = dec + 128;
    LAS float* KK = G + 64 * 129;
    const int tid = otid(), lane = tid & 63, wid = tid >> 6, wm = wid / WN, wn = wid % WN;
    const bool ctx = s < 16;
    const int T = ctx ? 256 : 2048, tok0 = ctx ? s * 256 : NCTX + (s - 16) * 2048, nch = T / 64;
    const bf16_t* proj = (const bf16_t*)(p.ws + WS_PROJ);
    const float* lbs = (const float*)(p.ws + WS_LBS);
    bf16_t* sbuf = (bf16_t*)(p.ws + WS_ST + (MIX ? ST_GLA_BYTES : 0));
    f32x16 S[1][NTL];
    {
        const float* st0 = ctx ? nullptr : (MIX ? p.state_hgrn + ((((size_t)(s - 16) * DEPTH + l) * 2 + dir) * 4 + hd) * 128 * 128
                                                : p.state_gla + ((((size_t)(s - 16) * DEPTH + l) * 2 + dir) * 4 + hd) * 64 * 128);
#pragma unroll
        for (int n = 0; n < NTL; ++n)
#pragma unroll
            for (int i = 0; i < 16; ++i) {
                const int d = wm * 32 + (i & 3) + 8 * (i >> 2) + 4 * (lane >> 5), v = wn * WTN + n * 32 + (lane & 31);
                S[0][n][i] = ctx ? 0.f : st0[(size_t)d * 128 + v];
            }
    }
    const int sd = tid & (DK - 1), t0 = tid / DK; constexpr int TS = 512 / DK;
    float lrw[16]; float lrb = 0.f, lb = 0.f;
    if (!MIX) {
#pragma unroll
        for (int r = 0; r < 16; ++r) lrw[r] = p.gla_lr_w[(((size_t)l * 2 + dir) * 16 + r) * 256 + hd * 64 + sd];
        lrb = p.gla_lr_b[((size_t)l * 2 + dir) * 256 + hd * 64 + sd];
    } else {
#pragma unroll
        for (int r = 0; r < 16; ++r) lrw[r] = 0.f;
        lb = lbs[(size_t)(dir * 4 + l) * 512 + hd * 128 + sd];
    }
    const int kcol = MIX ? (dir ? PJ_HFB : PJ_HFF) + hd * 128 + sd : PJ_GK + hd * 64 + sd;
    const int zcol = dir ? PJ_GZB : PJ_GZF;
    const int vv = tid & 127, vq = tid >> 7;
    const int vcol = (MIX ? PJ_HI : PJ_GV) + hd * 128 + vv;
    const int kd = tid >> 2, kq = tid & 3;
    const bool k2 = tid < 4 * DK;

    constexpr int NE = 64 / TS;
    unsigned kraw[NE]; unsigned vraw[8];
    const int widu = __builtin_amdgcn_readfirstlane(tid >> 6), gmt = (widu >> 1) & 1, gnt = widu & 1;
    bf16x8 gafr = {0, 0, 0, 0, 0, 0, 0, 0}; u32x4 gbw = {0u, 0u, 0u, 0u}; float gbias = 0.f;
    if (!MIX && widu < 4) {
        const float* lw = p.gla_lr_w + (((size_t)l * 2 + dir) * 16 + 8 * (lane >> 5)) * 256 + hd * 64 + gnt * 32 + (lane & 31);
        float wv[8];
#pragma unroll
        for (int j = 0; j < 8; ++j) wv[j] = lw[(size_t)j * 256];
        gbw.x = pk2(wv[0], wv[1]); gbw.y = pk2(wv[2], wv[3]); gbw.z = pk2(wv[4], wv[5]); gbw.w = pk2(wv[6], wv[7]);
        gbias = p.gla_lr_b[((size_t)l * 2 + dir) * 256 + hd * 64 + gnt * 32 + (lane & 31)];
    }
    auto load_chunk = [&](const bf16_t* prc) {
#pragma unroll
        for (int i = 0; i < NE; ++i) {
            const bf16_t* row = prc + (size_t)(t0 + TS * i) * NPROJ;
            kraw[i] = row[kcol];
        }
        if (!MIX && widu < 4) gafr = *(const bf16x8*)(prc + (size_t)(gmt * 32 + (lane & 31)) * NPROJ + zcol + 8 * (lane >> 5));
#pragma unroll
        for (int t = 0; t < 16; t += 2) {
            const unsigned a = prc[(size_t)(vq * 16 + t) * NPROJ + vcol], b = prc[(size_t)(vq * 16 + t + 1) * NPROJ + vcol];
            vraw[t >> 1] = a | (b << 16);
        }
    };
    auto store_state = [&](int gcs) {
        bf16_t* sb = sbuf + (((size_t)gcs * 2 + dir) * 4 + hd) * 128 * DK;
#pragma unroll
        for (int nn = 0; nn < NTL; ++nn)
#pragma unroll
            for (int q = 0; q < 4; ++q) {
                const int d0 = wm * 32 + 8 * q + 4 * (lane >> 5), v = wn * WTN + nn * 32 + (lane & 31);
                u32x2 w; w.x = pk2(S[0][nn][4 * q + 0], S[0][nn][4 * q + 1]); w.y = pk2(S[0][nn][4 * q + 2], S[0][nn][4 * q + 3]);
                *(u32x2*)(sb + (size_t)v * DK + d0) = w;
            }
    };
    load_chunk(proj + (size_t)(tok0 + (dir ? nch - 1 : 0) * 64) * NPROJ);
    store_state((tok0 >> 6) + (dir ? nch - 1 : 0));
    for (int n = 0; n < nch; ++n) {
        if (MIX) {
#pragma unroll
            for (int i = 0; i < NE; ++i) {
                const int t = t0 + TS * i; float gt, kt; const u32x4 zz = {0u, 0u, 0u, 0u};
                gate_raw<MIX>(kraw[i], zz, zz, lrw, lrb, lb, gt, kt);
                G[t * LDG + sd] = gt; KK[t * LDG + sd] = kt;
            }
        } else {
#pragma unroll
            for (int i = 0; i < NE; ++i) KK[(t0 + TS * i) * LDG + sd] = bflo(kraw[i]);
            if (widu < 4) {
                f32x16 zacc;
#pragma unroll
                for (int i = 0; i < 16; ++i) zacc[i] = 0.f;
                zacc = __builtin_amdgcn_mfma_f32_32x32x16_bf16(gafr, __builtin_bit_cast(bf16x8, gbw), zacc, 0, 0, 0);
#pragma unroll
                for (int i = 0; i < 16; ++i)
                    G[(gmt * 32 + (i & 3) + 8 * (i >> 2) + 4 * (lane >> 5)) * LDG + gnt * 32 + (lane & 31)] = logsigmoidf_(zacc[i] + gbias) * (1.0f / 16.0f);
            }
        }
#pragma unroll
        for (int q = 0; q < 2; ++q) { u32x4 w; w.x = vraw[4 * q]; w.y = vraw[4 * q + 1]; w.z = vraw[4 * q + 2]; w.w = vraw[4 * q + 3]; *(LAS u32x4*)(Bt + vv * LDT + vq * 16 + q * 8) = w; }
        if (n + 1 < nch) load_chunk(proj + (size_t)(tok0 + (dir ? nch - 2 - n : n + 1) * 64) * NPROJ);
        __syncthreads();
        if (k2) {
            float g[16]; float qs = 0.f;
#pragma unroll
            for (int t = 0; t < 16; ++t) { g[t] = G[(kq * 16 + t) * LDG + kd]; qs += g[t]; }
            const int lb4 = lane & ~3;
            const float s0 = __shfl(qs, lb4), s1 = __shfl(qs, lb4 + 1), s2 = __shfl(qs, lb4 + 2), s3 = __shfl(qs, lb4 + 3);
            const float total = (s0 + s1) + (s2 + s3);
            float pref = (kq > 0 ? s0 : 0.f) + (kq > 1 ? s1 : 0.f) + (kq > 2 ? s2 : 0.f);
            unsigned pkv[8];
#pragma unroll
            for (int t = 0; t < 16; ++t) {
                const float pe = pref; pref += g[t];
                const float w = dir ? pe : total - pref;
                const float kv = KK[(kq * 16 + t) * LDG + kd] * fexp_(w);
                if (t & 1) pkv[t >> 1] = pk2(__uint_as_float(pkv[t >> 1]), kv); else pkv[t >> 1] = __float_as_uint(kv);
            }
#pragma unroll
            for (int q = 0; q < 2; ++q) { u32x4 w; w.x = pkv[4 * q]; w.y = pkv[4 * q + 1]; w.z = pkv[4 * q + 2]; w.w = pkv[4 * q + 3]; *(LAS u32x4*)(At + kd * LDT + kq * 16 + q * 8) = w; }
            if (kq == 0) dec[kd] = fexp_(total);
        }
        __syncthreads();
#pragma unroll
        for (int nn = 0; nn < NTL; ++nn)
#pragma unroll
            for (int i = 0; i < 16; ++i) S[0][nn][i] *= dec[wm * 32 + (i & 3) + 8 * (i >> 2) + 4 * (lane >> 5)];
        mma_lds<1, NTL, 4>(S, At + wm * 32 * LDT, LDT, Bt + wn * WTN * LDT, LDT, lane);
        if (n + 1 < nch) store_state((tok0 >> 6) + (dir ? nch - 2 - n : n + 1));
        __syncthreads();
    }
    if (ctx) {
        float* o = MIX ? p.out + (size_t)NTOK * D + (size_t)16 * DEPTH * 2 * 4 * 64 * 128 + ((((size_t)s * DEPTH + l) * 2 + dir) * 4 + hd) * 128 * 128
                       : p.out + (size_t)NTOK * D + ((((size_t)s * DEPTH + l) * 2 + dir) * 4 + hd) * 64 * 128;
#pragma unroll
        for (int nn = 0; nn < NTL; ++nn)
#pragma unroll
            for (int i = 0; i < 16; ++i) {
                const int d = wm * 32 + (i & 3) + 8 * (i >> 2) + 4 * (lane >> 5), v = wn * WTN + nn * 32 + (lane & 31);
                o[(size_t)d * 128 + v] = S[0][nn][i];
            }
    }
}


__device__ __forceinline__ void gmlp_item(const Params& p, int l, int c2, int g, LAS unsigned char* lds) {
    constexpr int LDT = 136;
    LAS bf16_t* Aw = (LAS bf16_t*)lds;
    LAS bf16_t* Bt = Aw + 128 * LDT;
    const int tid = otid(), lane = tid & 63, wid = tid >> 6, wm = wid >> 2, wn = wid & 3;
    const bf16_t* proj = (const bf16_t*)(p.ws + WS_PROJ);
    const int tokb = c2 * 128;
    {
        const float* wsrc = p.gm_ws + ((size_t)l * 4 + g) * 128 * 128;
#pragma unroll
        for (int i = 0; i < 8; ++i) {
            const int e = (i * 512 + tid) * 4, pp = e >> 7, q = e & 127;
            const f32x4 v = *(const f32x4*)(wsrc + e);
            u32x2 w; w.x = pk2(v.x, v.y); w.y = pk2(v.z, v.w);
            *(LAS u32x2*)(Aw + pp * LDT + q) = w;
        }
    }
    {
        const int q = tid >> 2, part = tid & 3;
        const bf16_t* mv = proj + (size_t)(tokb + q) * NPROJ + PJ_MV;
        float s = 0.f, s2 = 0.f;
#pragma unroll
        for (int i = 0; i < 16; ++i) {
            const u32x4 u = *(const u32x4*)(mv + (i * 4 + part) * 8);
            const unsigned uu[4] = {u.x, u.y, u.z, u.w};
#pragma unroll
            for (int j = 0; j < 4; ++j) { const float a = geluf_(bflo(uu[j])), b = geluf_(bfhi(uu[j])); s += a + b; s2 += a * a + b * b; }
        }
        s += __shfl_xor(s, 1); s += __shfl_xor(s, 2); s2 += __shfl_xor(s2, 1); s2 += __shfl_xor(s2, 2);
        const float mean = s * (1.0f / 512.0f), var = fmaxf(s2 * (1.0f / 512.0f) - mean * mean, 0.f), rstd = rsqrtf(var + EPS);
        const float* gg = p.gm_norm_g + (size_t)l * 512 + g * 128 + part * 32;
        const bf16_t* mvg = mv + g * 128 + part * 32;
#pragma unroll
        for (int i = 0; i < 4; ++i) {
            const u32x4 u = *(const u32x4*)(mvg + i * 8);
            const unsigned uu[4] = {u.x, u.y, u.z, u.w};
#pragma unroll
            for (int j = 0; j < 4; ++j) {
                const int c = part * 32 + i * 8 + j * 2;
                const float a = (geluf_(bflo(uu[j])) - mean) * rstd * gg[i * 8 + j * 2], b = (geluf_(bfhi(uu[j])) - mean) * rstd * gg[i * 8 + j * 2 + 1];
                Bt[c * LDT + q] = f2bf(a); Bt[(c + 1) * LDT + q] = f2bf(b);
            }
        }
    }
    __syncthreads();
    f32x16 acc[2][1]; acc_zero<1>(acc);
    mma_lds<2, 1, 8>(acc, Aw + wm * 64 * LDT, LDT, Bt + wn * 32 * LDT, LDT, lane);
    bf16_t* ocat = (bf16_t*)(p.ws + WS_OCAT);
    const float* bs = p.gm_bs + ((size_t)l * 4 + g) * 128;
#pragma unroll
    for (int m = 0; m < 2; ++m)
#pragma unroll
        for (int i = 0; i < 16; ++i) {
            const int pp = wm * 64 + m * 32 + (i & 3) + 8 * (i >> 2) + 4 * (lane >> 5), c = wn * 32 + (lane & 31);
            const float mu = bf2f(proj[(size_t)(tokb + pp) * NPROJ + PJ_MU + g * 128 + c]);
            ocat[(size_t)2 * NTOK * 512 + (size_t)(tokb + pp) * 512 + g * 128 + c] = f2bf(geluf_(mu) * (acc[m][0][i] + bs[pp]));
        }
    __syncthreads();
}

__device__ __forceinline__ void phase_scan(const Params& p, int l, LAS unsigned char* lds) {
    LAS int* slot = (LAS int*)(lds + LDS_BYTES - 16);
    unsigned* ctr = (unsigned*)(p.ws + WS_CTR) + l;
    constexpr int NLAT = 8 * 2 * 4 * 2, NCX = 16 * 2 * 4 * 2, NGM = 160 * 4;
    for (;;) {
        if (otid() == 0) *slot = (int)atomicAdd(ctr, 1u);
        __syncthreads();
        const int j = *slot;
        __syncthreads();
        const int nconv = l + 1 < DEPTH ? CONV_BLOCK_ITEMS - CONV_IN_GEMM : 0;
        if (j >= NLAT + NCX + NGM + nconv) break;
        if (j >= NLAT + NCX + NGM) { convert_weights(p, l + 1, lds, CONV_IN_GEMM + j - (NLAT + NCX + NGM)); __syncthreads(); continue; }
        if (j < NLAT + NCX) {
            int r = j, s;
            if (r < NLAT) { s = 16 + (r >> 4); r &= 15; } else { r -= NLAT; s = r >> 4; r &= 15; }
            const int mix = r & 1, dir = (r >> 1) & 1, hd = r >> 2;
            if (mix) scan_job<1>(p, l, s, dir, hd, lds); else scan_job<0>(p, l, s, dir, hd, lds);
        } else { const int r = j - NLAT - NCX; gmlp_item(p, l, r >> 2, r & 3, lds); }
    }
}

template <int MIX>
__device__ __forceinline__ void out_item(const Params& p, int l, int gc, int hd, LAS unsigned char* lds) {
    constexpr int DK = MIX ? 128 : 64, LQ = DK + 8, LDV = 72, LDG = DK + 1;
    LAS bf16_t* QA = (LAS bf16_t*)lds;
    LAS bf16_t* KA = QA + 128 * LQ;
    LAS bf16_t* QS = KA + 128 * LQ;
    LAS bf16_t* VT = QS + 64 * LQ;
    LAS bf16_t* P = VT + 128 * LDV;
    LAS float* C = (LAS float*)(P + 64 * LDV);
    LAS float* BS = C + (MIX ? 64 : 128) * LDG;
    LAS bf16_t* ST = KA;
    LAS float* Of = (LAS float*)lds;
    const int tid = otid(), lane = tid & 63, wid = __builtin_amdgcn_readfirstlane(tid >> 6);
    const int tokb = gc * 64;
    const bf16_t* proj = (const bf16_t*)(p.ws + WS_PROJ);
    const bf16_t* pr = proj + (size_t)tokb * NPROJ;
    const float* lbs = (const float*)(p.ws + WS_LBS);
    const bf16_t* sbuf = (const bf16_t*)(p.ws + WS_ST + (MIX ? ST_GLA_BYTES : 0));
    constexpr int NPQ = 64 * (DK / 8), NRQ = NPQ / 512;
    u32x4 rq[NRQ], rk[NRQ];
    auto load_raw = [&](int dr) {
        const int kcol0 = MIX ? (dr ? PJ_HFB : PJ_HFF) + hd * 128 : PJ_GK + hd * 64;
        const int qcol0 = MIX ? PJ_HQ + hd * 128 : PJ_GQ + hd * 64;
#pragma unroll
        for (int k = 0; k < NRQ; ++k) { const int e = tid + 512 * k; const int t = e / (DK / 8), c8 = (e % (DK / 8)) * 8;
            rq[k] = *(const u32x4*)(pr + (size_t)t * NPROJ + qcol0 + c8); rk[k] = *(const u32x4*)(pr + (size_t)t * NPROJ + kcol0 + c8); }
    };
    load_raw(0);
    const int kdp = tid & (DK - 1);
    float gnv[16];
    {
        const float* gn = (MIX ? p.hg_norm_g : p.gla_norm_g) + (size_t)l * 512 + hd * 128 + (tid & 7) * 16;
#pragma unroll
        for (int j = 0; j < 16; j += 4) { const f32x4 t4 = *(const f32x4*)(gn + j); gnv[j] = t4.x; gnv[j + 1] = t4.y; gnv[j + 2] = t4.z; gnv[j + 3] = t4.w; }
    }
    const float lbd0 = MIX ? lbs[(size_t)(0 * 4 + l) * 512 + hd * 128 + kdp] : 0.f, lbd1 = MIX ? lbs[(size_t)(1 * 4 + l) * 512 + hd * 128 + kdp] : 0.f;
    typedef float f32x2p_t __attribute__((ext_vector_type(2)));
    const f32x2p_t zz2 = {0.f, 0.f};
    const f32x2p_t lbp0 = MIX ? *(const f32x2p_t*)(lbs + (size_t)(0 * 4 + l) * 512 + hd * 128 + 2 * (tid & 63)) : zz2, lbp1 = MIX ? *(const f32x2p_t*)(lbs + (size_t)(1 * 4 + l) * 512 + hd * 128 + 2 * (tid & 63)) : zz2;
    if (!MIX) {
        const int gd = wid >> 2, mt = (wid >> 1) & 1, nt = wid & 1, r = lane & 31, h = lane >> 5;
        const bf16x8 afr = *(const bf16x8*)(pr + (size_t)(mt * 32 + r) * NPROJ + (gd ? PJ_GZB : PJ_GZF) + 8 * h);
        const float* lw = p.gla_lr_w + (((size_t)l * 2 + gd) * 16 + 8 * h) * 256 + hd * 64 + nt * 32 + r;
        float wv[8];
#pragma unroll
        for (int j = 0; j < 8; ++j) wv[j] = lw[(size_t)j * 256];
        const float bias = p.gla_lr_b[((size_t)l * 2 + gd) * 256 + hd * 64 + nt * 32 + r];
        u32x4 bw; bw.x = pk2(wv[0], wv[1]); bw.y = pk2(wv[2], wv[3]); bw.z = pk2(wv[4], wv[5]); bw.w = pk2(wv[6], wv[7]);
        f32x16 zacc;
#pragma unroll
        for (int i = 0; i < 16; ++i) zacc[i] = 0.f;
        zacc = __builtin_amdgcn_mfma_f32_32x32x16_bf16(afr, __builtin_bit_cast(bf16x8, bw), zacc, 0, 0, 0);
#pragma unroll
        for (int i = 0; i < 16; ++i) {
            const int t = mt * 32 + (i & 3) + 8 * (i >> 2) + 4 * h;
            C[(gd * 64 + (gd ? 63 - t : t)) * LDG + nt * 32 + r] = logsigmoidf_(zacc[i] + bias) * (1.0f / 16.0f);
        }
    }
    const bf16_t* gatep = pr + (size_t)(tid >> 3) * NPROJ + (MIX ? PJ_HO : PJ_GO) + hd * 128 + (tid & 7) * 16;
    const u32x4 g0 = *(const u32x4*)gatep, g1 = *(const u32x4*)(gatep + 8);
    {
        const int vv = tid & 127, qt = tid >> 7;
        const int vcol = (MIX ? PJ_HI : PJ_GV) + hd * 128 + vv;
        unsigned pkv[8];
#pragma unroll
        for (int t = 0; t < 16; t += 2) {
            const unsigned a = pr[(size_t)(qt * 16 + t) * NPROJ + vcol], b = pr[(size_t)(qt * 16 + t + 1) * NPROJ + vcol];
            pkv[t >> 1] = a | (b << 16);
        }
#pragma unroll
        for (int q = 0; q < 2; ++q) { u32x4 w; w.x = pkv[4 * q]; w.y = pkv[4 * q + 1]; w.z = pkv[4 * q + 2]; w.w = pkv[4 * q + 3]; *(LAS u32x4*)(VT + vv * LDV + qt * 16 + q * 8) = w; }
    }
    const int wm = wid >> 2, wn = wid & 3;
    f32x16 o[1][1];
#pragma unroll
    for (int i = 0; i < 16; ++i) o[0][0][i] = 0.f;

#pragma unroll 1
    for (int dir = 0; dir < 2; ++dir) {
        const int kd = tid & (DK - 1), ba = tid / DK;
#pragma unroll
        for (int k = 0; k < NRQ; ++k) { const int e = tid + 512 * k; const int t = e / (DK / 8), c8 = (e % (DK / 8)) * 8;
            *(LAS u32x4*)(QS + t * LQ + c8) = rq[k]; *(LAS u32x4*)(KA + (64 + (dir ? 63 - t : t)) * LQ + c8) = rk[k]; }
        __syncthreads();
        if (MIX) {
            const int cp = tid & 63, bh = tid >> 6, bah = bh >> 1, u0 = (bh & 1) * 8;
            const float lbA = dir ? lbp1.x : lbp0.x, lbB = dir ? lbp1.y : lbp0.y;
            float gA[8], gB[8], kA[8], kB[8]; float thA = 0.f, thB = 0.f;
            {
                const LAS bf16_t* kzr = KA + (64 + bah * 16 + u0) * LQ + 2 * cp;
#pragma unroll
                for (int u = 0; u < 8; ++u) {
                    const unsigned raw = *(const LAS unsigned*)(kzr + u * LQ);
                    const float sa = sigmoidf_(bflo(raw)), sb = sigmoidf_(bfhi(raw));
                    gA[u] = flog_(lbA + (1.0f - lbA) * sa); kA[u] = (1.0f - lbA) * (1.0f - sa); thA += gA[u];
                    gB[u] = flog_(lbB + (1.0f - lbB) * sb); kB[u] = (1.0f - lbB) * (1.0f - sb); thB += gB[u];
                }
                typedef float f32x2_t __attribute__((ext_vector_type(2)));
                f32x2_t th; th.x = thA; th.y = thB;
                *(LAS f32x2_t*)(BS + bh * DK + 2 * cp) = th;
            }
            __syncthreads();
            {
                typedef float f32x2_t __attribute__((ext_vector_type(2)));
                f32x2_t hh[8];
#pragma unroll
                for (int j = 0; j < 8; ++j) hh[j] = *(const LAS f32x2_t*)(BS + j * DK + 2 * cp);
                const f32x2_t T0 = hh[0] + hh[1], T1 = hh[2] + hh[3], T2 = hh[4] + hh[5], T3 = hh[6] + hh[7];
                const f32x2_t Tb = bah == 0 ? T0 : bah == 1 ? T1 : bah == 2 ? T2 : T3;
                const f32x2_t l7 = bah == 0 ? hh[0] : bah == 1 ? hh[2] : bah == 2 ? hh[4] : hh[6];
                const f32x2_t zero2 = {0.f, 0.f};
                const f32x2_t base = bah == 0 ? zero2 : bah == 1 ? T0 : bah == 2 ? T0 + T1 : T0 + T1 + T2;
                const f32x2_t c31 = T0 + T1;
                float lpA = u0 ? l7.x : 0.f, lpB = u0 ? l7.y : 0.f;
                const float qscale = 0.08838834764831845f;
                LAS bf16_t* qz = QA + (64 + bah * 16 + u0) * LQ + 2 * cp;
                LAS bf16_t* kz = KA + (64 + bah * 16 + u0) * LQ + 2 * cp;
                LAS bf16_t* xrow = (bah < 2 ? KA + (bah * 16 + u0) * LQ : QA + (bah * 16 + u0 - 32) * LQ) + 2 * cp;
                LAS bf16_t* yrow = ((bah & 1) ? QA + (32 + (bah >> 1) * 16 + u0) * LQ : KA + (32 + (bah >> 1) * 16 + u0) * LQ) + 2 * cp;
                const bool xk = bah < 2, yq = (bah & 1) != 0;
#pragma unroll
                for (int u = 0; u < 8; ++u) {
                    const int pp = bah * 16 + u0 + u, t = dir ? 63 - pp : pp;
                    lpA += gA[u]; lpB += gB[u];
                    const float cA = base.x + lpA, cB = base.y + lpB;
                    const unsigned qraw = *(const LAS unsigned*)(QS + t * LQ + 2 * cp);
                    const float qa = bflo(qraw) * qscale, qb = bfhi(qraw) * qscale;
                    *(LAS unsigned*)(QS + t * LQ + 2 * cp) = pk2(qa * fexp_(cA), qb * fexp_(cB));
                    *(LAS unsigned*)(qz + u * LQ) = pk2(qa * fexp_(lpA - l7.x), qb * fexp_(lpB - l7.y));
                    *(LAS unsigned*)(kz + u * LQ) = pk2(kA[u] * fexp_(l7.x - lpA), kB[u] * fexp_(l7.y - lpB));
                    *(LAS unsigned*)(xrow + u * LQ) = pk2((xk ? kA[u] : qa) * fexp_(xk ? c31.x - cA : cA - c31.x), (xk ? kB[u] : qb) * fexp_(xk ? c31.y - cB : cB - c31.y));
                    *(LAS unsigned*)(yrow + u * LQ) = pk2((yq ? qa : kA[u]) * fexp_(yq ? lpA : Tb.x - lpA), (yq ? qb : kB[u]) * fexp_(yq ? lpB : Tb.y - lpB));
                }
            }
            __syncthreads();
        } else {
        float gk[16], kk[16]; float lp7 = 0.f, Ta = 0.f;
        if (MIX) {
            const float lb = dir ? lbd1 : lbd0;
            const LAS bf16_t* kz0 = KA + (64 + ba * 16) * LQ + kd;
#pragma unroll
            for (int u = 0; u < 16; ++u) {
                const float sg = sigmoidf_(bf2f(kz0[u * LQ]));
                gk[u] = flog_(lb + (1.0f - lb) * sg); kk[u] = (1.0f - lb) * (1.0f - sg);
                Ta += gk[u]; if (u == 7) lp7 = Ta;
            }
            BS[ba * DK + kd] = Ta;
        } else {
            if (ba < 4) {
#pragma unroll
                for (int u = 0; u < 16; ++u) { gk[u] = C[(dir * 64 + ba * 16 + u) * LDG + kd]; Ta += gk[u]; if (u == 7) lp7 = Ta; }
                BS[ba * DK + kd] = Ta;
            }
        }
        __syncthreads();
        if (ba < 4) {
            const float T0 = BS[kd], T1 = BS[DK + kd], T2 = BS[2 * DK + kd];
            const float base = ba == 0 ? 0.f : ba == 1 ? T0 : ba == 2 ? T0 + T1 : T0 + T1 + T2;
            const float c31 = T0 + T1;
            const float qscale = MIX ? 0.08838834764831845f : 0.125f;
            LAS bf16_t* qz = QA + (64 + ba * 16) * LQ + kd;
            LAS bf16_t* kz = KA + (64 + ba * 16) * LQ + kd;
            LAS bf16_t* xrow = (ba < 2 ? KA + (ba * 16) * LQ : QA + (ba * 16 - 32) * LQ) + kd;
            LAS bf16_t* yrow = ((ba & 1) ? QA + (32 + (ba >> 1) * 16) * LQ : KA + (32 + (ba >> 1) * 16) * LQ) + kd;
            float lp = 0.f;
#pragma unroll
            for (int u = 0; u < 16; ++u) {
                const int pp = ba * 16 + u, t = dir ? 63 - pp : pp;
                lp += gk[u];
                const float c = base + lp;
                const float qv = bf2f(QS[t * LQ + kd]) * qscale;
                const float kt = MIX ? kk[u] : bf2f(kz[u * LQ]);
                QS[t * LQ + kd] = f2bf(qv * fexp_(c));
                qz[u * LQ] = f2bf(qv * fexp_(lp - lp7));
                kz[u * LQ] = f2bf(kt * fexp_(lp7 - lp));
                xrow[u * LQ] = f2bf(ba < 2 ? kt * fexp_(c31 - c) : qv * fexp_(c - c31));
                yrow[u * LQ] = f2bf((ba & 1) ? qv * fexp_(lp) : kt * fexp_(Ta - lp));
            }
        }
        __syncthreads();
        }
        if (dir == 0) load_raw(1);
        constexpr int PIECES = 128 * DK / 8, NPC = PIECES / 512;
        u32x4 stv[NPC];
        {
            const bf16_t* sb = sbuf + (((size_t)gc * 2 + dir) * 4 + hd) * 128 * DK;
#pragma unroll
            for (int k = 0; k < NPC; ++k) { const int e = tid + 512 * k; const int v = e / (DK / 8), d0 = (e % (DK / 8)) * 8; stv[k] = *(const u32x4*)(sb + (size_t)v * DK + d0); }
        }
        if (wid < 4) {
            f32x16 sc[1][1];
#pragma unroll
            for (int i = 0; i < 16; ++i) sc[0][0][i] = 0.f;
            mma_lds<1, 1, DK / 16>(sc, KA + wid * 32 * LQ, LQ, QA + wid * 32 * LQ, LQ, lane);
            const int cc = lane & 31;
#pragma unroll
            for (int q = 0; q < 4; ++q) {
                const int r0 = 8 * q + 4 * (lane >> 5);
                int pi, pj0; bool wr = true, zero = false, tri = false;
                if (wid == 0) { pi = 32 + cc; pj0 = r0; }
                else if (wid == 1) { pi = cc < 16 ? 16 + cc : 32 + cc; pj0 = r0 < 16 ? r0 : r0 + 16; wr = (r0 < 16) == (cc < 16); }
                else { const int off = (wid - 2) * 32; pi = off + cc; pj0 = off + r0; const bool same = (r0 >> 4) == (cc >> 4); tri = same; zero = !same && r0 >= 16; wr = same || zero; }
                float v[4];
#pragma unroll
                for (int e = 0; e < 4; ++e) { float x = sc[0][0][4 * q + e]; if (tri && (r0 + e > cc)) x = 0.f; if (zero) x = 0.f; v[e] = x; }
                if (wr) {
                    u32x2 w;
                    if (dir == 0) { w.x = pk2(v[0], v[1]); w.y = pk2(v[2], v[3]); *(LAS u32x2*)(P + pi * LDV + pj0) = w; }
                    else { w.x = pk2(v[3], v[2]); w.y = pk2(v[1], v[0]); *(LAS u32x2*)(P + (63 - pi) * LDV + (60 - pj0)) = w; }
                }
            }
        } else if (wid == 4) {
#pragma unroll
            for (int k = 0; k < 2; ++k) {
                const int idx = lane * 2 + k, row = idx >> 2, piece = idx & 3;
                const int ti = dir ? 32 + row : row, tj = (dir ? 0 : 32) + piece * 8;
                u32x4 z; z.x = 0; z.y = 0; z.z = 0; z.w = 0;
                *(LAS u32x4*)(P + ti * LDV + tj) = z;
            }
        }
        __syncthreads();
#pragma unroll
        for (int k = 0; k < NPC; ++k) { const int e = tid + 512 * k; const int v = e / (DK / 8), d0 = (e % (DK / 8)) * 8; *(LAS u32x4*)(ST + v * LQ + d0) = stv[k]; }
        mma_lds<1, 1, 4>(o, P + wm * 32 * LDV, LDV, VT + wn * 32 * LDV, LDV, lane);
        __syncthreads();
        mma_lds<1, 1, DK / 16>(o, QS + wm * 32 * LQ, LQ, ST + wn * 32 * LQ, LQ, lane);
        __syncthreads();
    }
#pragma unroll
    for (int i = 0; i < 16; ++i) Of[(wm * 32 + (i & 3) + 8 * (i >> 2) + 4 * (lane >> 5)) * 132 + wn * 32 + (lane & 31)] = o[0][0][i];
    __syncthreads();
    {
        const int i_ = tid >> 3, seg = tid & 7;
        const LAS float* orow = Of + i_ * 132 + seg * 16;
        float v[16]; float ss = 0.f;
#pragma unroll
        for (int j = 0; j < 16; ++j) { v[j] = orow[j]; ss += v[j] * v[j]; }
        ss += __shfl_xor(ss, 1); ss += __shfl_xor(ss, 2); ss += __shfl_xor(ss, 4);
        const float r = rsqrtf(ss * (1.0f / 128.0f) + EPS);
        const unsigned gu[8] = {g0.x, g0.y, g0.z, g0.w, g1.x, g1.y, g1.z, g1.w};
        unsigned ow[8];
#pragma unroll
        for (int j = 0; j < 8; ++j) {
            const float a = v[2 * j] * r * gnv[2 * j] * siluf_(bflo(gu[j])), b = v[2 * j + 1] * r * gnv[2 * j + 1] * siluf_(bfhi(gu[j]));
            ow[j] = pk2(a, b);
        }
        bf16_t* dst = (bf16_t*)(p.ws + WS_OCAT) + (size_t)(MIX ? 1 : 0) * NTOK * 512 + (size_t)(tokb + i_) * 512 + hd * 128 + seg * 16;
        u32x4 w0, w1; w0.x = ow[0]; w0.y = ow[1]; w0.z = ow[2]; w0.w = ow[3]; w1.x = ow[4]; w1.y = ow[5]; w1.z = ow[6]; w1.w = ow[7];
        *(u32x4*)dst = w0; *(u32x4*)(dst + 8) = w1;
    }
    __syncthreads();
}


__device__ __forceinline__ void phase_out(const Params& p, int l, LAS unsigned char* lds) {
    constexpr int NIT = NCHUNK * 4 * 2;
    for (int it = blockIdx.x; it < NIT; it += gridDim.x) {
        const int mix = (it >> 8) & 1, rem = (it & 255) | ((it >> 9) << 8), hd = rem & 3, gc = rem >> 2;
        if (mix) out_item<1>(p, l, gc, hd, lds); else out_item<0>(p, l, gc, hd, lds);
    }
}

__device__ __forceinline__ void phase_merge(const Params& p, int l, LAS unsigned char* lds) {
    const bf16_t* ocat = (const bf16_t*)(p.ws + WS_OCAT);
    const bf16_t* G3 = (const bf16_t*)(p.ws + WS_PROJ);
    const bf16_t* WbrT = (const bf16_t*)(p.ws + WS_W + (size_t)(l & 1) * W_END + W_BR);
    bf16_t* merged = (bf16_t*)(p.ws + WS_ST);
    const int lane = otid() & 63, wid = otid() >> 6, wm = wid >> 2, wn = wid & 3;
    constexpr int nM = NTOK / 128, nN = 8;
    for (int t = blockIdx.x; t < nM * nN; t += gridDim.x) {
        int tm, tn; tile_coords(t, nN, tm, tn);
        const int row0 = tm * 128, col0 = tn * 128;
        f32x16 tot[2][1]; acc_zero<1>(tot);
#pragma unroll 1
        for (int b = 0; b < 3; ++b) {
            f32x16 ba[2][1]; acc_zero<1>(ba);
            gemm_kloop<128>(lds, ocat + (size_t)row0 * 1536 + b * 512, 1536, WbrT + ((size_t)b * D + col0) * 512, 512, 128, 512, ba);
#pragma unroll
            for (int m = 0; m < 2; ++m)
#pragma unroll
                for (int i = 0; i < 16; ++i) {
                    const int row = row0 + wm * 64 + m * 32 + (i & 3) + 8 * (i >> 2) + 4 * (lane >> 5), col = col0 + wn * 32 + (lane & 31);
                    tot[m][0][i] += bf2f(G3[(size_t)row * NGATE + b * 1024 + col]) * ba[m][0][i];
                }
        }
#pragma unroll
        for (int m = 0; m < 2; ++m)
#pragma unroll
            for (int i = 0; i < 16; ++i) {
                const int row = row0 + wm * 64 + m * 32 + (i & 3) + 8 * (i >> 2) + 4 * (lane >> 5), col = col0 + wn * 32 + (lane & 31);
                merged[(size_t)row * D + col] = f2bf(tot[m][0][i]);
            }
    }
}

__device__ __forceinline__ void run_phase(const Params& p, int ph, LAS unsigned char* lds) {
    if (ph == 0) { phase0(p, lds); return; }
    if (ph == NPHASE - 1) { norm_phase(p, p.final_norm_g, nullptr, 0, 0, nullptr, 1); return; }
    const int l = (ph - 1) / 10, sp = (ph - 1) % 10;
    const float* mod_l = (const float*)(p.ws + WS_MOD) + (size_t)l * 9 * 6144;
    bf16_t* hbuf = (bf16_t*)(p.ws + WS_H);
    bf16_t* proj = (bf16_t*)(p.ws + WS_PROJ);
    const unsigned char* wl = p.ws + WS_W + (size_t)(l & 1) * W_END;
    switch (sp) {
        case 0: if (l == 0) convert_weights(p, l, lds); norm_phase(p, p.norm_mix_g + (size_t)l * D, mod_l, 0, 1024, hbuf, 0); break;
        case 1: { PEpiBf16 e{proj, NPROJ, NPROJ, 0}; pg8_gemm(lds, hbuf, (const bf16_t*)(wl + W_IN), NTOK, 5376, D, e);
            if (l + 1 < DEPTH && blockIdx.x >= 144) { for (int k = 0; k < 2; ++k) convert_weights(p, l + 1, lds, ((int)blockIdx.x - 144) * 2 + k); } } break;
        case 2: phase_scan(p, l, lds); break;
        case 3: phase_out(p, l, lds); break;
        case 4: {
            PEpiBf16 e{proj, NGATE, NGATE, 2}; pg8_gemm(lds, hbuf, (const bf16_t*)(wl + W_G), NTOK, NGATE, D, e);
            PEpiGate e2{proj, NGATE}; pg8_gemm(lds, (const bf16_t*)(p.ws + WS_OCAT), (const bf16_t*)(wl + W_BR), NTOK, NGATE, 512, e2, (size_t)NTOK * 512 * 2);
            if (l + 1 < DEPTH && blockIdx.x >= 192) { for (int k = 0; k < 4; ++k) convert_weights(p, l + 1, lds, CONV_IN_P2 + ((int)blockIdx.x - 192) * 4 + k); } } break;
        case 5: sum3_phase(p); break;
        case 6: {
            PEpiResid e{p.out, mod_l + 2048}; pg8_gemm(lds, (const bf16_t*)(p.ws + WS_ST), (const bf16_t*)(wl + W_OUT), 16384, D, D, e);
            EpiResidOff e2{p.out, mod_l + 2048, 16384}; gemm_phase<128>(lds, (const bf16_t*)(p.ws + WS_ST) + (size_t)16384 * D, D, (const bf16_t*)(wl + W_OUT), D, NTOK - 16384, D, D, e2); } break;
        case 7: norm_phase(p, p.norm_ffn_g + (size_t)l * D, mod_l, 3072, 4096, hbuf, 0); break;
        case 8: { PEpiBf16 e{proj, DFF, DFF, 1}; pg8_gemm(lds, hbuf, (const bf16_t*)(wl + W_FF1), NTOK, DFF, D, e); } break;
        case 9: { PEpiResid e{p.out, mod_l + 5120}; pg8_gemm(lds, proj, (const bf16_t*)(wl + W_FF2), 16384, D, DFF, e);
            EpiResidOff e2{p.out, mod_l + 5120, 16384}; gemm_phase<128>(lds, proj + (size_t)16384 * DFF, DFF, (const bf16_t*)(wl + W_FF2), DFF, NTOK - 16384, D, DFF, e2); } break;
    }
}

__global__ void __launch_bounds__(512) fwd_megakernel(Params p) {
    extern __shared__ __attribute__((aligned(16))) unsigned char smem[];
    LAS unsigned char* lds = (LAS unsigned char*)smem;
    cg::grid_group grid = cg::this_grid();
    unsigned nbar = 0;
    for (int ph = p.ph_lo; ph < p.ph_hi; ++ph) {
        run_phase(p, ph, lds);
        if (ph + 1 < p.ph_hi) {
            if (ph == 0) grid.sync();
            else { ++nbar; grid_barrier((unsigned*)(p.ws + WS_CTR) + 64, nbar); }
        }
    }
}

extern "C" void kernel_launch(void* const* d_in, const int* in_sizes, int n_in, void* d_out, int out_size, void* d_ws, size_t ws_size, hipStream_t stream) {
    static int grid_blocks = 0;
    if (!grid_blocks) {
        int dev = 0, cus = 0, per_cu = 0;
        hipGetDevice(&dev);
        hipDeviceGetAttribute(&cus, hipDeviceAttributeMultiprocessorCount, dev);
        if (hipFuncSetAttribute((const void*)fwd_megakernel, hipFuncAttributeMaxDynamicSharedMemorySize, LDS_BYTES) != hipSuccess) fprintf(stderr, "hipFuncSetAttribute failed\n");
        hipOccupancyMaxActiveBlocksPerMultiprocessor(&per_cu, (const void*)fwd_megakernel, 512, LDS_BYTES);
        if (per_cu < 1) { fprintf(stderr, "occupancy query says %d blocks/CU\n", per_cu); per_cu = 1; }
        grid_blocks = cus * 1;
        (void)hipGetLastError();
        if (n_in != 26 || ws_size < WS_END) fprintf(stderr, "kernel_launch: unexpected n_in %d or ws_size %zu (need %zu)\n", n_in, ws_size, (size_t)WS_END);
    }
    Params p{};
    const float** pp = (const float**)&p;
    for (int i = 0; i < 26; ++i) pp[i] = (const float*)d_in[i];
    p.out = (float*)d_out; p.ws = (unsigned char*)d_ws; p.ph_lo = 0; p.ph_hi = NPHASE;
    void* args[] = {&p};
    hipError_t e = hipLaunchCooperativeKernel((const void*)fwd_megakernel, dim3(grid_blocks), dim3(512), args, LDS_BYTES, stream);
    if (e != hipSuccess) fprintf(stderr, "cooperative launch failed: %s (grid %d)\n", hipGetErrorString(e), grid_blocks);
}
```

```cpp
#include <hip/hip_runtime.h>
#include <hip/hip_cooperative_groups.h>
#include <cstdio>
namespace cg = cooperative_groups;

#define LAS __attribute__((address_space(3)))
typedef unsigned short bf16_t;
typedef short bf16x8 __attribute__((ext_vector_type(8)));
typedef float f32x16 __attribute__((ext_vector_type(16)));
typedef float f32x4 __attribute__((ext_vector_type(4)));
typedef unsigned u32x4 __attribute__((ext_vector_type(4)));
typedef unsigned u32x2 __attribute__((ext_vector_type(2)));

constexpr int D = 1024, DEPTH = 4, NTOK = 20480, NCTX = 4096, DFF = 4096;
constexpr int DIN = 8224, NPROJ = 5152, NGATE = 3072;
constexpr int PJ_GQ = 0, PJ_GK = 256, PJ_GV = 512, PJ_GO = 1024, PJ_GZF = 1536, PJ_GZB = 1552, PJ_HQ = 1568, PJ_HFF = 2080,
              PJ_HFB = 2592, PJ_HI = 3104, PJ_HO = 3616, PJ_MU = 4128, PJ_MV = 4640;
constexpr int NCHUNK = NTOK / 64;
constexpr float EPS = 1e-6f;
constexpr int LDS_BYTES = 160 * 1024;
constexpr int NPHASE = 2 + DEPTH * 10;

constexpr size_t WS_PROJ = 0;
constexpr size_t WS_ST   = WS_PROJ + (size_t)NTOK * NPROJ * 2;
constexpr size_t ST_GLA_BYTES = (size_t)NCHUNK * 2 * 4 * 128 * 64 * 2, ST_HG_BYTES = (size_t)NCHUNK * 2 * 4 * 128 * 128 * 2;
constexpr size_t WS_OCAT = WS_ST + ST_GLA_BYTES + ST_HG_BYTES;
constexpr size_t WS_H    = WS_OCAT + (size_t)NTOK * 1536 * 2;
constexpr size_t WS_W    = WS_H + (size_t)NTOK * D * 2;
constexpr size_t W_IN = 0, W_G = W_IN + (size_t)NPROJ * D * 2, W_BR = W_G + (size_t)NGATE * D * 2, W_OUT = W_BR + (size_t)3 * D * 512 * 2,
                 W_FF1 = W_OUT + (size_t)D * D * 2, W_FF2 = W_FF1 + (size_t)DFF * D * 2, W_END = W_FF2 + (size_t)D * DFF * 2;
constexpr size_t WS_MOD  = WS_W + 2 * W_END;
constexpr size_t WS_LBS  = WS_MOD + (size_t)DEPTH * 9 * 6144 * 4;
constexpr size_t WS_CTR  = WS_LBS + 2 * 4 * 512 * 4;
constexpr size_t WS_END  = WS_CTR + 4096;

struct Params {
    const float *x_prompt, *x_sample, *c, *state_gla, *state_hgrn, *c_ctx, *ada_w, *ada_b, *norm_mix_g, *norm_ffn_g, *w_in, *gla_lr_w,
        *gla_lr_b, *gla_norm_g, *hg_lb_logits, *hg_norm_g, *gm_norm_g, *gm_ws, *gm_bs, *w_br_gla, *w_br_hg, *w_br_gm, *w_out, *w_ff1, *w_ff2,
        *final_norm_g;
    float* out; unsigned char* ws; int ph_lo, ph_hi;
};

typedef __bf16 bf16x2_t __attribute__((ext_vector_type(2)));
__device__ __forceinline__ unsigned pk2(float lo, float hi) { bf16x2_t v; v.x = (__bf16)lo; v.y = (__bf16)hi; return __builtin_bit_cast(unsigned, v); }
__device__ __forceinline__ bf16_t f2bf(float f) { return (bf16_t)(pk2(f, 0.f) & 0xffffu); }
__device__ __forceinline__ float bf2f(bf16_t h) { return __uint_as_float(((unsigned)h) << 16); }
__device__ __forceinline__ float bflo(unsigned u) { return __uint_as_float(u << 16); }
__device__ __forceinline__ float bfhi(unsigned u) { return __uint_as_float(u & 0xffff0000u); }
__device__ __forceinline__ float fexp_(float x) { return __builtin_amdgcn_exp2f(x * 1.4426950408889634f); }
__device__ __forceinline__ float flog_(float x) { return __builtin_amdgcn_logf(x) * 0.6931471805599453f; }
__device__ __forceinline__ float sigmoidf_(float x) { return __builtin_amdgcn_rcpf(1.0f + fexp_(-x)); }
__device__ __forceinline__ float siluf_(float x) { return x * sigmoidf_(x); }
__device__ __forceinline__ float geluf_(float x) { const float y = 0.7978845608028654f * (x + 0.044715f * x * x * x); const float t = 1.0f - 2.0f * __builtin_amdgcn_rcpf(1.0f + fexp_(2.0f * y)); return 0.5f * x * (1.0f + t); }
__device__ __forceinline__ float logsigmoidf_(float x) { return fminf(x, 0.f) - flog_(1.0f + fexp_(-fabsf(x))); }
__device__ __forceinline__ float wave_sum(float v) {
#pragma unroll
    for (int o = 1; o < 64; o <<= 1) v += __shfl_xor(v, o);
    return v;
}
__device__ __forceinline__ int mod_row(int tok) { return tok < NCTX ? 0 : 1 + ((tok - NCTX) >> 11); }
__device__ __forceinline__ int otid() { int t = (int)__builtin_amdgcn_workitem_id_x(); asm volatile("" : "+v"(t)); return t; }
#define LDS_WAIT() asm volatile("s_waitcnt lgkmcnt(0)" ::: "memory")

template <int MT, int NTL, int KS>
__device__ __forceinline__ void mma_lds(f32x16 (&acc)[MT][NTL], const LAS bf16_t* As, int lda, const LAS bf16_t* Bs, int ldb, int lane) {
    const int r = lane & 31, h = lane >> 5;
    const LAS bf16_t* ap = As + r * lda + h * 8;
    const LAS bf16_t* bp = Bs + r * ldb + h * 8;
#pragma unroll
    for (int ks = 0; ks < KS; ++ks) {
        bf16x8 a[MT], b[NTL];
#pragma unroll
        for (int m = 0; m < MT; ++m) a[m] = *(const LAS bf16x8*)(ap + m * 32 * lda + ks * 16);
#pragma unroll
        for (int n = 0; n < NTL; ++n) b[n] = *(const LAS bf16x8*)(bp + n * 32 * ldb + ks * 16);
#pragma unroll
        for (int m = 0; m < MT; ++m)
#pragma unroll
            for (int n = 0; n < NTL; ++n) acc[m][n] = __builtin_amdgcn_mfma_f32_32x32x16_bf16(a[m], b[n], acc[m][n], 0, 0, 0);
    }
}

template <int BM>
__device__ __forceinline__ void gemm_kloop(LAS unsigned char* lds, const bf16_t* __restrict__ Ag, int lda, const bf16_t* __restrict__ Bg, int ldb, int brows,
                                           int K, f32x16 (&acc)[2][(128 / (8 / (BM / 64))) / 32]) {
    static_assert(BM == 128, "128-row tiles only");
    constexpr int WN = 4, WTN = 32, NTL = 1, LDT = 136, NP = 4;
    LAS bf16_t* As = (LAS bf16_t*)lds;
    LAS bf16_t* Bs = As + 2 * 128 * LDT;
    const int tid = otid(), lane = tid & 63, wid = tid >> 6, wm = wid / WN, wn = wid % WN;
    const int lrow = tid >> 4, lc = (tid & 15) * 8;
    const bf16_t* ap[NP]; const bf16_t* bp[NP];
#pragma unroll
    for (int p = 0; p < NP; ++p) ap[p] = Ag + (size_t)(lrow + p * 32) * lda + lc;
#pragma unroll
    for (int p = 0; p < NP; ++p) { int br = lrow + p * 32; br = br < brows ? br : brows - 1; bp[p] = Bg + (size_t)br * ldb + lc; }
    u32x4 ra[3][NP], rb[3][NP];
    const int nk = K / 128;
#define KL_ISSUE(S, step) do { _Pragma("unroll") for (int p = 0; p < NP; ++p) ra[S][p] = *(const u32x4*)(ap[p] + (step) * 128); \
                               _Pragma("unroll") for (int p = 0; p < NP; ++p) rb[S][p] = *(const u32x4*)(bp[p] + (step) * 128); } while (0)
#define KL_WRITE(S, stage) do { _Pragma("unroll") for (int p = 0; p < NP; ++p) *(LAS u32x4*)(As + (stage) * 128 * LDT + (lrow + p * 32) * LDT + lc) = ra[S][p]; \
                                _Pragma("unroll") for (int p = 0; p < NP; ++p) *(LAS u32x4*)(Bs + (stage) * 128 * LDT + (lrow + p * 32) * LDT + lc) = rb[S][p]; } while (0)
#define KL_STEP(J, JN) if (kt + J < nk) { const int s_ = kt + J; if (s_ + 3 < nk) KL_ISSUE(J, s_ + 3); \
        mma_lds<2, NTL, 8>(acc, As + (s_ & 1) * 128 * LDT + wm * 64 * LDT, LDT, Bs + (s_ & 1) * 128 * LDT + wn * WTN * LDT, LDT, lane); \
        if (s_ + 1 < nk) KL_WRITE(JN, (s_ + 1) & 1); __syncthreads(); }
    KL_ISSUE(0, 0); if (nk > 1) KL_ISSUE(1, 1); if (nk > 2) KL_ISSUE(2, 2);
    KL_WRITE(0, 0);
    __syncthreads();
    for (int kt = 0; kt < nk; kt += 3) { KL_STEP(0, 1) KL_STEP(1, 2) KL_STEP(2, 0) }
#undef KL_ISSUE
#undef KL_WRITE
#undef KL_STEP
}

template <int NTL>
__device__ __forceinline__ void acc_zero(f32x16 (&acc)[2][NTL]) {
#pragma unroll
    for (int m = 0; m < 2; ++m)
#pragma unroll
        for (int n = 0; n < NTL; ++n)
#pragma unroll
            for (int i = 0; i < 16; ++i) acc[m][n][i] = 0.f;
}

__device__ __forceinline__ void tile_coords(int t, int nN, int& tm, int& tn) { const int q = t >> 3; tn = q % nN; tm = (q / nN) * 8 + (t & 7); }

template <int BM, class Epi>
__device__ __forceinline__ void gemm_phase(LAS unsigned char* lds, const bf16_t* A, int lda, const bf16_t* Bt, int ldb, int M, int N, int K, const Epi& epi) {
    constexpr int WM = BM / 64, WN = 8 / WM, WTN = 128 / WN, NTL = WTN / 32;
    const int nM = M / BM, nN = (N + 127) / 128, ntiles = nM * nN;
    const int lane = otid() & 63, wid = otid() >> 6, wm = wid / WN, wn = wid % WN;
    for (int t = blockIdx.x; t < ntiles; t += gridDim.x) {
        int tm, tn; tile_coords(t, nN, tm, tn);
        const int row0 = tm * BM, col0 = tn * 128;
        f32x16 acc[2][NTL]; acc_zero<NTL>(acc);
        gemm_kloop<BM>(lds, A + (size_t)row0 * lda, lda, Bt + (size_t)col0 * ldb, ldb, min(128, N - col0), K, acc);
#pragma unroll
        for (int m = 0; m < 2; ++m)
#pragma unroll
            for (int n = 0; n < NTL; ++n) {
                const int col = col0 + wn * WTN + n * 32 + (lane & 31);
#pragma unroll
                for (int i = 0; i < 16; ++i) {
                    const int row = row0 + wm * 64 + m * 32 + (i & 3) + 8 * (i >> 2) + 4 * (lane >> 5);
                    epi(row, col, acc[m][n][i]);
                }
            }
    }
}

struct EpiBf16 { bf16_t* C; int ldc, N; __device__ __forceinline__ void operator()(int row, int col, float v) const { if (col < N) C[(size_t)row * ldc + col] = f2bf(v); } };
struct EpiRelu2 { bf16_t* C; int ldc; __device__ __forceinline__ void operator()(int row, int col, float v) const { v = fmaxf(v, 0.f); C[(size_t)row * ldc + col] = f2bf(v * v); } };
struct EpiResidOff { float* x; const float* gate; int roff; __device__ __forceinline__ void operator()(int row, int col, float v) const {
    const int r = row + roff; const float g = gate[mod_row(r) * 6144 + col]; float* p = x + (size_t)r * D + col; *p = *p + g * v; } };
struct EpiResid { float* x; const float* gate;   __device__ __forceinline__ void operator()(int row, int col, float v) const {
    const float g = gate[mod_row(row) * 6144 + col]; float* p = x + (size_t)row * D + col; *p = *p + g * v; } };

namespace pg8 {
#define PG8_LAS __attribute__((address_space(3)))
typedef unsigned short bf16_t;
typedef short bf16x8 __attribute__((ext_vector_type(8)));
typedef float f32x4 __attribute__((ext_vector_type(4)));
typedef unsigned u32x4 __attribute__((ext_vector_type(4)));
constexpr int BM = 256, BK = 64, HALF = 128, HTB = HALF * BK * 2  , STAGE_BYTES = 8 * HTB, NXCD = 8, WGM = 8;

__host__ __device__ __forceinline__ int lds_byte(int r, int c) { const int st = (r >> 4) * 2 + (c >> 5), rr = r & 15, cc = c & 31, ob = rr * 64 + cc * 2; return st * 1024 + (ob ^ (((ob >> 9) & 1) << 5)); }
__host__ __device__ __forceinline__ void stage_rc(int b, int& R, int& C) { const int st = b / 1024, sb = b % 1024, swz = sb ^ (((sb >> 9) & 1) << 5); R = (st >> 1) * 16 + swz / 64; C = (st & 1) * 32 + (swz % 64) / 2; }
__host__ __device__ __forceinline__ int perm32(int rho) { const int n = rho >> 4, i = rho & 15; return 8 * (i >> 2) + 4 * n + (i & 3); }

struct Unit { int pm, pn; };
struct Gemm { const bf16_t* A; const bf16_t* Bt; int M, N, K; size_t agrp; };

struct StaticOrder {
    int nM, nN, nwg, G, c;
    __host__ __device__ void init(int M, int N, int G_, int c_) { nM = M / BM; nN = N / BM; nwg = nM * nN; G = G_; c = c_; }
    __host__ __device__ bool next(int i, Unit& u) const {
        const long L = (long)i * G + c; if (L >= nwg) return false;
        int wgid = (int)L; { const int q = nwg / NXCD, r = nwg % NXCD, xcd = wgid % NXCD, off = wgid / NXCD; wgid = (xcd < r ? xcd * (q + 1) : r * (q + 1) + (xcd - r) * q) + off; }
        const int nig = WGM * nN, gid = wgid / nig, fm = gid * WGM, gsz = (nM - fm) < WGM ? (nM - fm) : WGM;
        u.pm = fm + ((wgid % nig) % gsz); u.pn = (wgid % nig) / gsz; return true;
    }
    __device__ __forceinline__ void a_ready(const Unit&) const {}
    __device__ __forceinline__ void done(const Unit&) const {}
};
__device__ __forceinline__ unsigned cvt_pk_bf16(float lo, float hi) { unsigned r; asm volatile("v_cvt_pk_bf16_f32 %0, %1, %2" : "=v"(r) : "v"(lo), "v"(hi)); return r; }
template <class Epi, class Sched, bool STAMP = false>
__device__ __forceinline__ void gemm_phase(PG8_LAS unsigned char* lds, const Gemm g, const Sched& S, const Epi& E, unsigned long long* stamps) {
    const int tid = otid(), wid = __builtin_amdgcn_readfirstlane(tid >> 6), lane = tid & 63, wr = wid >> 2, wc = wid & 3, fr = lane & 15, fq = lane >> 4;
    const int K = g.K, nt = K / BK;
    int ts_lo = 0, ts_hi = 0, nts = 0; const unsigned long long rt_entry = STAMP ? (unsigned long long)wall_clock64() : 0ull;
#define PG8_STAMP() do { if (STAMP && wid == 0 && nts < 64) { const unsigned long long _c = (unsigned long long)clock64(); \
        ts_lo = (lane == nts) ? (int)(unsigned)_c : ts_lo; ts_hi = (lane == nts) ? (int)(unsigned)(_c >> 32) : ts_hi; ++nts; } } while (0)
    PG8_STAMP();
    unsigned voffA[2], voffB[2];
#pragma unroll
    for (int i = 0; i < 2; ++i) { int R, C; stage_rc(tid * 16 + i * 8192, R, C); const int Rb = Epi::PERM ? ((R & ~31) + perm32(R & 31)) : R;
        voffA[i] = (unsigned)(R * K + C) * 2u; voffB[i] = (unsigned)(Rb * K + C) * 2u; }
    const size_t kstep = (size_t)(BK * 2);
    const size_t hstep = (size_t)HALF * K * 2;
    const size_t tstep = 2 * hstep;
    const unsigned ldsw = (unsigned)wid * 1024u;
    const int aoff = lds_byte(wr * 64 + fr, fq * 8), boff = lds_byte(wc * 32 + fr, fq * 8);
#define PG8_SA(b, h) (((b) * 2 + (h)) * HTB)
#define PG8_SB(b, h) ((4 + (b) * 2 + (h)) * HTB)
#define PG8_STAGE(bufoff, gbase, voff) do { _Pragma("unroll") for (int _i = 0; _i < 2; ++_i) \
        __builtin_amdgcn_global_load_lds((const unsigned*)((const char*)(gbase) + (voff)[_i]), (PG8_LAS unsigned*)(lds + (bufoff) + ldsw + _i * 8192), 16, 0, 0); } while (0)
#define PG8_LDA(dst, b, h) do { _Pragma("unroll") for (int m = 0; m < 4; ++m) _Pragma("unroll") for (int k = 0; k < 2; ++k) dst[m][k] = *(const PG8_LAS bf16x8*)(lds + PG8_SA(b, h) + aoff + m * 2048 + k * 1024); } while (0)
#define PG8_LDB(dst, b, h) do { _Pragma("unroll") for (int n = 0; n < 2; ++n) _Pragma("unroll") for (int k = 0; k < 2; ++k) dst[n][k] = *(const PG8_LAS bf16x8*)(lds + PG8_SB(b, h) + boff + n * 2048 + k * 1024); } while (0)
#define PG8_MMA(ai, bj, At, Bt) do { __builtin_amdgcn_s_setprio(1); _Pragma("unroll") for (int m = 0; m < 4; ++m) _Pragma("unroll") for (int n = 0; n < 2; ++n) _Pragma("unroll") for (int k = 0; k < 2; ++k) \
        acc[ai][bj][m][n] = __builtin_amdgcn_mfma_f32_16x16x32_bf16(Bt[n][k], At[m][k], acc[ai][bj][m][n], 0, 0, 0); __builtin_amdgcn_s_setprio(0); } while (0)
#define PG8_WAIT_V(n) asm volatile("s_waitcnt vmcnt(" #n ")" ::: "memory")
#define PG8_WAIT_L(n) asm volatile("s_waitcnt lgkmcnt(" #n ")" ::: "memory")
#define PG8_BAR __builtin_amdgcn_s_barrier()
#define PG8_SCHED __builtin_amdgcn_sched_barrier(0)
    Unit cur, nxt; int ui = 0;
    if (!S.next(0, cur)) return;
    f32x4 acc[2][2][4][2];
#pragma unroll
    for (int a = 0; a < 2; ++a)
#pragma unroll
        for (int b = 0; b < 2; ++b)
#pragma unroll
            for (int m = 0; m < 4; ++m)
#pragma unroll
                for (int n = 0; n < 2; ++n) acc[a][b][m][n] = (f32x4){0.f, 0.f, 0.f, 0.f};
    bf16x8 At[4][2], B0[2][2], B1[2][2];
    const char* cA = (const char*)g.A + (size_t)cur.pm * tstep + (size_t)(cur.pn >> 2) * g.agrp; const char* cB = (const char*)g.Bt + (size_t)cur.pn * tstep;
    S.a_ready(cur);
    PG8_STAGE(PG8_SB(0, 0), cB, voffB); PG8_STAGE(PG8_SA(0, 0), cA, voffA); PG8_STAGE(PG8_SB(0, 1), cB + hstep, voffB); PG8_STAGE(PG8_SA(0, 1), cA + hstep, voffA);
    if (wr == 1) PG8_BAR;
    PG8_WAIT_V(4); PG8_BAR;
    PG8_STAGE(PG8_SB(1, 0), cB + kstep, voffB); PG8_STAGE(PG8_SA(1, 0), cA + kstep, voffA); PG8_STAGE(PG8_SB(1, 1), cB + hstep + kstep, voffB);
    PG8_WAIT_V(6); PG8_BAR;
    PG8_STAMP();
    for (;;) {
        const bool has_next = S.next(ui + 1, nxt);
        const char* nA = has_next ? (const char*)g.A + (size_t)nxt.pm * tstep + (size_t)(nxt.pn >> 2) * g.agrp : cA; const char* nB = has_next ? (const char*)g.Bt + (size_t)nxt.pn * tstep : cB;
        for (int t = 0; t < nt; t += 2) {
            const bool last = (t == nt - 2);
            const char* a1 = cA + (size_t)(t + 1) * kstep;
            const char* a2 = last ? nA : cA + (size_t)(t + 2) * kstep; const char* b2 = last ? nB : cB + (size_t)(t + 2) * kstep;
            const char* a3 = a2 + kstep; const char* b3 = b2 + kstep;
            if (last && has_next) S.a_ready(nxt);
            PG8_LDB(B0, 0, 0); PG8_SCHED; PG8_LDA(At, 0, 0); PG8_STAGE(PG8_SA(1, 1), a1 + hstep, voffA);
            PG8_WAIT_L(8); PG8_BAR; PG8_WAIT_L(0); PG8_MMA(0, 0, At, B0); PG8_BAR; PG8_SCHED;
            PG8_LDB(B1, 0, 1); PG8_STAGE(PG8_SB(0, 0), b2, voffB);
            PG8_BAR; PG8_WAIT_L(0); PG8_MMA(0, 1, At, B1); PG8_BAR;
            PG8_LDA(At, 0, 1); PG8_STAGE(PG8_SA(0, 0), a2, voffA);
            PG8_BAR; PG8_WAIT_L(0); PG8_MMA(1, 0, At, B0); PG8_BAR; PG8_SCHED;
            PG8_STAGE(PG8_SB(0, 1), b2 + hstep, voffB);
            PG8_WAIT_V(6); PG8_BAR; PG8_MMA(1, 1, At, B1); PG8_BAR;
            PG8_LDB(B0, 1, 0); PG8_SCHED; PG8_LDA(At, 1, 0); PG8_STAGE(PG8_SA(0, 1), a2 + hstep, voffA);
            PG8_WAIT_L(8); PG8_BAR; PG8_WAIT_L(0); PG8_MMA(0, 0, At, B0); PG8_BAR; PG8_SCHED;
            PG8_LDB(B1, 1, 1); PG8_STAGE(PG8_SB(1, 0), b3, voffB);
            PG8_BAR; PG8_WAIT_L(0); PG8_MMA(0, 1, At, B1); PG8_BAR;
            PG8_LDA(At, 1, 1); PG8_STAGE(PG8_SA(1, 0), a3, voffA);
            PG8_BAR; PG8_WAIT_L(0); PG8_MMA(1, 0, At, B0); PG8_BAR; PG8_SCHED;
            PG8_STAGE(PG8_SB(1, 1), b3 + hstep, voffB);
            PG8_WAIT_V(6); PG8_BAR; PG8_MMA(1, 1, At, B1); PG8_BAR;
        }
        PG8_STAMP();
        if constexpr (!Epi::AFTER_DRAIN) { E(acc, cur, wr, wc, fr, fq); S.done(cur); }
        PG8_STAMP();
        if (!has_next) break;
#pragma unroll
        for (int a = 0; a < 2; ++a)
#pragma unroll
            for (int b = 0; b < 2; ++b)
#pragma unroll
                for (int m = 0; m < 4; ++m)
#pragma unroll
                    for (int n = 0; n < 2; ++n) acc[a][b][m][n] = (f32x4){0.f, 0.f, 0.f, 0.f};
        cur = nxt; cA = nA; cB = nB; ++ui;
    }
    PG8_WAIT_V(0);
    if (wr == 0) PG8_BAR;
    PG8_BAR;
    if constexpr (Epi::AFTER_DRAIN) { E.fused(acc, cur, wr, wc, fr, fq, lds, wid, lane); S.done(cur); }
    PG8_STAMP();
    if (STAMP && wid == 0) { stamps[lane] = lane < nts ? (((unsigned long long)(unsigned)ts_hi << 32) | (unsigned)ts_lo) : 0ull;
        if (lane == 62) stamps[62] = rt_entry; if (lane == 63) stamps[63] = (unsigned long long)wall_clock64(); }
#undef PG8_STAMP
#undef PG8_SA
#undef PG8_SB
#undef PG8_STAGE
#undef PG8_LDA
#undef PG8_LDB
#undef PG8_MMA
#undef PG8_WAIT_V
#undef PG8_WAIT_L
#undef PG8_BAR
#undef PG8_SCHED
}
}

struct PEpiBf16 {
    static constexpr bool PERM = true, AFTER_DRAIN = false;
    bf16_t* C; int ldc, N, act;
    __device__ __forceinline__ void operator()(const pg8::f32x4 (&acc)[2][2][4][2], const pg8::Unit& u, int wr, int wc, int fr, int fq) const {
        const int row0 = u.pm * 256 + wr * 64 + fr, col0 = u.pn * 256 + wc * 32 + 8 * fq;
#pragma unroll
        for (int ai = 0; ai < 2; ++ai)
#pragma unroll
            for (int m = 0; m < 4; ++m) {
                bf16_t* rowp = C + (size_t)(row0 + ai * 128 + m * 16) * ldc;
#pragma unroll
                for (int bj = 0; bj < 2; ++bj) {
                    const int col = col0 + bj * 128;
                    pg8::f32x4 v0 = acc[ai][bj][m][0], v1 = acc[ai][bj][m][1];
                    if (act == 1) { v0.x = fmaxf(v0.x, 0.f); v0.y = fmaxf(v0.y, 0.f); v0.z = fmaxf(v0.z, 0.f); v0.w = fmaxf(v0.w, 0.f); v0 = v0 * v0;
                                    v1.x = fmaxf(v1.x, 0.f); v1.y = fmaxf(v1.y, 0.f); v1.z = fmaxf(v1.z, 0.f); v1.w = fmaxf(v1.w, 0.f); v1 = v1 * v1; }
                    if (act == 2) { v0.x = sigmoidf_(v0.x); v0.y = sigmoidf_(v0.y); v0.z = sigmoidf_(v0.z); v0.w = sigmoidf_(v0.w);
                                    v1.x = sigmoidf_(v1.x); v1.y = sigmoidf_(v1.y); v1.z = sigmoidf_(v1.z); v1.w = sigmoidf_(v1.w); }
                    u32x4 w; w.x = pk2(v0.x, v0.y); w.y = pk2(v0.z, v0.w); w.z = pk2(v1.x, v1.y); w.w = pk2(v1.z, v1.w);
                    if (col < N) *(u32x4*)(rowp + col) = w;
                }
            }
    }
};
struct PEpiResid {
    static constexpr bool PERM = true, AFTER_DRAIN = false;
    float* x; const float* gate;
    __device__ __forceinline__ void operator()(const pg8::f32x4 (&acc)[2][2][4][2], const pg8::Unit& u, int wr, int wc, int fr, int fq) const {
        const int row0 = u.pm * 256 + wr * 64 + fr, col0 = u.pn * 256 + wc * 32 + 8 * fq;
#pragma unroll
        for (int ai = 0; ai < 2; ++ai)
#pragma unroll
            for (int m = 0; m < 4; ++m) {
                const int row = row0 + ai * 128 + m * 16;
                float* rowp = x + (size_t)row * D; const float* gp = gate + (size_t)mod_row(row) * 6144;
#pragma unroll
                for (int bj = 0; bj < 2; ++bj) {
                    const int col = col0 + bj * 128;
                    const f32x4 g0 = *(const f32x4*)(gp + col), g1 = *(const f32x4*)(gp + col + 4);
                    f32x4 x0 = *(const f32x4*)(rowp + col), x1 = *(const f32x4*)(rowp + col + 4);
                    x0 = x0 + g0 * acc[ai][bj][m][0]; x1 = x1 + g1 * acc[ai][bj][m][1];
                    *(f32x4*)(rowp + col) = x0; *(f32x4*)(rowp + col + 4) = x1;
                }
            }
    }
};
struct PEpiGate {
    static constexpr bool PERM = true, AFTER_DRAIN = false;
    bf16_t* G; int ldc;
    __device__ __forceinline__ void operator()(const pg8::f32x4 (&acc)[2][2][4][2], const pg8::Unit& u, int wr, int wc, int fr, int fq) const {
        const int row0 = u.pm * 256 + wr * 64 + fr, col0 = u.pn * 256 + wc * 32 + 8 * fq;
#pragma unroll
        for (int ai = 0; ai < 2; ++ai)
#pragma unroll
            for (int m = 0; m < 4; ++m) {
                bf16_t* rowp = G + (size_t)(row0 + ai * 128 + m * 16) * ldc;
#pragma unroll
                for (int bj = 0; bj < 2; ++bj) {
                    const int col = col0 + bj * 128;
                    const u32x4 g = *(const u32x4*)(rowp + col);
                    const pg8::f32x4 v0 = acc[ai][bj][m][0], v1 = acc[ai][bj][m][1];
                    u32x4 w; w.x = pk2(bflo(g.x) * v0.x, bfhi(g.x) * v0.y); w.y = pk2(bflo(g.y) * v0.z, bfhi(g.y) * v0.w);
                    w.z = pk2(bflo(g.z) * v1.x, bfhi(g.z) * v1.y); w.w = pk2(bflo(g.w) * v1.z, bfhi(g.w) * v1.w);
                    *(u32x4*)(rowp + col) = w;
                }
            }
    }
};
__device__ __forceinline__ void sum3_phase(const Params& p) {
    const bf16_t* Y = (const bf16_t*)(p.ws + WS_PROJ); bf16_t* merged = (bf16_t*)(p.ws + WS_ST);
    for (size_t i = (size_t)blockIdx.x * 512 + otid(); i < (size_t)NTOK * (D / 8); i += (size_t)gridDim.x * 512) {
        const size_t row = i >> 7; const int c8 = (int)(i & 127) * 8;
        const bf16_t* yr = Y + row * NGATE + c8;
        const u32x4 a = *(const u32x4*)yr, b = *(const u32x4*)(yr + 1024), c = *(const u32x4*)(yr + 2048);
        u32x4 w; w.x = pk2(bflo(a.x) + bflo(b.x) + bflo(c.x), bfhi(a.x) + bfhi(b.x) + bfhi(c.x)); w.y = pk2(bflo(a.y) + bflo(b.y) + bflo(c.y), bfhi(a.y) + bfhi(b.y) + bfhi(c.y));
        w.z = pk2(bflo(a.z) + bflo(b.z) + bflo(c.z), bfhi(a.z) + bfhi(b.z) + bfhi(c.z)); w.w = pk2(bflo(a.w) + bflo(b.w) + bflo(c.w), bfhi(a.w) + bfhi(b.w) + bfhi(c.w));
        *(u32x4*)(merged + row * D + c8) = w;
    }
}
template <class Epi>
__device__ __forceinline__ void pg8_gemm(LAS unsigned char* lds, const bf16_t* A, const bf16_t* Bt, int M, int N, int K, const Epi& e, size_t agrp = 0) {
    pg8::Gemm g{A, Bt, M, N, K, agrp};
    pg8::StaticOrder so; so.init(M, N, (int)gridDim.x, (int)blockIdx.x);
    pg8::gemm_phase<Epi, pg8::StaticOrder, false>(lds, g, so, e, nullptr);
    __syncthreads();
}

__device__ __forceinline__ void grid_barrier(unsigned* bar, unsigned k) {
    asm volatile("s_waitcnt vmcnt(0)" ::: "memory");
    __syncthreads();
    if (otid() == 0) {
        const unsigned g = blockIdx.x & 7u, ng = (gridDim.x + 7u - g) >> 3;
        __builtin_amdgcn_fence(__ATOMIC_RELEASE, "agent");
        asm volatile("s_waitcnt vmcnt(0)" ::: "memory");
        const unsigned c = __hip_atomic_fetch_add(bar + 16 * g, 1u, __ATOMIC_RELAXED, __HIP_MEMORY_SCOPE_AGENT);
        if (c == ng * k - 1u) {
            const unsigned ngroups = gridDim.x < 8u ? gridDim.x : 8u;
            const unsigned t = __hip_atomic_fetch_add(bar + 128, 1u, __ATOMIC_RELAXED, __HIP_MEMORY_SCOPE_AGENT);
            if (t == ngroups * k - 1u)
                for (unsigned j = 0; j < ngroups; ++j) __hip_atomic_store(bar + 144 + 16 * j, k, __ATOMIC_RELAXED, __HIP_MEMORY_SCOPE_AGENT);
        }
        unsigned spins = 0;
        while (__hip_atomic_load(bar + 144 + 16 * g, __ATOMIC_RELAXED, __HIP_MEMORY_SCOPE_AGENT) < k && ++spins < (1u << 28)) __builtin_amdgcn_s_sleep(1);
        __builtin_amdgcn_fence(__ATOMIC_ACQUIRE, "agent");
        asm volatile("s_waitcnt vmcnt(0)" ::: "memory");
    }
    __syncthreads();
}

__device__ __forceinline__ void transpose_item(const float* __restrict__ W, int N, int K, int k0, int n0, bf16_t* __restrict__ dst  , LAS float* scr, int lane) {
    {
        const int kr = lane >> 3, c4 = (lane & 7) * 4;
        f32x4 v[8];
#pragma unroll
        for (int i = 0; i < 8; ++i) v[i] = *(const f32x4*)(W + (size_t)(k0 + i * 8 + kr) * N + n0 + c4);
#pragma unroll
        for (int i = 0; i < 8; ++i) { LAS float* d = scr + (i * 8 + kr) * 33 + c4; d[0] = v[i].x; d[1] = v[i].y; d[2] = v[i].z; d[3] = v[i].w; }
    }
    LDS_WAIT();
    const int c = lane & 7;
#pragma unroll
    for (int j = 0; j < 4; ++j) {
        const int n = (lane >> 3) + 8 * j; const LAS float* s = scr + (8 * c) * 33 + n;
        u32x4 o; o.x = pk2(s[0 * 33], s[1 * 33]); o.y = pk2(s[2 * 33], s[3 * 33]); o.z = pk2(s[4 * 33], s[5 * 33]); o.w = pk2(s[6 * 33], s[7 * 33]);
        *(u32x4*)(dst + (size_t)n * K + k0 + 8 * c) = o;
    }
    LDS_WAIT();
}

constexpr int CONV_NIT = 16 * 257 + 3 * 8 * 32 + 16 * 32 + 16 * 128 + 64 * 32, CONV_BLOCK_ITEMS = (CONV_NIT + 7) / 8;
constexpr int CONV_IN_P2 = 112 * 2, CONV_IN_P4 = 64 * 4, CONV_IN_GEMM = CONV_IN_P2 + CONV_IN_P4;
__device__ __forceinline__ void convert_weights(const Params& p, int l, LAS unsigned char* lds, int bitem = -1) {
    const int lane = otid() & 63, wid = otid() >> 6;
    LAS float* scr = (LAS float*)(lds + wid * 16384);
    unsigned char* wb = p.ws + WS_W + (size_t)(l & 1) * W_END;
    constexpr int I_IN = 16 * 257, I_BR = 8 * 32, I_OUT = 16 * 32, I_FF1 = 16 * 128, I_FF2 = 64 * 32;
    constexpr int NIT = I_IN + 3 * I_BR + I_OUT + I_FF1 + I_FF2;
    for (int it = (bitem < 0 ? blockIdx.x * 8 + wid : bitem * 8 + wid); it < NIT; it += (bitem < 0 ? gridDim.x * 8 : NIT)) {
        int r = it;
        if (r < I_IN) { const int kb = r / 257, nb = r % 257, n0 = nb * 32;
            bf16_t* dst = n0 < NPROJ ? (bf16_t*)(wb + W_IN) + (size_t)n0 * D : (bf16_t*)(wb + W_G) + (size_t)(n0 - NPROJ) * D;
            transpose_item(p.w_in + (size_t)l * D * DIN, DIN, D, kb * 64, n0, dst, scr, lane); continue; }
        r -= I_IN;
        if (r < 3 * I_BR) { const int b = r / I_BR, q = r % I_BR, kb = q / 32, nb = q % 32;
            const float* W = (b == 0 ? p.w_br_gla : b == 1 ? p.w_br_hg : p.w_br_gm) + (size_t)l * 512 * D;
            transpose_item(W, D, 512, kb * 64, nb * 32, (bf16_t*)(wb + W_BR) + (size_t)b * D * 512 + (size_t)nb * 32 * 512, scr, lane); continue; }
        r -= 3 * I_BR;
        if (r < I_OUT) { const int kb = r / 32, nb = r % 32;
            transpose_item(p.w_out + (size_t)l * D * D, D, D, kb * 64, nb * 32, (bf16_t*)(wb + W_OUT) + (size_t)nb * 32 * D, scr, lane); continue; }
        r -= I_OUT;
        if (r < I_FF1) { const int kb = r / 128, nb = r % 128;
            transpose_item(p.w_ff1 + (size_t)l * D * DFF, DFF, D, kb * 64, nb * 32, (bf16_t*)(wb + W_FF1) + (size_t)nb * 32 * D, scr, lane); continue; }
        r -= I_FF1;
        { const int kb = r / 32, nb = r % 32;
            transpose_item(p.w_ff2 + (size_t)l * DFF * D, D, DFF, kb * 64, nb * 32, (bf16_t*)(wb + W_FF2) + (size_t)nb * 32 * DFF, scr, lane); }
    }
}

__device__ __forceinline__ void phase0(const Params& p, LAS unsigned char* lds) {
    const int tid = otid();
    float* x = p.out;
    for (size_t i = (size_t)blockIdx.x * 512 + tid; i < (size_t)NTOK * (D / 4); i += (size_t)gridDim.x * 512) {
        const int tok = (int)(i >> 8), c4 = (int)(i & 255) * 4;
        f32x4 v;
        if (tok < NCTX) v = *(const f32x4*)(p.x_prompt + (size_t)tok * D + c4);
        else {
            const int lt = tok - NCTX; v = *(const f32x4*)(p.x_sample + (size_t)lt * D + c4);
            const int t = lt & 2047; const float rr = (float)(t >> 6), cc = (float)(t & 63);
            const int sec = c4 >> 8; const float pos = sec < 2 ? rr : cc;
#pragma unroll
            for (int j = 0; j < 4; ++j) {
                const int f = (c4 + j) & 255;
                const float omega = exp2f((float)f * (-13.287712379549449f / 256.0f));
                const float a = pos * omega;
                v[j] += (sec & 1) ? __cosf(a) : __sinf(a);
            }
        }
        *(f32x4*)(x + i * 4) = v;
    }
    if (blockIdx.x == 0) {
        float* lbs = (float*)(p.ws + WS_LBS);
        for (int i = tid; i < 1024; i += 512) {
            const int dir = i >> 9, ch = i & 511; float lg[4], mx = -1e30f;
            for (int l = 0; l < 4; ++l) { lg[l] = p.hg_lb_logits[(size_t)(dir * 4 + l) * 512 + ch]; mx = fmaxf(mx, lg[l]); }
            float s = 0.f; for (int l = 0; l < 4; ++l) { lg[l] = expf(lg[l] - mx); s += lg[l]; }
            float cum = 0.f, c0 = 0.f;
            for (int l = 0; l < 4; ++l) { cum += lg[l] / s; if (l == 0) c0 = cum; lbs[(size_t)(dir * 4 + l) * 512 + ch] = cum - c0; }
        }
        for (int i = tid; i < 1024; i += 512) ((unsigned*)(p.ws + WS_CTR))[i] = 0u;
    }
    LAS float* sc = (LAS float*)lds;
    LAS float* red = sc + 9 * 1024;
    for (int i = tid; i < 9 * 1024; i += 512) { const int r = i >> 10, k = i & 1023; const float v = r == 0 ? p.c_ctx[k] : p.c[(size_t)(r - 1) * D + k]; sc[i] = siluf_(v); }
    __syncthreads();
    float* mod = (float*)(p.ws + WS_MOD);
    for (int u = blockIdx.x; u < DEPTH * 48; u += gridDim.x) {
        const int l = u / 48, cb = u % 48, cl = tid & 127, kp = tid >> 7, n = cb * 128 + cl;
        const float* w = p.ada_w + (size_t)l * D * 6144 + n;
        float a[9];
#pragma unroll
        for (int r = 0; r < 9; ++r) a[r] = 0.f;
#pragma unroll 4
        for (int k = kp * 256; k < kp * 256 + 256; ++k) {
            const float wv = w[(size_t)k * 6144];
#pragma unroll
            for (int r = 0; r < 9; ++r) a[r] += sc[r * 1024 + k] * wv;
        }
#pragma unroll
        for (int r = 0; r < 9; ++r) red[(kp * 9 + r) * 128 + cl] = a[r];
        __syncthreads();
        for (int i = tid; i < 9 * 128; i += 512) {
            const int r = i >> 7, c2 = i & 127;
            const float s = red[(0 * 9 + r) * 128 + c2] + red[(1 * 9 + r) * 128 + c2] + red[(2 * 9 + r) * 128 + c2] + red[(3 * 9 + r) * 128 + c2];
            mod[((size_t)l * 9 + r) * 6144 + cb * 128 + c2] = s + p.ada_b[(size_t)l * 6144 + cb * 128 + c2];
        }
        __syncthreads();
    }
}

__device__ __forceinline__ void norm_phase(const Params& p, const float* g, const float* mod_l, int off_sh, int off_sc, bf16_t* hout, int mode) {
    const int lane = otid() & 63, wid = otid() >> 6;
    float* x = p.out;
    for (int row = blockIdx.x * 8 + wid; row < NTOK; row += gridDim.x * 8) {
        f32x4 v[4]; float s = 0.f;
        float* xr = x + (size_t)row * D;
#pragma unroll
        for (int j = 0; j < 4; ++j) { v[j] = *(const f32x4*)(xr + lane * 4 + 256 * j); s += v[j].x * v[j].x + v[j].y * v[j].y + v[j].z * v[j].z + v[j].w * v[j].w; }
        const float rstd = rsqrtf(wave_sum(s) * (1.0f / D) + EPS);
        if (mode == 0) {
            const float* mr = mod_l + (size_t)mod_row(row) * 6144;
#pragma unroll
            for (int j = 0; j < 4; ++j) {
                const int c = lane * 4 + 256 * j;
                const f32x4 gg = *(const f32x4*)(g + c), sh = *(const f32x4*)(mr + off_sh + c), scv = *(const f32x4*)(mr + off_sc + c);
                const f32x4 o = (v[j] * rstd) * gg * (scv + 1.0f) + sh;
                u32x2 w; w.x = pk2(o.x, o.y); w.y = pk2(o.z, o.w);
                *(u32x2*)(hout + (size_t)row * D + c) = w;
            }
        } else {
#pragma unroll
            for (int j = 0; j < 4; ++j) { const int c = lane * 4 + 256 * j; const f32x4 gg = *(const f32x4*)(g + c); *(f32x4*)(xr + c) = (v[j] * rstd) * gg; }
        }
    }
}

template <int MIX>
__device__ __forceinline__ void gate_eval(const bf16_t* row, int kcol, int zcol, const float (&lrw)[16], float lrb, float lb, float& gt, float& kt) {
    if (!MIX) {
        const bf16_t* zr = row + zcol;
        const u32x4 z0 = *(const u32x4*)zr, z1 = *(const u32x4*)(zr + 8);
        float z = lrb;
        z += bflo(z0.x) * lrw[0] + bfhi(z0.x) * lrw[1] + bflo(z0.y) * lrw[2] + bfhi(z0.y) * lrw[3] + bflo(z0.z) * lrw[4] + bfhi(z0.z) * lrw[5] + bflo(z0.w) * lrw[6] + bfhi(z0.w) * lrw[7];
        z += bflo(z1.x) * lrw[8] + bfhi(z1.x) * lrw[9] + bflo(z1.y) * lrw[10] + bfhi(z1.y) * lrw[11] + bflo(z1.z) * lrw[12] + bfhi(z1.z) * lrw[13] + bflo(z1.w) * lrw[14] + bfhi(z1.w) * lrw[15];
        gt = logsigmoidf_(z) * (1.0f / 16.0f);
        kt = bf2f(row[kcol]);
    } else {
        const float xf = bf2f(row[kcol]);
        const float sg = sigmoidf_(xf);
        gt = flog_(lb + (1.0f - lb) * sg);
        kt = (1.0f - lb) * (1.0f - sg);
    }
}

template <int MIX>
__device__ __forceinline__ void gate_raw(unsigned kraw, const u32x4& z0, const u32x4& z1, const float (&lrw)[16], float lrb, float lb, float& gt, float& kt) {
    if (!MIX) {
        float z = lrb;
        z += bflo(z0.x) * lrw[0] + bfhi(z0.x) * lrw[1] + bflo(z0.y) * lrw[2] + bfhi(z0.y) * lrw[3] + bflo(z0.z) * lrw[4] + bfhi(z0.z) * lrw[5] + bflo(z0.w) * lrw[6] + bfhi(z0.w) * lrw[7];
        z += bflo(z1.x) * lrw[8] + bfhi(z1.x) * lrw[9] + bflo(z1.y) * lrw[10] + bfhi(z1.y) * lrw[11] + bflo(z1.z) * lrw[12] + bfhi(z1.z) * lrw[13] + bflo(z1.w) * lrw[14] + bfhi(z1.w) * lrw[15];
        gt = logsigmoidf_(z) * (1.0f / 16.0f);
        kt = bflo(kraw);
    } else {
        const float xf = bflo(kraw);
        const float sg = sigmoidf_(xf);
        gt = flog_(lb + (1.0f - lb) * sg);
        kt = (1.0f - lb) * (1.0f - sg);
    }
}

template <int MIX>
__device__ __forceinline__ void scan_job(const Params& p, int l, int s, int dir, int hd, LAS unsigned char* lds) {
    constexpr int DK = MIX ? 128 : 64, WM = DK / 32, WN = 8 / WM, WTN = 128 / WN, NTL = WTN / 32, LDT = 72, LDG = DK + 1;
    LAS bf16_t* At = (LAS bf16_t*)lds;
    LAS bf16_t* Bt = At + 128 * LDT;
    LAS float* dec = (LAS float*)(lds + 2 * 128 * LDT * 2);
    LAS float* G = dec + 128;
    LAS float* KK = G + 64 * 129;
    const int tid = otid(), lane = tid & 63, wid = tid >> 6, wm = wid / WN, wn = wid % WN;
    const bool ctx = s < 16;
    const int T = ctx ? 256 : 2048, tok0 = ctx ? s * 256 : NCTX + (s - 16) * 2048, nch = T / 64;
    const bf16_t* proj = (const bf16_t*)(p.ws + WS_PROJ);
    const float* lbs = (const float*)(p.ws + WS_LBS);
    bf16_t* sbuf = (bf16_t*)(p.ws + WS_ST + (MIX ? ST_GLA_BYTES : 0));
    f32x16 S[1][NTL];
    {
        const float* st0 = ctx ? nullptr : (MIX ? p.state_hgrn + ((((size_t)(s - 16) * DEPTH + l) * 2 + dir) * 4 + hd) * 128 * 128
                                                : p.state_gla + ((((size_t)(s - 16) * DEPTH + l) * 2 + dir) * 4 + hd) * 64 * 128);
#pragma unroll
        for (int n = 0; n < NTL; ++n)
#pragma unroll
            for (int i = 0; i < 16; ++i) {
                const int d = wm * 32 + (i & 3) + 8 * (i >> 2) + 4 * (lane >> 5), v = wn * WTN + n * 32 + (lane & 31);
                S[0][n][i] = ctx ? 0.f : st0[(size_t)d * 128 + v];
            }
    }
    const int sd = tid & (DK - 1), t0 = tid / DK; constexpr int TS = 512 / DK;
    float lrw[16]; float lrb = 0.f, lb = 0.f;
    if (!MIX) {
#pragma unroll
        for (int r = 0; r < 16; ++r) lrw[r] = p.gla_lr_w[(((size_t)l * 2 + dir) * 16 + r) * 256 + hd * 64 + sd];
        lrb = p.gla_lr_b[((size_t)l * 2 + dir) * 256 + hd * 64 + sd];
    } else {
#pragma unroll
        for (int r = 0; r < 16; ++r) lrw[r] = 0.f;
        lb = lbs[(size_t)(dir * 4 + l) * 512 + hd * 128 + sd];
    }
    const int kcol = MIX ? (dir ? PJ_HFB : PJ_HFF) + hd * 128 + sd : PJ_GK + hd * 64 + sd;
    const int zcol = dir ? PJ_GZB : PJ_GZF;
    const int vv = tid & 127, vq = tid >> 7;
    const int vcol = (MIX ? PJ_HI : PJ_GV) + hd * 128 + vv;
    const int kd = tid >> 2, kq = tid & 3;
    const bool k2 = tid < 4 * DK;

    constexpr int NE = 64 / TS;
    unsigned kraw[NE]; unsigned vraw[8];
    const int widu = __builtin_amdgcn_readfirstlane(tid >> 6), gmt = (widu >> 1) & 1, gnt = widu & 1;
    bf16x8 gafr = {0, 0, 0, 0, 0, 0, 0, 0}; u32x4 gbw = {0u, 0u, 0u, 0u}; float gbias = 0.f;
    if (!MIX && widu < 4) {
        const float* lw = p.gla_lr_w + (((size_t)l * 2 + dir) * 16 + 8 * (lane >> 5)) * 256 + hd * 64 + gnt * 32 + (lane & 31);
        float wv[8];
#pragma unroll
        for (int j = 0; j < 8; ++j) wv[j] = lw[(size_t)j * 256];
        gbw.x = pk2(wv[0], wv[1]); gbw.y = pk2(wv[2], wv[3]); gbw.z = pk2(wv[4], wv[5]); gbw.w = pk2(wv[6], wv[7]);
        gbias = p.gla_lr_b[((size_t)l * 2 + dir) * 256 + hd * 64 + gnt * 32 + (lane & 31)];
    }
    auto load_chunk = [&](const bf16_t* prc) {
#pragma unroll
        for (int i = 0; i < NE; ++i) {
            const bf16_t* row = prc + (size_t)(t0 + TS * i) * NPROJ;
            kraw[i] = row[kcol];
        }
        if (!MIX && widu < 4) gafr = *(const bf16x8*)(prc + (size_t)(gmt * 32 + (lane & 31)) * NPROJ + zcol + 8 * (lane >> 5));
#pragma unroll
        for (int t = 0; t < 16; t += 2) {
            const unsigned a = prc[(size_t)(vq * 16 + t) * NPROJ + vcol], b = prc[(size_t)(vq * 16 + t + 1) * NPROJ + vcol];
            vraw[t >> 1] = a | (b << 16);
        }
    };
    auto store_state = [&](int gcs) {
        bf16_t* sb = sbuf + (((size_t)gcs * 2 + dir) * 4 + hd) * 128 * DK;
#pragma unroll
        for (int nn = 0; nn < NTL; ++nn)
#pragma unroll
            for (int q = 0; q < 4; ++q) {
                const int d0 = wm * 32 + 8 * q + 4 * (lane >> 5), v = wn * WTN + nn * 32 + (lane & 31);
                u32x2 w; w.x = pk2(S[0][nn][4 * q + 0], S[0][nn][4 * q + 1]); w.y = pk2(S[0][nn][4 * q + 2], S[0][nn][4 * q + 3]);
                *(u32x2*)(sb + (size_t)v * DK + d0) = w;
            }
    };
    load_chunk(proj + (size_t)(tok0 + (dir ? nch - 1 : 0) * 64) * NPROJ);
    store_state((tok0 >> 6) + (dir ? nch - 1 : 0));
    for (int n = 0; n < nch; ++n) {
        if (MIX) {
#pragma unroll
            for (int i = 0; i < NE; ++i) {
                const int t = t0 + TS * i; float gt, kt; const u32x4 zz = {0u, 0u, 0u, 0u};
                gate_raw<MIX>(kraw[i], zz, zz, lrw, lrb, lb, gt, kt);
                G[t * LDG + sd] = gt; KK[t * LDG + sd] = kt;
            }
        } else {
#pragma unroll
            for (int i = 0; i < NE; ++i) KK[(t0 + TS * i) * LDG + sd] = bflo(kraw[i]);
            if (widu < 4) {
                f32x16 zacc;
#pragma unroll
                for (int i = 0; i < 16; ++i) zacc[i] = 0.f;
                zacc = __builtin_amdgcn_mfma_f32_32x32x16_bf16(gafr, __builtin_bit_cast(bf16x8, gbw), zacc, 0, 0, 0);
#pragma unroll
                for (int i = 0; i < 16; ++i)
                    G[(gmt * 32 + (i & 3) + 8 * (i >> 2) + 4 * (lane >> 5)) * LDG + gnt * 32 + (lane & 31)] = logsigmoidf_(zacc[i] + gbias) * (1.0f / 16.0f);
            }
        }
#pragma unroll
        for (int q = 0; q < 2; ++q) { u32x4 w; w.x = vraw[4 * q]; w.y = vraw[4 * q + 1]; w.z = vraw[4 * q + 2]; w.w = vraw[4 * q + 3]; *(LAS u32x4*)(Bt + vv * LDT + vq * 16 + q * 8) = w; }
        if (n + 1 < nch) load_chunk(proj + (size_t)(tok0 + (dir ? nch - 2 - n : n + 1) * 64) * NPROJ);
        __syncthreads();
        if (k2) {
            float g[16]; float qs = 0.f;
#pragma unroll
            for (int t = 0; t < 16; ++t) { g[t] = G[(kq * 16 + t) * LDG + kd]; qs += g[t]; }
            const int lb4 = lane & ~3;
            const float s0 = __shfl(qs, lb4), s1 = __shfl(qs, lb4 + 1), s2 = __shfl(qs, lb4 + 2), s3 = __shfl(qs, lb4 + 3);
            const float total = (s0 + s1) + (s2 + s3);
            float pref = (kq > 0 ? s0 : 0.f) + (kq > 1 ? s1 : 0.f) + (kq > 2 ? s2 : 0.f);
            unsigned pkv[8];
#pragma unroll
            for (int t = 0; t < 16; ++t) {
                const float pe = pref; pref += g[t];
                const float w = dir ? pe : total - pref;
                const float kv = KK[(kq * 16 + t) * LDG + kd] * fexp_(w);
                if (t & 1) pkv[t >> 1] = pk2(__uint_as_float(pkv[t >> 1]), kv); else pkv[t >> 1] = __float_as_uint(kv);
            }
#pragma unroll
            for (int q = 0; q < 2; ++q) { u32x4 w; w.x = pkv[4 * q]; w.y = pkv[4 * q + 1]; w.z = pkv[4 * q + 2]; w.w = pkv[4 * q + 3]; *(LAS u32x4*)(At + kd * LDT + kq * 16 + q * 8) = w; }
            if (kq == 0) dec[kd] = fexp_(total);
        }
        __syncthreads();
#pragma unroll
        for (int nn = 0; nn < NTL; ++nn)
#pragma unroll
            for (int i = 0; i < 16; ++i) S[0][nn][i] *= dec[wm * 32 + (i & 3) + 8 * (i >> 2) + 4 * (lane >> 5)];
        mma_lds<1, NTL, 4>(S, At + wm * 32 * LDT, LDT, Bt + wn * WTN * LDT, LDT, lane);
        if (n + 1 < nch) store_state((tok0 >> 6) + (dir ? nch - 2 - n : n + 1));
        __syncthreads();
    }
    if (ctx) {
        float* o = MIX ? p.out + (size_t)NTOK * D + (size_t)16 * DEPTH * 2 * 4 * 64 * 128 + ((((size_t)s * DEPTH + l) * 2 + dir) * 4 + hd) * 128 * 128
                       : p.out + (size_t)NTOK * D + ((((size_t)s * DEPTH + l) * 2 + dir) * 4 + hd) * 64 * 128;
#pragma unroll
        for (int nn = 0; nn < NTL; ++nn)
#pragma unroll
            for (int i = 0; i < 16; ++i) {
                const int d = wm * 32 + (i & 3) + 8 * (i >> 2) + 4 * (lane >> 5), v = wn * WTN + nn * 32 + (lane & 31);
                o[(size_t)d * 128 + v] = S[0][nn][i];
            }
    }
}


__device__ __forceinline__ void gmlp_item(const Params& p, int l, int c2, int g, LAS unsigned char* lds) {
    constexpr int LDT = 136;
    LAS bf16_t* Aw = (LAS bf16_t*)lds;
    LAS bf16_t* Bt = Aw + 128 * LDT;
    const int tid = otid(), lane = tid & 63, wid = tid >> 6, wm = wid >> 2, wn = wid & 3;
    const bf16_t* proj = (const bf16_t*)(p.ws + WS_PROJ);
    const int tokb = c2 * 128;
    {
        const float* wsrc = p.gm_ws + ((size_t)l * 4 + g) * 128 * 128;
#pragma unroll
        for (int i = 0; i < 8; ++i) {
            const int e = (i * 512 + tid) * 4, pp = e >> 7, q = e & 127;
            const f32x4 v = *(const f32x4*)(wsrc + e);
            u32x2 w; w.x = pk2(v.x, v.y); w.y = pk2(v.z, v.w);
            *(LAS u32x2*)(Aw + pp * LDT + q) = w;
        }
    }
    {
        const int q = tid >> 2, part = tid & 3;
        const bf16_t* mv = proj + (size_t)(tokb + q) * NPROJ + PJ_MV;
        float s = 0.f, s2 = 0.f;
#pragma unroll
        for (int i = 0; i < 16; ++i) {
            const u32x4 u = *(const u32x4*)(mv + (i * 4 + part) * 8);
            const unsigned uu[4] = {u.x, u.y, u.z, u.w};
#pragma unroll
            for (int j = 0; j < 4; ++j) { const float a = geluf_(bflo(uu[j])), b = geluf_(bfhi(uu[j])); s += a + b; s2 += a * a + b * b; }
        }
        s += __shfl_xor(s, 1); s += __shfl_xor(s, 2); s2 += __shfl_xor(s2, 1); s2 += __shfl_xor(s2, 2);
        const float mean = s * (1.0f / 512.0f), var = fmaxf(s2 * (1.0f / 512.0f) - mean * mean, 0.f), rstd = rsqrtf(var + EPS);
        const float* gg = p.gm_norm_g + (size_t)l * 512 + g * 128 + part * 32;
        const bf16_t* mvg = mv + g * 128 + part * 32;
#pragma unroll
        for (int i = 0; i < 4; ++i) {
            const u32x4 u = *(const u32x4*)(mvg + i * 8);
            const unsigned uu[4] = {u.x, u.y, u.z, u.w};
#pragma unroll
            for (int j = 0; j < 4; ++j) {
                const int c = part * 32 + i * 8 + j * 2;
                const float a = (geluf_(bflo(uu[j])) - mean) * rstd * gg[i * 8 + j * 2], b = (geluf_(bfhi(uu[j])) - mean) * rstd * gg[i * 8 + j * 2 + 1];
                Bt[c * LDT + q] = f2bf(a); Bt[(c + 1) * LDT + q] = f2bf(b);
            }
        }
    }
    __syncthreads();
    f32x16 acc[2][1]; acc_zero<1>(acc);
    mma_lds<2, 1, 8>(acc, Aw + wm * 64 * LDT, LDT, Bt + wn * 32 * LDT, LDT, lane);
    bf16_t* ocat = (bf16_t*)(p.ws + WS_OCAT);
    const float* bs = p.gm_bs + ((size_t)l * 4 + g) * 128;
#pragma unroll
    for (int m = 0; m < 2; ++m)
#pragma unroll
        for (int i = 0; i < 16; ++i) {
            const int pp = wm * 64 + m * 32 + (i & 3) + 8 * (i >> 2) + 4 * (lane >> 5), c = wn * 32 + (lane & 31);
            const float mu = bf2f(proj[(size_t)(tokb + pp) * NPROJ + PJ_MU + g * 128 + c]);
            ocat[(size_t)2 * NTOK * 512 + (size_t)(tokb + pp) * 512 + g * 128 + c] = f2bf(geluf_(mu) * (acc[m][0][i] + bs[pp]));
        }
    __syncthreads();
}

__device__ __forceinline__ void phase_scan(const Params& p, int l, LAS unsigned char* lds) {
    LAS int* slot = (LAS int*)(lds + LDS_BYTES - 16);
    unsigned* ctr = (unsigned*)(p.ws + WS_CTR) + l;
    constexpr int NLAT = 8 * 2 * 4 * 2, NCX = 16 * 2 * 4 * 2, NGM = 160 * 4;
    for (;;) {
        if (otid() == 0) *slot = (int)atomicAdd(ctr, 1u);
        __syncthreads();
        const int j = *slot;
        __syncthreads();
        const int nconv = l + 1 < DEPTH ? CONV_BLOCK_ITEMS - CONV_IN_GEMM : 0;
        if (j >= NLAT + NCX + NGM + nconv) break;
        if (j >= NLAT + NCX + NGM) { convert_weights(p, l + 1, lds, CONV_IN_GEMM + j - (NLAT + NCX + NGM)); __syncthreads(); continue; }
        if (j < NLAT + NCX) {
            int r = j, s;
            if (r < NLAT) { s = 16 + (r >> 4); r &= 15; } else { r -= NLAT; s = r >> 4; r &= 15; }
            const int mix = r & 1, dir = (r >> 1) & 1, hd = r >> 2;
            if (mix) scan_job<1>(p, l, s, dir, hd, lds); else scan_job<0>(p, l, s, dir, hd, lds);
        } else { const int r = j - NLAT - NCX; gmlp_item(p, l, r >> 2, r & 3, lds); }
    }
}

template <int MIX>
__device__ __forceinline__ void out_item(const Params& p, int l, int gc, int hd, LAS unsigned char* lds) {
    constexpr int DK = MIX ? 128 : 64, LQ = DK + 8, LDV = 72, LDG = DK + 1;
    LAS bf16_t* QA = (LAS bf16_t*)lds;
    LAS bf16_t* KA = QA + 128 * LQ;
    LAS bf16_t* QS = KA + 128 * LQ;
    LAS bf16_t* VT = QS + 64 * LQ;
    LAS bf16_t* P = VT + 128 * LDV;
    LAS float* C = (LAS float*)(P + 64 * LDV);
    LAS float* BS = C + (MIX ? 64 : 128) * LDG;
    LAS bf16_t* ST = KA;
    LAS float* Of = (LAS float*)lds;
    const int tid = otid(), lane = tid & 63, wid = __builtin_amdgcn_readfirstlane(tid >> 6);
    const int tokb = gc * 64;
    const bf16_t* proj = (const bf16_t*)(p.ws + WS_PROJ);
    const bf16_t* pr = proj + (size_t)tokb * NPROJ;
    const float* lbs = (const float*)(p.ws + WS_LBS);
    const bf16_t* sbuf = (const bf16_t*)(p.ws + WS_ST + (MIX ? ST_GLA_BYTES : 0));
    constexpr int NPQ = 64 * (DK / 8), NRQ = NPQ / 512;
    u32x4 rq[NRQ], rk[NRQ];
    auto load_raw = [&](int dr) {
        const int kcol0 = MIX ? (dr ? PJ_HFB : PJ_HFF) + hd * 128 : PJ_GK + hd * 64;
        const int qcol0 = MIX ? PJ_HQ + hd * 128 : PJ_GQ + hd * 64;
#pragma unroll
        for (int k = 0; k < NRQ; ++k) { const int e = tid + 512 * k; const int t = e / (DK / 8), c8 = (e % (DK / 8)) * 8;
            rq[k] = *(const u32x4*)(pr + (size_t)t * NPROJ + qcol0 + c8); rk[k] = *(const u32x4*)(pr + (size_t)t * NPROJ + kcol0 + c8); }
    };
    load_raw(0);
    const int kdp = tid & (DK - 1);
    float gnv[16];
    {
        const float* gn = (MIX ? p.hg_norm_g : p.gla_norm_g) + (size_t)l * 512 + hd * 128 + (tid & 7) * 16;
#pragma unroll
        for (int j = 0; j < 16; j += 4) { const f32x4 t4 = *(const f32x4*)(gn + j); gnv[j] = t4.x; gnv[j + 1] = t4.y; gnv[j + 2] = t4.z; gnv[j + 3] = t4.w; }
    }
    const float lbd0 = MIX ? lbs[(size_t)(0 * 4 + l) * 512 + hd * 128 + kdp] : 0.f, lbd1 = MIX ? lbs[(size_t)(1 * 4 + l) * 512 + hd * 128 + kdp] : 0.f;
    typedef float f32x2p_t __attribute__((ext_vector_type(2)));
    const f32x2p_t zz2 = {0.f, 0.f};
    const f32x2p_t lbp0 = MIX ? *(const f32x2p_t*)(lbs + (size_t)(0 * 4 + l) * 512 + hd * 128 + 2 * (tid & 63)) : zz2, lbp1 = MIX ? *(const f32x2p_t*)(lbs + (size_t)(1 * 4 + l) * 512 + hd * 128 + 2 * (tid & 63)) : zz2;
    if (!MIX) {
        const int gd = wid >> 2, mt = (wid >> 1) & 1, nt = wid & 1, r = lane & 31, h = lane >> 5;
        const bf16x8 afr = *(const bf16x8*)(pr + (size_t)(mt * 32 + r) * NPROJ + (gd ? PJ_GZB : PJ_GZF) + 8 * h);
        const float* lw = p.gla_lr_w + (((size_t)l * 2 + gd) * 16 + 8 * h) * 256 + hd * 64 + nt * 32 + r;
        float wv[8];
#pragma unroll
        for (int j = 0; j < 8; ++j) wv[j] = lw[(size_t)j * 256];
        const float bias = p.gla_lr_b[((size_t)l * 2 + gd) * 256 + hd * 64 + nt * 32 + r];
        u32x4 bw; bw.x = pk2(wv[0], wv[1]); bw.y = pk2(wv[2], wv[3]); bw.z = pk2(wv[4], wv[5]); bw.w = pk2(wv[6], wv[7]);
        f32x16 zacc;
#pragma unroll
        for (int i = 0; i < 16; ++i) zacc[i] = 0.f;
        zacc = __builtin_amdgcn_mfma_f32_32x32x16_bf16(afr, __builtin_bit_cast(bf16x8, bw), zacc, 0, 0, 0);
#pragma unroll
        for (int i = 0; i < 16; ++i) {
            const int t = mt * 32 + (i & 3) + 8 * (i >> 2) + 4 * h;
            C[(gd * 64 + (gd ? 63 - t : t)) * LDG + nt * 32 + r] = logsigmoidf_(zacc[i] + bias) * (1.0f / 16.0f);
        }
    }
    const bf16_t* gatep = pr + (size_t)(tid >> 3) * NPROJ + (MIX ? PJ_HO : PJ_GO) + hd * 128 + (tid & 7) * 16;
    const u32x4 g0 = *(const u32x4*)gatep, g1 = *(const u32x4*)(gatep + 8);
    {
        const int vv = tid & 127, qt = tid >> 7;
        const int vcol = (MIX ? PJ_HI : PJ_GV) + hd * 128 + vv;
        unsigned pkv[8];
#pragma unroll
        for (int t = 0; t < 16; t += 2) {
            const unsigned a = pr[(size_t)(qt * 16 + t) * NPROJ + vcol], b = pr[(size_t)(qt * 16 + t + 1) * NPROJ + vcol];
            pkv[t >> 1] = a | (b << 16);
        }
#pragma unroll
        for (int q = 0; q < 2; ++q) { u32x4 w; w.x = pkv[4 * q]; w.y = pkv[4 * q + 1]; w.z = pkv[4 * q + 2]; w.w = pkv[4 * q + 3]; *(LAS u32x4*)(VT + vv * LDV + qt * 16 + q * 8) = w; }
    }
    const int wm = wid >> 2, wn = wid & 3;
    f32x16 o[1][1];
#pragma unroll
    for (int i = 0; i < 16; ++i) o[0][0][i] = 0.f;

#pragma unroll 1
    for (int dir = 0; dir < 2; ++dir) {
        const int kd = tid & (DK - 1), ba = tid / DK;
#pragma unroll
        for (int k = 0; k < NRQ; ++k) { const int e = tid + 512 * k; const int t = e / (DK / 8), c8 = (e % (DK / 8)) * 8;
            *(LAS u32x4*)(QS + t * LQ + c8) = rq[k]; *(LAS u32x4*)(KA + (64 + (dir ? 63 - t : t)) * LQ + c8) = rk[k]; }
        __syncthreads();
        if (MIX) {
            const int cp = tid & 63, bh = tid >> 6, bah = bh >> 1, u0 = (bh & 1) * 8;
            const float lbA = dir ? lbp1.x : lbp0.x, lbB = dir ? lbp1.y : lbp0.y;
            float gA[8], gB[8], kA[8], kB[8]; float thA = 0.f, thB = 0.f;
            {
                const LAS bf16_t* kzr = KA + (64 + bah * 16 + u0) * LQ + 2 * cp;
#pragma unroll
                for (int u = 0; u < 8; ++u) {
                    const unsigned raw = *(const LAS unsigned*)(kzr + u * LQ);
                    const float sa = sigmoidf_(bflo(raw)), sb = sigmoidf_(bfhi(raw));
                    gA[u] = flog_(lbA + (1.0f - lbA) * sa); kA[u] = (1.0f - lbA) * (1.0f - sa); thA += gA[u];
                    gB[u] = flog_(lbB + (1.0f - lbB) * sb); kB[u] = (1.0f - lbB) * (1.0f - sb); thB += gB[u];
                }
                typedef float f32x2_t __attribute__((ext_vector_type(2)));
                f32x2_t th; th.x = thA; th.y = thB;
                *(LAS f32x2_t*)(BS + bh * DK + 2 * cp) = th;
            }
            __syncthreads();
            {
                typedef float f32x2_t __attribute__((ext_vector_type(2)));
                f32x2_t hh[8];
#pragma unroll
                for (int j = 0; j < 8; ++j) hh[j] = *(const LAS f32x2_t*)(BS + j * DK + 2 * cp);
                const f32x2_t T0 = hh[0] + hh[1], T1 = hh[2] + hh[3], T2 = hh[4] + hh[5], T3 = hh[6] + hh[7];
                const f32x2_t Tb = bah == 0 ? T0 : bah == 1 ? T1 : bah == 2 ? T2 : T3;
                const f32x2_t l7 = bah == 0 ? hh[0] : bah == 1 ? hh[2] : bah == 2 ? hh[4] : hh[6];
                const f32x2_t zero2 = {0.f, 0.f};
                const f32x2_t base = bah == 0 ? zero2 : bah == 1 ? T0 : bah == 2 ? T0 + T1 : T0 + T1 + T2;
                const f32x2_t c31 = T0 + T1;
                float lpA = u0 ? l7.x : 0.f, lpB = u0 ? l7.y : 0.f;
                const float qscale = 0.08838834764831845f;
                LAS bf16_t* qz = QA + (64 + bah * 16 + u0) * LQ + 2 * cp;
                LAS bf16_t* kz = KA + (64 + bah * 16 + u0) * LQ + 2 * cp;
                LAS bf16_t* xrow = (bah < 2 ? KA + (bah * 16 + u0) * LQ : QA + (bah * 16 + u0 - 32) * LQ) + 2 * cp;
                LAS bf16_t* yrow = ((bah & 1) ? QA + (32 + (bah >> 1) * 16 + u0) * LQ : KA + (32 + (bah >> 1) * 16 + u0) * LQ) + 2 * cp;
                const bool xk = bah < 2, yq = (bah & 1) != 0;
#pragma unroll
                for (int u = 0; u < 8; ++u) {
                    const int pp = bah * 16 + u0 + u, t = dir ? 63 - pp : pp;
                    lpA += gA[u]; lpB += gB[u];
                    const float cA = base.x + lpA, cB = base.y + lpB;
                    const unsigned qraw = *(const LAS unsigned*)(QS + t * LQ + 2 * cp);
                    const float qa = bflo(qraw) * qscale, qb = bfhi(qraw) * qscale;
                    *(LAS unsigned*)(QS + t * LQ + 2 * cp) = pk2(qa * fexp_(cA), qb * fexp_(cB));
                    *(LAS unsigned*)(qz + u * LQ) = pk2(qa * fexp_(lpA - l7.x), qb * fexp_(lpB - l7.y));
                    *(LAS unsigned*)(kz + u * LQ) = pk2(kA[u] * fexp_(l7.x - lpA), kB[u] * fexp_(l7.y - lpB));
                    *(LAS unsigned*)(xrow + u * LQ) = pk2((xk ? kA[u] : qa) * fexp_(xk ? c31.x - cA : cA - c31.x), (xk ? kB[u] : qb) * fexp_(xk ? c31.y - cB : cB - c31.y));
                    *(LAS unsigned*)(yrow + u * LQ) = pk2((yq ? qa : kA[u]) * fexp_(yq ? lpA : Tb.x - lpA), (yq ? qb : kB[u]) * fexp_(yq ? lpB : Tb.y - lpB));
                }
            }
            __syncthreads();
        } else {
        float gk[16], kk[16]; float lp7 = 0.f, Ta = 0.f;
        if (MIX) {
            const float lb = dir ? lbd1 : lbd0;
            const LAS bf16_t* kz0 = KA + (64 + ba * 16) * LQ + kd;
#pragma unroll
            for (int u = 0; u < 16; ++u) {
                const float sg = sigmoidf_(bf2f(kz0[u * LQ]));
                gk[u] = flog_(lb + (1.0f - lb) * sg); kk[u] = (1.0f - lb) * (1.0f - sg);
                Ta += gk[u]; if (u == 7) lp7 = Ta;
            }
            BS[ba * DK + kd] = Ta;
        } else {
            if (ba < 4) {
#pragma unroll
                for (int u = 0; u < 16; ++u) { gk[u] = C[(dir * 64 + ba * 16 + u) * LDG + kd]; Ta += gk[u]; if (u == 7) lp7 = Ta; }
                BS[ba * DK + kd] = Ta;
            }
        }
        __syncthreads();
        if (ba < 4) {
            const float T0 = BS[kd], T1 = BS[DK + kd], T2 = BS[2 * DK + kd];
            const float base = ba == 0 ? 0.f : ba == 1 ? T0 : ba == 2 ? T0 + T1 : T0 + T1 + T2;
            const float c31 = T0 + T1;
            const float qscale = MIX ? 0.08838834764831845f : 0.125f;
            LAS bf16_t* qz = QA + (64 + ba * 16) * LQ + kd;
            LAS bf16_t* kz = KA + (64 + ba * 16) * LQ + kd;
            LAS bf16_t* xrow = (ba < 2 ? KA + (ba * 16) * LQ : QA + (ba * 16 - 32) * LQ) + kd;
            LAS bf16_t* yrow = ((ba & 1) ? QA + (32 + (ba >> 1) * 16) * LQ : KA + (32 + (ba >> 1) * 16) * LQ) + kd;
            float lp = 0.f;
#pragma unroll
            for (int u = 0; u < 16; ++u) {
                const int pp = ba * 16 + u, t = dir ? 63 - pp : pp;
                lp += gk[u];
                const float c = base + lp;
                const float qv = bf2f(QS[t * LQ + kd]) * qscale;
                const float kt = MIX ? kk[u] : bf2f(kz[u * LQ]);
                QS[t * LQ + kd] = f2bf(qv * fexp_(c));
                qz[u * LQ] = f2bf(qv * fexp_(lp - lp7));
                kz[u * LQ] = f2bf(kt * fexp_(lp7 - lp));
                xrow[u * LQ] = f2bf(ba < 2 ? kt * fexp_(c31 - c) : qv * fexp_(c - c31));
                yrow[u * LQ] = f2bf((ba & 1) ? qv * fexp_(lp) : kt * fexp_(Ta - lp));
            }
        }
        __syncthreads();
        }
        if (dir == 0) load_raw(1);
        constexpr int PIECES = 128 * DK / 8, NPC = PIECES / 512;
        u32x4 stv[NPC];
        {
            const bf16_t* sb = sbuf + (((size_t)gc * 2 + dir) * 4 + hd) * 128 * DK;
#pragma unroll
            for (int k = 0; k < NPC; ++k) { const int e = tid + 512 * k; const int v = e / (DK / 8), d0 = (e % (DK / 8)) * 8; stv[k] = *(const u32x4*)(sb + (size_t)v * DK + d0); }
        }
        if (wid < 4) {
            f32x16 sc[1][1];
#pragma unroll
            for (int i = 0; i < 16; ++i) sc[0][0][i] = 0.f;
            mma_lds<1, 1, DK / 16>(sc, KA + wid * 32 * LQ, LQ, QA + wid * 32 * LQ, LQ, lane);
            const int cc = lane & 31;
#pragma unroll
            for (int q = 0; q < 4; ++q) {
                const int r0 = 8 * q + 4 * (lane >> 5);
                int pi, pj0; bool wr = true, zero = false, tri = false;
                if (wid == 0) { pi = 32 + cc; pj0 = r0; }
                else if (wid == 1) { pi = cc < 16 ? 16 + cc : 32 + cc; pj0 = r0 < 16 ? r0 : r0 + 16; wr = (r0 < 16) == (cc < 16); }
                else { const int off = (wid - 2) * 32; pi = off + cc; pj0 = off + r0; const bool same = (r0 >> 4) == (cc >> 4); tri = same; zero = !same && r0 >= 16; wr = same || zero; }
                float v[4];
#pragma unroll
                for (int e = 0; e < 4; ++e) { float x = sc[0][0][4 * q + e]; if (tri && (r0 + e > cc)) x = 0.f; if (zero) x = 0.f; v[e] = x; }
                if (wr) {
                    u32x2 w;
                    if (dir == 0) { w.x = pk2(v[0], v[1]); w.y = pk2(v[2], v[3]); *(LAS u32x2*)(P + pi * LDV + pj0) = w; }
                    else { w.x = pk2(v[3], v[2]); w.y = pk2(v[1], v[0]); *(LAS u32x2*)(P + (63 - pi) * LDV + (60 - pj0)) = w; }
                }
            }
        } else if (wid == 4) {
#pragma unroll
            for (int k = 0; k < 2; ++k) {
                const int idx = lane * 2 + k, row = idx >> 2, piece = idx & 3;
                const int ti = dir ? 32 + row : row, tj = (dir ? 0 : 32) + piece * 8;
                u32x4 z; z.x = 0; z.y = 0; z.z = 0; z.w = 0;
                *(LAS u32x4*)(P + ti * LDV + tj) = z;
            }
        }
        __syncthreads();
#pragma unroll
        for (int k = 0; k < NPC; ++k) { const int e = tid + 512 * k; const int v = e / (DK / 8), d0 = (e % (DK / 8)) * 8; *(LAS u32x4*)(ST + v * LQ + d0) = stv[k]; }
        mma_lds<1, 1, 4>(o, P + wm * 32 * LDV, LDV, VT + wn * 32 * LDV, LDV, lane);
        __syncthreads();
        mma_lds<1, 1, DK / 16>(o, QS + wm * 32 * LQ, LQ, ST + wn * 32 * LQ, LQ, lane);
        __syncthreads();
    }
#pragma unroll
    for (int i = 0; i < 16; ++i) Of[(wm * 32 + (i & 3) + 8 * (i >> 2) + 4 * (lane >> 5)) * 132 + wn * 32 + (lane & 31)] = o[0][0][i];
    __syncthreads();
    {
        const int i_ = tid >> 3, seg = tid & 7;
        const LAS float* orow = Of + i_ * 132 + seg * 16;
        float v[16]; float ss = 0.f;
#pragma unroll
        for (int j = 0; j < 16; ++j) { v[j] = orow[j]; ss += v[j] * v[j]; }
        ss += __shfl_xor(ss, 1); ss += __shfl_xor(ss, 2); ss += __shfl_xor(ss, 4);
        const float r = rsqrtf(ss * (1.0f / 128.0f) + EPS);
        const unsigned gu[8] = {g0.x, g0.y, g0.z, g0.w, g1.x, g1.y, g1.z, g1.w};
        unsigned ow[8];
#pragma unroll
        for (int j = 0; j < 8; ++j) {
            const float a = v[2 * j] * r * gnv[2 * j] * siluf_(bflo(gu[j])), b = v[2 * j + 1] * r * gnv[2 * j + 1] * siluf_(bfhi(gu[j]));
            ow[j] = pk2(a, b);
        }
        bf16_t* dst = (bf16_t*)(p.ws + WS_OCAT) + (size_t)(MIX ? 1 : 0) * NTOK * 512 + (size_t)(tokb + i_) * 512 + hd * 128 + seg * 16;
        u32x4 w0, w1; w0.x = ow[0]; w0.y = ow[1]; w0.z = ow[2]; w0.w = ow[3]; w1.x = ow[4]; w1.y = ow[5]; w1.z = ow[6]; w1.w = ow[7];
        *(u32x4*)dst = w0; *(u32x4*)(dst + 8) = w1;
    }
    __syncthreads();
}


__device__ __forceinline__ void phase_out(const Params& p, int l, LAS unsigned char* lds) {
    constexpr int NIT = NCHUNK * 4 * 2;
    for (int it = blockIdx.x; it < NIT; it += gridDim.x) {
        const int mix = (it >> 8) & 1, rem = (it & 255) | ((it >> 9) << 8), hd = rem & 3, gc = rem >> 2;
        if (mix) out_item<1>(p, l, gc, hd, lds); else out_item<0>(p, l, gc, hd, lds);
    }
}

__device__ __forceinline__ void phase_merge(const Params& p, int l, LAS unsigned char* lds) {
    const bf16_t* ocat = (const bf16_t*)(p.ws + WS_OCAT);
    const bf16_t* G3 = (const bf16_t*)(p.ws + WS_PROJ);
    const bf16_t* WbrT = (const bf16_t*)(p.ws + WS_W + (size_t)(l & 1) * W_END + W_BR);
    bf16_t* merged = (bf16_t*)(p.ws + WS_ST);
    const int lane = otid() & 63, wid = otid() >> 6, wm = wid >> 2, wn = wid & 3;
    constexpr int nM = NTOK / 128, nN = 8;
    for (int t = blockIdx.x; t < nM * nN; t += gridDim.x) {
        int tm, tn; tile_coords(t, nN, tm, tn);
        const int row0 = tm * 128, col0 = tn * 128;
        f32x16 tot[2][1]; acc_zero<1>(tot);
#pragma unroll 1
        for (int b = 0; b < 3; ++b) {
            f32x16 ba[2][1]; acc_zero<1>(ba);
            gemm_kloop<128>(lds, ocat + (size_t)row0 * 1536 + b * 512, 1536, WbrT + ((size_t)b * D + col0) * 512, 512, 128, 512, ba);
#pragma unroll
            for (int m = 0; m < 2; ++m)
#pragma unroll
                for (int i = 0; i < 16; ++i) {
                    const int row = row0 + wm * 64 + m * 32 + (i & 3) + 8 * (i >> 2) + 4 * (lane >> 5), col = col0 + wn * 32 + (lane & 31);
                    tot[m][0][i] += bf2f(G3[(size_t)row * NGATE + b * 1024 + col]) * ba[m][0][i];
                }
        }
#pragma unroll
        for (int m = 0; m < 2; ++m)
#pragma unroll
            for (int i = 0; i < 16; ++i) {
                const int row = row0 + wm * 64 + m * 32 + (i & 3) + 8 * (i >> 2) + 4 * (lane >> 5), col = col0 + wn * 32 + (lane & 31);
                merged[(size_t)row * D + col] = f2bf(tot[m][0][i]);
            }
    }
}

__device__ __forceinline__ void run_phase(const Params& p, int ph, LAS unsigned char* lds) {
    if (ph == 0) { phase0(p, lds); return; }
    if (ph == NPHASE - 1) { norm_phase(p, p.final_norm_g, nullptr, 0, 0, nullptr, 1); return; }
    const int l = (ph - 1) / 10, sp = (ph - 1) % 10;
    const float* mod_l = (const float*)(p.ws + WS_MOD) + (size_t)l * 9 * 6144;
    bf16_t* hbuf = (bf16_t*)(p.ws + WS_H);
    bf16_t* proj = (bf16_t*)(p.ws + WS_PROJ);
    const unsigned char* wl = p.ws + WS_W + (size_t)(l & 1) * W_END;
    switch (sp) {
        case 0: if (l == 0) convert_weights(p, l, lds); norm_phase(p, p.norm_mix_g + (size_t)l * D, mod_l, 0, 1024, hbuf, 0); break;
        case 1: { PEpiBf16 e{proj, NPROJ, NPROJ, 0}; pg8_gemm(lds, hbuf, (const bf16_t*)(wl + W_IN), NTOK, 5376, D, e);
            if (l + 1 < DEPTH && blockIdx.x >= 144) { for (int k = 0; k < 2; ++k) convert_weights(p, l + 1, lds, ((int)blockIdx.x - 144) * 2 + k); } } break;
        case 2: phase_scan(p, l, lds); break;
        case 3: phase_out(p, l, lds); break;
        case 4: {
            PEpiBf16 e{proj, NGATE, NGATE, 2}; pg8_gemm(lds, hbuf, (const bf16_t*)(wl + W_G), NTOK, NGATE, D, e);
            PEpiGate e2{proj, NGATE}; pg8_gemm(lds, (const bf16_t*)(p.ws + WS_OCAT), (const bf16_t*)(wl + W_BR), NTOK, NGATE, 512, e2, (size_t)NTOK * 512 * 2);
            if (l + 1 < DEPTH && blockIdx.x >= 192) { for (int k = 0; k < 4; ++k) convert_weights(p, l + 1, lds, CONV_IN_P2 + ((int)blockIdx.x - 192) * 4 + k); } } break;
        case 5: sum3_phase(p); break;
        case 6: {
            PEpiResid e{p.out, mod_l + 2048}; pg8_gemm(lds, (const bf16_t*)(p.ws + WS_ST), (const bf16_t*)(wl + W_OUT), 16384, D, D, e);
            EpiResidOff e2{p.out, mod_l + 2048, 16384}; gemm_phase<128>(lds, (const bf16_t*)(p.ws + WS_ST) + (size_t)16384 * D, D, (const bf16_t*)(wl + W_OUT), D, NTOK - 16384, D, D, e2); } break;
        case 7: norm_phase(p, p.norm_ffn_g + (size_t)l * D, mod_l, 3072, 4096, hbuf, 0); break;
        case 8: { PEpiBf16 e{proj, DFF, DFF, 1}; pg8_gemm(lds, hbuf, (const bf16_t*)(wl + W_FF1), NTOK, DFF, D, e); } break;
        case 9: { PEpiResid e{p.out, mod_l + 5120}; pg8_gemm(lds, proj, (const bf16_t*)(wl + W_FF2), 16384, D, DFF, e);
            EpiResidOff e2{p.out, mod_l + 5120, 16384}; gemm_phase<128>(lds, proj + (size_t)16384 * DFF, DFF, (const bf16_t*)(wl + W_FF2), DFF, NTOK - 16384, D, DFF, e2); } break;
    }
}

__global__ void __launch_bounds__(512) fwd_megakernel(Params p) {
    extern __shared__ __attribute__((aligned(16))) unsigned char smem[];
    LAS unsigned char* lds = (LAS unsigned char*)smem;
    cg::grid_group grid = cg::this_grid();
    unsigned nbar = 0;
    for (int ph = p.ph_lo; ph < p.ph_hi; ++ph) {
        run_phase(p, ph, lds);
        if (ph + 1 < p.ph_hi) {
            if (ph == 0) grid.sync();
            else { ++nbar; grid_barrier((unsigned*)(p.ws + WS_CTR) + 64, nbar); }
        }
    }
}

extern "C" void kernel_launch(void* const* d_in, const int* in_sizes, int n_in, void* d_out, int out_size, void* d_ws, size_t ws_size, hipStream_t stream) {
    static int grid_blocks = 0;
    if (!grid_blocks) {
        int dev = 0, cus = 0, per_cu = 0;
        hipGetDevice(&dev);
        hipDeviceGetAttribute(&cus, hipDeviceAttributeMultiprocessorCount, dev);
        if (hipFuncSetAttribute((const void*)fwd_megakernel, hipFuncAttributeMaxDynamicSharedMemorySize, LDS_BYTES) != hipSuccess) fprintf(stderr, "hipFuncSetAttribute failed\n");
        hipOccupancyMaxActiveBlocksPerMultiprocessor(&per_cu, (const void*)fwd_megakernel, 512, LDS_BYTES);
        if (per_cu < 1) { fprintf(stderr, "occupancy query says %d blocks/CU\n", per_cu); per_cu = 1; }
        grid_blocks = cus * 1;
        (void)hipGetLastError();
        if (n_in != 26 || ws_size < WS_END) fprintf(stderr, "kernel_launch: unexpected n_in %d or ws_size %zu (need %zu)\n", n_in, ws_size, (size_t)WS_END);
    }
    Params p{};
    const float** pp = (const float**)&p;
    for (int i = 0; i < 26; ++i) pp[i] = (const float*)d_in[i];
    p.out = (float*)d_out; p.ws = (unsigned char*)d_ws; p.ph_lo = 0; p.ph_hi = NPHASE;
    void* args[] = {&p};
    hipError_t e = hipLaunchCooperativeKernel((const void*)fwd_megakernel, dim3(grid_blocks), dim3(512), args, LDS_BYTES, stream);
    if (e != hipSuccess) fprintf(stderr, "cooperative launch failed: %s (grid %d)\n", hipGetErrorString(e), grid_blocks);
}
```

```cpp
#include <hip/hip_runtime.h>
#include <hip/hip_cooperative_groups.h>
#include <cstdio>
namespace cg = cooperative_groups;

#define LAS __attribute__((address_space(3)))
typedef unsigned short bf16_t;
typedef short bf16x8 __attribute__((ext_vector_type(8)));
typedef float f32x16 __attribute__((ext_vector_type(16)));
typedef float f32x4 __attribute__((ext_vector_type(4)));
typedef unsigned u32x4 __attribute__((ext_vector_type(4)));
typedef unsigned u32x2 __attribute__((ext_vector_type(2)));

constexpr int D = 1024, DEPTH = 4, NTOK = 20480, NCTX = 4096, DFF = 4096;
constexpr int DIN = 8224, NPROJ = 5152, NGATE = 3072;
constexpr int PJ_GQ = 0, PJ_GK = 256, PJ_GV = 512, PJ_GO = 1024, PJ_GZF = 1536, PJ_GZB = 1552, PJ_HQ = 1568, PJ_HFF = 2080,
              PJ_HFB = 2592, PJ_HI = 3104, PJ_HO = 3616, PJ_MU = 4128, PJ_MV = 4640;
constexpr int NCHUNK = NTOK / 64;
constexpr float EPS = 1e-6f;
constexpr int LDS_BYTES = 160 * 1024;
constexpr int NPHASE = 2 + DEPTH * 10;

constexpr size_t WS_PROJ = 0;
constexpr size_t WS_ST   = WS_PROJ + (size_t)NTOK * NPROJ * 2;
constexpr size_t ST_GLA_BYTES = (size_t)NCHUNK * 2 * 4 * 128 * 64 * 2, ST_HG_BYTES = (size_t)NCHUNK * 2 * 4 * 128 * 128 * 2;
constexpr size_t WS_OCAT = WS_ST + ST_GLA_BYTES + ST_HG_BYTES;
constexpr size_t WS_H    = WS_OCAT + (size_t)NTOK * 1536 * 2;
constexpr size_t WS_W    = WS_H + (size_t)NTOK * D * 2;
constexpr size_t W_IN = 0, W_G = W_IN + (size_t)NPROJ * D * 2, W_BR = W_G + (size_t)NGATE * D * 2, W_OUT = W_BR + (size_t)3 * D * 512 * 2,
                 W_FF1 = W_OUT + (size_t)D * D * 2, W_FF2 = W_FF1 + (size_t)DFF * D * 2, W_END = W_FF2 + (size_t)D * DFF * 2;
constexpr size_t WS_MOD  = WS_W + 2 * W_END;
constexpr size_t WS_LBS  = WS_MOD + (size_t)DEPTH * 9 * 6144 * 4;
constexpr size_t WS_CTR  = WS_LBS + 2 * 4 * 512 * 4;
constexpr size_t WS_END  = WS_CTR + 4096;

struct Params {
    const float *x_prompt, *x_sample, *c, *state_gla, *state_hgrn, *c_ctx, *ada_w, *ada_b, *norm_mix_g, *norm_ffn_g, *w_in, *gla_lr_w,
        *gla_lr_b, *gla_norm_g, *hg_lb_logits, *hg_norm_g, *gm_norm_g, *gm_ws, *gm_bs, *w_br_gla, *w_br_hg, *w_br_gm, *w_out, *w_ff1, *w_ff2,
        *final_norm_g;
    float* out; unsigned char* ws; int ph_lo, ph_hi;
};

typedef __bf16 bf16x2_t __attribute__((ext_vector_type(2)));
__device__ __forceinline__ unsigned pk2(float lo, float hi) { bf16x2_t v; v.x = (__bf16)lo; v.y = (__bf16)hi; return __builtin_bit_cast(unsigned, v); }
__device__ __forceinline__ bf16_t f2bf(float f) { return (bf16_t)(pk2(f, 0.f) & 0xffffu); }
__device__ __forceinline__ float bf2f(bf16_t h) { return __uint_as_float(((unsigned)h) << 16); }
__device__ __forceinline__ float bflo(unsigned u) { return __uint_as_float(u << 16); }
__device__ __forceinline__ float bfhi(unsigned u) { return __uint_as_float(u & 0xffff0000u); }
__device__ __forceinline__ float fexp_(float x) { return __builtin_amdgcn_exp2f(x * 1.4426950408889634f); }
__device__ __forceinline__ float flog_(float x) { return __builtin_amdgcn_logf(x) * 0.6931471805599453f; }
__device__ __forceinline__ float sigmoidf_(float x) { return __builtin_amdgcn_rcpf(1.0f + fexp_(-x)); }
__device__ __forceinline__ float siluf_(float x) { return x * sigmoidf_(x); }
__device__ __forceinline__ float geluf_(float x) { const float y = 0.7978845608028654f * (x + 0.044715f * x * x * x); const float t = 1.0f - 2.0f * __builtin_amdgcn_rcpf(1.0f + fexp_(2.0f * y)); return 0.5f * x * (1.0f + t); }
__device__ __forceinline__ float logsigmoidf_(float x) { return fminf(x, 0.f) - flog_(1.0f + fexp_(-fabsf(x))); }
__device__ __forceinline__ float wave_sum(float v) {
#pragma unroll
    for (int o = 1; o < 64; o <<= 1) v += __shfl_xor(v, o);
    return v;
}
__device__ __forceinline__ int mod_row(int tok) { return tok < NCTX ? 0 : 1 + ((tok - NCTX) >> 11); }
__device__ __forceinline__ int otid() { int t = (int)__builtin_amdgcn_workitem_id_x(); asm volatile("" : "+v"(t)); return t; }
#define LDS_WAIT() asm volatile("s_waitcnt lgkmcnt(0)" ::: "memory")

template <int MT, int NTL, int KS>
__device__ __forceinline__ void mma_lds(f32x16 (&acc)[MT][NTL], const LAS bf16_t* As, int lda, const LAS bf16_t* Bs, int ldb, int lane) {
    const int r = lane & 31, h = lane >> 5;
    const LAS bf16_t* ap = As + r * lda + h * 8;
    const LAS bf16_t* bp = Bs + r * ldb + h * 8;
#pragma unroll
    for (int ks = 0; ks < KS; ++ks) {
        bf16x8 a[MT], b[NTL];
#pragma unroll
        for (int m = 0; m < MT; ++m) a[m] = *(const LAS bf16x8*)(ap + m * 32 * lda + ks * 16);
#pragma unroll
        for (int n = 0; n < NTL; ++n) b[n] = *(const LAS bf16x8*)(bp + n * 32 * ldb + ks * 16);
#pragma unroll
        for (int m = 0; m < MT; ++m)
#pragma unroll
            for (int n = 0; n < NTL; ++n) acc[m][n] = __builtin_amdgcn_mfma_f32_32x32x16_bf16(a[m], b[n], acc[m][n], 0, 0, 0);
    }
}

template <int BM>
__device__ __forceinline__ void gemm_kloop(LAS unsigned char* lds, const bf16_t* __restrict__ Ag, int lda, const bf16_t* __restrict__ Bg, int ldb, int brows,
                                           int K, f32x16 (&acc)[2][(128 / (8 / (BM / 64))) / 32]) {
    static_assert(BM == 128, "128-row tiles only");
    constexpr int WN = 4, WTN = 32, NTL = 1, LDT = 136, NP = 4;
    LAS bf16_t* As = (LAS bf16_t*)lds;
    LAS bf16_t* Bs = As + 2 * 128 * LDT;
    const int tid = otid(), lane = tid & 63, wid = tid >> 6, wm = wid / WN, wn = wid % WN;
    const int lrow = tid >> 4, lc = (tid & 15) * 8;
    const bf16_t* ap[NP]; const bf16_t* bp[NP];
#pragma unroll
    for (int p = 0; p < NP; ++p) ap[p] = Ag + (size_t)(lrow + p * 32) * lda + lc;
#pragma unroll
    for (int p = 0; p < NP; ++p) { int br = lrow + p * 32; br = br < brows ? br : brows - 1; bp[p] = Bg + (size_t)br * ldb + lc; }
    u32x4 ra[3][NP], rb[3][NP];
    const int nk = K / 128;
#define KL_ISSUE(S, step) do { _Pragma("unroll") for (int p = 0; p < NP; ++p) ra[S][p] = *(const u32x4*)(ap[p] + (step) * 128); \
                               _Pragma("unroll") for (int p = 0; p < NP; ++p) rb[S][p] = *(const u32x4*)(bp[p] + (step) * 128); } while (0)
#define KL_WRITE(S, stage) do { _Pragma("unroll") for (int p = 0; p < NP; ++p) *(LAS u32x4*)(As + (stage) * 128 * LDT + (lrow + p * 32) * LDT + lc) = ra[S][p]; \
                                _Pragma("unroll") for (int p = 0; p < NP; ++p) *(LAS u32x4*)(Bs + (stage) * 128 * LDT + (lrow + p * 32) * LDT + lc) = rb[S][p]; } while (0)
#define KL_STEP(J, JN) if (kt + J < nk) { const int s_ = kt + J; if (s_ + 3 < nk) KL_ISSUE(J, s_ + 3); \
        mma_lds<2, NTL, 8>(acc, As + (s_ & 1) * 128 * LDT + wm * 64 * LDT, LDT, Bs + (s_ & 1) * 128 * LDT + wn * WTN * LDT, LDT, lane); \
        if (s_ + 1 < nk) KL_WRITE(JN, (s_ + 1) & 1); __syncthreads(); }
    KL_ISSUE(0, 0); if (nk > 1) KL_ISSUE(1, 1); if (nk > 2) KL_ISSUE(2, 2);
    KL_WRITE(0, 0);
    __syncthreads();
    for (int kt = 0; kt < nk; kt += 3) { KL_STEP(0, 1) KL_STEP(1, 2) KL_STEP(2, 0) }
#undef KL_ISSUE
#undef KL_WRITE
#undef KL_STEP
}

template <int NTL>
__device__ __forceinline__ void acc_zero(f32x16 (&acc)[2][NTL]) {
#pragma unroll
    for (int m = 0; m < 2; ++m)
#pragma unroll
        for (int n = 0; n < NTL; ++n)
#pragma unroll
            for (int i = 0; i < 16; ++i) acc[m][n][i] = 0.f;
}

__device__ __forceinline__ void tile_coords(int t, int nN, int& tm, int& tn) { const int q = t >> 3; tn = q % nN; tm = (q / nN) * 8 + (t & 7); }

template <int BM, class Epi>
__device__ __forceinline__ void gemm_phase(LAS unsigned char* lds, const bf16_t* A, int lda, const bf16_t* Bt, int ldb, int M, int N, int K, const Epi& epi) {
    constexpr int WM = BM / 64, WN = 8 / WM, WTN = 128 / WN, NTL = WTN / 32;
    const int nM = M / BM, nN = (N + 127) / 128, ntiles = nM * nN;
    const int lane = otid() & 63, wid = otid() >> 6, wm = wid / WN, wn = wid % WN;
    for (int t = blockIdx.x; t < ntiles; t += gridDim.x) {
        int tm, tn; tile_coords(t, nN, tm, tn);
        const int row0 = tm * BM, col0 = tn * 128;
        f32x16 acc[2][NTL]; acc_zero<NTL>(acc);
        gemm_kloop<BM>(lds, A + (size_t)row0 * lda, lda, Bt + (size_t)col0 * ldb, ldb, min(128, N - col0), K, acc);
#pragma unroll
        for (int m = 0; m < 2; ++m)
#pragma unroll
            for (int n = 0; n < NTL; ++n) {
                const int col = col0 + wn * WTN + n * 32 + (lane & 31);
#pragma unroll
                for (int i = 0; i < 16; ++i) {
                    const int row = row0 + wm * 64 + m * 32 + (i & 3) + 8 * (i >> 2) + 4 * (lane >> 5);
                    epi(row, col, acc[m][n][i]);
                }
            }
    }
}

struct EpiBf16 { bf16_t* C; int ldc, N; __device__ __forceinline__ void operator()(int row, int col, float v) const { if (col < N) C[(size_t)row * ldc + col] = f2bf(v); } };
struct EpiRelu2 { bf16_t* C; int ldc; __device__ __forceinline__ void operator()(int row, int col, float v) const { v = fmaxf(v, 0.f); C[(size_t)row * ldc + col] = f2bf(v * v); } };
struct EpiResidOff { float* x; const float* gate; int roff; __device__ __forceinline__ void operator()(int row, int col, float v) const {
    const int r = row + roff; const float g = gate[mod_row(r) * 6144 + col]; float* p = x + (size_t)r * D + col; *p = *p + g * v; } };
struct EpiResid { float* x; const float* gate;   __device__ __forceinline__ void operator()(int row, int col, float v) const {
    const float g = gate[mod_row(row) * 6144 + col]; float* p = x + (size_t)row * D + col; *p = *p + g * v; } };

namespace pg8 {
#define PG8_LAS __attribute__((address_space(3)))
typedef unsigned short bf16_t;
typedef short bf16x8 __attribute__((ext_vector_type(8)));
typedef float f32x4 __attribute__((ext_vector_type(4)));
typedef unsigned u32x4 __attribute__((ext_vector_type(4)));
constexpr int BM = 256, BK = 64, HALF = 128, HTB = HALF * BK * 2  , STAGE_BYTES = 8 * HTB, NXCD = 8, WGM = 8;

__host__ __device__ __forceinline__ int lds_byte(int r, int c) { const int st = (r >> 4) * 2 + (c >> 5), rr = r & 15, cc = c & 31, ob = rr * 64 + cc * 2; return st * 1024 + (ob ^ (((ob >> 9) & 1) << 5)); }
__host__ __device__ __forceinline__ void stage_rc(int b, int& R, int& C) { const int st = b / 1024, sb = b % 1024, swz = sb ^ (((sb >> 9) & 1) << 5); R = (st >> 1) * 16 + swz / 64; C = (st & 1) * 32 + (swz % 64) / 2; }
__host__ __device__ __forceinline__ int perm32(int rho) { const int n = rho >> 4, i = rho & 15; return 8 * (i >> 2) + 4 * n + (i & 3); }

struct Unit { int pm, pn; };
struct Gemm { const bf16_t* A; const bf16_t* Bt; int M, N, K; size_t agrp; };

struct StaticOrder {
    int nM, nN, nwg, G, c;
    __host__ __device__ void init(int M, int N, int G_, int c_) { nM = M / BM; nN = N / BM; nwg = nM * nN; G = G_; c = c_; }
    __host__ __device__ bool next(int i, Unit& u) const {
        const long L = (long)i * G + c; if (L >= nwg) return false;
        int wgid = (int)L; { const int q = nwg / NXCD, r = nwg % NXCD, xcd = wgid % NXCD, off = wgid / NXCD; wgid = (xcd < r ? xcd * (q + 1) : r * (q + 1) + (xcd - r) * q) + off; }
        const int nig = WGM * nN, gid = wgid / nig, fm = gid * WGM, gsz = (nM - fm) < WGM ? (nM - fm) : WGM;
        u.pm = fm + ((wgid % nig) % gsz); u.pn = (wgid % nig) / gsz; return true;
    }
    __device__ __forceinline__ void a_ready(const Unit&) const {}
    __device__ __forceinline__ void done(const Unit&) const {}
};
__device__ __forceinline__ unsigned cvt_pk_bf16(float lo, float hi) { unsigned r; asm volatile("v_cvt_pk_bf16_f32 %0, %1, %2" : "=v"(r) : "v"(lo), "v"(hi)); return r; }
template <class Epi, class Sched, bool STAMP = false>
__device__ __forceinline__ void gemm_phase(PG8_LAS unsigned char* lds, const Gemm g, const Sched& S, const Epi& E, unsigned long long* stamps) {
    const int tid = otid(), wid = __builtin_amdgcn_readfirstlane(tid >> 6), lane = tid & 63, wr = wid >> 2, wc = wid & 3, fr = lane & 15, fq = lane >> 4;
    const int K = g.K, nt = K / BK;
    int ts_lo = 0, ts_hi = 0, nts = 0; const unsigned long long rt_entry = STAMP ? (unsigned long long)wall_clock64() : 0ull;
#define PG8_STAMP() do { if (STAMP && wid == 0 && nts < 64) { const unsigned long long _c = (unsigned long long)clock64(); \
        ts_lo = (lane == nts) ? (int)(unsigned)_c : ts_lo; ts_hi = (lane == nts) ? (int)(unsigned)(_c >> 32) : ts_hi; ++nts; } } while (0)
    PG8_STAMP();
    unsigned voffA[2], voffB[2];
#pragma unroll
    for (int i = 0; i < 2; ++i) { int R, C; stage_rc(tid * 16 + i * 8192, R, C); const int Rb = Epi::PERM ? ((R & ~31) + perm32(R & 31)) : R;
        voffA[i] = (unsigned)(R * K + C) * 2u; voffB[i] = (unsigned)(Rb * K + C) * 2u; }
    const size_t kstep = (size_t)(BK * 2);
    const size_t hstep = (size_t)HALF * K * 2;
    const size_t tstep = 2 * hstep;
    const unsigned ldsw = (unsigned)wid * 1024u;
    const int aoff = lds_byte(wr * 64 + fr, fq * 8), boff = lds_byte(wc * 32 + fr, fq * 8);
#define PG8_SA(b, h) (((b) * 2 + (h)) * HTB)
#define PG8_SB(b, h) ((4 + (b) * 2 + (h)) * HTB)
#define PG8_STAGE(bufoff, gbase, voff) do { _Pragma("unroll") for (int _i = 0; _i < 2; ++_i) \
        __builtin_amdgcn_global_load_lds((const unsigned*)((const char*)(gbase) + (voff)[_i]), (PG8_LAS unsigned*)(lds + (bufoff) + ldsw + _i * 8192), 16, 0, 0); } while (0)
#define PG8_LDA(dst, b, h) do { _Pragma("unroll") for (int m = 0; m < 4; ++m) _Pragma("unroll") for (int k = 0; k < 2; ++k) dst[m][k] = *(const PG8_LAS bf16x8*)(lds + PG8_SA(b, h) + aoff + m * 2048 + k * 1024); } while (0)
#define PG8_LDB(dst, b, h) do { _Pragma("unroll") for (int n = 0; n < 2; ++n) _Pragma("unroll") for (int k = 0; k < 2; ++k) dst[n][k] = *(const PG8_LAS bf16x8*)(lds + PG8_SB(b, h) + boff + n * 2048 + k * 1024); } while (0)
#define PG8_MMA(ai, bj, At, Bt) do { __builtin_amdgcn_s_setprio(1); _Pragma("unroll") for (int m = 0; m < 4; ++m) _Pragma("unroll") for (int n = 0; n < 2; ++n) _Pragma("unroll") for (int k = 0; k < 2; ++k) \
        acc[ai][bj][m][n] = __builtin_amdgcn_mfma_f32_16x16x32_bf16(Bt[n][k], At[m][k], acc[ai][bj][m][n], 0, 0, 0); __builtin_amdgcn_s_setprio(0); } while (0)
#define PG8_WAIT_V(n) asm volatile("s_waitcnt vmcnt(" #n ")" ::: "memory")
#define PG8_WAIT_L(n) asm volatile("s_waitcnt lgkmcnt(" #n ")" ::: "memory")
#define PG8_BAR __builtin_amdgcn_s_barrier()
#define PG8_SCHED __builtin_amdgcn_sched_barrier(0)
    Unit cur, nxt; int ui = 0;
    if (!S.next(0, cur)) return;
    f32x4 acc[2][2][4][2];
#pragma unroll
    for (int a = 0; a < 2; ++a)
#pragma unroll
        for (int b = 0; b < 2; ++b)
#pragma unroll
            for (int m = 0; m < 4; ++m)
#pragma unroll
                for (int n = 0; n < 2; ++n) acc[a][b][m][n] = (f32x4){0.f, 0.f, 0.f, 0.f};
    bf16x8 At[4][2], B0[2][2], B1[2][2];
    const char* cA = (const char*)g.A + (size_t)cur.pm * tstep + (size_t)(cur.pn >> 2) * g.agrp; const char* cB = (const char*)g.Bt + (size_t)cur.pn * tstep;
    S.a_ready(cur);
    PG8_STAGE(PG8_SB(0, 0), cB, voffB); PG8_STAGE(PG8_SA(0, 0), cA, voffA); PG8_STAGE(PG8_SB(0, 1), cB + hstep, voffB); PG8_STAGE(PG8_SA(0, 1), cA + hstep, voffA);
    if (wr == 1) PG8_BAR;
    PG8_WAIT_V(4); PG8_BAR;
    PG8_STAGE(PG8_SB(1, 0), cB + kstep, voffB); PG8_STAGE(PG8_SA(1, 0), cA + kstep, voffA); PG8_STAGE(PG8_SB(1, 1), cB + hstep + kstep, voffB);
    PG8_WAIT_V(6); PG8_BAR;
    PG8_STAMP();
    for (;;) {
        const bool has_next = S.next(ui + 1, nxt);
        const char* nA = has_next ? (const char*)g.A + (size_t)nxt.pm * tstep + (size_t)(nxt.pn >> 2) * g.agrp : cA; const char* nB = has_next ? (const char*)g.Bt + (size_t)nxt.pn * tstep : cB;
        for (int t = 0; t < nt; t += 2) {
            const bool last = (t == nt - 2);
            const char* a1 = cA + (size_t)(t + 1) * kstep;
            const char* a2 = last ? nA : cA + (size_t)(t + 2) * kstep; const char* b2 = last ? nB : cB + (size_t)(t + 2) * kstep;
            const char* a3 = a2 + kstep; const char* b3 = b2 + kstep;
            if (last && has_next) S.a_ready(nxt);
            PG8_LDB(B0, 0, 0); PG8_SCHED; PG8_LDA(At, 0, 0); PG8_STAGE(PG8_SA(1, 1), a1 + hstep, voffA);
            PG8_WAIT_L(8); PG8_BAR; PG8_WAIT_L(0); PG8_MMA(0, 0, At, B0); PG8_BAR; PG8_SCHED;
            PG8_LDB(B1, 0, 1); PG8_STAGE(PG8_SB(0, 0), b2, voffB);
            PG8_BAR; PG8_WAIT_L(0); PG8_MMA(0, 1, At, B1); PG8_BAR;
            PG8_LDA(At, 0, 1); PG8_STAGE(PG8_SA(0, 0), a2, voffA);
            PG8_BAR; PG8_WAIT_L(0); PG8_MMA(1, 0, At, B0); PG8_BAR; PG8_SCHED;
            PG8_STAGE(PG8_SB(0, 1), b2 + hstep, voffB);
            PG8_WAIT_V(6); PG8_BAR; PG8_MMA(1, 1, At, B1); PG8_BAR;
            PG8_LDB(B0, 1, 0); PG8_SCHED; PG8_LDA(At, 1, 0); PG8_STAGE(PG8_SA(0, 1), a2 + hstep, voffA);
            PG8_WAIT_L(8); PG8_BAR; PG8_WAIT_L(0); PG8_MMA(0, 0, At, B0); PG8_BAR; PG8_SCHED;
            PG8_LDB(B1, 1, 1); PG8_STAGE(PG8_SB(1, 0), b3, voffB);
            PG8_BAR; PG8_WAIT_L(0); PG8_MMA(0, 1, At, B1); PG8_BAR;
            PG8_LDA(At, 1, 1); PG8_STAGE(PG8_SA(1, 0), a3, voffA);
            PG8_BAR; PG8_WAIT_L(0); PG8_MMA(1, 0, At, B0); PG8_BAR; PG8_SCHED;
            PG8_STAGE(PG8_SB(1, 1), b3 + hstep, voffB);
            PG8_WAIT_V(6); PG8_BAR; PG8_MMA(1, 1, At, B1); PG8_BAR;
        }
        PG8_STAMP();
        if constexpr (!Epi::AFTER_DRAIN) { E(acc, cur, wr, wc, fr, fq); S.done(cur); }
        PG8_STAMP();
        if (!has_next) break;
#pragma unroll
        for (int a = 0; a < 2; ++a)
#pragma unroll
            for (int b = 0; b < 2; ++b)
#pragma unroll
                for (int m = 0; m < 4; ++m)
#pragma unroll
                    for (int n = 0; n < 2; ++n) acc[a][b][m][n] = (f32x4){0.f, 0.f, 0.f, 0.f};
        cur = nxt; cA = nA; cB = nB; ++ui;
    }
    PG8_WAIT_V(0);
    if (wr == 0) PG8_BAR;
    PG8_BAR;
    if constexpr (Epi::AFTER_DRAIN) { E.fused(acc, cur, wr, wc, fr, fq, lds, wid, lane); S.done(cur); }
    PG8_STAMP();
    if (STAMP && wid == 0) { stamps[lane] = lane < nts ? (((unsigned long long)(unsigned)ts_hi << 32) | (unsigned)ts_lo) : 0ull;
        if (lane == 62) stamps[62] = rt_entry; if (lane == 63) stamps[63] = (unsigned long long)wall_clock64(); }
#undef PG8_STAMP
#undef PG8_SA
#undef PG8_SB
#undef PG8_STAGE
#undef PG8_LDA
#undef PG8_LDB
#undef PG8_MMA
#undef PG8_WAIT_V
#undef PG8_WAIT_L
#undef PG8_BAR
#undef PG8_SCHED
}
}

struct PEpiBf16 {
    static constexpr bool PERM = true, AFTER_DRAIN = false;
    bf16_t* C; int ldc, N, act;
    __device__ __forceinline__ void operator()(const pg8::f32x4 (&acc)[2][2][4][2], const pg8::Unit& u, int wr, int wc, int fr, int fq) const {
        const int row0 = u.pm * 256 + wr * 64 + fr, col0 = u.pn * 256 + wc * 32 + 8 * fq;
#pragma unroll
        for (int ai = 0; ai < 2; ++ai)
#pragma unroll
            for (int m = 0; m < 4; ++m) {
                bf16_t* rowp = C + (size_t)(row0 + ai * 128 + m * 16) * ldc;
#pragma unroll
                for (int bj = 0; bj < 2; ++bj) {
                    const int col = col0 + bj * 128;
                    pg8::f32x4 v0 = acc[ai][bj][m][0], v1 = acc[ai][bj][m][1];
                    if (act == 1) { v0.x = fmaxf(v0.x, 0.f); v0.y = fmaxf(v0.y, 0.f); v0.z = fmaxf(v0.z, 0.f); v0.w = fmaxf(v0.w, 0.f); v0 = v0 * v0;
                                    v1.x = fmaxf(v1.x, 0.f); v1.y = fmaxf(v1.y, 0.f); v1.z = fmaxf(v1.z, 0.f); v1.w = fmaxf(v1.w, 0.f); v1 = v1 * v1; }
                    if (act == 2) { v0.x = sigmoidf_(v0.x); v0.y = sigmoidf_(v0.y); v0.z = sigmoidf_(v0.z); v0.w = sigmoidf_(v0.w);
                                    v1.x = sigmoidf_(v1.x); v1.y = sigmoidf_(v1.y); v1.z = sigmoidf_(v1.z); v1.w = sigmoidf_(v1.w); }
                    u32x4 w; w.x = pk2(v0.x, v0.y); w.y = pk2(v0.z, v0.w); w.z = pk2(v1.x, v1.y); w.w = pk2(v1.z, v1.w);
                    if (col < N) *(u32x4*)(rowp + col) = w;
                }
            }
    }
};
struct PEpiResid {
    static constexpr bool PERM = true, AFTER_DRAIN = false;
    float* x; const float* gate;
    __device__ __forceinline__ void operator()(const pg8::f32x4 (&acc)[2][2][4][2], const pg8::Unit& u, int wr, int wc, int fr, int fq) const {
        const int row0 = u.pm * 256 + wr * 64 + fr, col0 = u.pn * 256 + wc * 32 + 8 * fq;
#pragma unroll
        for (int ai = 0; ai < 2; ++ai)
#pragma unroll
            for (int m = 0; m < 4; ++m) {
                const int row = row0 + ai * 128 + m * 16;
                float* rowp = x + (size_t)row * D; const float* gp = gate + (size_t)mod_row(row) * 6144;
#pragma unroll
                for (int bj = 0; bj < 2; ++bj) {
                    const int col = col0 + bj * 128;
                    const f32x4 g0 = *(const f32x4*)(gp + col), g1 = *(const f32x4*)(gp + col + 4);
                    f32x4 x0 = *(const f32x4*)(rowp + col), x1 = *(const f32x4*)(rowp + col + 4);
                    x0 = x0 + g0 * acc[ai][bj][m][0]; x1 = x1 + g1 * acc[ai][bj][m][1];
                    *(f32x4*)(rowp + col) = x0; *(f32x4*)(rowp + col + 4) = x1;
                }
            }
    }
};
struct PEpiGate {
    static constexpr bool PERM = true, AFTER_DRAIN = false;
    bf16_t* G; int ldc;
    __device__ __forceinline__ void operator()(const pg8::f32x4 (&acc)[2][2][4][2], const pg8::Unit& u, int wr, int wc, int fr, int fq) const {
        const int row0 = u.pm * 256 + wr * 64 + fr, col0 = u.pn * 256 + wc * 32 + 8 * fq;
#pragma unroll
        for (int ai = 0; ai < 2; ++ai)
#pragma unroll
            for (int m = 0; m < 4; ++m) {
                bf16_t* rowp = G + (size_t)(row0 + ai * 128 + m * 16) * ldc;
#pragma unroll
                for (int bj = 0; bj < 2; ++bj) {
                    const int col = col0 + bj * 128;
                    const u32x4 g = *(const u32x4*)(rowp + col);
                    const pg8::f32x4 v0 = acc[ai][bj][m][0], v1 = acc[ai][bj][m][1];
                    u32x4 w; w.x = pk2(bflo(g.x) * v0.x, bfhi(g.x) * v0.y); w.y = pk2(bflo(g.y) * v0.z, bfhi(g.y) * v0.w);
                    w.z = pk2(bflo(g.z) * v1.x, bfhi(g.z) * v1.y); w.w = pk2(bflo(g.w) * v1.z, bfhi(g.w) * v1.w);
                    *(u32x4*)(rowp + col) = w;
                }
            }
    }
};
__device__ __forceinline__ void sum3_phase(const Params& p) {
    const bf16_t* Y = (const bf16_t*)(p.ws + WS_PROJ); bf16_t* merged = (bf16_t*)(p.ws + WS_ST);
    for (size_t i = (size_t)blockIdx.x * 512 + otid(); i < (size_t)NTOK * (D / 8); i += (size_t)gridDim.x * 512) {
        const size_t row = i >> 7; const int c8 = (int)(i & 127) * 8;
        const bf16_t* yr = Y + row * NGATE + c8;
        const u32x4 a = *(const u32x4*)yr, b = *(const u32x4*)(yr + 1024), c = *(const u32x4*)(yr + 2048);
        u32x4 w; w.x = pk2(bflo(a.x) + bflo(b.x) + bflo(c.x), bfhi(a.x) + bfhi(b.x) + bfhi(c.x)); w.y = pk2(bflo(a.y) + bflo(b.y) + bflo(c.y), bfhi(a.y) + bfhi(b.y) + bfhi(c.y));
        w.z = pk2(bflo(a.z) + bflo(b.z) + bflo(c.z), bfhi(a.z) + bfhi(b.z) + bfhi(c.z)); w.w = pk2(bflo(a.w) + bflo(b.w) + bflo(c.w), bfhi(a.w) + bfhi(b.w) + bfhi(c.w));
        *(u32x4*)(merged + row * D + c8) = w;
    }
}
template <class Epi>
__device__ __forceinline__ void pg8_gemm(LAS unsigned char* lds, const bf16_t* A, const bf16_t* Bt, int M, int N, int K, const Epi& e, size_t agrp = 0) {
    pg8::Gemm g{A, Bt, M, N, K, agrp};
    pg8::StaticOrder so; so.init(M, N, (int)gridDim.x, (int)blockIdx.x);
    pg8::gemm_phase<Epi, pg8::StaticOrder, false>(lds, g, so, e, nullptr);
    __syncthreads();
}

__device__ __forceinline__ void grid_barrier(unsigned* bar, unsigned k) {
    asm volatile("s_waitcnt vmcnt(0)" ::: "memory");
    __syncthreads();
    if (otid() == 0) {
        const unsigned g = blockIdx.x & 7u, ng = (gridDim.x + 7u - g) >> 3;
        __builtin_amdgcn_fence(__ATOMIC_RELEASE, "agent");
        asm volatile("s_waitcnt vmcnt(0)" ::: "memory");
        const unsigned c = __hip_atomic_fetch_add(bar + 16 * g, 1u, __ATOMIC_RELAXED, __HIP_MEMORY_SCOPE_AGENT);
        if (c == ng * k - 1u) {
            const unsigned ngroups = gridDim.x < 8u ? gridDim.x : 8u;
            const unsigned t = __hip_atomic_fetch_add(bar + 128, 1u, __ATOMIC_RELAXED, __HIP_MEMORY_SCOPE_AGENT);
            if (t == ngroups * k - 1u)
                for (unsigned j = 0; j < ngroups; ++j) __hip_atomic_store(bar + 144 + 16 * j, k, __ATOMIC_RELAXED, __HIP_MEMORY_SCOPE_AGENT);
        }
        unsigned spins = 0;
        while (__hip_atomic_load(bar + 144 + 16 * g, __ATOMIC_RELAXED, __HIP_MEMORY_SCOPE_AGENT) < k && ++spins < (1u << 28)) __builtin_amdgcn_s_sleep(1);
        __builtin_amdgcn_fence(__ATOMIC_ACQUIRE, "agent");
        asm volatile("s_waitcnt vmcnt(0)" ::: "memory");
    }
    __syncthreads();
}

__device__ __forceinline__ void transpose_item(const float* __restrict__ W, int N, int K, int k0, int n0, bf16_t* __restrict__ dst  , LAS float* scr, int lane) {
    {
        const int kr = lane >> 3, c4 = (lane & 7) * 4;
        f32x4 v[8];
#pragma unroll
        for (int i = 0; i < 8; ++i) v[i] = *(const f32x4*)(W + (size_t)(k0 + i * 8 + kr) * N + n0 + c4);
#pragma unroll
        for (int i = 0; i < 8; ++i) { LAS float* d = scr + (i * 8 + kr) * 33 + c4; d[0] = v[i].x; d[1] = v[i].y; d[2] = v[i].z; d[3] = v[i].w; }
    }
    LDS_WAIT();
    const int c = lane & 7;
#pragma unroll
    for (int j = 0; j < 4; ++j) {
        const int n = (lane >> 3) + 8 * j; const LAS float* s = scr + (8 * c) * 33 + n;
        u32x4 o; o.x = pk2(s[0 * 33], s[1 * 33]); o.y = pk2(s[2 * 33], s[3 * 33]); o.z = pk2(s[4 * 33], s[5 * 33]); o.w = pk2(s[6 * 33], s[7 * 33]);
        *(u32x4*)(dst + (size_t)n * K + k0 + 8 * c) = o;
    }
    LDS_WAIT();
}

constexpr int CONV_NIT = 16 * 257 + 3 * 8 * 32 + 16 * 32 + 16 * 128 + 64 * 32, CONV_BLOCK_ITEMS = (CONV_NIT + 7) / 8;
constexpr int CONV_IN_P2 = 112 * 2, CONV_IN_P4 = 64 * 4, CONV_IN_GEMM = CONV_IN_P2 + CONV_IN_P4;
__device__ __forceinline__ void convert_weights(const Params& p, int l, LAS unsigned char* lds, int bitem = -1) {
    const int lane = otid() & 63, wid = otid() >> 6;
    LAS float* scr = (LAS float*)(lds + wid * 16384);
    unsigned char* wb = p.ws + WS_W + (size_t)(l & 1) * W_END;
    constexpr int I_IN = 16 * 257, I_BR = 8 * 32, I_OUT = 16 * 32, I_FF1 = 16 * 128, I_FF2 = 64 * 32;
    constexpr int NIT = I_IN + 3 * I_BR + I_OUT + I_FF1 + I_FF2;
    for (int it = (bitem < 0 ? blockIdx.x * 8 + wid : bitem * 8 + wid); it < NIT; it += (bitem < 0 ? gridDim.x * 8 : NIT)) {
        int r = it;
        if (r < I_IN) { const int kb = r / 257, nb = r % 257, n0 = nb * 32;
            bf16_t* dst = n0 < NPROJ ? (bf16_t*)(wb + W_IN) + (size_t)n0 * D : (bf16_t*)(wb + W_G) + (size_t)(n0 - NPROJ) * D;
            transpose_item(p.w_in + (size_t)l * D * DIN, DIN, D, kb * 64, n0, dst, scr, lane); continue; }
        r -= I_IN;
        if (r < 3 * I_BR) { const int b = r / I_BR, q = r % I_BR, kb = q / 32, nb = q % 32;
            const float* W = (b == 0 ? p.w_br_gla : b == 1 ? p.w_br_hg : p.w_br_gm) + (size_t)l * 512 * D;
            transpose_item(W, D, 512, kb * 64, nb * 32, (bf16_t*)(wb + W_BR) + (size_t)b * D * 512 + (size_t)nb * 32 * 512, scr, lane); continue; }
        r -= 3 * I_BR;
        if (r < I_OUT) { const int kb = r / 32, nb = r % 32;
            transpose_item(p.w_out + (size_t)l * D * D, D, D, kb * 64, nb * 32, (bf16_t*)(wb + W_OUT) + (size_t)nb * 32 * D, scr, lane); continue; }
        r -= I_OUT;
        if (r < I_FF1) { const int kb = r / 128, nb = r % 128;
            transpose_item(p.w_ff1 + (size_t)l * D * DFF, DFF, D, kb * 64, nb * 32, (bf16_t*)(wb + W_FF1) + (size_t)nb * 32 * D, scr, lane); continue; }
        r -= I_FF1;
        { const int kb = r / 32, nb = r % 32;
            transpose_item(p.w_ff2 + (size_t)l * DFF * D, D, DFF, kb * 64, nb * 32, (bf16_t*)(wb + W_FF2) + (size_t)nb * 32 * DFF, scr, lane); }
    }
}

__device__ __forceinline__ void phase0(const Params& p, LAS unsigned char* lds) {
    const int tid = otid();
    float* x = p.out;
    for (size_t i = (size_t)blockIdx.x * 512 + tid; i < (size_t)NTOK * (D / 4); i += (size_t)gridDim.x * 512) {
        const int tok = (int)(i >> 8), c4 = (int)(i & 255) * 4;
        f32x4 v;
        if (tok < NCTX) v = *(const f32x4*)(p.x_prompt + (size_t)tok * D + c4);
        else {
            const int lt = tok - NCTX; v = *(const f32x4*)(p.x_sample + (size_t)lt * D + c4);
            const int t = lt & 2047; const float rr = (float)(t >> 6), cc = (float)(t & 63);
            const int sec = c4 >> 8; const float pos = sec < 2 ? rr : cc;
#pragma unroll
            for (int j = 0; j < 4; ++j) {
                const int f = (c4 + j) & 255;
                const float omega = exp2f((float)f * (-13.287712379549449f / 256.0f));
                const float a = pos * omega;
                v[j] += (sec & 1) ? __cosf(a) : __sinf(a);
            }
        }
        *(f32x4*)(x + i * 4) = v;
    }
    if (blockIdx.x == 0) {
        float* lbs = (float*)(p.ws + WS_LBS);
        for (int i = tid; i < 1024; i += 512) {
            const int dir = i >> 9, ch = i & 511; float lg[4], mx = -1e30f;
            for (int l = 0; l < 4; ++l) { lg[l] = p.hg_lb_logits[(size_t)(dir * 4 + l) * 512 + ch]; mx = fmaxf(mx, lg[l]); }
            float s = 0.f; for (int l = 0; l < 4; ++l) { lg[l] = expf(lg[l] - mx); s += lg[l]; }
            float cum = 0.f, c0 = 0.f;
            for (int l = 0; l < 4; ++l) { cum += lg[l] / s; if (l == 0) c0 = cum; lbs[(size_t)(dir * 4 + l) * 512 + ch] = cum - c0; }
        }
        for (int i = tid; i < 1024; i += 512) ((unsigned*)(p.ws + WS_CTR))[i] = 0u;
    }
    LAS float* sc = (LAS float*)lds;
    LAS float* red = sc + 9 * 1024;
    for (int i = tid; i < 9 * 1024; i += 512) { const int r = i >> 10, k = i & 1023; const float v = r == 0 ? p.c_ctx[k] : p.c[(size_t)(r - 1) * D + k]; sc[i] = siluf_(v); }
    __syncthreads();
    float* mod = (float*)(p.ws + WS_MOD);
    for (int u = blockIdx.x; u < DEPTH * 48; u += gridDim.x) {
        const int l = u / 48, cb = u % 48, cl = tid & 127, kp = tid >> 7, n = cb * 128 + cl;
        const float* w = p.ada_w + (size_t)l * D * 6144 + n;
        float a[9];
#pragma unroll
        for (int r = 0; r < 9; ++r) a[r] = 0.f;
#pragma unroll 4
        for (int k = kp * 256; k < kp * 256 + 256; ++k) {
            const float wv = w[(size_t)k * 6144];
#pragma unroll
            for (int r = 0; r < 9; ++r) a[r] += sc[r * 1024 + k] * wv;
        }
#pragma unroll
        for (int r = 0; r < 9; ++r) red[(kp * 9 + r) * 128 + cl] = a[r];
        __syncthreads();
        for (int i = tid; i < 9 * 128; i += 512) {
            const int r = i >> 7, c2 = i & 127;
            const float s = red[(0 * 9 + r) * 128 + c2] + red[(1 * 9 + r) * 128 + c2] + red[(2 * 9 + r) * 128 + c2] + red[(3 * 9 + r) * 128 + c2];
            mod[((size_t)l * 9 + r) * 6144 + cb * 128 + c2] = s + p.ada_b[(size_t)l * 6144 + cb * 128 + c2];
        }
        __syncthreads();
    }
}

__device__ __forceinline__ void norm_phase(const Params& p, const float* g, const float* mod_l, int off_sh, int off_sc, bf16_t* hout, int mode) {
    const int lane = otid() & 63, wid = otid() >> 6;
    float* x = p.out;
    for (int row = blockIdx.x * 8 + wid; row < NTOK; row += gridDim.x * 8) {
        f32x4 v[4]; float s = 0.f;
        float* xr = x + (size_t)row * D;
#pragma unroll
        for (int j = 0; j < 4; ++j) { v[j] = *(const f32x4*)(xr + lane * 4 + 256 * j); s += v[j].x * v[j].x + v[j].y * v[j].y + v[j].z * v[j].z + v[j].w * v[j].w; }
        const float rstd = rsqrtf(wave_sum(s) * (1.0f / D) + EPS);
        if (mode == 0) {
            const float* mr = mod_l + (size_t)mod_row(row) * 6144;
#pragma unroll
            for (int j = 0; j < 4; ++j) {
                const int c = lane * 4 + 256 * j;
                const f32x4 gg = *(const f32x4*)(g + c), sh = *(const f32x4*)(mr + off_sh + c), scv = *(const f32x4*)(mr + off_sc + c);
                const f32x4 o = (v[j] * rstd) * gg * (scv + 1.0f) + sh;
                u32x2 w; w.x = pk2(o.x, o.y); w.y = pk2(o.z, o.w);
                *(u32x2*)(hout + (size_t)row * D + c) = w;
            }
        } else {
#pragma unroll
            for (int j = 0; j < 4; ++j) { const int c = lane * 4 + 256 * j; const f32x4 gg = *(const f32x4*)(g + c); *(f32x4*)(xr + c) = (v[j] * rstd) * gg; }
        }
    }
}

template <int MIX>
__device__ __forceinline__ void gate_eval(const bf16_t* row, int kcol, int zcol, const float (&lrw)[16], float lrb, float lb, float& gt, float& kt) {
    if (!MIX) {
        const bf16_t* zr = row + zcol;
        const u32x4 z0 = *(const u32x4*)zr, z1 = *(const u32x4*)(zr + 8);
        float z = lrb;
        z += bflo(z0.x) * lrw[0] + bfhi(z0.x) * lrw[1] + bflo(z0.y) * lrw[2] + bfhi(z0.y) * lrw[3] + bflo(z0.z) * lrw[4] + bfhi(z0.z) * lrw[5] + bflo(z0.w) * lrw[6] + bfhi(z0.w) * lrw[7];
        z += bflo(z1.x) * lrw[8] + bfhi(z1.x) * lrw[9] + bflo(z1.y) * lrw[10] + bfhi(z1.y) * lrw[11] + bflo(z1.z) * lrw[12] + bfhi(z1.z) * lrw[13] + bflo(z1.w) * lrw[14] + bfhi(z1.w) * lrw[15];
        gt = logsigmoidf_(z) * (1.0f / 16.0f);
        kt = bf2f(row[kcol]);
    } else {
        const float xf = bf2f(row[kcol]);
        const float sg = sigmoidf_(xf);
        gt = flog_(lb + (1.0f - lb) * sg);
        kt = (1.0f - lb) * (1.0f - sg);
    }
}

template <int MIX>
__device__ __forceinline__ void gate_raw(unsigned kraw, const u32x4& z0, const u32x4& z1, const float (&lrw)[16], float lrb, float lb, float& gt, float& kt) {
    if (!MIX) {
        float z = lrb;
        z += bflo(z0.x) * lrw[0] + bfhi(z0.x) * lrw[1] + bflo(z0.y) * lrw[2] + bfhi(z0.y) * lrw[3] + bflo(z0.z) * lrw[4] + bfhi(z0.z) * lrw[5] + bflo(z0.w) * lrw[6] + bfhi(z0.w) * lrw[7];
        z += bflo(z1.x) * lrw[8] + bfhi(z1.x) * lrw[9] + bflo(z1.y) * lrw[10] + bfhi(z1.y) * lrw[11] + bflo(z1.z) * lrw[12] + bfhi(z1.z) * lrw[13] + bflo(z1.w) * lrw[14] + bfhi(z1.w) * lrw[15];
        gt = logsigmoidf_(z) * (1.0f / 16.0f);
        kt = bflo(kraw);
    } else {
        const float xf = bflo(kraw);
        const float sg = sigmoidf_(xf);
        gt = flog_(lb + (1.0f - lb) * sg);
        kt = (1.0f - lb) * (1.0f - sg);
    }
}

template <int MIX>
__device__ __forceinline__ void scan_job(const Params& p, int l, int s, int dir, int hd, LAS unsigned char* lds) {
    constexpr int DK = MIX ? 128 : 64, WM = DK / 32, WN = 8 / WM, WTN = 128 / WN, NTL = WTN / 32, LDT = 72, LDG = DK + 1;
    LAS bf16_t* At = (LAS bf16_t*)lds;
    LAS bf16_t* Bt = At + 128 * LDT;
    LAS float* dec = (LAS float*)(lds + 2 * 128 * LDT * 2);
    LAS float* G = dec + 128;
    LAS float* KK = G + 64 * 129;
    const int tid = otid(), lane = tid & 63, wid = tid >> 6, wm = wid / WN, wn = wid % WN;
    const bool ctx = s < 16;
    const int T = ctx ? 256 : 2048, tok0 = ctx ? s * 256 : NCTX + (s - 16) * 2048, nch = T / 64;
    const bf16_t* proj = (const bf16_t*)(p.ws + WS_PROJ);
    const float* lbs = (const float*)(p.ws + WS_LBS);
    bf16_t* sbuf = (bf16_t*)(p.ws + WS_ST + (MIX ? ST_GLA_BYTES : 0));
    f32x16 S[1][NTL];
    {
        const float* st0 = ctx ? nullptr : (MIX ? p.state_hgrn + ((((size_t)(s - 16) * DEPTH + l) * 2 + dir) * 4 + hd) * 128 * 128
                                                : p.state_gla + ((((size_t)(s - 16) * DEPTH + l) * 2 + dir) * 4 + hd) * 64 * 128);
#pragma unroll
        for (int n = 0; n < NTL; ++n)
#pragma unroll
            for (int i = 0; i < 16; ++i) {
                const int d = wm * 32 + (i & 3) + 8 * (i >> 2) + 4 * (lane >> 5), v = wn * WTN + n * 32 + (lane & 31);
                S[0][n][i] = ctx ? 0.f : st0[(size_t)d * 128 + v];
            }
    }
    const int sd = tid & (DK - 1), t0 = tid / DK; constexpr int TS = 512 / DK;
    float lrw[16]; float lrb = 0.f, lb = 0.f;
    if (!MIX) {
#pragma unroll
        for (int r = 0; r < 16; ++r) lrw[r] = p.gla_lr_w[(((size_t)l * 2 + dir) * 16 + r) * 256 + hd * 64 + sd];
        lrb = p.gla_lr_b[((size_t)l * 2 + dir) * 256 + hd * 64 + sd];
    } else {
#pragma unroll
        for (int r = 0; r < 16; ++r) lrw[r] = 0.f;
        lb = lbs[(size_t)(dir * 4 + l) * 512 + hd * 128 + sd];
    }
    const int kcol = MIX ? (dir ? PJ_HFB : PJ_HFF) + hd * 128 + sd : PJ_GK + hd * 64 + sd;
    const int zcol = dir ? PJ_GZB : PJ_GZF;
    const int vv = tid & 127, vq = tid >> 7;
    const int vcol = (MIX ? PJ_HI : PJ_GV) + hd * 128 + vv;
    const int kd = tid >> 2, kq = tid & 3;
    const bool k2 = tid < 4 * DK;

    constexpr int NE = 64 / TS;
    unsigned kraw[NE]; unsigned vraw[8];
    const int widu = __builtin_amdgcn_readfirstlane(tid >> 6), gmt = (widu >> 1) & 1, gnt = widu & 1;
    bf16x8 gafr = {0, 0, 0, 0, 0, 0, 0, 0}; u32x4 gbw = {0u, 0u, 0u, 0u}; float gbias = 0.f;
    if (!MIX && widu < 4) {
        const float* lw = p.gla_lr_w + (((size_t)l * 2 + dir) * 16 + 8 * (lane >> 5)) * 256 + hd * 64 + gnt * 32 + (lane & 31);
        float wv[8];
#pragma unroll
        for (int j = 0; j < 8; ++j) wv[j] = lw[(size_t)j * 256];
        gbw.x = pk2(wv[0], wv[1]); gbw.y = pk2(wv[2], wv[3]); gbw.z = pk2(wv[4], wv[5]); gbw.w = pk2(wv[6], wv[7]);
        gbias = p.gla_lr_b[((size_t)l * 2 + dir) * 256 + hd * 64 + gnt * 32 + (lane & 31)];
    }
    auto load_chunk = [&](const bf16_t* prc) {
#pragma unroll
        for (int i = 0; i < NE; ++i) {
            const bf16_t* row = prc + (size_t)(t0 + TS * i) * NPROJ;
            kraw[i] = row[kcol];
        }
        if (!MIX && widu < 4) gafr = *(const bf16x8*)(prc + (size_t)(gmt * 32 + (lane & 31)) * NPROJ + zcol + 8 * (lane >> 5));
#pragma unroll
        for (int t = 0; t < 16; t += 2) {
            const unsigned a = prc[(size_t)(vq * 16 + t) * NPROJ + vcol], b = prc[(size_t)(vq * 16 + t + 1) * NPROJ + vcol];
            vraw[t >> 1] = a | (b << 16);
        }
    };
    auto store_state = [&](int gcs) {
        bf16_t* sb = sbuf + (((size_t)gcs * 2 + dir) * 4 + hd) * 128 * DK;
#pragma unroll
        for (int nn = 0; nn < NTL; ++nn)
#pragma unroll
            for (int q = 0; q < 4; ++q) {
                const int d0 = wm * 32 + 8 * q + 4 * (lane >> 5), v = wn * WTN + nn * 32 + (lane & 31);
                u32x2 w; w.x = pk2(S[0][nn][4 * q + 0], S[0][nn][4 * q + 1]); w.y = pk2(S[0][nn][4 * q + 2], S[0][nn][4 * q + 3]);
                *(u32x2*)(sb + (size_t)v * DK + d0) = w;
            }
    };
    load_chunk(proj + (size_t)(tok0 + (dir ? nch - 1 : 0) * 64) * NPROJ);
    store_state((tok0 >> 6) + (dir ? nch - 1 : 0));
    for (int n = 0; n < nch; ++n) {
        if (MIX) {
#pragma unroll
            for (int i = 0; i < NE; ++i) {
                const int t = t0 + TS * i; float gt, kt; const u32x4 zz = {0u, 0u, 0u, 0u};
                gate_raw<MIX>(kraw[i], zz, zz, lrw, lrb, lb, gt, kt);
                G[t * LDG + sd] = gt; KK[t * LDG + sd] = kt;
            }
        } else {
#pragma unroll
            for (int i = 0; i < NE; ++i) KK[(t0 + TS * i) * LDG + sd] = bflo(kraw[i]);
            if (widu < 4) {
                f32x16 zacc;
#pragma unroll
                for (int i = 0; i < 16; ++i) zacc[i] = 0.f;
                zacc = __builtin_amdgcn_mfma_f32_32x32x16_bf16(gafr, __builtin_bit_cast(bf16x8, gbw), zacc, 0, 0, 0);
#pragma unroll
                for (int i = 0; i < 16; ++i)
                    G[(gmt * 32 + (i & 3) + 8 * (i >> 2) + 4 * (lane >> 5)) * LDG + gnt * 32 + (lane & 31)] = logsigmoidf_(zacc[i] + gbias) * (1.0f / 16.0f);
            }
        }
#pragma unroll
        for (int q = 0; q < 2; ++q) { u32x4 w; w.x = vraw[4 * q]; w.y = vraw[4 * q + 1]; w.z = vraw[4 * q + 2]; w.w = vraw[4 * q + 3]; *(LAS u32x4*)(Bt + vv * LDT + vq * 16 + q * 8) = w; }
        if (n + 1 < nch) load_chunk(proj + (size_t)(tok0 + (dir ? nch - 2 - n : n + 1) * 64) * NPROJ);
        __syncthreads();
        if (k2) {
            float g[16]; float qs = 0.f;
#pragma unroll
            for (int t = 0; t < 16; ++t) { g[t] = G[(kq * 16 + t) * LDG + kd]; qs += g[t]; }
            const int lb4 = lane & ~3;
            const float s0 = __shfl(qs, lb4), s1 = __shfl(qs, lb4 + 1), s2 = __shfl(qs, lb4 + 2), s3 = __shfl(qs, lb4 + 3);
            const float total = (s0 + s1) + (s2 + s3);
            float pref = (kq > 0 ? s0 : 0.f) + (kq > 1 ? s1 : 0.f) + (kq > 2 ? s2 : 0.f);
            unsigned pkv[8];
#pragma unroll
            for (int t = 0; t < 16; ++t) {
                const float pe = pref; pref += g[t];
                const float w = dir ? pe : total - pref;
                const float kv = KK[(kq * 16 + t) * LDG + kd] * fexp_(w);
                if (t & 1) pkv[t >> 1] = pk2(__uint_as_float(pkv[t >> 1]), kv); else pkv[t >> 1] = __float_as_uint(kv);
            }
#pragma unroll
            for (int q = 0; q < 2; ++q) { u32x4 w; w.x = pkv[4 * q]; w.y = pkv[4 * q + 1]; w.z = pkv[4 * q + 2]; w.w = pkv[4 * q + 3]; *(LAS u32x4*)(At + kd * LDT + kq * 16 + q * 8) = w; }
            if (kq == 0) dec[kd] = fexp_(total);
        }
        __syncthreads();
#pragma unroll
        for (int nn = 0; nn < NTL; ++nn)
#pragma unroll
            for (int i = 0; i < 16; ++i) S[0][nn][i] *= dec[wm * 32 + (i & 3) + 8 * (i >> 2) + 4 * (lane >> 5)];
        mma_lds<1, NTL, 4>(S, At + wm * 32 * LDT, LDT, Bt + wn * WTN * LDT, LDT, lane);
        if (n + 1 < nch) store_state((tok0 >> 6) + (dir ? nch - 2 - n : n + 1));
        __syncthreads();
    }
    if (ctx) {
        float* o = MIX ? p.out + (size_t)NTOK * D + (size_t)16 * DEPTH * 2 * 4 * 64 * 128 + ((((size_t)s * DEPTH + l) * 2 + dir) * 4 + hd) * 128 * 128
                       : p.out + (size_t)NTOK * D + ((((size_t)s * DEPTH + l) * 2 + dir) * 4 + hd) * 64 * 128;
#pragma unroll
        for (int nn = 0; nn < NTL; ++nn)
#pragma unroll
            for (int i = 0; i < 16; ++i) {
                const int d = wm * 32 + (i & 3) + 8 * (i >> 2) + 4 * (lane >> 5), v = wn * WTN + nn * 32 + (lane & 31);
                o[(size_t)d * 128 + v] = S[0][nn][i];
            }
    }
}


__device__ __forceinline__ void gmlp_item(const Params& p, int l, int c2, int g, LAS unsigned char* lds) {
    constexpr int LDT = 136;
    LAS bf16_t* Aw = (LAS bf16_t*)lds;
    LAS bf16_t* Bt = Aw + 128 * LDT;
    const int tid = otid(), lane = tid & 63, wid = tid >> 6, wm = wid >> 2, wn = wid & 3;
    const bf16_t* proj = (const bf16_t*)(p.ws + WS_PROJ);
    const int tokb = c2 * 128;
    {
        const float* wsrc = p.gm_ws + ((size_t)l * 4 + g) * 128 * 128;
#pragma unroll
        for (int i = 0; i < 8; ++i) {
            const int e = (i * 512 + tid) * 4, pp = e >> 7, q = e & 127;
            const f32x4 v = *(const f32x4*)(wsrc + e);
            u32x2 w; w.x = pk2(v.x, v.y); w.y = pk2(v.z, v.w);
            *(LAS u32x2*)(Aw + pp * LDT + q) = w;
        }
    }
    {
        const int q = tid >> 2, part = tid & 3;
        const bf16_t* mv = proj + (size_t)(tokb + q) * NPROJ + PJ_MV;
        float ggv[32];
        {
            const float* ggp = p.gm_norm_g + (size_t)l * 512 + g * 128 + part * 32;
#pragma unroll
            for (int i = 0; i < 8; ++i) { const f32x4 t4 = *(const f32x4*)(ggp + 4 * i); ggv[4 * i] = t4.x; ggv[4 * i + 1] = t4.y; ggv[4 * i + 2] = t4.z; ggv[4 * i + 3] = t4.w; }
        }
        float s = 0.f, s2 = 0.f;
#pragma unroll
        for (int i = 0; i < 16; ++i) {
            const u32x4 u = *(const u32x4*)(mv + (i * 4 + part) * 8);
            const unsigned uu[4] = {u.x, u.y, u.z, u.w};
#pragma unroll
            for (int j = 0; j < 4; ++j) { const float a = geluf_(bflo(uu[j])), b = geluf_(bfhi(uu[j])); s += a + b; s2 += a * a + b * b; }
        }
        s += __shfl_xor(s, 1); s += __shfl_xor(s, 2); s2 += __shfl_xor(s2, 1); s2 += __shfl_xor(s2, 2);
        const float mean = s * (1.0f / 512.0f), var = fmaxf(s2 * (1.0f / 512.0f) - mean * mean, 0.f), rstd = rsqrtf(var + EPS);
        const bf16_t* mvg = mv + g * 128 + part * 32;
#pragma unroll
        for (int i = 0; i < 4; ++i) {
            const u32x4 u = *(const u32x4*)(mvg + i * 8);
            const unsigned uu[4] = {u.x, u.y, u.z, u.w};
#pragma unroll
            for (int j = 0; j < 4; ++j) {
                const int c = part * 32 + i * 8 + j * 2;
                const float a = (geluf_(bflo(uu[j])) - mean) * rstd * ggv[i * 8 + j * 2], b = (geluf_(bfhi(uu[j])) - mean) * rstd * ggv[i * 8 + j * 2 + 1];
                Bt[c * LDT + q] = f2bf(a); Bt[(c + 1) * LDT + q] = f2bf(b);
            }
        }
    }
    const float* bs = p.gm_bs + ((size_t)l * 4 + g) * 128;
    bf16_t muv[2][16]; float bsv[2][16];
#pragma unroll
    for (int m = 0; m < 2; ++m)
#pragma unroll
        for (int i = 0; i < 16; ++i) {
            const int pp = wm * 64 + m * 32 + (i & 3) + 8 * (i >> 2) + 4 * (lane >> 5), c = wn * 32 + (lane & 31);
            muv[m][i] = proj[(size_t)(tokb + pp) * NPROJ + PJ_MU + g * 128 + c]; bsv[m][i] = bs[pp];
        }
    __syncthreads();
    f32x16 acc[2][1]; acc_zero<1>(acc);
    mma_lds<2, 1, 8>(acc, Aw + wm * 64 * LDT, LDT, Bt + wn * 32 * LDT, LDT, lane);
    bf16_t* ocat = (bf16_t*)(p.ws + WS_OCAT);
#pragma unroll
    for (int m = 0; m < 2; ++m)
#pragma unroll
        for (int i = 0; i < 16; ++i) {
            const int pp = wm * 64 + m * 32 + (i & 3) + 8 * (i >> 2) + 4 * (lane >> 5), c = wn * 32 + (lane & 31);
            ocat[(size_t)2 * NTOK * 512 + (size_t)(tokb + pp) * 512 + g * 128 + c] = f2bf(geluf_(bf2f(muv[m][i])) * (acc[m][0][i] + bsv[m][i]));
        }
    __syncthreads();
}

__device__ __forceinline__ void phase_scan(const Params& p, int l, LAS unsigned char* lds) {
    LAS int* slot = (LAS int*)(lds + LDS_BYTES - 16);
    unsigned* ctr = (unsigned*)(p.ws + WS_CTR) + l;
    constexpr int NLAT = 8 * 2 * 4 * 2, NCX = 16 * 2 * 4 * 2, NGM = 160 * 4;
    for (;;) {
        if (otid() == 0) *slot = (int)atomicAdd(ctr, 1u);
        __syncthreads();
        const int j = *slot;
        __syncthreads();
        const int nconv = l + 1 < DEPTH ? CONV_BLOCK_ITEMS - CONV_IN_GEMM : 0;
        if (j >= NLAT + NCX + NGM + nconv) break;
        if (j >= NLAT + NCX + NGM) { convert_weights(p, l + 1, lds, CONV_IN_GEMM + j - (NLAT + NCX + NGM)); __syncthreads(); continue; }
        if (j < NLAT + NCX) {
            int r = j, s;
            if (r < NLAT) { s = 16 + (r >> 4); r &= 15; } else { r -= NLAT; s = r >> 4; r &= 15; }
            const int mix = r & 1, dir = (r >> 1) & 1, hd = r >> 2;
            if (mix) scan_job<1>(p, l, s, dir, hd, lds); else scan_job<0>(p, l, s, dir, hd, lds);
        } else { const int r = j - NLAT - NCX; gmlp_item(p, l, r >> 2, r & 3, lds); }
    }
}

template <int MIX>
__device__ __forceinline__ void out_item(const Params& p, int l, int gc, int hd, LAS unsigned char* lds) {
    constexpr int DK = MIX ? 128 : 64, LQ = DK + 8, LDV = 72, LDG = DK + 1;
    LAS bf16_t* QA = (LAS bf16_t*)lds;
    LAS bf16_t* KA = QA + 128 * LQ;
    LAS bf16_t* QS = KA + 128 * LQ;
    LAS bf16_t* VT = QS + 64 * LQ;
    LAS bf16_t* P = VT + 128 * LDV;
    LAS float* C = (LAS float*)(P + 64 * LDV);
    LAS float* BS = C + (MIX ? 64 : 128) * LDG;
    LAS bf16_t* ST = KA;
    LAS float* Of = (LAS float*)lds;
    const int tid = otid(), lane = tid & 63, wid = __builtin_amdgcn_readfirstlane(tid >> 6);
    const int tokb = gc * 64;
    const bf16_t* proj = (const bf16_t*)(p.ws + WS_PROJ);
    const bf16_t* pr = proj + (size_t)tokb * NPROJ;
    const float* lbs = (const float*)(p.ws + WS_LBS);
    const bf16_t* sbuf = (const bf16_t*)(p.ws + WS_ST + (MIX ? ST_GLA_BYTES : 0));
    constexpr int NPQ = 64 * (DK / 8), NRQ = NPQ / 512;
    u32x4 rq[NRQ], rk[NRQ];
    auto load_raw = [&](int dr) {
        const int kcol0 = MIX ? (dr ? PJ_HFB : PJ_HFF) + hd * 128 : PJ_GK + hd * 64;
        const int qcol0 = MIX ? PJ_HQ + hd * 128 : PJ_GQ + hd * 64;
#pragma unroll
        for (int k = 0; k < NRQ; ++k) { const int e = tid + 512 * k; const int t = e / (DK / 8), c8 = (e % (DK / 8)) * 8;
            rq[k] = *(const u32x4*)(pr + (size_t)t * NPROJ + qcol0 + c8); rk[k] = *(const u32x4*)(pr + (size_t)t * NPROJ + kcol0 + c8); }
    };
    load_raw(0);
    const int kdp = tid & (DK - 1);
    float gnv[16];
    {
        const float* gn = (MIX ? p.hg_norm_g : p.gla_norm_g) + (size_t)l * 512 + hd * 128 + (tid & 7) * 16;
#pragma unroll
        for (int j = 0; j < 16; j += 4) { const f32x4 t4 = *(const f32x4*)(gn + j); gnv[j] = t4.x; gnv[j + 1] = t4.y; gnv[j + 2] = t4.z; gnv[j + 3] = t4.w; }
    }
    const float lbd0 = MIX ? lbs[(size_t)(0 * 4 + l) * 512 + hd * 128 + kdp] : 0.f, lbd1 = MIX ? lbs[(size_t)(1 * 4 + l) * 512 + hd * 128 + kdp] : 0.f;
    typedef float f32x2p_t __attribute__((ext_vector_type(2)));
    const f32x2p_t zz2 = {0.f, 0.f};
    const f32x2p_t lbp0 = MIX ? *(const f32x2p_t*)(lbs + (size_t)(0 * 4 + l) * 512 + hd * 128 + 2 * (tid & 63)) : zz2, lbp1 = MIX ? *(const f32x2p_t*)(lbs + (size_t)(1 * 4 + l) * 512 + hd * 128 + 2 * (tid & 63)) : zz2;
    if (!MIX) {
        const int gd = wid >> 2, mt = (wid >> 1) & 1, nt = wid & 1, r = lane & 31, h = lane >> 5;
        const bf16x8 afr = *(const bf16x8*)(pr + (size_t)(mt * 32 + r) * NPROJ + (gd ? PJ_GZB : PJ_GZF) + 8 * h);
        const float* lw = p.gla_lr_w + (((size_t)l * 2 + gd) * 16 + 8 * h) * 256 + hd * 64 + nt * 32 + r;
        float wv[8];
#pragma unroll
        for (int j = 0; j < 8; ++j) wv[j] = lw[(size_t)j * 256];
        const float bias = p.gla_lr_b[((size_t)l * 2 + gd) * 256 + hd * 64 + nt * 32 + r];
        u32x4 bw; bw.x = pk2(wv[0], wv[1]); bw.y = pk2(wv[2], wv[3]); bw.z = pk2(wv[4], wv[5]); bw.w = pk2(wv[6], wv[7]);
        f32x16 zacc;
#pragma unroll
        for (int i = 0; i < 16; ++i) zacc[i] = 0.f;
        zacc = __builtin_amdgcn_mfma_f32_32x32x16_bf16(afr, __builtin_bit_cast(bf16x8, bw), zacc, 0, 0, 0);
#pragma unroll
        for (int i = 0; i < 16; ++i) {
            const int t = mt * 32 + (i & 3) + 8 * (i >> 2) + 4 * h;
            C[(gd * 64 + (gd ? 63 - t : t)) * LDG + nt * 32 + r] = logsigmoidf_(zacc[i] + bias) * (1.0f / 16.0f);
        }
    }
    const bf16_t* gatep = pr + (size_t)(tid >> 3) * NPROJ + (MIX ? PJ_HO : PJ_GO) + hd * 128 + (tid & 7) * 16;
    const u32x4 g0 = *(const u32x4*)gatep, g1 = *(const u32x4*)(gatep + 8);
    {
        const int vv = tid & 127, qt = tid >> 7;
        const int vcol = (MIX ? PJ_HI : PJ_GV) + hd * 128 + vv;
        unsigned pkv[8];
#pragma unroll
        for (int t = 0; t < 16; t += 2) {
            const unsigned a = pr[(size_t)(qt * 16 + t) * NPROJ + vcol], b = pr[(size_t)(qt * 16 + t + 1) * NPROJ + vcol];
            pkv[t >> 1] = a | (b << 16);
        }
#pragma unroll
        for (int q = 0; q < 2; ++q) { u32x4 w; w.x = pkv[4 * q]; w.y = pkv[4 * q + 1]; w.z = pkv[4 * q + 2]; w.w = pkv[4 * q + 3]; *(LAS u32x4*)(VT + vv * LDV + qt * 16 + q * 8) = w; }
    }
    const int wm = wid >> 2, wn = wid & 3;
    f32x16 o[1][1];
#pragma unroll
    for (int i = 0; i < 16; ++i) o[0][0][i] = 0.f;

#pragma unroll 1
    for (int dir = 0; dir < 2; ++dir) {
        const int kd = tid & (DK - 1), ba = tid / DK;
#pragma unroll
        for (int k = 0; k < NRQ; ++k) { const int e = tid + 512 * k; const int t = e / (DK / 8), c8 = (e % (DK / 8)) * 8;
            *(LAS u32x4*)(QS + t * LQ + c8) = rq[k]; *(LAS u32x4*)(KA + (64 + (dir ? 63 - t : t)) * LQ + c8) = rk[k]; }
        __syncthreads();
        if (MIX) {
            const int cp = tid & 63, bh = tid >> 6, bah = bh >> 1, u0 = (bh & 1) * 8;
            const float lbA = dir ? lbp1.x : lbp0.x, lbB = dir ? lbp1.y : lbp0.y;
            float gA[8], gB[8], kA[8], kB[8]; float thA = 0.f, thB = 0.f;
            {
                const LAS bf16_t* kzr = KA + (64 + bah * 16 + u0) * LQ + 2 * cp;
#pragma unroll
                for (int u = 0; u < 8; ++u) {
                    const unsigned raw = *(const LAS unsigned*)(kzr + u * LQ);
                    const float sa = sigmoidf_(bflo(raw)), sb = sigmoidf_(bfhi(raw));
                    gA[u] = flog_(lbA + (1.0f - lbA) * sa); kA[u] = (1.0f - lbA) * (1.0f - sa); thA += gA[u];
                    gB[u] = flog_(lbB + (1.0f - lbB) * sb); kB[u] = (1.0f - lbB) * (1.0f - sb); thB += gB[u];
                }
                typedef float f32x2_t __attribute__((ext_vector_type(2)));
                f32x2_t th; th.x = thA; th.y = thB;
                *(LAS f32x2_t*)(BS + bh * DK + 2 * cp) = th;
            }
            __syncthreads();
            {
                typedef float f32x2_t __attribute__((ext_vector_type(2)));
                f32x2_t hh[8];
#pragma unroll
                for (int j = 0; j < 8; ++j) hh[j] = *(const LAS f32x2_t*)(BS + j * DK + 2 * cp);
                const f32x2_t T0 = hh[0] + hh[1], T1 = hh[2] + hh[3], T2 = hh[4] + hh[5], T3 = hh[6] + hh[7];
                const f32x2_t Tb = bah == 0 ? T0 : bah == 1 ? T1 : bah == 2 ? T2 : T3;
                const f32x2_t l7 = bah == 0 ? hh[0] : bah == 1 ? hh[2] : bah == 2 ? hh[4] : hh[6];
                const f32x2_t zero2 = {0.f, 0.f};
                const f32x2_t base = bah == 0 ? zero2 : bah == 1 ? T0 : bah == 2 ? T0 + T1 : T0 + T1 + T2;
                const f32x2_t c31 = T0 + T1;
                float lpA = u0 ? l7.x : 0.f, lpB = u0 ? l7.y : 0.f;
                const float qscale = 0.08838834764831845f;
                LAS bf16_t* qz = QA + (64 + bah * 16 + u0) * LQ + 2 * cp;
                LAS bf16_t* kz = KA + (64 + bah * 16 + u0) * LQ + 2 * cp;
                LAS bf16_t* xrow = (bah < 2 ? KA + (bah * 16 + u0) * LQ : QA + (bah * 16 + u0 - 32) * LQ) + 2 * cp;
                LAS bf16_t* yrow = ((bah & 1) ? QA + (32 + (bah >> 1) * 16 + u0) * LQ : KA + (32 + (bah >> 1) * 16 + u0) * LQ) + 2 * cp;
                const bool xk = bah < 2, yq = (bah & 1) != 0;
#pragma unroll
                for (int u = 0; u < 8; ++u) {
                    const int pp = bah * 16 + u0 + u, t = dir ? 63 - pp : pp;
                    lpA += gA[u]; lpB += gB[u];
                    const float cA = base.x + lpA, cB = base.y + lpB;
                    const unsigned qraw = *(const LAS unsigned*)(QS + t * LQ + 2 * cp);
                    const float qa = bflo(qraw) * qscale, qb = bfhi(qraw) * qscale;
                    *(LAS unsigned*)(QS + t * LQ + 2 * cp) = pk2(qa * fexp_(cA), qb * fexp_(cB));
                    *(LAS unsigned*)(qz + u * LQ) = pk2(qa * fexp_(lpA - l7.x), qb * fexp_(lpB - l7.y));
                    *(LAS unsigned*)(kz + u * LQ) = pk2(kA[u] * fexp_(l7.x - lpA), kB[u] * fexp_(l7.y - lpB));
                    *(LAS unsigned*)(xrow + u * LQ) = pk2((xk ? kA[u] : qa) * fexp_(xk ? c31.x - cA : cA - c31.x), (xk ? kB[u] : qb) * fexp_(xk ? c31.y - cB : cB - c31.y));
                    *(LAS unsigned*)(yrow + u * LQ) = pk2((yq ? qa : kA[u]) * fexp_(yq ? lpA : Tb.x - lpA), (yq ? qb : kB[u]) * fexp_(yq ? lpB : Tb.y - lpB));
                }
            }
            __syncthreads();
        } else {
        float gk[16], kk[16]; float lp7 = 0.f, Ta = 0.f;
        if (MIX) {
            const float lb = dir ? lbd1 : lbd0;
            const LAS bf16_t* kz0 = KA + (64 + ba * 16) * LQ + kd;
#pragma unroll
            for (int u = 0; u < 16; ++u) {
                const float sg = sigmoidf_(bf2f(kz0[u * LQ]));
                gk[u] = flog_(lb + (1.0f - lb) * sg); kk[u] = (1.0f - lb) * (1.0f - sg);
                Ta += gk[u]; if (u == 7) lp7 = Ta;
            }
            BS[ba * DK + kd] = Ta;
        } else {
            if (ba < 4) {
#pragma unroll
                for (int u = 0; u < 16; ++u) { gk[u] = C[(dir * 64 + ba * 16 + u) * LDG + kd]; Ta += gk[u]; if (u == 7) lp7 = Ta; }
                BS[ba * DK + kd] = Ta;
            }
        }
        __syncthreads();
        if (ba < 4) {
            const float T0 = BS[kd], T1 = BS[DK + kd], T2 = BS[2 * DK + kd];
            const float base = ba == 0 ? 0.f : ba == 1 ? T0 : ba == 2 ? T0 + T1 : T0 + T1 + T2;
            const float c31 = T0 + T1;
            const float qscale = MIX ? 0.08838834764831845f : 0.125f;
            LAS bf16_t* qz = QA + (64 + ba * 16) * LQ + kd;
            LAS bf16_t* kz = KA + (64 + ba * 16) * LQ + kd;
            LAS bf16_t* xrow = (ba < 2 ? KA + (ba * 16) * LQ : QA + (ba * 16 - 32) * LQ) + kd;
            LAS bf16_t* yrow = ((ba & 1) ? QA + (32 + (ba >> 1) * 16) * LQ : KA + (32 + (ba >> 1) * 16) * LQ) + kd;
            float lp = 0.f;
#pragma unroll
            for (int u = 0; u < 16; ++u) {
                const int pp = ba * 16 + u, t = dir ? 63 - pp : pp;
                lp += gk[u];
                const float c = base + lp;
                const float qv = bf2f(QS[t * LQ + kd]) * qscale;
                const float kt = MIX ? kk[u] : bf2f(kz[u * LQ]);
                QS[t * LQ + kd] = f2bf(qv * fexp_(c));
                qz[u * LQ] = f2bf(qv * fexp_(lp - lp7));
                kz[u * LQ] = f2bf(kt * fexp_(lp7 - lp));
                xrow[u * LQ] = f2bf(ba < 2 ? kt * fexp_(c31 - c) : qv * fexp_(c - c31));
                yrow[u * LQ] = f2bf((ba & 1) ? qv * fexp_(lp) : kt * fexp_(Ta - lp));
            }
        }
        __syncthreads();
        }
        if (dir == 0) load_raw(1);
        constexpr int PIECES = 128 * DK / 8, NPC = PIECES / 512;
        u32x4 stv[NPC];
        {
            const bf16_t* sb = sbuf + (((size_t)gc * 2 + dir) * 4 + hd) * 128 * DK;
#pragma unroll
            for (int k = 0; k < NPC; ++k) { const int e = tid + 512 * k; const int v = e / (DK / 8), d0 = (e % (DK / 8)) * 8; stv[k] = *(const u32x4*)(sb + (size_t)v * DK + d0); }
        }
        if (wid < 4) {
            f32x16 sc[1][1];
#pragma unroll
            for (int i = 0; i < 16; ++i) sc[0][0][i] = 0.f;
            mma_lds<1, 1, DK / 16>(sc, KA + wid * 32 * LQ, LQ, QA + wid * 32 * LQ, LQ, lane);
            const int cc = lane & 31;
#pragma unroll
            for (int q = 0; q < 4; ++q) {
                const int r0 = 8 * q + 4 * (lane >> 5);
                int pi, pj0; bool wr = true, zero = false, tri = false;
                if (wid == 0) { pi = 32 + cc; pj0 = r0; }
                else if (wid == 1) { pi = cc < 16 ? 16 + cc : 32 + cc; pj0 = r0 < 16 ? r0 : r0 + 16; wr = (r0 < 16) == (cc < 16); }
                else { const int off = (wid - 2) * 32; pi = off + cc; pj0 = off + r0; const bool same = (r0 >> 4) == (cc >> 4); tri = same; zero = !same && r0 >= 16; wr = same || zero; }
                float v[4];
#pragma unroll
                for (int e = 0; e < 4; ++e) { float x = sc[0][0][4 * q + e]; if (tri && (r0 + e > cc)) x = 0.f; if (zero) x = 0.f; v[e] = x; }
                if (wr) {
                    u32x2 w;
                    if (dir == 0) { w.x = pk2(v[0], v[1]); w.y = pk2(v[2], v[3]); *(LAS u32x2*)(P + pi * LDV + pj0) = w; }
                    else { w.x = pk2(v[3], v[2]); w.y = pk2(v[1], v[0]); *(LAS u32x2*)(P + (63 - pi) * LDV + (60 - pj0)) = w; }
                }
            }
        } else if (wid == 4) {
#pragma unroll
            for (int k = 0; k < 2; ++k) {
                const int idx = lane * 2 + k, row = idx >> 2, piece = idx & 3;
                const int ti = dir ? 32 + row : row, tj = (dir ? 0 : 32) + piece * 8;
                u32x4 z; z.x = 0; z.y = 0; z.z = 0; z.w = 0;
                *(LAS u32x4*)(P + ti * LDV + tj) = z;
            }
        }
        __syncthreads();
#pragma unroll
        for (int k = 0; k < NPC; ++k) { const int e = tid + 512 * k; const int v = e / (DK / 8), d0 = (e % (DK / 8)) * 8; *(LAS u32x4*)(ST + v * LQ + d0) = stv[k]; }
        mma_lds<1, 1, 4>(o, P + wm * 32 * LDV, LDV, VT + wn * 32 * LDV, LDV, lane);
        __syncthreads();
        mma_lds<1, 1, DK / 16>(o, QS + wm * 32 * LQ, LQ, ST + wn * 32 * LQ, LQ, lane);
        __syncthreads();
    }
#pragma unroll
    for (int i = 0; i < 16; ++i) Of[(wm * 32 + (i & 3) + 8 * (i >> 2) + 4 * (lane >> 5)) * 132 + wn * 32 + (lane & 31)] = o[0][0][i];
    __syncthreads();
    {
        const int i_ = tid >> 3, seg = tid & 7;
        const LAS float* orow = Of + i_ * 132 + seg * 16;
        float v[16]; float ss = 0.f;
#pragma unroll
        for (int j = 0; j < 16; ++j) { v[j] = orow[j]; ss += v[j] * v[j]; }
        ss += __shfl_xor(ss, 1); ss += __shfl_xor(ss, 2); ss += __shfl_xor(ss, 4);
        const float r = rsqrtf(ss * (1.0f / 128.0f) + EPS);
        const unsigned gu[8] = {g0.x, g0.y, g0.z, g0.w, g1.x, g1.y, g1.z, g1.w};
        unsigned ow[8];
#pragma unroll
        for (int j = 0; j < 8; ++j) {
            const float a = v[2 * j] * r * gnv[2 * j] * siluf_(bflo(gu[j])), b = v[2 * j + 1] * r * gnv[2 * j + 1] * siluf_(bfhi(gu[j]));
            ow[j] = pk2(a, b);
        }
        bf16_t* dst = (bf16_t*)(p.ws + WS_OCAT) + (size_t)(MIX ? 1 : 0) * NTOK * 512 + (size_t)(tokb + i_) * 512 + hd * 128 + seg * 16;
        u32x4 w0, w1; w0.x = ow[0]; w0.y = ow[1]; w0.z = ow[2]; w0.w = ow[3]; w1.x = ow[4]; w1.y = ow[5]; w1.z = ow[6]; w1.w = ow[7];
        *(u32x4*)dst = w0; *(u32x4*)(dst + 8) = w1;
    }
    __syncthreads();
}


__device__ __forceinline__ void phase_out(const Params& p, int l, LAS unsigned char* lds) {
    constexpr int NIT = NCHUNK * 4 * 2;
    for (int it = blockIdx.x; it < NIT; it += gridDim.x) {
        const int mix = (it >> 8) & 1, rem = (it & 255) | ((it >> 9) << 8), hd = rem & 3, gc = rem >> 2;
        if (mix) out_item<1>(p, l, gc, hd, lds); else out_item<0>(p, l, gc, hd, lds);
    }
}

__device__ __forceinline__ void phase_merge(const Params& p, int l, LAS unsigned char* lds) {
    const bf16_t* ocat = (const bf16_t*)(p.ws + WS_OCAT);
    const bf16_t* G3 = (const bf16_t*)(p.ws + WS_PROJ);
    const bf16_t* WbrT = (const bf16_t*)(p.ws + WS_W + (size_t)(l & 1) * W_END + W_BR);
    bf16_t* merged = (bf16_t*)(p.ws + WS_ST);
    const int lane = otid() & 63, wid = otid() >> 6, wm = wid >> 2, wn = wid & 3;
    constexpr int nM = NTOK / 128, nN = 8;
    for (int t = blockIdx.x; t < nM * nN; t += gridDim.x) {
        int tm, tn; tile_coords(t, nN, tm, tn);
        const int row0 = tm * 128, col0 = tn * 128;
        f32x16 tot[2][1]; acc_zero<1>(tot);
#pragma unroll 1
        for (int b = 0; b < 3; ++b) {
            f32x16 ba[2][1]; acc_zero<1>(ba);
            gemm_kloop<128>(lds, ocat + (size_t)row0 * 1536 + b * 512, 1536, WbrT + ((size_t)b * D + col0) * 512, 512, 128, 512, ba);
#pragma unroll
            for (int m = 0; m < 2; ++m)
#pragma unroll
                for (int i = 0; i < 16; ++i) {
                    const int row = row0 + wm * 64 + m * 32 + (i & 3) + 8 * (i >> 2) + 4 * (lane >> 5), col = col0 + wn * 32 + (lane & 31);
                    tot[m][0][i] += bf2f(G3[(size_t)row * NGATE + b * 1024 + col]) * ba[m][0][i];
                }
        }
#pragma unroll
        for (int m = 0; m < 2; ++m)
#pragma unroll
            for (int i = 0; i < 16; ++i) {
                const int row = row0 + wm * 64 + m * 32 + (i & 3) + 8 * (i >> 2) + 4 * (lane >> 5), col = col0 + wn * 32 + (lane & 31);
                merged[(size_t)row * D + col] = f2bf(tot[m][0][i]);
            }
    }
}

__device__ __forceinline__ void run_phase(const Params& p, int ph, LAS unsigned char* lds) {
    if (ph == 0) { phase0(p, lds); return; }
    if (ph == NPHASE - 1) { norm_phase(p, p.final_norm_g, nullptr, 0, 0, nullptr, 1); return; }
    const int l = (ph - 1) / 10, sp = (ph - 1) % 10;
    const float* mod_l = (const float*)(p.ws + WS_MOD) + (size_t)l * 9 * 6144;
    bf16_t* hbuf = (bf16_t*)(p.ws + WS_H);
    bf16_t* proj = (bf16_t*)(p.ws + WS_PROJ);
    const unsigned char* wl = p.ws + WS_W + (size_t)(l & 1) * W_END;
    switch (sp) {
        case 0: if (l == 0) convert_weights(p, l, lds); norm_phase(p, p.norm_mix_g + (size_t)l * D, mod_l, 0, 1024, hbuf, 0); break;
        case 1: { PEpiBf16 e{proj, NPROJ, NPROJ, 0}; pg8_gemm(lds, hbuf, (const bf16_t*)(wl + W_IN), NTOK, 5376, D, e);
            if (l + 1 < DEPTH && blockIdx.x >= 144) { for (int k = 0; k < 2; ++k) convert_weights(p, l + 1, lds, ((int)blockIdx.x - 144) * 2 + k); } } break;
        case 2: phase_scan(p, l, lds); break;
        case 3: phase_out(p, l, lds); break;
        case 4: {
            PEpiBf16 e{proj, NGATE, NGATE, 2}; pg8_gemm(lds, hbuf, (const bf16_t*)(wl + W_G), NTOK, NGATE, D, e);
            PEpiGate e2{proj, NGATE}; pg8_gemm(lds, (const bf16_t*)(p.ws + WS_OCAT), (const bf16_t*)(wl + W_BR), NTOK, NGATE, 512, e2, (size_t)NTOK * 512 * 2);
            if (l + 1 < DEPTH && blockIdx.x >= 192) { for (int k = 0; k < 4; ++k) convert_weights(p, l + 1, lds, CONV_IN_P2 + ((int)blockIdx.x - 192) * 4 + k); } } break;
        case 5: sum3_phase(p); break;
        case 6: {
            PEpiResid e{p.out, mod_l + 2048}; pg8_gemm(lds, (const bf16_t*)(p.ws + WS_ST), (const bf16_t*)(wl + W_OUT), 16384, D, D, e);
            EpiResidOff e2{p.out, mod_l + 2048, 16384}; gemm_phase<128>(lds, (const bf16_t*)(p.ws + WS_ST) + (size_t)16384 * D, D, (const bf16_t*)(wl + W_OUT), D, NTOK - 16384, D, D, e2); } break;
        case 7: norm_phase(p, p.norm_ffn_g + (size_t)l * D, mod_l, 3072, 4096, hbuf, 0); break;
        case 8: { PEpiBf16 e{proj, DFF, DFF, 1}; pg8_gemm(lds, hbuf, (const bf16_t*)(wl + W_FF1), NTOK, DFF, D, e); } break;
        case 9: { PEpiResid e{p.out, mod_l + 5120}; pg8_gemm(lds, proj, (const bf16_t*)(wl + W_FF2), 16384, D, DFF, e);
            EpiResidOff e2{p.out, mod_l + 5120, 16384}; gemm_phase<128>(lds, proj + (size_t)16384 * DFF, DFF, (const bf16_t*)(wl + W_FF2), DFF, NTOK - 16384, D, DFF, e2); } break;
    }
}

__global__ void __launch_bounds__(512) fwd_megakernel(Params p) {
    extern __shared__ __attribute__((aligned(16))) unsigned char smem[];
    LAS unsigned char* lds = (LAS unsigned char*)smem;
    cg::grid_group grid = cg::this_grid();
    unsigned nbar = 0;
    for (int ph = p.ph_lo; ph < p.ph_hi; ++ph) {
        run_phase(p, ph, lds);
        if (ph + 1 < p.ph_hi) {
            if (ph == 0) grid.sync();
            else { ++nbar; grid_barrier((unsigned*)(p.ws + WS_CTR) + 64, nbar); }
        }
    }
}

extern "C" void kernel_launch(void* const* d_in, const int* in_sizes, int n_in, void* d_out, int out_size, void* d_ws, size_t ws_size, hipStream_t stream) {
    static int grid_blocks = 0;
    if (!grid_blocks) {
        int dev = 0, cus = 0, per_cu = 0;
        hipGetDevice(&dev);
        hipDeviceGetAttribute(&cus, hipDeviceAttributeMultiprocessorCount, dev);
        if (hipFuncSetAttribute((const void*)fwd_megakernel, hipFuncAttributeMaxDynamicSharedMemorySize, LDS_BYTES) != hipSuccess) fprintf(stderr, "hipFuncSetAttribute failed\n");
        hipOccupancyMaxActiveBlocksPerMultiprocessor(&per_cu, (const void*)fwd_megakernel, 512, LDS_BYTES);
        if (per_cu < 1) { fprintf(stderr, "occupancy query says %d blocks/CU\n", per_cu); per_cu = 1; }
        grid_blocks = cus * 1;
        (void)hipGetLastError();
        if (n_in != 26 || ws_size < WS_END) fprintf(stderr, "kernel_launch: unexpected n_in %d or ws_size %zu (need %zu)\n", n_in, ws_size, (size_t)WS_END);
    }
    Params p{};
    const float** pp = (const float**)&p;
    for (int i = 0; i < 26; ++i) pp[i] = (const float*)d_in[i];
    p.out = (float*)d_out; p.ws = (unsigned char*)d_ws; p.ph_lo = 0; p.ph_hi = NPHASE;
    void* args[] = {&p};
    hipError_t e = hipLaunchCooperativeKernel((const void*)fwd_megakernel, dim3(grid_blocks), dim3(512), args, LDS_BYTES, stream);
    if (e != hipSuccess) fprintf(stderr, "cooperative launch failed: %s (grid %d)\n", hipGetErrorString(e), grid_blocks);
}
```

```cpp
#include <hip/hip_runtime.h>
#include <hip/hip_cooperative_groups.h>
#include <cstdio>
namespace cg = cooperative_groups;

#define LAS __attribute__((address_space(3)))
typedef unsigned short bf16_t;
typedef short bf16x8 __attribute__((ext_vector_type(8)));
typedef float f32x16 __attribute__((ext_vector_type(16)));
typedef float f32x4 __attribute__((ext_vector_type(4)));
typedef unsigned u32x4 __attribute__((ext_vector_type(4)));
typedef unsigned u32x2 __attribute__((ext_vector_type(2)));

constexpr int D = 1024, DEPTH = 4, NTOK = 20480, NCTX = 4096, DFF = 4096;
constexpr int DIN = 8224, NPROJ = 5152, NGATE = 3072;
constexpr int PJ_GQ = 0, PJ_GK = 256, PJ_GV = 512, PJ_GO = 1024, PJ_GZF = 1536, PJ_GZB = 1552, PJ_HQ = 1568, PJ_HFF = 2080,
              PJ_HFB = 2592, PJ_HI = 3104, PJ_HO = 3616, PJ_MU = 4128, PJ_MV = 4640;
constexpr int NCHUNK = NTOK / 64;
constexpr float EPS = 1e-6f;
constexpr int LDS_BYTES = 160 * 1024;
constexpr int NPHASE = 2 + DEPTH * 10;

constexpr size_t WS_PROJ = 0;
constexpr size_t WS_ST   = WS_PROJ + (size_t)NTOK * NPROJ * 2;
constexpr size_t ST_GLA_BYTES = (size_t)NCHUNK * 2 * 4 * 128 * 64 * 2, ST_HG_BYTES = (size_t)NCHUNK * 2 * 4 * 128 * 128 * 2;
constexpr size_t WS_OCAT = WS_ST + ST_GLA_BYTES + ST_HG_BYTES;
constexpr size_t WS_H    = WS_OCAT + (size_t)NTOK * 1536 * 2;
constexpr size_t WS_W    = WS_H + (size_t)NTOK * D * 2;
constexpr size_t W_IN = 0, W_G = W_IN + (size_t)NPROJ * D * 2, W_BR = W_G + (size_t)NGATE * D * 2, W_OUT = W_BR + (size_t)3 * D * 512 * 2,
                 W_FF1 = W_OUT + (size_t)D * D * 2, W_FF2 = W_FF1 + (size_t)DFF * D * 2, W_END = W_FF2 + (size_t)D * DFF * 2;
constexpr size_t WS_MOD  = WS_W + 2 * W_END;
constexpr size_t WS_LBS  = WS_MOD + (size_t)DEPTH * 9 * 6144 * 4;
constexpr size_t WS_CTR  = WS_LBS + 2 * 4 * 512 * 4;
constexpr size_t WS_END  = WS_CTR + 4096;

struct Params {
    const float *x_prompt, *x_sample, *c, *state_gla, *state_hgrn, *c_ctx, *ada_w, *ada_b, *norm_mix_g, *norm_ffn_g, *w_in, *gla_lr_w,
        *gla_lr_b, *gla_norm_g, *hg_lb_logits, *hg_norm_g, *gm_norm_g, *gm_ws, *gm_bs, *w_br_gla, *w_br_hg, *w_br_gm, *w_out, *w_ff1, *w_ff2,
        *final_norm_g;
    float* out; unsigned char* ws; int ph_lo, ph_hi;
};

typedef __bf16 bf16x2_t __attribute__((ext_vector_type(2)));
__device__ __forceinline__ unsigned pk2(float lo, float hi) { bf16x2_t v; v.x = (__bf16)lo; v.y = (__bf16)hi; return __builtin_bit_cast(unsigned, v); }
__device__ __forceinline__ bf16_t f2bf(float f) { return (bf16_t)(pk2(f, 0.f) & 0xffffu); }
__device__ __forceinline__ float bf2f(bf16_t h) { return __uint_as_float(((unsigned)h) << 16); }
__device__ __forceinline__ float bflo(unsigned u) { return __uint_as_float(u << 16); }
__device__ __forceinline__ float bfhi(unsigned u) { return __uint_as_float(u & 0xffff0000u); }
__device__ __forceinline__ float fexp_(float x) { return __builtin_amdgcn_exp2f(x * 1.4426950408889634f); }
__device__ __forceinline__ float flog_(float x) { return __builtin_amdgcn_logf(x) * 0.6931471805599453f; }
__device__ __forceinline__ float sigmoidf_(float x) { return __builtin_amdgcn_rcpf(1.0f + fexp_(-x)); }
__device__ __forceinline__ float siluf_(float x) { return x * sigmoidf_(x); }
__device__ __forceinline__ float geluf_(float x) { const float y = 0.7978845608028654f * (x + 0.044715f * x * x * x); const float t = 1.0f - 2.0f * __builtin_amdgcn_rcpf(1.0f + fexp_(2.0f * y)); return 0.5f * x * (1.0f + t); }
__device__ __forceinline__ float logsigmoidf_(float x) { return fminf(x, 0.f) - flog_(1.0f + fexp_(-fabsf(x))); }
__device__ __forceinline__ float wave_sum(float v) {
#pragma unroll
    for (int o = 1; o < 64; o <<= 1) v += __shfl_xor(v, o);
    return v;
}
__device__ __forceinline__ int mod_row(int tok) { return tok < NCTX ? 0 : 1 + ((tok - NCTX) >> 11); }
__device__ __forceinline__ int otid() { int t = (int)__builtin_amdgcn_workitem_id_x(); asm volatile("" : "+v"(t)); return t; }
#define LDS_WAIT() asm volatile("s_waitcnt lgkmcnt(0)" ::: "memory")

template <int MT, int NTL, int KS>
__device__ __forceinline__ void mma_lds(f32x16 (&acc)[MT][NTL], const LAS bf16_t* As, int lda, const LAS bf16_t* Bs, int ldb, int lane) {
    const int r = lane & 31, h = lane >> 5;
    const LAS bf16_t* ap = As + r * lda + h * 8;
    const LAS bf16_t* bp = Bs + r * ldb + h * 8;
#pragma unroll
    for (int ks = 0; ks < KS; ++ks) {
        bf16x8 a[MT], b[NTL];
#pragma unroll
        for (int m = 0; m < MT; ++m) a[m] = *(const LAS bf16x8*)(ap + m * 32 * lda + ks * 16);
#pragma unroll
        for (int n = 0; n < NTL; ++n) b[n] = *(const LAS bf16x8*)(bp + n * 32 * ldb + ks * 16);
#pragma unroll
        for (int m = 0; m < MT; ++m)
#pragma unroll
            for (int n = 0; n < NTL; ++n) acc[m][n] = __builtin_amdgcn_mfma_f32_32x32x16_bf16(a[m], b[n], acc[m][n], 0, 0, 0);
    }
}

template <int BM>
__device__ __forceinline__ void gemm_kloop(LAS unsigned char* lds, const bf16_t* __restrict__ Ag, int lda, const bf16_t* __restrict__ Bg, int ldb, int brows,
                                           int K, f32x16 (&acc)[2][(128 / (8 / (BM / 64))) / 32]) {
    static_assert(BM == 128, "128-row tiles only");
    constexpr int WN = 4, WTN = 32, NTL = 1, LDT = 136, NP = 4;
    LAS bf16_t* As = (LAS bf16_t*)lds;
    LAS bf16_t* Bs = As + 2 * 128 * LDT;
    const int tid = otid(), lane = tid & 63, wid = tid >> 6, wm = wid / WN, wn = wid % WN;
    const int lrow = tid >> 4, lc = (tid & 15) * 8;
    const bf16_t* ap[NP]; const bf16_t* bp[NP];
#pragma unroll
    for (int p = 0; p < NP; ++p) ap[p] = Ag + (size_t)(lrow + p * 32) * lda + lc;
#pragma unroll
    for (int p = 0; p < NP; ++p) { int br = lrow + p * 32; br = br < brows ? br : brows - 1; bp[p] = Bg + (size_t)br * ldb + lc; }
    u32x4 ra[3][NP], rb[3][NP];
    const int nk = K / 128;
#define KL_ISSUE(S, step) do { _Pragma("unroll") for (int p = 0; p < NP; ++p) ra[S][p] = *(const u32x4*)(ap[p] + (step) * 128); \
                               _Pragma("unroll") for (int p = 0; p < NP; ++p) rb[S][p] = *(const u32x4*)(bp[p] + (step) * 128); } while (0)
#define KL_WRITE(S, stage) do { _Pragma("unroll") for (int p = 0; p < NP; ++p) *(LAS u32x4*)(As + (stage) * 128 * LDT + (lrow + p * 32) * LDT + lc) = ra[S][p]; \
                                _Pragma("unroll") for (int p = 0; p < NP; ++p) *(LAS u32x4*)(Bs + (stage) * 128 * LDT + (lrow + p * 32) * LDT + lc) = rb[S][p]; } while (0)
#define KL_STEP(J, JN) if (kt + J < nk) { const int s_ = kt + J; if (s_ + 3 < nk) KL_ISSUE(J, s_ + 3); \
        mma_lds<2, NTL, 8>(acc, As + (s_ & 1) * 128 * LDT + wm * 64 * LDT, LDT, Bs + (s_ & 1) * 128 * LDT + wn * WTN * LDT, LDT, lane); \
        if (s_ + 1 < nk) KL_WRITE(JN, (s_ + 1) & 1); __syncthreads(); }
    KL_ISSUE(0, 0); if (nk > 1) KL_ISSUE(1, 1); if (nk > 2) KL_ISSUE(2, 2);
    KL_WRITE(0, 0);
    __syncthreads();
    for (int kt = 0; kt < nk; kt += 3) { KL_STEP(0, 1) KL_STEP(1, 2) KL_STEP(2, 0) }
#undef KL_ISSUE
#undef KL_WRITE
#undef KL_STEP
}

template <int NTL>
__device__ __forceinline__ void acc_zero(f32x16 (&acc)[2][NTL]) {
#pragma unroll
    for (int m = 0; m < 2; ++m)
#pragma unroll
        for (int n = 0; n < NTL; ++n)
#pragma unroll
            for (int i = 0; i < 16; ++i) acc[m][n][i] = 0.f;
}

__device__ __forceinline__ void tile_coords(int t, int nN, int& tm, int& tn) { const int q = t >> 3; tn = q % nN; tm = (q / nN) * 8 + (t & 7); }

template <int BM, class Epi>
__device__ __forceinline__ void gemm_phase(LAS unsigned char* lds, const bf16_t* A, int lda, const bf16_t* Bt, int ldb, int M, int N, int K, const Epi& epi) {
    constexpr int WM = BM / 64, WN = 8 / WM, WTN = 128 / WN, NTL = WTN / 32;
    const int nM = M / BM, nN = (N + 127) / 128, ntiles = nM * nN;
    const int lane = otid() & 63, wid = otid() >> 6, wm = wid / WN, wn = wid % WN;
    for (int t = blockIdx.x; t < ntiles; t += gridDim.x) {
        int tm, tn; tile_coords(t, nN, tm, tn);
        const int row0 = tm * BM, col0 = tn * 128;
        f32x16 acc[2][NTL]; acc_zero<NTL>(acc);
        gemm_kloop<BM>(lds, A + (size_t)row0 * lda, lda, Bt + (size_t)col0 * ldb, ldb, min(128, N - col0), K, acc);
#pragma unroll
        for (int m = 0; m < 2; ++m)
#pragma unroll
            for (int n = 0; n < NTL; ++n) {
                const int col = col0 + wn * WTN + n * 32 + (lane & 31);
#pragma unroll
                for (int i = 0; i < 16; ++i) {
                    const int row = row0 + wm * 64 + m * 32 + (i & 3) + 8 * (i >> 2) + 4 * (lane >> 5);
                    epi(row, col, acc[m][n][i]);
                }
            }
    }
}

__device__ __forceinline__ void gemm_resid_tiles(LAS unsigned char* lds, const bf16_t* A, int lda, const bf16_t* Bt, int ldb, int M, int K, float* x, const float* gate, int roff) {
    const int nM = M / 128, nN = 8, ntiles = nM * nN;
    const int lane = otid() & 63, wid = otid() >> 6, wm = wid >> 2, wn = wid & 3;
    for (int t = blockIdx.x; t < ntiles; t += gridDim.x) {
        int tm, tn; tile_coords(t, nN, tm, tn);
        const int row0 = tm * 128, col0 = tn * 128;
        f32x16 acc[2][1]; acc_zero<1>(acc);
        gemm_kloop<128>(lds, A + (size_t)row0 * lda, lda, Bt + (size_t)col0 * ldb, ldb, 128, K, acc);
        const int col = col0 + wn * 32 + (lane & 31), rbase = roff + row0 + wm * 64 + 4 * (lane >> 5);
        const float g = gate[(size_t)mod_row(roff + row0) * 6144 + col];
        float xv[2][16];
#pragma unroll
        for (int m = 0; m < 2; ++m)
#pragma unroll
            for (int i = 0; i < 16; ++i) xv[m][i] = x[(size_t)(rbase + m * 32 + (i & 3) + 8 * (i >> 2)) * D + col];
#pragma unroll
        for (int m = 0; m < 2; ++m)
#pragma unroll
            for (int i = 0; i < 16; ++i) x[(size_t)(rbase + m * 32 + (i & 3) + 8 * (i >> 2)) * D + col] = xv[m][i] + g * acc[m][0][i];
    }
}

struct EpiBf16 { bf16_t* C; int ldc, N; __device__ __forceinline__ void operator()(int row, int col, float v) const { if (col < N) C[(size_t)row * ldc + col] = f2bf(v); } };
struct EpiRelu2 { bf16_t* C; int ldc; __device__ __forceinline__ void operator()(int row, int col, float v) const { v = fmaxf(v, 0.f); C[(size_t)row * ldc + col] = f2bf(v * v); } };
struct EpiResidOff { float* x; const float* gate; int roff; __device__ __forceinline__ void operator()(int row, int col, float v) const {
    const int r = row + roff; const float g = gate[mod_row(r) * 6144 + col]; float* p = x + (size_t)r * D + col; *p = *p + g * v; } };
struct EpiResid { float* x; const float* gate;   __device__ __forceinline__ void operator()(int row, int col, float v) const {
    const float g = gate[mod_row(row) * 6144 + col]; float* p = x + (size_t)row * D + col; *p = *p + g * v; } };

namespace pg8 {
#define PG8_LAS __attribute__((address_space(3)))
typedef unsigned short bf16_t;
typedef short bf16x8 __attribute__((ext_vector_type(8)));
typedef float f32x4 __attribute__((ext_vector_type(4)));
typedef unsigned u32x4 __attribute__((ext_vector_type(4)));
constexpr int BM = 256, BK = 64, HALF = 128, HTB = HALF * BK * 2  , STAGE_BYTES = 8 * HTB, NXCD = 8, WGM = 8;

__host__ __device__ __forceinline__ int lds_byte(int r, int c) { const int st = (r >> 4) * 2 + (c >> 5), rr = r & 15, cc = c & 31, ob = rr * 64 + cc * 2; return st * 1024 + (ob ^ (((ob >> 9) & 1) << 5)); }
__host__ __device__ __forceinline__ void stage_rc(int b, int& R, int& C) { const int st = b / 1024, sb = b % 1024, swz = sb ^ (((sb >> 9) & 1) << 5); R = (st >> 1) * 16 + swz / 64; C = (st & 1) * 32 + (swz % 64) / 2; }
__host__ __device__ __forceinline__ int perm32(int rho) { const int n = rho >> 4, i = rho & 15; return 8 * (i >> 2) + 4 * n + (i & 3); }

struct Unit { int pm, pn; };
struct Gemm { const bf16_t* A; const bf16_t* Bt; int M, N, K; size_t agrp; };

struct StaticOrder {
    int nM, nN, nwg, G, c;
    __host__ __device__ void init(int M, int N, int G_, int c_) { nM = M / BM; nN = N / BM; nwg = nM * nN; G = G_; c = c_; }
    __host__ __device__ bool next(int i, Unit& u) const {
        const long L = (long)i * G + c; if (L >= nwg) return false;
        int wgid = (int)L; { const int q = nwg / NXCD, r = nwg % NXCD, xcd = wgid % NXCD, off = wgid / NXCD; wgid = (xcd < r ? xcd * (q + 1) : r * (q + 1) + (xcd - r) * q) + off; }
        const int nig = WGM * nN, gid = wgid / nig, fm = gid * WGM, gsz = (nM - fm) < WGM ? (nM - fm) : WGM;
        u.pm = fm + ((wgid % nig) % gsz); u.pn = (wgid % nig) / gsz; return true;
    }
    __device__ __forceinline__ void a_ready(const Unit&) const {}
    __device__ __forceinline__ void done(const Unit&) const {}
};
__device__ __forceinline__ unsigned cvt_pk_bf16(float lo, float hi) { unsigned r; asm volatile("v_cvt_pk_bf16_f32 %0, %1, %2" : "=v"(r) : "v"(lo), "v"(hi)); return r; }
template <class Epi, class Sched, bool STAMP = false>
__device__ __forceinline__ void gemm_phase(PG8_LAS unsigned char* lds, const Gemm g, const Sched& S, const Epi& E, unsigned long long* stamps) {
    const int tid = otid(), wid = __builtin_amdgcn_readfirstlane(tid >> 6), lane = tid & 63, wr = wid >> 2, wc = wid & 3, fr = lane & 15, fq = lane >> 4;
    const int K = g.K, nt = K / BK;
    int ts_lo = 0, ts_hi = 0, nts = 0; const unsigned long long rt_entry = STAMP ? (unsigned long long)wall_clock64() : 0ull;
#define PG8_STAMP() do { if (STAMP && wid == 0 && nts < 64) { const unsigned long long _c = (unsigned long long)clock64(); \
        ts_lo = (lane == nts) ? (int)(unsigned)_c : ts_lo; ts_hi = (lane == nts) ? (int)(unsigned)(_c >> 32) : ts_hi; ++nts; } } while (0)
    PG8_STAMP();
    unsigned voffA[2], voffB[2];
#pragma unroll
    for (int i = 0; i < 2; ++i) { int R, C; stage_rc(tid * 16 + i * 8192, R, C); const int Rb = Epi::PERM ? ((R & ~31) + perm32(R & 31)) : R;
        voffA[i] = (unsigned)(R * K + C) * 2u; voffB[i] = (unsigned)(Rb * K + C) * 2u; }
    const size_t kstep = (size_t)(BK * 2);
    const size_t hstep = (size_t)HALF * K * 2;
    const size_t tstep = 2 * hstep;
    const unsigned ldsw = (unsigned)wid * 1024u;
    const int aoff = lds_byte(wr * 64 + fr, fq * 8), boff = lds_byte(wc * 32 + fr, fq * 8);
#define PG8_SA(b, h) (((b) * 2 + (h)) * HTB)
#define PG8_SB(b, h) ((4 + (b) * 2 + (h)) * HTB)
#define PG8_STAGE(bufoff, gbase, voff) do { _Pragma("unroll") for (int _i = 0; _i < 2; ++_i) \
        __builtin_amdgcn_global_load_lds((const unsigned*)((const char*)(gbase) + (voff)[_i]), (PG8_LAS unsigned*)(lds + (bufoff) + ldsw + _i * 8192), 16, 0, 0); } while (0)
#define PG8_LDA(dst, b, h) do { _Pragma("unroll") for (int m = 0; m < 4; ++m) _Pragma("unroll") for (int k = 0; k < 2; ++k) dst[m][k] = *(const PG8_LAS bf16x8*)(lds + PG8_SA(b, h) + aoff + m * 2048 + k * 1024); } while (0)
#define PG8_LDB(dst, b, h) do { _Pragma("unroll") for (int n = 0; n < 2; ++n) _Pragma("unroll") for (int k = 0; k < 2; ++k) dst[n][k] = *(const PG8_LAS bf16x8*)(lds + PG8_SB(b, h) + boff + n * 2048 + k * 1024); } while (0)
#define PG8_MMA(ai, bj, At, Bt) do { __builtin_amdgcn_s_setprio(1); _Pragma("unroll") for (int m = 0; m < 4; ++m) _Pragma("unroll") for (int n = 0; n < 2; ++n) _Pragma("unroll") for (int k = 0; k < 2; ++k) \
        acc[ai][bj][m][n] = __builtin_amdgcn_mfma_f32_16x16x32_bf16(Bt[n][k], At[m][k], acc[ai][bj][m][n], 0, 0, 0); __builtin_amdgcn_s_setprio(0); } while (0)
#define PG8_WAIT_V(n) asm volatile("s_waitcnt vmcnt(" #n ")" ::: "memory")
#define PG8_WAIT_L(n) asm volatile("s_waitcnt lgkmcnt(" #n ")" ::: "memory")
#define PG8_BAR __builtin_amdgcn_s_barrier()
#define PG8_SCHED __builtin_amdgcn_sched_barrier(0)
    Unit cur, nxt; int ui = 0;
    if (!S.next(0, cur)) return;
    f32x4 acc[2][2][4][2];
#pragma unroll
    for (int a = 0; a < 2; ++a)
#pragma unroll
        for (int b = 0; b < 2; ++b)
#pragma unroll
            for (int m = 0; m < 4; ++m)
#pragma unroll
                for (int n = 0; n < 2; ++n) acc[a][b][m][n] = (f32x4){0.f, 0.f, 0.f, 0.f};
    bf16x8 At[4][2], B0[2][2], B1[2][2];
    const char* cA = (const char*)g.A + (size_t)cur.pm * tstep + (size_t)(cur.pn >> 2) * g.agrp; const char* cB = (const char*)g.Bt + (size_t)cur.pn * tstep;
    S.a_ready(cur);
    PG8_STAGE(PG8_SB(0, 0), cB, voffB); PG8_STAGE(PG8_SA(0, 0), cA, voffA); PG8_STAGE(PG8_SB(0, 1), cB + hstep, voffB); PG8_STAGE(PG8_SA(0, 1), cA + hstep, voffA);
    if (wr == 1) PG8_BAR;
    PG8_WAIT_V(4); PG8_BAR;
    PG8_STAGE(PG8_SB(1, 0), cB + kstep, voffB); PG8_STAGE(PG8_SA(1, 0), cA + kstep, voffA); PG8_STAGE(PG8_SB(1, 1), cB + hstep + kstep, voffB);
    PG8_WAIT_V(6); PG8_BAR;
    PG8_STAMP();
    for (;;) {
        const bool has_next = S.next(ui + 1, nxt);
        const char* nA = has_next ? (const char*)g.A + (size_t)nxt.pm * tstep + (size_t)(nxt.pn >> 2) * g.agrp : cA; const char* nB = has_next ? (const char*)g.Bt + (size_t)nxt.pn * tstep : cB;
        for (int t = 0; t < nt; t += 2) {
            const bool last = (t == nt - 2);
            const char* a1 = cA + (size_t)(t + 1) * kstep;
            const char* a2 = last ? nA : cA + (size_t)(t + 2) * kstep; const char* b2 = last ? nB : cB + (size_t)(t + 2) * kstep;
            const char* a3 = a2 + kstep; const char* b3 = b2 + kstep;
            if (last && has_next) S.a_ready(nxt);
            PG8_LDB(B0, 0, 0); PG8_SCHED; PG8_LDA(At, 0, 0); PG8_STAGE(PG8_SA(1, 1), a1 + hstep, voffA);
            PG8_WAIT_L(8); PG8_BAR; PG8_WAIT_L(0); PG8_MMA(0, 0, At, B0); PG8_BAR; PG8_SCHED;
            PG8_LDB(B1, 0, 1); PG8_STAGE(PG8_SB(0, 0), b2, voffB);
            PG8_BAR; PG8_WAIT_L(0); PG8_MMA(0, 1, At, B1); PG8_BAR;
            PG8_LDA(At, 0, 1); PG8_STAGE(PG8_SA(0, 0), a2, voffA);
            PG8_BAR; PG8_WAIT_L(0); PG8_MMA(1, 0, At, B0); PG8_BAR; PG8_SCHED;
            PG8_STAGE(PG8_SB(0, 1), b2 + hstep, voffB);
            PG8_WAIT_V(6); PG8_BAR; PG8_MMA(1, 1, At, B1); PG8_BAR;
            PG8_LDB(B0, 1, 0); PG8_SCHED; PG8_LDA(At, 1, 0); PG8_STAGE(PG8_SA(0, 1), a2 + hstep, voffA);
            PG8_WAIT_L(8); PG8_BAR; PG8_WAIT_L(0); PG8_MMA(0, 0, At, B0); PG8_BAR; PG8_SCHED;
            PG8_LDB(B1, 1, 1); PG8_STAGE(PG8_SB(1, 0), b3, voffB);
            PG8_BAR; PG8_WAIT_L(0); PG8_MMA(0, 1, At, B1); PG8_BAR;
            PG8_LDA(At, 1, 1); PG8_STAGE(PG8_SA(1, 0), a3, voffA);
            PG8_BAR; PG8_WAIT_L(0); PG8_MMA(1, 0, At, B0); PG8_BAR; PG8_SCHED;
            PG8_STAGE(PG8_SB(1, 1), b3 + hstep, voffB);
            PG8_WAIT_V(6); PG8_BAR; PG8_MMA(1, 1, At, B1); PG8_BAR;
        }
        PG8_STAMP();
        if constexpr (!Epi::AFTER_DRAIN) { E(acc, cur, wr, wc, fr, fq); S.done(cur); }
        PG8_STAMP();
        if (!has_next) break;
#pragma unroll
        for (int a = 0; a < 2; ++a)
#pragma unroll
            for (int b = 0; b < 2; ++b)
#pragma unroll
                for (int m = 0; m < 4; ++m)
#pragma unroll
                    for (int n = 0; n < 2; ++n) acc[a][b][m][n] = (f32x4){0.f, 0.f, 0.f, 0.f};
        cur = nxt; cA = nA; cB = nB; ++ui;
    }
    PG8_WAIT_V(0);
    if (wr == 0) PG8_BAR;
    PG8_BAR;
    if constexpr (Epi::AFTER_DRAIN) { E.fused(acc, cur, wr, wc, fr, fq, lds, wid, lane); S.done(cur); }
    PG8_STAMP();
    if (STAMP && wid == 0) { stamps[lane] = lane < nts ? (((unsigned long long)(unsigned)ts_hi << 32) | (unsigned)ts_lo) : 0ull;
        if (lane == 62) stamps[62] = rt_entry; if (lane == 63) stamps[63] = (unsigned long long)wall_clock64(); }
#undef PG8_STAMP
#undef PG8_SA
#undef PG8_SB
#undef PG8_STAGE
#undef PG8_LDA
#undef PG8_LDB
#undef PG8_MMA
#undef PG8_WAIT_V
#undef PG8_WAIT_L
#undef PG8_BAR
#undef PG8_SCHED
}
}

struct PEpiBf16 {
    static constexpr bool PERM = true, AFTER_DRAIN = false;
    bf16_t* C; int ldc, N, act;
    __device__ __forceinline__ void operator()(const pg8::f32x4 (&acc)[2][2][4][2], const pg8::Unit& u, int wr, int wc, int fr, int fq) const {
        const int row0 = u.pm * 256 + wr * 64 + fr, col0 = u.pn * 256 + wc * 32 + 8 * fq;
#pragma unroll
        for (int ai = 0; ai < 2; ++ai)
#pragma unroll
            for (int m = 0; m < 4; ++m) {
                bf16_t* rowp = C + (size_t)(row0 + ai * 128 + m * 16) * ldc;
#pragma unroll
                for (int bj = 0; bj < 2; ++bj) {
                    const int col = col0 + bj * 128;
                    pg8::f32x4 v0 = acc[ai][bj][m][0], v1 = acc[ai][bj][m][1];
                    if (act == 1) { v0.x = fmaxf(v0.x, 0.f); v0.y = fmaxf(v0.y, 0.f); v0.z = fmaxf(v0.z, 0.f); v0.w = fmaxf(v0.w, 0.f); v0 = v0 * v0;
                                    v1.x = fmaxf(v1.x, 0.f); v1.y = fmaxf(v1.y, 0.f); v1.z = fmaxf(v1.z, 0.f); v1.w = fmaxf(v1.w, 0.f); v1 = v1 * v1; }
                    if (act == 2) { v0.x = sigmoidf_(v0.x); v0.y = sigmoidf_(v0.y); v0.z = sigmoidf_(v0.z); v0.w = sigmoidf_(v0.w);
                                    v1.x = sigmoidf_(v1.x); v1.y = sigmoidf_(v1.y); v1.z = sigmoidf_(v1.z); v1.w = sigmoidf_(v1.w); }
                    u32x4 w; w.x = pk2(v0.x, v0.y); w.y = pk2(v0.z, v0.w); w.z = pk2(v1.x, v1.y); w.w = pk2(v1.z, v1.w);
                    if (col < N) *(u32x4*)(rowp + col) = w;
                }
            }
    }
};
struct PEpiResid {
    static constexpr bool PERM = true, AFTER_DRAIN = false;
    float* x; const float* gate;
    __device__ __forceinline__ void operator()(const pg8::f32x4 (&acc)[2][2][4][2], const pg8::Unit& u, int wr, int wc, int fr, int fq) const {
        const int row0 = u.pm * 256 + wr * 64 + fr, col0 = u.pn * 256 + wc * 32 + 8 * fq;
        const float* gp = gate + (size_t)mod_row(u.pm * 256) * 6144 + col0;
        f32x4 g[2][2];
#pragma unroll
        for (int bj = 0; bj < 2; ++bj) { g[bj][0] = *(const f32x4*)(gp + bj * 128); g[bj][1] = *(const f32x4*)(gp + bj * 128 + 4); }
#pragma unroll
        for (int ai = 0; ai < 2; ++ai) {
            f32x4 xv[4][2][2];
#pragma unroll
            for (int m = 0; m < 4; ++m)
#pragma unroll
                for (int bj = 0; bj < 2; ++bj) {
                    const float* rp = x + (size_t)(row0 + ai * 128 + m * 16) * D + col0 + bj * 128;
                    xv[m][bj][0] = *(const f32x4*)rp; xv[m][bj][1] = *(const f32x4*)(rp + 4);
                }
#pragma unroll
            for (int m = 0; m < 4; ++m)
#pragma unroll
                for (int bj = 0; bj < 2; ++bj) {
                    float* rp = x + (size_t)(row0 + ai * 128 + m * 16) * D + col0 + bj * 128;
                    *(f32x4*)rp = xv[m][bj][0] + g[bj][0] * acc[ai][bj][m][0]; *(f32x4*)(rp + 4) = xv[m][bj][1] + g[bj][1] * acc[ai][bj][m][1];
                }
        }
    }
};
struct PEpiGate {
    static constexpr bool PERM = true, AFTER_DRAIN = false;
    bf16_t* G; int ldc;
    __device__ __forceinline__ void operator()(const pg8::f32x4 (&acc)[2][2][4][2], const pg8::Unit& u, int wr, int wc, int fr, int fq) const {
        const int row0 = u.pm * 256 + wr * 64 + fr, col0 = u.pn * 256 + wc * 32 + 8 * fq;
#pragma unroll
        for (int ai = 0; ai < 2; ++ai)
#pragma unroll
            for (int m = 0; m < 4; ++m) {
                bf16_t* rowp = G + (size_t)(row0 + ai * 128 + m * 16) * ldc;
#pragma unroll
                for (int bj = 0; bj < 2; ++bj) {
                    const int col = col0 + bj * 128;
                    const u32x4 g = *(const u32x4*)(rowp + col);
                    const pg8::f32x4 v0 = acc[ai][bj][m][0], v1 = acc[ai][bj][m][1];
                    u32x4 w; w.x = pk2(bflo(g.x) * v0.x, bfhi(g.x) * v0.y); w.y = pk2(bflo(g.y) * v0.z, bfhi(g.y) * v0.w);
                    w.z = pk2(bflo(g.z) * v1.x, bfhi(g.z) * v1.y); w.w = pk2(bflo(g.w) * v1.z, bfhi(g.w) * v1.w);
                    *(u32x4*)(rowp + col) = w;
                }
            }
    }
};
__device__ __forceinline__ void sum3_phase(const Params& p) {
    const bf16_t* Y = (const bf16_t*)(p.ws + WS_PROJ); bf16_t* merged = (bf16_t*)(p.ws + WS_ST);
    for (size_t i = (size_t)blockIdx.x * 512 + otid(); i < (size_t)NTOK * (D / 8); i += (size_t)gridDim.x * 512) {
        const size_t row = i >> 7; const int c8 = (int)(i & 127) * 8;
        const bf16_t* yr = Y + row * NGATE + c8;
        const u32x4 a = *(const u32x4*)yr, b = *(const u32x4*)(yr + 1024), c = *(const u32x4*)(yr + 2048);
        u32x4 w; w.x = pk2(bflo(a.x) + bflo(b.x) + bflo(c.x), bfhi(a.x) + bfhi(b.x) + bfhi(c.x)); w.y = pk2(bflo(a.y) + bflo(b.y) + bflo(c.y), bfhi(a.y) + bfhi(b.y) + bfhi(c.y));
        w.z = pk2(bflo(a.z) + bflo(b.z) + bflo(c.z), bfhi(a.z) + bfhi(b.z) + bfhi(c.z)); w.w = pk2(bflo(a.w) + bflo(b.w) + bflo(c.w), bfhi(a.w) + bfhi(b.w) + bfhi(c.w));
        *(u32x4*)(merged + row * D + c8) = w;
    }
}
template <class Epi>
__device__ __forceinline__ void pg8_gemm(LAS unsigned char* lds, const bf16_t* A, const bf16_t* Bt, int M, int N, int K, const Epi& e, size_t agrp = 0) {
    pg8::Gemm g{A, Bt, M, N, K, agrp};
    pg8::StaticOrder so; so.init(M, N, (int)gridDim.x, (int)blockIdx.x);
    pg8::gemm_phase<Epi, pg8::StaticOrder, false>(lds, g, so, e, nullptr);
    __syncthreads();
}

__device__ __forceinline__ void grid_barrier(unsigned* bar, unsigned k) {
    asm volatile("s_waitcnt vmcnt(0)" ::: "memory");
    __syncthreads();
    if (otid() == 0) {
        const unsigned g = blockIdx.x & 7u, ng = (gridDim.x + 7u - g) >> 3;
        __builtin_amdgcn_fence(__ATOMIC_RELEASE, "agent");
        asm volatile("s_waitcnt vmcnt(0)" ::: "memory");
        const unsigned c = __hip_atomic_fetch_add(bar + 16 * g, 1u, __ATOMIC_RELAXED, __HIP_MEMORY_SCOPE_AGENT);
        if (c == ng * k - 1u) {
            const unsigned ngroups = gridDim.x < 8u ? gridDim.x : 8u;
            const unsigned t = __hip_atomic_fetch_add(bar + 128, 1u, __ATOMIC_RELAXED, __HIP_MEMORY_SCOPE_AGENT);
            if (t == ngroups * k - 1u)
                for (unsigned j = 0; j < ngroups; ++j) __hip_atomic_store(bar + 144 + 16 * j, k, __ATOMIC_RELAXED, __HIP_MEMORY_SCOPE_AGENT);
        }
        unsigned spins = 0;
        while (__hip_atomic_load(bar + 144 + 16 * g, __ATOMIC_RELAXED, __HIP_MEMORY_SCOPE_AGENT) < k && ++spins < (1u << 28)) __builtin_amdgcn_s_sleep(1);
        __builtin_amdgcn_fence(__ATOMIC_ACQUIRE, "agent");
        asm volatile("s_waitcnt vmcnt(0)" ::: "memory");
    }
    __syncthreads();
}

__device__ __forceinline__ void transpose_item(const float* __restrict__ W, int N, int K, int k0, int n0, bf16_t* __restrict__ dst  , LAS float* scr, int lane) {
    {
        const int kr = lane >> 3, c4 = (lane & 7) * 4;
        f32x4 v[8];
#pragma unroll
        for (int i = 0; i < 8; ++i) v[i] = *(const f32x4*)(W + (size_t)(k0 + i * 8 + kr) * N + n0 + c4);
#pragma unroll
        for (int i = 0; i < 8; ++i) { LAS float* d = scr + (i * 8 + kr) * 33 + c4; d[0] = v[i].x; d[1] = v[i].y; d[2] = v[i].z; d[3] = v[i].w; }
    }
    LDS_WAIT();
    const int c = lane & 7;
#pragma unroll
    for (int j = 0; j < 4; ++j) {
        const int n = (lane >> 3) + 8 * j; const LAS float* s = scr + (8 * c) * 33 + n;
        u32x4 o; o.x = pk2(s[0 * 33], s[1 * 33]); o.y = pk2(s[2 * 33], s[3 * 33]); o.z = pk2(s[4 * 33], s[5 * 33]); o.w = pk2(s[6 * 33], s[7 * 33]);
        *(u32x4*)(dst + (size_t)n * K + k0 + 8 * c) = o;
    }
    LDS_WAIT();
}

constexpr int CONV_NIT = 16 * 257 + 3 * 8 * 32 + 16 * 32 + 16 * 128 + 64 * 32, CONV_BLOCK_ITEMS = (CONV_NIT + 7) / 8;
constexpr int CONV_IN_P2 = 112 * 2, CONV_IN_P4 = 64 * 4, CONV_IN_GEMM = CONV_IN_P2 + CONV_IN_P4;
__device__ __forceinline__ void convert_weights(const Params& p, int l, LAS unsigned char* lds, int bitem = -1) {
    const int lane = otid() & 63, wid = otid() >> 6;
    LAS float* scr = (LAS float*)(lds + wid * 16384);
    unsigned char* wb = p.ws + WS_W + (size_t)(l & 1) * W_END;
    constexpr int I_IN = 16 * 257, I_BR = 8 * 32, I_OUT = 16 * 32, I_FF1 = 16 * 128, I_FF2 = 64 * 32;
    constexpr int NIT = I_IN + 3 * I_BR + I_OUT + I_FF1 + I_FF2;
    for (int it = (bitem < 0 ? blockIdx.x * 8 + wid : bitem * 8 + wid); it < NIT; it += (bitem < 0 ? gridDim.x * 8 : NIT)) {
        int r = it;
        if (r < I_IN) { const int kb = r / 257, nb = r % 257, n0 = nb * 32;
            bf16_t* dst = n0 < NPROJ ? (bf16_t*)(wb + W_IN) + (size_t)n0 * D : (bf16_t*)(wb + W_G) + (size_t)(n0 - NPROJ) * D;
            transpose_item(p.w_in + (size_t)l * D * DIN, DIN, D, kb * 64, n0, dst, scr, lane); continue; }
        r -= I_IN;
        if (r < 3 * I_BR) { const int b = r / I_BR, q = r % I_BR, kb = q / 32, nb = q % 32;
            const float* W = (b == 0 ? p.w_br_gla : b == 1 ? p.w_br_hg : p.w_br_gm) + (size_t)l * 512 * D;
            transpose_item(W, D, 512, kb * 64, nb * 32, (bf16_t*)(wb + W_BR) + (size_t)b * D * 512 + (size_t)nb * 32 * 512, scr, lane); continue; }
        r -= 3 * I_BR;
        if (r < I_OUT) { const int kb = r / 32, nb = r % 32;
            transpose_item(p.w_out + (size_t)l * D * D, D, D, kb * 64, nb * 32, (bf16_t*)(wb + W_OUT) + (size_t)nb * 32 * D, scr, lane); continue; }
        r -= I_OUT;
        if (r < I_FF1) { const int kb = r / 128, nb = r % 128;
            transpose_item(p.w_ff1 + (size_t)l * D * DFF, DFF, D, kb * 64, nb * 32, (bf16_t*)(wb + W_FF1) + (size_t)nb * 32 * D, scr, lane); continue; }
        r -= I_FF1;
        { const int kb = r / 32, nb = r % 32;
            transpose_item(p.w_ff2 + (size_t)l * DFF * D, D, DFF, kb * 64, nb * 32, (bf16_t*)(wb + W_FF2) + (size_t)nb * 32 * DFF, scr, lane); }
    }
}

__device__ __forceinline__ void phase0(const Params& p, LAS unsigned char* lds) {
    const int tid = otid();
    float* x = p.out;
    for (size_t i = (size_t)blockIdx.x * 512 + tid; i < (size_t)NTOK * (D / 4); i += (size_t)gridDim.x * 512) {
        const int tok = (int)(i >> 8), c4 = (int)(i & 255) * 4;
        f32x4 v;
        if (tok < NCTX) v = *(const f32x4*)(p.x_prompt + (size_t)tok * D + c4);
        else {
            const int lt = tok - NCTX; v = *(const f32x4*)(p.x_sample + (size_t)lt * D + c4);
            const int t = lt & 2047; const float rr = (float)(t >> 6), cc = (float)(t & 63);
            const int sec = c4 >> 8; const float pos = sec < 2 ? rr : cc;
#pragma unroll
            for (int j = 0; j < 4; ++j) {
                const int f = (c4 + j) & 255;
                const float omega = exp2f((float)f * (-13.287712379549449f / 256.0f));
                const float a = pos * omega;
                v[j] += (sec & 1) ? __cosf(a) : __sinf(a);
            }
        }
        *(f32x4*)(x + i * 4) = v;
    }
    if (blockIdx.x == 0) {
        float* lbs = (float*)(p.ws + WS_LBS);
        for (int i = tid; i < 1024; i += 512) {
            const int dir = i >> 9, ch = i & 511; float lg[4], mx = -1e30f;
            for (int l = 0; l < 4; ++l) { lg[l] = p.hg_lb_logits[(size_t)(dir * 4 + l) * 512 + ch]; mx = fmaxf(mx, lg[l]); }
            float s = 0.f; for (int l = 0; l < 4; ++l) { lg[l] = expf(lg[l] - mx); s += lg[l]; }
            float cum = 0.f, c0 = 0.f;
            for (int l = 0; l < 4; ++l) { cum += lg[l] / s; if (l == 0) c0 = cum; lbs[(size_t)(dir * 4 + l) * 512 + ch] = cum - c0; }
        }
        for (int i = tid; i < 1024; i += 512) ((unsigned*)(p.ws + WS_CTR))[i] = 0u;
    }
    LAS float* sc = (LAS float*)lds;
    LAS float* red = sc + 9 * 1024;
    for (int i = tid; i < 9 * 1024; i += 512) { const int r = i >> 10, k = i & 1023; const float v = r == 0 ? p.c_ctx[k] : p.c[(size_t)(r - 1) * D + k]; sc[i] = siluf_(v); }
    __syncthreads();
    float* mod = (float*)(p.ws + WS_MOD);
    for (int u = blockIdx.x; u < DEPTH * 48; u += gridDim.x) {
        const int l = u / 48, cb = u % 48, cl = tid & 127, kp = tid >> 7, n = cb * 128 + cl;
        const float* w = p.ada_w + (size_t)l * D * 6144 + n;
        float a[9];
#pragma unroll
        for (int r = 0; r < 9; ++r) a[r] = 0.f;
#pragma unroll 4
        for (int k = kp * 256; k < kp * 256 + 256; ++k) {
            const float wv = w[(size_t)k * 6144];
#pragma unroll
            for (int r = 0; r < 9; ++r) a[r] += sc[r * 1024 + k] * wv;
        }
#pragma unroll
        for (int r = 0; r < 9; ++r) red[(kp * 9 + r) * 128 + cl] = a[r];
        __syncthreads();
        for (int i = tid; i < 9 * 128; i += 512) {
            const int r = i >> 7, c2 = i & 127;
            const float s = red[(0 * 9 + r) * 128 + c2] + red[(1 * 9 + r) * 128 + c2] + red[(2 * 9 + r) * 128 + c2] + red[(3 * 9 + r) * 128 + c2];
            mod[((size_t)l * 9 + r) * 6144 + cb * 128 + c2] = s + p.ada_b[(size_t)l * 6144 + cb * 128 + c2];
        }
        __syncthreads();
    }
}

__device__ __forceinline__ void norm_phase(const Params& p, const float* g, const float* mod_l, int off_sh, int off_sc, bf16_t* hout, int mode) {
    const int lane = otid() & 63, wid = otid() >> 6;
    float* x = p.out;
    for (int row = blockIdx.x * 8 + wid; row < NTOK; row += gridDim.x * 8) {
        f32x4 v[4]; float s = 0.f;
        float* xr = x + (size_t)row * D;
#pragma unroll
        for (int j = 0; j < 4; ++j) { v[j] = *(const f32x4*)(xr + lane * 4 + 256 * j); s += v[j].x * v[j].x + v[j].y * v[j].y + v[j].z * v[j].z + v[j].w * v[j].w; }
        const float rstd = rsqrtf(wave_sum(s) * (1.0f / D) + EPS);
        if (mode == 0) {
            const float* mr = mod_l + (size_t)mod_row(row) * 6144;
#pragma unroll
            for (int j = 0; j < 4; ++j) {
                const int c = lane * 4 + 256 * j;
                const f32x4 gg = *(const f32x4*)(g + c), sh = *(const f32x4*)(mr + off_sh + c), scv = *(const f32x4*)(mr + off_sc + c);
                const f32x4 o = (v[j] * rstd) * gg * (scv + 1.0f) + sh;
                u32x2 w; w.x = pk2(o.x, o.y); w.y = pk2(o.z, o.w);
                *(u32x2*)(hout + (size_t)row * D + c) = w;
            }
        } else {
#pragma unroll
            for (int j = 0; j < 4; ++j) { const int c = lane * 4 + 256 * j; const f32x4 gg = *(const f32x4*)(g + c); *(f32x4*)(xr + c) = (v[j] * rstd) * gg; }
        }
    }
}

template <int MIX>
__device__ __forceinline__ void gate_eval(const bf16_t* row, int kcol, int zcol, const float (&lrw)[16], float lrb, float lb, float& gt, float& kt) {
    if (!MIX) {
        const bf16_t* zr = row + zcol;
        const u32x4 z0 = *(const u32x4*)zr, z1 = *(const u32x4*)(zr + 8);
        float z = lrb;
        z += bflo(z0.x) * lrw[0] + bfhi(z0.x) * lrw[1] + bflo(z0.y) * lrw[2] + bfhi(z0.y) * lrw[3] + bflo(z0.z) * lrw[4] + bfhi(z0.z) * lrw[5] + bflo(z0.w) * lrw[6] + bfhi(z0.w) * lrw[7];
        z += bflo(z1.x) * lrw[8] + bfhi(z1.x) * lrw[9] + bflo(z1.y) * lrw[10] + bfhi(z1.y) * lrw[11] + bflo(z1.z) * lrw[12] + bfhi(z1.z) * lrw[13] + bflo(z1.w) * lrw[14] + bfhi(z1.w) * lrw[15];
        gt = logsigmoidf_(z) * (1.0f / 16.0f);
        kt = bf2f(row[kcol]);
    } else {
        const float xf = bf2f(row[kcol]);
        const float sg = sigmoidf_(xf);
        gt = flog_(lb + (1.0f - lb) * sg);
        kt = (1.0f - lb) * (1.0f - sg);
    }
}

template <int MIX>
__device__ __forceinline__ void gate_raw(unsigned kraw, const u32x4& z0, const u32x4& z1, const float (&lrw)[16], float lrb, float lb, float& gt, float& kt) {
    if (!MIX) {
        float z = lrb;
        z += bflo(z0.x) * lrw[0] + bfhi(z0.x) * lrw[1] + bflo(z0.y) * lrw[2] + bfhi(z0.y) * lrw[3] + bflo(z0.z) * lrw[4] + bfhi(z0.z) * lrw[5] + bflo(z0.w) * lrw[6] + bfhi(z0.w) * lrw[7];
        z += bflo(z1.x) * lrw[8] + bfhi(z1.x) * lrw[9] + bflo(z1.y) * lrw[10] + bfhi(z1.y) * lrw[11] + bflo(z1.z) * lrw[12] + bfhi(z1.z) * lrw[13] + bflo(z1.w) * lrw[14] + bfhi(z1.w) * lrw[15];
        gt = logsigmoidf_(z) * (1.0f / 16.0f);
        kt = bflo(kraw);
    } else {
        const float xf = bflo(kraw);
        const float sg = sigmoidf_(xf);
        gt = flog_(lb + (1.0f - lb) * sg);
        kt = (1.0f - lb) * (1.0f - sg);
    }
}

template <int MIX>
__device__ __forceinline__ void scan_job(const Params& p, int l, int s, int dir, int hd, LAS unsigned char* lds) {
    constexpr int DK = MIX ? 128 : 64, WM = DK / 32, WN = 8 / WM, WTN = 128 / WN, NTL = WTN / 32, LDT = 72, LDG = DK + 1;
    LAS bf16_t* At = (LAS bf16_t*)lds;
    LAS bf16_t* Bt = At + 128 * LDT;
    LAS float* dec = (LAS float*)(lds + 2 * 128 * LDT * 2);
    LAS float* G = dec + 128;
    LAS float* KK = G + 64 * 129;
    const int tid = otid(), lane = tid & 63, wid = tid >> 6, wm = wid / WN, wn = wid % WN;
    const bool ctx = s < 16;
    const int T = ctx ? 256 : 2048, tok0 = ctx ? s * 256 : NCTX + (s - 16) * 2048, nch = T / 64;
    const bf16_t* proj = (const bf16_t*)(p.ws + WS_PROJ);
    const float* lbs = (const float*)(p.ws + WS_LBS);
    bf16_t* sbuf = (bf16_t*)(p.ws + WS_ST + (MIX ? ST_GLA_BYTES : 0));
    f32x16 S[1][NTL];
    {
        const float* st0 = ctx ? nullptr : (MIX ? p.state_hgrn + ((((size_t)(s - 16) * DEPTH + l) * 2 + dir) * 4 + hd) * 128 * 128
                                                : p.state_gla + ((((size_t)(s - 16) * DEPTH + l) * 2 + dir) * 4 + hd) * 64 * 128);
#pragma unroll
        for (int n = 0; n < NTL; ++n)
#pragma unroll
            for (int i = 0; i < 16; ++i) {
                const int d = wm * 32 + (i & 3) + 8 * (i >> 2) + 4 * (lane >> 5), v = wn * WTN + n * 32 + (lane & 31);
                S[0][n][i] = ctx ? 0.f : st0[(size_t)d * 128 + v];
            }
    }
    const int sd = tid & (DK - 1), t0 = tid / DK; constexpr int TS = 512 / DK;
    float lrw[16]; float lrb = 0.f, lb = 0.f;
    if (!MIX) {
#pragma unroll
        for (int r = 0; r < 16; ++r) lrw[r] = p.gla_lr_w[(((size_t)l * 2 + dir) * 16 + r) * 256 + hd * 64 + sd];
        lrb = p.gla_lr_b[((size_t)l * 2 + dir) * 256 + hd * 64 + sd];
    } else {
#pragma unroll
        for (int r = 0; r < 16; ++r) lrw[r] = 0.f;
        lb = lbs[(size_t)(dir * 4 + l) * 512 + hd * 128 + sd];
    }
    const int kcol = MIX ? (dir ? PJ_HFB : PJ_HFF) + hd * 128 + sd : PJ_GK + hd * 64 + sd;
    const int zcol = dir ? PJ_GZB : PJ_GZF;
    const int vv = tid & 127, vq = tid >> 7;
    const int vcol = (MIX ? PJ_HI : PJ_GV) + hd * 128 + vv;
    const int kd = tid >> 2, kq = tid & 3;
    const bool k2 = tid < 4 * DK;

    constexpr int NE = 64 / TS;
    unsigned kraw[NE]; unsigned vraw[8];
    const int widu = __builtin_amdgcn_readfirstlane(tid >> 6), gmt = (widu >> 1) & 1, gnt = widu & 1;
    bf16x8 gafr = {0, 0, 0, 0, 0, 0, 0, 0}; u32x4 gbw = {0u, 0u, 0u, 0u}; float gbias = 0.f;
    if (!MIX && widu < 4) {
        const float* lw = p.gla_lr_w + (((size_t)l * 2 + dir) * 16 + 8 * (lane >> 5)) * 256 + hd * 64 + gnt * 32 + (lane & 31);
        float wv[8];
#pragma unroll
        for (int j = 0; j < 8; ++j) wv[j] = lw[(size_t)j * 256];
        gbw.x = pk2(wv[0], wv[1]); gbw.y = pk2(wv[2], wv[3]); gbw.z = pk2(wv[4], wv[5]); gbw.w = pk2(wv[6], wv[7]);
        gbias = p.gla_lr_b[((size_t)l * 2 + dir) * 256 + hd * 64 + gnt * 32 + (lane & 31)];
    }
    auto load_chunk = [&](const bf16_t* prc) {
#pragma unroll
        for (int i = 0; i < NE; ++i) {
            const bf16_t* row = prc + (size_t)(t0 + TS * i) * NPROJ;
            kraw[i] = row[kcol];
        }
        if (!MIX && widu < 4) gafr = *(const bf16x8*)(prc + (size_t)(gmt * 32 + (lane & 31)) * NPROJ + zcol + 8 * (lane >> 5));
#pragma unroll
        for (int t = 0; t < 16; t += 2) {
            const unsigned a = prc[(size_t)(vq * 16 + t) * NPROJ + vcol], b = prc[(size_t)(vq * 16 + t + 1) * NPROJ + vcol];
            vraw[t >> 1] = a | (b << 16);
        }
    };
    auto store_state = [&](int gcs) {
        bf16_t* sb = sbuf + (((size_t)gcs * 2 + dir) * 4 + hd) * 128 * DK;
#pragma unroll
        for (int nn = 0; nn < NTL; ++nn)
#pragma unroll
            for (int q = 0; q < 4; ++q) {
                const int d0 = wm * 32 + 8 * q + 4 * (lane >> 5), v = wn * WTN + nn * 32 + (lane & 31);
                u32x2 w; w.x = pk2(S[0][nn][4 * q + 0], S[0][nn][4 * q + 1]); w.y = pk2(S[0][nn][4 * q + 2], S[0][nn][4 * q + 3]);
                *(u32x2*)(sb + (size_t)v * DK + d0) = w;
            }
    };
    load_chunk(proj + (size_t)(tok0 + (dir ? nch - 1 : 0) * 64) * NPROJ);
    store_state((tok0 >> 6) + (dir ? nch - 1 : 0));
    for (int n = 0; n < nch; ++n) {
        if (MIX) {
#pragma unroll
            for (int i = 0; i < NE; ++i) {
                const int t = t0 + TS * i; float gt, kt; const u32x4 zz = {0u, 0u, 0u, 0u};
                gate_raw<MIX>(kraw[i], zz, zz, lrw, lrb, lb, gt, kt);
                G[t * LDG + sd] = gt; KK[t * LDG + sd] = kt;
            }
        } else {
#pragma unroll
            for (int i = 0; i < NE; ++i) KK[(t0 + TS * i) * LDG + sd] = bflo(kraw[i]);
            if (widu < 4) {
                f32x16 zacc;
#pragma unroll
                for (int i = 0; i < 16; ++i) zacc[i] = 0.f;
                zacc = __builtin_amdgcn_mfma_f32_32x32x16_bf16(gafr, __builtin_bit_cast(bf16x8, gbw), zacc, 0, 0, 0);
#pragma unroll
                for (int i = 0; i < 16; ++i)
                    G[(gmt * 32 + (i & 3) + 8 * (i >> 2) + 4 * (lane >> 5)) * LDG + gnt * 32 + (lane & 31)] = logsigmoidf_(zacc[i] + gbias) * (1.0f / 16.0f);
            }
        }
#pragma unroll
        for (int q = 0; q < 2; ++q) { u32x4 w; w.x = vraw[4 * q]; w.y = vraw[4 * q + 1]; w.z = vraw[4 * q + 2]; w.w = vraw[4 * q + 3]; *(LAS u32x4*)(Bt + vv * LDT + vq * 16 + q * 8) = w; }
        if (n + 1 < nch) load_chunk(proj + (size_t)(tok0 + (dir ? nch - 2 - n : n + 1) * 64) * NPROJ);
        __syncthreads();
        if (k2) {
            float g[16]; float qs = 0.f;
#pragma unroll
            for (int t = 0; t < 16; ++t) { g[t] = G[(kq * 16 + t) * LDG + kd]; qs += g[t]; }
            const int lb4 = lane & ~3;
            const float s0 = __shfl(qs, lb4), s1 = __shfl(qs, lb4 + 1), s2 = __shfl(qs, lb4 + 2), s3 = __shfl(qs, lb4 + 3);
            const float total = (s0 + s1) + (s2 + s3);
            float pref = (kq > 0 ? s0 : 0.f) + (kq > 1 ? s1 : 0.f) + (kq > 2 ? s2 : 0.f);
            unsigned pkv[8];
#pragma unroll
            for (int t = 0; t < 16; ++t) {
                const float pe = pref; pref += g[t];
                const float w = dir ? pe : total - pref;
                const float kv = KK[(kq * 16 + t) * LDG + kd] * fexp_(w);
                if (t & 1) pkv[t >> 1] = pk2(__uint_as_float(pkv[t >> 1]), kv); else pkv[t >> 1] = __float_as_uint(kv);
            }
#pragma unroll
            for (int q = 0; q < 2; ++q) { u32x4 w; w.x = pkv[4 * q]; w.y = pkv[4 * q + 1]; w.z = pkv[4 * q + 2]; w.w = pkv[4 * q + 3]; *(LAS u32x4*)(At + kd * LDT + kq * 16 + q * 8) = w; }
            if (kq == 0) dec[kd] = fexp_(total);
        }
        __syncthreads();
#pragma unroll
        for (int nn = 0; nn < NTL; ++nn)
#pragma unroll
            for (int i = 0; i < 16; ++i) S[0][nn][i] *= dec[wm * 32 + (i & 3) + 8 * (i >> 2) + 4 * (lane >> 5)];
        mma_lds<1, NTL, 4>(S, At + wm * 32 * LDT, LDT, Bt + wn * WTN * LDT, LDT, lane);
        if (n + 1 < nch) store_state((tok0 >> 6) + (dir ? nch - 2 - n : n + 1));
        __syncthreads();
    }
    if (ctx) {
        float* o = MIX ? p.out + (size_t)NTOK * D + (size_t)16 * DEPTH * 2 * 4 * 64 * 128 + ((((size_t)s * DEPTH + l) * 2 + dir) * 4 + hd) * 128 * 128
                       : p.out + (size_t)NTOK * D + ((((size_t)s * DEPTH + l) * 2 + dir) * 4 + hd) * 64 * 128;
#pragma unroll
        for (int nn = 0; nn < NTL; ++nn)
#pragma unroll
            for (int i = 0; i < 16; ++i) {
                const int d = wm * 32 + (i & 3) + 8 * (i >> 2) + 4 * (lane >> 5), v = wn * WTN + nn * 32 + (lane & 31);
                o[(size_t)d * 128 + v] = S[0][nn][i];
            }
    }
}


__device__ __forceinline__ void gmlp_item(const Params& p, int l, int c2, int g, LAS unsigned char* lds) {
    constexpr int LDT = 136;
    LAS bf16_t* Aw = (LAS bf16_t*)lds;
    LAS bf16_t* Bt = Aw + 128 * LDT;
    const int tid = otid(), lane = tid & 63, wid = tid >> 6, wm = wid >> 2, wn = wid & 3;
    const bf16_t* proj = (const bf16_t*)(p.ws + WS_PROJ);
    const int tokb = c2 * 128;
    {
        const float* wsrc = p.gm_ws + ((size_t)l * 4 + g) * 128 * 128;
#pragma unroll
        for (int i = 0; i < 8; ++i) {
            const int e = (i * 512 + tid) * 4, pp = e >> 7, q = e & 127;
            const f32x4 v = *(const f32x4*)(wsrc + e);
            u32x2 w; w.x = pk2(v.x, v.y); w.y = pk2(v.z, v.w);
            *(LAS u32x2*)(Aw + pp * LDT + q) = w;
        }
    }
    {
        const int q = tid >> 2, part = tid & 3;
        const bf16_t* mv = proj + (size_t)(tokb + q) * NPROJ + PJ_MV;
        float ggv[32];
        {
            const float* ggp = p.gm_norm_g + (size_t)l * 512 + g * 128 + part * 32;
#pragma unroll
            for (int i = 0; i < 8; ++i) { const f32x4 t4 = *(const f32x4*)(ggp + 4 * i); ggv[4 * i] = t4.x; ggv[4 * i + 1] = t4.y; ggv[4 * i + 2] = t4.z; ggv[4 * i + 3] = t4.w; }
        }
        float s = 0.f, s2 = 0.f;
#pragma unroll
        for (int i = 0; i < 16; ++i) {
            const u32x4 u = *(const u32x4*)(mv + (i * 4 + part) * 8);
            const unsigned uu[4] = {u.x, u.y, u.z, u.w};
#pragma unroll
            for (int j = 0; j < 4; ++j) { const float a = geluf_(bflo(uu[j])), b = geluf_(bfhi(uu[j])); s += a + b; s2 += a * a + b * b; }
        }
        s += __shfl_xor(s, 1); s += __shfl_xor(s, 2); s2 += __shfl_xor(s2, 1); s2 += __shfl_xor(s2, 2);
        const float mean = s * (1.0f / 512.0f), var = fmaxf(s2 * (1.0f / 512.0f) - mean * mean, 0.f), rstd = rsqrtf(var + EPS);
        const bf16_t* mvg = mv + g * 128 + part * 32;
#pragma unroll
        for (int i = 0; i < 4; ++i) {
            const u32x4 u = *(const u32x4*)(mvg + i * 8);
            const unsigned uu[4] = {u.x, u.y, u.z, u.w};
#pragma unroll
            for (int j = 0; j < 4; ++j) {
                const int c = part * 32 + i * 8 + j * 2;
                const float a = (geluf_(bflo(uu[j])) - mean) * rstd * ggv[i * 8 + j * 2], b = (geluf_(bfhi(uu[j])) - mean) * rstd * ggv[i * 8 + j * 2 + 1];
                Bt[c * LDT + q] = f2bf(a); Bt[(c + 1) * LDT + q] = f2bf(b);
            }
        }
    }
    const float* bs = p.gm_bs + ((size_t)l * 4 + g) * 128;
    bf16_t muv[2][16]; float bsv[2][16];
#pragma unroll
    for (int m = 0; m < 2; ++m)
#pragma unroll
        for (int i = 0; i < 16; ++i) {
            const int pp = wm * 64 + m * 32 + (i & 3) + 8 * (i >> 2) + 4 * (lane >> 5), c = wn * 32 + (lane & 31);
            muv[m][i] = proj[(size_t)(tokb + pp) * NPROJ + PJ_MU + g * 128 + c]; bsv[m][i] = bs[pp];
        }
    __syncthreads();
    f32x16 acc[2][1]; acc_zero<1>(acc);
    mma_lds<2, 1, 8>(acc, Aw + wm * 64 * LDT, LDT, Bt + wn * 32 * LDT, LDT, lane);
    bf16_t* ocat = (bf16_t*)(p.ws + WS_OCAT);
#pragma unroll
    for (int m = 0; m < 2; ++m)
#pragma unroll
        for (int i = 0; i < 16; ++i) {
            const int pp = wm * 64 + m * 32 + (i & 3) + 8 * (i >> 2) + 4 * (lane >> 5), c = wn * 32 + (lane & 31);
            ocat[(size_t)2 * NTOK * 512 + (size_t)(tokb + pp) * 512 + g * 128 + c] = f2bf(geluf_(bf2f(muv[m][i])) * (acc[m][0][i] + bsv[m][i]));
        }
    __syncthreads();
}

__device__ __forceinline__ void phase_scan(const Params& p, int l, LAS unsigned char* lds) {
    LAS int* slot = (LAS int*)(lds + LDS_BYTES - 16);
    unsigned* ctr = (unsigned*)(p.ws + WS_CTR) + l;
    constexpr int NLAT = 8 * 2 * 4 * 2, NCX = 16 * 2 * 4 * 2, NGM = 160 * 4;
    for (;;) {
        if (otid() == 0) *slot = (int)atomicAdd(ctr, 1u);
        __syncthreads();
        const int j = *slot;
        __syncthreads();
        const int nconv = l + 1 < DEPTH ? CONV_BLOCK_ITEMS - CONV_IN_GEMM : 0;
        if (j >= NLAT + NCX + NGM + nconv) break;
        if (j >= NLAT + NCX + NGM) { convert_weights(p, l + 1, lds, CONV_IN_GEMM + j - (NLAT + NCX + NGM)); __syncthreads(); continue; }
        if (j < NLAT + NCX) {
            int r = j, s;
            if (r < NLAT) { s = 16 + (r >> 4); r &= 15; } else { r -= NLAT; s = r >> 4; r &= 15; }
            const int mix = r & 1, dir = (r >> 1) & 1, hd = r >> 2;
            if (mix) scan_job<1>(p, l, s, dir, hd, lds); else scan_job<0>(p, l, s, dir, hd, lds);
        } else { const int r = j - NLAT - NCX; gmlp_item(p, l, r >> 2, r & 3, lds); }
    }
}

template <int MIX>
__device__ __forceinline__ void out_item(const Params& p, int l, int gc, int hd, LAS unsigned char* lds) {
    constexpr int DK = MIX ? 128 : 64, LQ = DK + 8, LDV = 72, LDG = DK + 1;
    LAS bf16_t* QA = (LAS bf16_t*)lds;
    LAS bf16_t* KA = QA + 128 * LQ;
    LAS bf16_t* QS = KA + 128 * LQ;
    LAS bf16_t* VT = QS + 64 * LQ;
    LAS bf16_t* P = VT + 128 * LDV;
    LAS float* C = (LAS float*)(P + 64 * LDV);
    LAS float* BS = C + (MIX ? 64 : 128) * LDG;
    LAS bf16_t* ST = KA;
    LAS float* Of = (LAS float*)lds;
    const int tid = otid(), lane = tid & 63, wid = __builtin_amdgcn_readfirstlane(tid >> 6);
    const int tokb = gc * 64;
    const bf16_t* proj = (const bf16_t*)(p.ws + WS_PROJ);
    const bf16_t* pr = proj + (size_t)tokb * NPROJ;
    const float* lbs = (const float*)(p.ws + WS_LBS);
    const bf16_t* sbuf = (const bf16_t*)(p.ws + WS_ST + (MIX ? ST_GLA_BYTES : 0));
    constexpr int NPQ = 64 * (DK / 8), NRQ = NPQ / 512;
    u32x4 rq[NRQ], rk[NRQ];
    auto load_raw = [&](int dr) {
        const int kcol0 = MIX ? (dr ? PJ_HFB : PJ_HFF) + hd * 128 : PJ_GK + hd * 64;
        const int qcol0 = MIX ? PJ_HQ + hd * 128 : PJ_GQ + hd * 64;
#pragma unroll
        for (int k = 0; k < NRQ; ++k) { const int e = tid + 512 * k; const int t = e / (DK / 8), c8 = (e % (DK / 8)) * 8;
            rq[k] = *(const u32x4*)(pr + (size_t)t * NPROJ + qcol0 + c8); rk[k] = *(const u32x4*)(pr + (size_t)t * NPROJ + kcol0 + c8); }
    };
    load_raw(0);
    const int kdp = tid & (DK - 1);
    float gnv[16];
    {
        const float* gn = (MIX ? p.hg_norm_g : p.gla_norm_g) + (size_t)l * 512 + hd * 128 + (tid & 7) * 16;
#pragma unroll
        for (int j = 0; j < 16; j += 4) { const f32x4 t4 = *(const f32x4*)(gn + j); gnv[j] = t4.x; gnv[j + 1] = t4.y; gnv[j + 2] = t4.z; gnv[j + 3] = t4.w; }
    }
    const float lbd0 = MIX ? lbs[(size_t)(0 * 4 + l) * 512 + hd * 128 + kdp] : 0.f, lbd1 = MIX ? lbs[(size_t)(1 * 4 + l) * 512 + hd * 128 + kdp] : 0.f;
    typedef float f32x2p_t __attribute__((ext_vector_type(2)));
    const f32x2p_t zz2 = {0.f, 0.f};
    const f32x2p_t lbp0 = MIX ? *(const f32x2p_t*)(lbs + (size_t)(0 * 4 + l) * 512 + hd * 128 + 2 * (tid & 63)) : zz2, lbp1 = MIX ? *(const f32x2p_t*)(lbs + (size_t)(1 * 4 + l) * 512 + hd * 128 + 2 * (tid & 63)) : zz2;
    if (!MIX) {
        const int gd = wid >> 2, mt = (wid >> 1) & 1, nt = wid & 1, r = lane & 31, h = lane >> 5;
        const bf16x8 afr = *(const bf16x8*)(pr + (size_t)(mt * 32 + r) * NPROJ + (gd ? PJ_GZB : PJ_GZF) + 8 * h);
        const float* lw = p.gla_lr_w + (((size_t)l * 2 + gd) * 16 + 8 * h) * 256 + hd * 64 + nt * 32 + r;
        float wv[8];
#pragma unroll
        for (int j = 0; j < 8; ++j) wv[j] = lw[(size_t)j * 256];
        const float bias = p.gla_lr_b[((size_t)l * 2 + gd) * 256 + hd * 64 + nt * 32 + r];
        u32x4 bw; bw.x = pk2(wv[0], wv[1]); bw.y = pk2(wv[2], wv[3]); bw.z = pk2(wv[4], wv[5]); bw.w = pk2(wv[6], wv[7]);
        f32x16 zacc;
#pragma unroll
        for (int i = 0; i < 16; ++i) zacc[i] = 0.f;
        zacc = __builtin_amdgcn_mfma_f32_32x32x16_bf16(afr, __builtin_bit_cast(bf16x8, bw), zacc, 0, 0, 0);
#pragma unroll
        for (int i = 0; i < 16; ++i) {
            const int t = mt * 32 + (i & 3) + 8 * (i >> 2) + 4 * h;
            C[(gd * 64 + (gd ? 63 - t : t)) * LDG + nt * 32 + r] = logsigmoidf_(zacc[i] + bias) * (1.0f / 16.0f);
        }
    }
    const bf16_t* gatep = pr + (size_t)(tid >> 3) * NPROJ + (MIX ? PJ_HO : PJ_GO) + hd * 128 + (tid & 7) * 16;
    const u32x4 g0 = *(const u32x4*)gatep, g1 = *(const u32x4*)(gatep + 8);
    {
        const int vv = tid & 127, qt = tid >> 7;
        const int vcol = (MIX ? PJ_HI : PJ_GV) + hd * 128 + vv;
        unsigned pkv[8];
#pragma unroll
        for (int t = 0; t < 16; t += 2) {
            const unsigned a = pr[(size_t)(qt * 16 + t) * NPROJ + vcol], b = pr[(size_t)(qt * 16 + t + 1) * NPROJ + vcol];
            pkv[t >> 1] = a | (b << 16);
        }
#pragma unroll
        for (int q = 0; q < 2; ++q) { u32x4 w; w.x = pkv[4 * q]; w.y = pkv[4 * q + 1]; w.z = pkv[4 * q + 2]; w.w = pkv[4 * q + 3]; *(LAS u32x4*)(VT + vv * LDV + qt * 16 + q * 8) = w; }
    }
    const int wm = wid >> 2, wn = wid & 3;
    f32x16 o[1][1];
#pragma unroll
    for (int i = 0; i < 16; ++i) o[0][0][i] = 0.f;

#pragma unroll 1
    for (int dir = 0; dir < 2; ++dir) {
        const int kd = tid & (DK - 1), ba = tid / DK;
#pragma unroll
        for (int k = 0; k < NRQ; ++k) { const int e = tid + 512 * k; const int t = e / (DK / 8), c8 = (e % (DK / 8)) * 8;
            *(LAS u32x4*)(QS + t * LQ + c8) = rq[k]; *(LAS u32x4*)(KA + (64 + (dir ? 63 - t : t)) * LQ + c8) = rk[k]; }
        __syncthreads();
        if (MIX) {
            const int cp = tid & 63, bh = tid >> 6, bah = bh >> 1, u0 = (bh & 1) * 8;
            const float lbA = dir ? lbp1.x : lbp0.x, lbB = dir ? lbp1.y : lbp0.y;
            float gA[8], gB[8], kA[8], kB[8]; float thA = 0.f, thB = 0.f;
            {
                const LAS bf16_t* kzr = KA + (64 + bah * 16 + u0) * LQ + 2 * cp;
#pragma unroll
                for (int u = 0; u < 8; ++u) {
                    const unsigned raw = *(const LAS unsigned*)(kzr + u * LQ);
                    const float sa = sigmoidf_(bflo(raw)), sb = sigmoidf_(bfhi(raw));
                    gA[u] = flog_(lbA + (1.0f - lbA) * sa); kA[u] = (1.0f - lbA) * (1.0f - sa); thA += gA[u];
                    gB[u] = flog_(lbB + (1.0f - lbB) * sb); kB[u] = (1.0f - lbB) * (1.0f - sb); thB += gB[u];
                }
                typedef float f32x2_t __attribute__((ext_vector_type(2)));
                f32x2_t th; th.x = thA; th.y = thB;
                *(LAS f32x2_t*)(BS + bh * DK + 2 * cp) = th;
            }
            __syncthreads();
            {
                typedef float f32x2_t __attribute__((ext_vector_type(2)));
                f32x2_t hh[8];
#pragma unroll
                for (int j = 0; j < 8; ++j) hh[j] = *(const LAS f32x2_t*)(BS + j * DK + 2 * cp);
                const f32x2_t T0 = hh[0] + hh[1], T1 = hh[2] + hh[3], T2 = hh[4] + hh[5], T3 = hh[6] + hh[7];
                const f32x2_t Tb = bah == 0 ? T0 : bah == 1 ? T1 : bah == 2 ? T2 : T3;
                const f32x2_t l7 = bah == 0 ? hh[0] : bah == 1 ? hh[2] : bah == 2 ? hh[4] : hh[6];
                const f32x2_t zero2 = {0.f, 0.f};
                const f32x2_t base = bah == 0 ? zero2 : bah == 1 ? T0 : bah == 2 ? T0 + T1 : T0 + T1 + T2;
                const f32x2_t c31 = T0 + T1;
                float lpA = u0 ? l7.x : 0.f, lpB = u0 ? l7.y : 0.f;
                const float qscale = 0.08838834764831845f;
                LAS bf16_t* qz = QA + (64 + bah * 16 + u0) * LQ + 2 * cp;
                LAS bf16_t* kz = KA + (64 + bah * 16 + u0) * LQ + 2 * cp;
                LAS bf16_t* xrow = (bah < 2 ? KA + (bah * 16 + u0) * LQ : QA + (bah * 16 + u0 - 32) * LQ) + 2 * cp;
                LAS bf16_t* yrow = ((bah & 1) ? QA + (32 + (bah >> 1) * 16 + u0) * LQ : KA + (32 + (bah >> 1) * 16 + u0) * LQ) + 2 * cp;
                const bool xk = bah < 2, yq = (bah & 1) != 0;
#pragma unroll
                for (int u = 0; u < 8; ++u) {
                    const int pp = bah * 16 + u0 + u, t = dir ? 63 - pp : pp;
                    lpA += gA[u]; lpB += gB[u];
                    const float cA = base.x + lpA, cB = base.y + lpB;
                    const unsigned qraw = *(const LAS unsigned*)(QS + t * LQ + 2 * cp);
                    const float qa = bflo(qraw) * qscale, qb = bfhi(qraw) * qscale;
                    *(LAS unsigned*)(QS + t * LQ + 2 * cp) = pk2(qa * fexp_(cA), qb * fexp_(cB));
                    *(LAS unsigned*)(qz + u * LQ) = pk2(qa * fexp_(lpA - l7.x), qb * fexp_(lpB - l7.y));
                    *(LAS unsigned*)(kz + u * LQ) = pk2(kA[u] * fexp_(l7.x - lpA), kB[u] * fexp_(l7.y - lpB));
                    *(LAS unsigned*)(xrow + u * LQ) = pk2((xk ? kA[u] : qa) * fexp_(xk ? c31.x - cA : cA - c31.x), (xk ? kB[u] : qb) * fexp_(xk ? c31.y - cB : cB - c31.y));
                    *(LAS unsigned*)(yrow + u * LQ) = pk2((yq ? qa : kA[u]) * fexp_(yq ? lpA : Tb.x - lpA), (yq ? qb : kB[u]) * fexp_(yq ? lpB : Tb.y - lpB));
                }
            }
            __syncthreads();
        } else {
        float gk[16], kk[16]; float lp7 = 0.f, Ta = 0.f;
        if (MIX) {
            const float lb = dir ? lbd1 : lbd0;
            const LAS bf16_t* kz0 = KA + (64 + ba * 16) * LQ + kd;
#pragma unroll
            for (int u = 0; u < 16; ++u) {
                const float sg = sigmoidf_(bf2f(kz0[u * LQ]));
                gk[u] = flog_(lb + (1.0f - lb) * sg); kk[u] = (1.0f - lb) * (1.0f - sg);
                Ta += gk[u]; if (u == 7) lp7 = Ta;
            }
            BS[ba * DK + kd] = Ta;
        } else {
            if (ba < 4) {
#pragma unroll
                for (int u = 0; u < 16; ++u) { gk[u] = C[(dir * 64 + ba * 16 + u) * LDG + kd]; Ta += gk[u]; if (u == 7) lp7 = Ta; }
                BS[ba * DK + kd] = Ta;
            }
        }
        __syncthreads();
        if (ba < 4) {
            const float T0 = BS[kd], T1 = BS[DK + kd], T2 = BS[2 * DK + kd];
            const float base = ba == 0 ? 0.f : ba == 1 ? T0 : ba == 2 ? T0 + T1 : T0 + T1 + T2;
            const float c31 = T0 + T1;
            const float qscale = MIX ? 0.08838834764831845f : 0.125f;
            LAS bf16_t* qz = QA + (64 + ba * 16) * LQ + kd;
            LAS bf16_t* kz = KA + (64 + ba * 16) * LQ + kd;
            LAS bf16_t* xrow = (ba < 2 ? KA + (ba * 16) * LQ : QA + (ba * 16 - 32) * LQ) + kd;
            LAS bf16_t* yrow = ((ba & 1) ? QA + (32 + (ba >> 1) * 16) * LQ : KA + (32 + (ba >> 1) * 16) * LQ) + kd;
            float lp = 0.f;
#pragma unroll
            for (int u = 0; u < 16; ++u) {
                const int pp = ba * 16 + u, t = dir ? 63 - pp : pp;
                lp += gk[u];
                const float c = base + lp;
                const float qv = bf2f(QS[t * LQ + kd]) * qscale;
                const float kt = MIX ? kk[u] : bf2f(kz[u * LQ]);
                QS[t * LQ + kd] = f2bf(qv * fexp_(c));
                qz[u * LQ] = f2bf(qv * fexp_(lp - lp7));
                kz[u * LQ] = f2bf(kt * fexp_(lp7 - lp));
                xrow[u * LQ] = f2bf(ba < 2 ? kt * fexp_(c31 - c) : qv * fexp_(c - c31));
                yrow[u * LQ] = f2bf((ba & 1) ? qv * fexp_(lp) : kt * fexp_(Ta - lp));
            }
        }
        __syncthreads();
        }
        if (dir == 0) load_raw(1);
        constexpr int PIECES = 128 * DK / 8, NPC = PIECES / 512;
        u32x4 stv[NPC];
        {
            const bf16_t* sb = sbuf + (((size_t)gc * 2 + dir) * 4 + hd) * 128 * DK;
#pragma unroll
            for (int k = 0; k < NPC; ++k) { const int e = tid + 512 * k; const int v = e / (DK / 8), d0 = (e % (DK / 8)) * 8; stv[k] = *(const u32x4*)(sb + (size_t)v * DK + d0); }
        }
        if (wid < 4) {
            f32x16 sc[1][1];
#pragma unroll
            for (int i = 0; i < 16; ++i) sc[0][0][i] = 0.f;
            mma_lds<1, 1, DK / 16>(sc, KA + wid * 32 * LQ, LQ, QA + wid * 32 * LQ, LQ, lane);
            const int cc = lane & 31;
#pragma unroll
            for (int q = 0; q < 4; ++q) {
                const int r0 = 8 * q + 4 * (lane >> 5);
                int pi, pj0; bool wr = true, zero = false, tri = false;
                if (wid == 0) { pi = 32 + cc; pj0 = r0; }
                else if (wid == 1) { pi = cc < 16 ? 16 + cc : 32 + cc; pj0 = r0 < 16 ? r0 : r0 + 16; wr = (r0 < 16) == (cc < 16); }
                else { const int off = (wid - 2) * 32; pi = off + cc; pj0 = off + r0; const bool same = (r0 >> 4) == (cc >> 4); tri = same; zero = !same && r0 >= 16; wr = same || zero; }
                float v[4];
#pragma unroll
                for (int e = 0; e < 4; ++e) { float x = sc[0][0][4 * q + e]; if (tri && (r0 + e > cc)) x = 0.f; if (zero) x = 0.f; v[e] = x; }
                if (wr) {
                    u32x2 w;
                    if (dir == 0) { w.x = pk2(v[0], v[1]); w.y = pk2(v[2], v[3]); *(LAS u32x2*)(P + pi * LDV + pj0) = w; }
                    else { w.x = pk2(v[3], v[2]); w.y = pk2(v[1], v[0]); *(LAS u32x2*)(P + (63 - pi) * LDV + (60 - pj0)) = w; }
                }
            }
        } else if (wid == 4) {
#pragma unroll
            for (int k = 0; k < 2; ++k) {
                const int idx = lane * 2 + k, row = idx >> 2, piece = idx & 3;
                const int ti = dir ? 32 + row : row, tj = (dir ? 0 : 32) + piece * 8;
                u32x4 z; z.x = 0; z.y = 0; z.z = 0; z.w = 0;
                *(LAS u32x4*)(P + ti * LDV + tj) = z;
            }
        }
        __syncthreads();
#pragma unroll
        for (int k = 0; k < NPC; ++k) { const int e = tid + 512 * k; const int v = e / (DK / 8), d0 = (e % (DK / 8)) * 8; *(LAS u32x4*)(ST + v * LQ + d0) = stv[k]; }
        mma_lds<1, 1, 4>(o, P + wm * 32 * LDV, LDV, VT + wn * 32 * LDV, LDV, lane);
        __syncthreads();
        mma_lds<1, 1, DK / 16>(o, QS + wm * 32 * LQ, LQ, ST + wn * 32 * LQ, LQ, lane);
        __syncthreads();
    }
#pragma unroll
    for (int i = 0; i < 16; ++i) Of[(wm * 32 + (i & 3) + 8 * (i >> 2) + 4 * (lane >> 5)) * 132 + wn * 32 + (lane & 31)] = o[0][0][i];
    __syncthreads();
    {
        const int i_ = tid >> 3, seg = tid & 7;
        const LAS float* orow = Of + i_ * 132 + seg * 16;
        float v[16]; float ss = 0.f;
#pragma unroll
        for (int j = 0; j < 16; ++j) { v[j] = orow[j]; ss += v[j] * v[j]; }
        ss += __shfl_xor(ss, 1); ss += __shfl_xor(ss, 2); ss += __shfl_xor(ss, 4);
        const float r = rsqrtf(ss * (1.0f / 128.0f) + EPS);
        const unsigned gu[8] = {g0.x, g0.y, g0.z, g0.w, g1.x, g1.y, g1.z, g1.w};
        unsigned ow[8];
#pragma unroll
        for (int j = 0; j < 8; ++j) {
            const float a = v[2 * j] * r * gnv[2 * j] * siluf_(bflo(gu[j])), b = v[2 * j + 1] * r * gnv[2 * j + 1] * siluf_(bfhi(gu[j]));
            ow[j] = pk2(a, b);
        }
        bf16_t* dst = (bf16_t*)(p.ws + WS_OCAT) + (size_t)(MIX ? 1 : 0) * NTOK * 512 + (size_t)(tokb + i_) * 512 + hd * 128 + seg * 16;
        u32x4 w0, w1; w0.x = ow[0]; w0.y = ow[1]; w0.z = ow[2]; w0.w = ow[3]; w1.x = ow[4]; w1.y = ow[5]; w1.z = ow[6]; w1.w = ow[7];
        *(u32x4*)dst = w0; *(u32x4*)(dst + 8) = w1;
    }
    __syncthreads();
}


__device__ __forceinline__ void phase_out(const Params& p, int l, LAS unsigned char* lds) {
    constexpr int NIT = NCHUNK * 4 * 2;
    for (int it = blockIdx.x; it < NIT; it += gridDim.x) {
        const int mix = (it >> 8) & 1, rem = (it & 255) | ((it >> 9) << 8), hd = rem & 3, gc = rem >> 2;
        if (mix) out_item<1>(p, l, gc, hd, lds); else out_item<0>(p, l, gc, hd, lds);
    }
}

__device__ __forceinline__ void phase_merge(const Params& p, int l, LAS unsigned char* lds) {
    const bf16_t* ocat = (const bf16_t*)(p.ws + WS_OCAT);
    const bf16_t* G3 = (const bf16_t*)(p.ws + WS_PROJ);
    const bf16_t* WbrT = (const bf16_t*)(p.ws + WS_W + (size_t)(l & 1) * W_END + W_BR);
    bf16_t* merged = (bf16_t*)(p.ws + WS_ST);
    const int lane = otid() & 63, wid = otid() >> 6, wm = wid >> 2, wn = wid & 3;
    constexpr int nM = NTOK / 128, nN = 8;
    for (int t = blockIdx.x; t < nM * nN; t += gridDim.x) {
        int tm, tn; tile_coords(t, nN, tm, tn);
        const int row0 = tm * 128, col0 = tn * 128;
        f32x16 tot[2][1]; acc_zero<1>(tot);
#pragma unroll 1
        for (int b = 0; b < 3; ++b) {
            f32x16 ba[2][1]; acc_zero<1>(ba);
            gemm_kloop<128>(lds, ocat + (size_t)row0 * 1536 + b * 512, 1536, WbrT + ((size_t)b * D + col0) * 512, 512, 128, 512, ba);
#pragma unroll
            for (int m = 0; m < 2; ++m)
#pragma unroll
                for (int i = 0; i < 16; ++i) {
                    const int row = row0 + wm * 64 + m * 32 + (i & 3) + 8 * (i >> 2) + 4 * (lane >> 5), col = col0 + wn * 32 + (lane & 31);
                    tot[m][0][i] += bf2f(G3[(size_t)row * NGATE + b * 1024 + col]) * ba[m][0][i];
                }
        }
#pragma unroll
        for (int m = 0; m < 2; ++m)
#pragma unroll
            for (int i = 0; i < 16; ++i) {
                const int row = row0 + wm * 64 + m * 32 + (i & 3) + 8 * (i >> 2) + 4 * (lane >> 5), col = col0 + wn * 32 + (lane & 31);
                merged[(size_t)row * D + col] = f2bf(tot[m][0][i]);
            }
    }
}

__device__ __forceinline__ void run_phase(const Params& p, int ph, LAS unsigned char* lds) {
    if (ph == 0) { phase0(p, lds); return; }
    if (ph == NPHASE - 1) { norm_phase(p, p.final_norm_g, nullptr, 0, 0, nullptr, 1); return; }
    const int l = (ph - 1) / 10, sp = (ph - 1) % 10;
    const float* mod_l = (const float*)(p.ws + WS_MOD) + (size_t)l * 9 * 6144;
    bf16_t* hbuf = (bf16_t*)(p.ws + WS_H);
    bf16_t* proj = (bf16_t*)(p.ws + WS_PROJ);
    const unsigned char* wl = p.ws + WS_W + (size_t)(l & 1) * W_END;
    switch (sp) {
        case 0: if (l == 0) convert_weights(p, l, lds); norm_phase(p, p.norm_mix_g + (size_t)l * D, mod_l, 0, 1024, hbuf, 0); break;
        case 1: { PEpiBf16 e{proj, NPROJ, NPROJ, 0}; pg8_gemm(lds, hbuf, (const bf16_t*)(wl + W_IN), NTOK, 5376, D, e);
            if (l + 1 < DEPTH && blockIdx.x >= 144) { for (int k = 0; k < 2; ++k) convert_weights(p, l + 1, lds, ((int)blockIdx.x - 144) * 2 + k); } } break;
        case 2: phase_scan(p, l, lds); break;
        case 3: phase_out(p, l, lds); break;
        case 4: {
            PEpiBf16 e{proj, NGATE, NGATE, 2}; pg8_gemm(lds, hbuf, (const bf16_t*)(wl + W_G), NTOK, NGATE, D, e);
            PEpiGate e2{proj, NGATE}; pg8_gemm(lds, (const bf16_t*)(p.ws + WS_OCAT), (const bf16_t*)(wl + W_BR), NTOK, NGATE, 512, e2, (size_t)NTOK * 512 * 2);
            if (l + 1 < DEPTH && blockIdx.x >= 192) { for (int k = 0; k < 4; ++k) convert_weights(p, l + 1, lds, CONV_IN_P2 + ((int)blockIdx.x - 192) * 4 + k); } } break;
        case 5: sum3_phase(p); break;
        case 6: {
            PEpiResid e{p.out, mod_l + 2048}; pg8_gemm(lds, (const bf16_t*)(p.ws + WS_ST), (const bf16_t*)(wl + W_OUT), 16384, D, D, e);
            gemm_resid_tiles(lds, (const bf16_t*)(p.ws + WS_ST) + (size_t)16384 * D, D, (const bf16_t*)(wl + W_OUT), D, NTOK - 16384, D, p.out, mod_l + 2048, 16384); } break;
        case 7: norm_phase(p, p.norm_ffn_g + (size_t)l * D, mod_l, 3072, 4096, hbuf, 0); break;
        case 8: { PEpiBf16 e{proj, DFF, DFF, 1}; pg8_gemm(lds, hbuf, (const bf16_t*)(wl + W_FF1), NTOK, DFF, D, e); } break;
        case 9: { PEpiResid e{p.out, mod_l + 5120}; pg8_gemm(lds, proj, (const bf16_t*)(wl + W_FF2), 16384, D, DFF, e);
            gemm_resid_tiles(lds, proj + (size_t)16384 * DFF, DFF, (const bf16_t*)(wl + W_FF2), DFF, NTOK - 16384, DFF, p.out, mod_l + 5120, 16384); } break;
    }
}

__global__ void __launch_bounds__(512) fwd_megakernel(Params p) {
    extern __shared__ __attribute__((aligned(16))) unsigned char smem[];
    LAS unsigned char* lds = (LAS unsigned char*)smem;
    cg::grid_group grid = cg::this_grid();
    unsigned nbar = 0;
    for (int ph = p.ph_lo; ph < p.ph_hi; ++ph) {
        run_phase(p, ph, lds);
        if (ph + 1 < p.ph_hi) {
            if (ph == 0) grid.sync();
            else { ++nbar; grid_barrier((unsigned*)(p.ws + WS_CTR) + 64, nbar); }
        }
    }
}

extern "C" void kernel_launch(void* const* d_in, const int* in_sizes, int n_in, void* d_out, int out_size, void* d_ws, size_t ws_size, hipStream_t stream) {
    static int grid_blocks = 0;
    if (!grid_blocks) {
        int dev = 0, cus = 0, per_cu = 0;
        hipGetDevice(&dev);
        hipDeviceGetAttribute(&cus, hipDeviceAttributeMultiprocessorCount, dev);
        if (hipFuncSetAttribute((const void*)fwd_megakernel, hipFuncAttributeMaxDynamicSharedMemorySize, LDS_BYTES) != hipSuccess) fprintf(stderr, "hipFuncSetAttribute failed\n");
        hipOccupancyMaxActiveBlocksPerMultiprocessor(&per_cu, (const void*)fwd_megakernel, 512, LDS_BYTES);
        if (per_cu < 1) { fprintf(stderr, "occupancy query says %d blocks/CU\n", per_cu); per_cu = 1; }
        grid_blocks = cus * 1;
        (void)hipGetLastError();
        if (n_in != 26 || ws_size < WS_END) fprintf(stderr, "kernel_launch: unexpected n_in %d or ws_size %zu (need %zu)\n", n_in, ws_size, (size_t)WS_END);
    }
    Params p{};
    const float** pp = (const float**)&p;
    for (int i = 0; i < 26; ++i) pp[i] = (const float*)d_in[i];
    p.out = (float*)d_out; p.ws = (unsigned char*)d_ws; p.ph_lo = 0; p.ph_hi = NPHASE;
    void* args[] = {&p};
    hipError_t e = hipLaunchCooperativeKernel((const void*)fwd_megakernel, dim3(grid_blocks), dim3(512), args, LDS_BYTES, stream);
    if (e != hipSuccess) fprintf(stderr, "cooperative launch failed: %s (grid %d)\n", hipGetErrorString(e), grid_blocks);
}
```

```cpp
#include <hip/hip_runtime.h>
#include <hip/hip_cooperative_groups.h>
#include <cstdio>
namespace cg = cooperative_groups;

#define LAS __attribute__((address_space(3)))
typedef unsigned short bf16_t;
typedef short bf16x8 __attribute__((ext_vector_type(8)));
typedef float f32x16 __attribute__((ext_vector_type(16)));
typedef float f32x4 __attribute__((ext_vector_type(4)));
typedef unsigned u32x4 __attribute__((ext_vector_type(4)));
typedef unsigned u32x2 __attribute__((ext_vector_type(2)));

constexpr int D = 1024, DEPTH = 4, NTOK = 20480, NCTX = 4096, DFF = 4096;
constexpr int DIN = 8224, NPROJ = 5152, NGATE = 3072;
constexpr int PJ_GQ = 0, PJ_GK = 256, PJ_GV = 512, PJ_GO = 1024, PJ_GZF = 1536, PJ_GZB = 1552, PJ_HQ = 1568, PJ_HFF = 2080,
              PJ_HFB = 2592, PJ_HI = 3104, PJ_HO = 3616, PJ_MU = 4128, PJ_MV = 4640;
constexpr int NCHUNK = NTOK / 64;
constexpr float EPS = 1e-6f;
constexpr int LDS_BYTES = 160 * 1024;
constexpr int NPHASE = 2 + DEPTH * 10;

constexpr size_t WS_PROJ = 0;
constexpr size_t WS_ST   = WS_PROJ + (size_t)NTOK * NPROJ * 2;
constexpr size_t ST_GLA_BYTES = (size_t)NCHUNK * 2 * 4 * 128 * 64 * 2, ST_HG_BYTES = (size_t)NCHUNK * 2 * 4 * 128 * 128 * 2;
constexpr size_t WS_OCAT = WS_ST + ST_GLA_BYTES + ST_HG_BYTES;
constexpr size_t WS_H    = WS_OCAT + (size_t)NTOK * 1536 * 2;
constexpr size_t WS_W    = WS_H + (size_t)NTOK * D * 2;
constexpr size_t W_IN = 0, W_G = W_IN + (size_t)NPROJ * D * 2, W_BR = W_G + (size_t)NGATE * D * 2, W_OUT = W_BR + (size_t)3 * D * 512 * 2,
                 W_FF1 = W_OUT + (size_t)D * D * 2, W_FF2 = W_FF1 + (size_t)DFF * D * 2, W_END = W_FF2 + (size_t)D * DFF * 2;
constexpr size_t WS_MOD  = WS_W + 2 * W_END;
constexpr size_t WS_LBS  = WS_MOD + (size_t)DEPTH * 9 * 6144 * 4;
constexpr size_t WS_CTR  = WS_LBS + 2 * 4 * 512 * 4;
constexpr size_t WS_END  = WS_CTR + 4096;

struct Params {
    const float *x_prompt, *x_sample, *c, *state_gla, *state_hgrn, *c_ctx, *ada_w, *ada_b, *norm_mix_g, *norm_ffn_g, *w_in, *gla_lr_w,
        *gla_lr_b, *gla_norm_g, *hg_lb_logits, *hg_norm_g, *gm_norm_g, *gm_ws, *gm_bs, *w_br_gla, *w_br_hg, *w_br_gm, *w_out, *w_ff1, *w_ff2,
        *final_norm_g;
    float* out; unsigned char* ws; int ph_lo, ph_hi;
};

typedef __bf16 bf16x2_t __attribute__((ext_vector_type(2)));
__device__ __forceinline__ unsigned pk2(float lo, float hi) { bf16x2_t v; v.x = (__bf16)lo; v.y = (__bf16)hi; return __builtin_bit_cast(unsigned, v); }
__device__ __forceinline__ bf16_t f2bf(float f) { return (bf16_t)(pk2(f, 0.f) & 0xffffu); }
__device__ __forceinline__ float bf2f(bf16_t h) { return __uint_as_float(((unsigned)h) << 16); }
__device__ __forceinline__ float bflo(unsigned u) { return __uint_as_float(u << 16); }
__device__ __forceinline__ float bfhi(unsigned u) { return __uint_as_float(u & 0xffff0000u); }
__device__ __forceinline__ float fexp_(float x) { return __builtin_amdgcn_exp2f(x * 1.4426950408889634f); }
__device__ __forceinline__ float flog_(float x) { return __builtin_amdgcn_logf(x) * 0.6931471805599453f; }
__device__ __forceinline__ float sigmoidf_(float x) { return __builtin_amdgcn_rcpf(1.0f + fexp_(-x)); }
__device__ __forceinline__ float siluf_(float x) { return x * sigmoidf_(x); }
__device__ __forceinline__ float geluf_(float x) { const float y = 0.7978845608028654f * (x + 0.044715f * x * x * x); const float t = 1.0f - 2.0f * __builtin_amdgcn_rcpf(1.0f + fexp_(2.0f * y)); return 0.5f * x * (1.0f + t); }
__device__ __forceinline__ float logsigmoidf_(float x) { return fminf(x, 0.f) - flog_(1.0f + fexp_(-fabsf(x))); }
__device__ __forceinline__ float wave_sum(float v) {
#pragma unroll
    for (int o = 1; o < 64; o <<= 1) v += __shfl_xor(v, o);
    return v;
}
__device__ __forceinline__ int mod_row(int tok) { return tok < NCTX ? 0 : 1 + ((tok - NCTX) >> 11); }
__device__ __forceinline__ int otid() { int t = (int)__builtin_amdgcn_workitem_id_x(); asm volatile("" : "+v"(t)); return t; }
#define LDS_WAIT() asm volatile("s_waitcnt lgkmcnt(0)" ::: "memory")

template <int MT, int NTL, int KS>
__device__ __forceinline__ void mma_lds(f32x16 (&acc)[MT][NTL], const LAS bf16_t* As, int lda, const LAS bf16_t* Bs, int ldb, int lane) {
    const int r = lane & 31, h = lane >> 5;
    const LAS bf16_t* ap = As + r * lda + h * 8;
    const LAS bf16_t* bp = Bs + r * ldb + h * 8;
#pragma unroll
    for (int ks = 0; ks < KS; ++ks) {
        bf16x8 a[MT], b[NTL];
#pragma unroll
        for (int m = 0; m < MT; ++m) a[m] = *(const LAS bf16x8*)(ap + m * 32 * lda + ks * 16);
#pragma unroll
        for (int n = 0; n < NTL; ++n) b[n] = *(const LAS bf16x8*)(bp + n * 32 * ldb + ks * 16);
#pragma unroll
        for (int m = 0; m < MT; ++m)
#pragma unroll
            for (int n = 0; n < NTL; ++n) acc[m][n] = __builtin_amdgcn_mfma_f32_32x32x16_bf16(a[m], b[n], acc[m][n], 0, 0, 0);
    }
}

template <int BM>
__device__ __forceinline__ void gemm_kloop(LAS unsigned char* lds, const bf16_t* __restrict__ Ag, int lda, const bf16_t* __restrict__ Bg, int ldb, int brows,
                                           int K, f32x16 (&acc)[2][(128 / (8 / (BM / 64))) / 32]) {
    static_assert(BM == 128, "128-row tiles only");
    constexpr int WN = 4, WTN = 32, NTL = 1, LDT = 136, NP = 4;
    LAS bf16_t* As = (LAS bf16_t*)lds;
    LAS bf16_t* Bs = As + 2 * 128 * LDT;
    const int tid = otid(), lane = tid & 63, wid = tid >> 6, wm = wid / WN, wn = wid % WN;
    const int lrow = tid >> 4, lc = (tid & 15) * 8;
    const bf16_t* ap[NP]; const bf16_t* bp[NP];
#pragma unroll
    for (int p = 0; p < NP; ++p) ap[p] = Ag + (size_t)(lrow + p * 32) * lda + lc;
#pragma unroll
    for (int p = 0; p < NP; ++p) { int br = lrow + p * 32; br = br < brows ? br : brows - 1; bp[p] = Bg + (size_t)br * ldb + lc; }
    u32x4 ra[3][NP], rb[3][NP];
    const int nk = K / 128;
#define KL_ISSUE(S, step) do { _Pragma("unroll") for (int p = 0; p < NP; ++p) ra[S][p] = *(const u32x4*)(ap[p] + (step) * 128); \
                               _Pragma("unroll") for (int p = 0; p < NP; ++p) rb[S][p] = *(const u32x4*)(bp[p] + (step) * 128); } while (0)
#define KL_WRITE(S, stage) do { _Pragma("unroll") for (int p = 0; p < NP; ++p) *(LAS u32x4*)(As + (stage) * 128 * LDT + (lrow + p * 32) * LDT + lc) = ra[S][p]; \
                                _Pragma("unroll") for (int p = 0; p < NP; ++p) *(LAS u32x4*)(Bs + (stage) * 128 * LDT + (lrow + p * 32) * LDT + lc) = rb[S][p]; } while (0)
#define KL_STEP(J, JN) if (kt + J < nk) { const int s_ = kt + J; if (s_ + 3 < nk) KL_ISSUE(J, s_ + 3); \
        mma_lds<2, NTL, 8>(acc, As + (s_ & 1) * 128 * LDT + wm * 64 * LDT, LDT, Bs + (s_ & 1) * 128 * LDT + wn * WTN * LDT, LDT, lane); \
        if (s_ + 1 < nk) KL_WRITE(JN, (s_ + 1) & 1); __syncthreads(); }
    KL_ISSUE(0, 0); if (nk > 1) KL_ISSUE(1, 1); if (nk > 2) KL_ISSUE(2, 2);
    KL_WRITE(0, 0);
    __syncthreads();
    for (int kt = 0; kt < nk; kt += 3) { KL_STEP(0, 1) KL_STEP(1, 2) KL_STEP(2, 0) }
#undef KL_ISSUE
#undef KL_WRITE
#undef KL_STEP
}

template <int NTL>
__device__ __forceinline__ void acc_zero(f32x16 (&acc)[2][NTL]) {
#pragma unroll
    for (int m = 0; m < 2; ++m)
#pragma unroll
        for (int n = 0; n < NTL; ++n)
#pragma unroll
            for (int i = 0; i < 16; ++i) acc[m][n][i] = 0.f;
}

__device__ __forceinline__ void tile_coords(int t, int nN, int& tm, int& tn) { const int q = t >> 3; tn = q % nN; tm = (q / nN) * 8 + (t & 7); }

template <int BM, class Epi>
__device__ __forceinline__ void gemm_phase(LAS unsigned char* lds, const bf16_t* A, int lda, const bf16_t* Bt, int ldb, int M, int N, int K, const Epi& epi) {
    constexpr int WM = BM / 64, WN = 8 / WM, WTN = 128 / WN, NTL = WTN / 32;
    const int nM = M / BM, nN = (N + 127) / 128, ntiles = nM * nN;
    const int lane = otid() & 63, wid = otid() >> 6, wm = wid / WN, wn = wid % WN;
    for (int t = blockIdx.x; t < ntiles; t += gridDim.x) {
        int tm, tn; tile_coords(t, nN, tm, tn);
        const int row0 = tm * BM, col0 = tn * 128;
        f32x16 acc[2][NTL]; acc_zero<NTL>(acc);
        gemm_kloop<BM>(lds, A + (size_t)row0 * lda, lda, Bt + (size_t)col0 * ldb, ldb, min(128, N - col0), K, acc);
#pragma unroll
        for (int m = 0; m < 2; ++m)
#pragma unroll
            for (int n = 0; n < NTL; ++n) {
                const int col = col0 + wn * WTN + n * 32 + (lane & 31);
#pragma unroll
                for (int i = 0; i < 16; ++i) {
                    const int row = row0 + wm * 64 + m * 32 + (i & 3) + 8 * (i >> 2) + 4 * (lane >> 5);
                    epi(row, col, acc[m][n][i]);
                }
            }
    }
}

__device__ __forceinline__ void gemm_resid_tiles(LAS unsigned char* lds, const bf16_t* A, int lda, const bf16_t* Bt, int ldb, int M, int K, float* x, const float* gate, int roff) {
    const int nM = M / 128, nN = 8, ntiles = nM * nN;
    const int lane = otid() & 63, wid = otid() >> 6, wm = wid >> 2, wn = wid & 3;
    for (int t = blockIdx.x; t < ntiles; t += gridDim.x) {
        int tm, tn; tile_coords(t, nN, tm, tn);
        const int row0 = tm * 128, col0 = tn * 128;
        f32x16 acc[2][1]; acc_zero<1>(acc);
        gemm_kloop<128>(lds, A + (size_t)row0 * lda, lda, Bt + (size_t)col0 * ldb, ldb, 128, K, acc);
        const int col = col0 + wn * 32 + (lane & 31), rbase = roff + row0 + wm * 64 + 4 * (lane >> 5);
        const float g = gate[(size_t)mod_row(roff + row0) * 6144 + col];
        float xv[2][16];
#pragma unroll
        for (int m = 0; m < 2; ++m)
#pragma unroll
            for (int i = 0; i < 16; ++i) xv[m][i] = x[(size_t)(rbase + m * 32 + (i & 3) + 8 * (i >> 2)) * D + col];
#pragma unroll
        for (int m = 0; m < 2; ++m)
#pragma unroll
            for (int i = 0; i < 16; ++i) x[(size_t)(rbase + m * 32 + (i & 3) + 8 * (i >> 2)) * D + col] = xv[m][i] + g * acc[m][0][i];
    }
}

struct EpiBf16 { bf16_t* C; int ldc, N; __device__ __forceinline__ void operator()(int row, int col, float v) const { if (col < N) C[(size_t)row * ldc + col] = f2bf(v); } };
struct EpiRelu2 { bf16_t* C; int ldc; __device__ __forceinline__ void operator()(int row, int col, float v) const { v = fmaxf(v, 0.f); C[(size_t)row * ldc + col] = f2bf(v * v); } };
struct EpiResidOff { float* x; const float* gate; int roff; __device__ __forceinline__ void operator()(int row, int col, float v) const {
    const int r = row + roff; const float g = gate[mod_row(r) * 6144 + col]; float* p = x + (size_t)r * D + col; *p = *p + g * v; } };
struct EpiResid { float* x; const float* gate;   __device__ __forceinline__ void operator()(int row, int col, float v) const {
    const float g = gate[mod_row(row) * 6144 + col]; float* p = x + (size_t)row * D + col; *p = *p + g * v; } };

namespace pg8 {
#define PG8_LAS __attribute__((address_space(3)))
typedef unsigned short bf16_t;
typedef short bf16x8 __attribute__((ext_vector_type(8)));
typedef float f32x4 __attribute__((ext_vector_type(4)));
typedef unsigned u32x4 __attribute__((ext_vector_type(4)));
constexpr int BM = 256, BK = 64, HALF = 128, HTB = HALF * BK * 2  , STAGE_BYTES = 8 * HTB, NXCD = 8, WGM = 8;

__host__ __device__ __forceinline__ int lds_byte(int r, int c) { const int st = (r >> 4) * 2 + (c >> 5), rr = r & 15, cc = c & 31, ob = rr * 64 + cc * 2; return st * 1024 + (ob ^ (((ob >> 9) & 1) << 5)); }
__host__ __device__ __forceinline__ void stage_rc(int b, int& R, int& C) { const int st = b / 1024, sb = b % 1024, swz = sb ^ (((sb >> 9) & 1) << 5); R = (st >> 1) * 16 + swz / 64; C = (st & 1) * 32 + (swz % 64) / 2; }
__host__ __device__ __forceinline__ int perm32(int rho) { const int n = rho >> 4, i = rho & 15; return 8 * (i >> 2) + 4 * n + (i & 3); }

struct Unit { int pm, pn; };
struct Gemm { const bf16_t* A; const bf16_t* Bt; int M, N, K; size_t agrp; };

struct StaticOrder {
    int nM, nN, nwg, G, c;
    __host__ __device__ void init(int M, int N, int G_, int c_) { nM = M / BM; nN = N / BM; nwg = nM * nN; G = G_; c = c_; }
    __host__ __device__ bool next(int i, Unit& u) const {
        const long L = (long)i * G + c; if (L >= nwg) return false;
        int wgid = (int)L; { const int q = nwg / NXCD, r = nwg % NXCD, xcd = wgid % NXCD, off = wgid / NXCD; wgid = (xcd < r ? xcd * (q + 1) : r * (q + 1) + (xcd - r) * q) + off; }
        const int nig = WGM * nN, gid = wgid / nig, fm = gid * WGM, gsz = (nM - fm) < WGM ? (nM - fm) : WGM;
        u.pm = fm + ((wgid % nig) % gsz); u.pn = (wgid % nig) / gsz; return true;
    }
    __device__ __forceinline__ void a_ready(const Unit&) const {}
    __device__ __forceinline__ void done(const Unit&) const {}
};
__device__ __forceinline__ unsigned cvt_pk_bf16(float lo, float hi) { unsigned r; asm volatile("v_cvt_pk_bf16_f32 %0, %1, %2" : "=v"(r) : "v"(lo), "v"(hi)); return r; }
template <class Epi, class Sched, bool STAMP = false>
__device__ __forceinline__ void gemm_phase(PG8_LAS unsigned char* lds, const Gemm g, const Sched& S, const Epi& E, unsigned long long* stamps) {
    const int tid = otid(), wid = __builtin_amdgcn_readfirstlane(tid >> 6), lane = tid & 63, wr = wid >> 2, wc = wid & 3, fr = lane & 15, fq = lane >> 4;
    const int K = g.K, nt = K / BK;
    int ts_lo = 0, ts_hi = 0, nts = 0; const unsigned long long rt_entry = STAMP ? (unsigned long long)wall_clock64() : 0ull;
#define PG8_STAMP() do { if (STAMP && wid == 0 && nts < 64) { const unsigned long long _c = (unsigned long long)clock64(); \
        ts_lo = (lane == nts) ? (int)(unsigned)_c : ts_lo; ts_hi = (lane == nts) ? (int)(unsigned)(_c >> 32) : ts_hi; ++nts; } } while (0)
    PG8_STAMP();
    unsigned voffA[2], voffB[2];
#pragma unroll
    for (int i = 0; i < 2; ++i) { int R, C; stage_rc(tid * 16 + i * 8192, R, C); const int Rb = Epi::PERM ? ((R & ~31) + perm32(R & 31)) : R;
        voffA[i] = (unsigned)(R * K + C) * 2u; voffB[i] = (unsigned)(Rb * K + C) * 2u; }
    const size_t kstep = (size_t)(BK * 2);
    const size_t hstep = (size_t)HALF * K * 2;
    const size_t tstep = 2 * hstep;
    const unsigned ldsw = (unsigned)wid * 1024u;
    const int aoff = lds_byte(wr * 64 + fr, fq * 8), boff = lds_byte(wc * 32 + fr, fq * 8);
#define PG8_SA(b, h) (((b) * 2 + (h)) * HTB)
#define PG8_SB(b, h) ((4 + (b) * 2 + (h)) * HTB)
#define PG8_STAGE(bufoff, gbase, voff) do { _Pragma("unroll") for (int _i = 0; _i < 2; ++_i) \
        __builtin_amdgcn_global_load_lds((const unsigned*)((const char*)(gbase) + (voff)[_i]), (PG8_LAS unsigned*)(lds + (bufoff) + ldsw + _i * 8192), 16, 0, 0); } while (0)
#define PG8_LDA(dst, b, h) do { _Pragma("unroll") for (int m = 0; m < 4; ++m) _Pragma("unroll") for (int k = 0; k < 2; ++k) dst[m][k] = *(const PG8_LAS bf16x8*)(lds + PG8_SA(b, h) + aoff + m * 2048 + k * 1024); } while (0)
#define PG8_LDB(dst, b, h) do { _Pragma("unroll") for (int n = 0; n < 2; ++n) _Pragma("unroll") for (int k = 0; k < 2; ++k) dst[n][k] = *(const PG8_LAS bf16x8*)(lds + PG8_SB(b, h) + boff + n * 2048 + k * 1024); } while (0)
#define PG8_MMA(ai, bj, At, Bt) do { __builtin_amdgcn_s_setprio(1); _Pragma("unroll") for (int m = 0; m < 4; ++m) _Pragma("unroll") for (int n = 0; n < 2; ++n) _Pragma("unroll") for (int k = 0; k < 2; ++k) \
        acc[ai][bj][m][n] = __builtin_amdgcn_mfma_f32_16x16x32_bf16(Bt[n][k], At[m][k], acc[ai][bj][m][n], 0, 0, 0); __builtin_amdgcn_s_setprio(0); } while (0)
#define PG8_WAIT_V(n) asm volatile("s_waitcnt vmcnt(" #n ")" ::: "memory")
#define PG8_WAIT_L(n) asm volatile("s_waitcnt lgkmcnt(" #n ")" ::: "memory")
#define PG8_BAR __builtin_amdgcn_s_barrier()
#define PG8_SCHED __builtin_amdgcn_sched_barrier(0)
    Unit cur, nxt; int ui = 0;
    if (!S.next(0, cur)) return;
    f32x4 acc[2][2][4][2];
#pragma unroll
    for (int a = 0; a < 2; ++a)
#pragma unroll
        for (int b = 0; b < 2; ++b)
#pragma unroll
            for (int m = 0; m < 4; ++m)
#pragma unroll
                for (int n = 0; n < 2; ++n) acc[a][b][m][n] = (f32x4){0.f, 0.f, 0.f, 0.f};
    bf16x8 At[4][2], B0[2][2], B1[2][2];
    const char* cA = (const char*)g.A + (size_t)cur.pm * tstep + (size_t)(cur.pn >> 2) * g.agrp; const char* cB = (const char*)g.Bt + (size_t)cur.pn * tstep;
    S.a_ready(cur);
    PG8_STAGE(PG8_SB(0, 0), cB, voffB); PG8_STAGE(PG8_SA(0, 0), cA, voffA); PG8_STAGE(PG8_SB(0, 1), cB + hstep, voffB); PG8_STAGE(PG8_SA(0, 1), cA + hstep, voffA);
    if (wr == 1) PG8_BAR;
    PG8_WAIT_V(4); PG8_BAR;
    PG8_STAGE(PG8_SB(1, 0), cB + kstep, voffB); PG8_STAGE(PG8_SA(1, 0), cA + kstep, voffA); PG8_STAGE(PG8_SB(1, 1), cB + hstep + kstep, voffB);
    PG8_WAIT_V(6); PG8_BAR;
    PG8_STAMP();
    for (;;) {
        const bool has_next = S.next(ui + 1, nxt);
        const char* nA = has_next ? (const char*)g.A + (size_t)nxt.pm * tstep + (size_t)(nxt.pn >> 2) * g.agrp : cA; const char* nB = has_next ? (const char*)g.Bt + (size_t)nxt.pn * tstep : cB;
        for (int t = 0; t < nt; t += 2) {
            const bool last = (t == nt - 2);
            const char* a1 = cA + (size_t)(t + 1) * kstep;
            const char* a2 = last ? nA : cA + (size_t)(t + 2) * kstep; const char* b2 = last ? nB : cB + (size_t)(t + 2) * kstep;
            const char* a3 = a2 + kstep; const char* b3 = b2 + kstep;
            if (last && has_next) S.a_ready(nxt);
            PG8_LDB(B0, 0, 0); PG8_SCHED; PG8_LDA(At, 0, 0); PG8_STAGE(PG8_SA(1, 1), a1 + hstep, voffA);
            PG8_WAIT_L(8); PG8_BAR; PG8_WAIT_L(0); PG8_MMA(0, 0, At, B0); PG8_BAR; PG8_SCHED;
            PG8_LDB(B1, 0, 1); PG8_STAGE(PG8_SB(0, 0), b2, voffB);
            PG8_BAR; PG8_WAIT_L(0); PG8_MMA(0, 1, At, B1); PG8_BAR;
            PG8_LDA(At, 0, 1); PG8_STAGE(PG8_SA(0, 0), a2, voffA);
            PG8_BAR; PG8_WAIT_L(0); PG8_MMA(1, 0, At, B0); PG8_BAR; PG8_SCHED;
            PG8_STAGE(PG8_SB(0, 1), b2 + hstep, voffB);
            PG8_WAIT_V(6); PG8_BAR; PG8_MMA(1, 1, At, B1); PG8_BAR;
            PG8_LDB(B0, 1, 0); PG8_SCHED; PG8_LDA(At, 1, 0); PG8_STAGE(PG8_SA(0, 1), a2 + hstep, voffA);
            PG8_WAIT_L(8); PG8_BAR; PG8_WAIT_L(0); PG8_MMA(0, 0, At, B0); PG8_BAR; PG8_SCHED;
            PG8_LDB(B1, 1, 1); PG8_STAGE(PG8_SB(1, 0), b3, voffB);
            PG8_BAR; PG8_WAIT_L(0); PG8_MMA(0, 1, At, B1); PG8_BAR;
            PG8_LDA(At, 1, 1); PG8_STAGE(PG8_SA(1, 0), a3, voffA);
            PG8_BAR; PG8_WAIT_L(0); PG8_MMA(1, 0, At, B0); PG8_BAR; PG8_SCHED;
            PG8_STAGE(PG8_SB(1, 1), b3 + hstep, voffB);
            PG8_WAIT_V(6); PG8_BAR; PG8_MMA(1, 1, At, B1); PG8_BAR;
        }
        PG8_STAMP();
        if constexpr (!Epi::AFTER_DRAIN) { E(acc, cur, wr, wc, fr, fq); S.done(cur); }
        PG8_STAMP();
        if (!has_next) break;
#pragma unroll
        for (int a = 0; a < 2; ++a)
#pragma unroll
            for (int b = 0; b < 2; ++b)
#pragma unroll
                for (int m = 0; m < 4; ++m)
#pragma unroll
                    for (int n = 0; n < 2; ++n) acc[a][b][m][n] = (f32x4){0.f, 0.f, 0.f, 0.f};
        cur = nxt; cA = nA; cB = nB; ++ui;
    }
    PG8_WAIT_V(0);
    if (wr == 0) PG8_BAR;
    PG8_BAR;
    if constexpr (Epi::AFTER_DRAIN) { E.fused(acc, cur, wr, wc, fr, fq, lds, wid, lane); S.done(cur); }
    PG8_STAMP();
    if (STAMP && wid == 0) { stamps[lane] = lane < nts ? (((unsigned long long)(unsigned)ts_hi << 32) | (unsigned)ts_lo) : 0ull;
        if (lane == 62) stamps[62] = rt_entry; if (lane == 63) stamps[63] = (unsigned long long)wall_clock64(); }
#undef PG8_STAMP
#undef PG8_SA
#undef PG8_SB
#undef PG8_STAGE
#undef PG8_LDA
#undef PG8_LDB
#undef PG8_MMA
#undef PG8_WAIT_V
#undef PG8_WAIT_L
#undef PG8_BAR
#undef PG8_SCHED
}
}

struct PEpiBf16 {
    static constexpr bool PERM = true, AFTER_DRAIN = false;
    bf16_t* C; int ldc, N, act;
    __device__ __forceinline__ void operator()(const pg8::f32x4 (&acc)[2][2][4][2], const pg8::Unit& u, int wr, int wc, int fr, int fq) const {
        const int row0 = u.pm * 256 + wr * 64 + fr, col0 = u.pn * 256 + wc * 32 + 8 * fq;
#pragma unroll
        for (int ai = 0; ai < 2; ++ai)
#pragma unroll
            for (int m = 0; m < 4; ++m) {
                bf16_t* rowp = C + (size_t)(row0 + ai * 128 + m * 16) * ldc;
#pragma unroll
                for (int bj = 0; bj < 2; ++bj) {
                    const int col = col0 + bj * 128;
                    pg8::f32x4 v0 = acc[ai][bj][m][0], v1 = acc[ai][bj][m][1];
                    if (act == 1) { v0.x = fmaxf(v0.x, 0.f); v0.y = fmaxf(v0.y, 0.f); v0.z = fmaxf(v0.z, 0.f); v0.w = fmaxf(v0.w, 0.f); v0 = v0 * v0;
                                    v1.x = fmaxf(v1.x, 0.f); v1.y = fmaxf(v1.y, 0.f); v1.z = fmaxf(v1.z, 0.f); v1.w = fmaxf(v1.w, 0.f); v1 = v1 * v1; }
                    if (act == 2) { v0.x = sigmoidf_(v0.x); v0.y = sigmoidf_(v0.y); v0.z = sigmoidf_(v0.z); v0.w = sigmoidf_(v0.w);
                                    v1.x = sigmoidf_(v1.x); v1.y = sigmoidf_(v1.y); v1.z = sigmoidf_(v1.z); v1.w = sigmoidf_(v1.w); }
                    u32x4 w; w.x = pk2(v0.x, v0.y); w.y = pk2(v0.z, v0.w); w.z = pk2(v1.x, v1.y); w.w = pk2(v1.z, v1.w);
                    if (col < N) *(u32x4*)(rowp + col) = w;
                }
            }
    }
};
struct PEpiResid {
    static constexpr bool PERM = true, AFTER_DRAIN = false;
    float* x; const float* gate;
    __device__ __forceinline__ void operator()(const pg8::f32x4 (&acc)[2][2][4][2], const pg8::Unit& u, int wr, int wc, int fr, int fq) const {
        const int row0 = u.pm * 256 + wr * 64 + fr, col0 = u.pn * 256 + wc * 32 + 8 * fq;
        const float* gp = gate + (size_t)mod_row(u.pm * 256) * 6144 + col0;
        f32x4 g[2][2];
#pragma unroll
        for (int bj = 0; bj < 2; ++bj) { g[bj][0] = *(const f32x4*)(gp + bj * 128); g[bj][1] = *(const f32x4*)(gp + bj * 128 + 4); }
#pragma unroll
        for (int ai = 0; ai < 2; ++ai) {
            f32x4 xv[4][2][2];
#pragma unroll
            for (int m = 0; m < 4; ++m)
#pragma unroll
                for (int bj = 0; bj < 2; ++bj) {
                    const float* rp = x + (size_t)(row0 + ai * 128 + m * 16) * D + col0 + bj * 128;
                    xv[m][bj][0] = *(const f32x4*)rp; xv[m][bj][1] = *(const f32x4*)(rp + 4);
                }
#pragma unroll
            for (int m = 0; m < 4; ++m)
#pragma unroll
                for (int bj = 0; bj < 2; ++bj) {
                    float* rp = x + (size_t)(row0 + ai * 128 + m * 16) * D + col0 + bj * 128;
                    *(f32x4*)rp = xv[m][bj][0] + g[bj][0] * acc[ai][bj][m][0]; *(f32x4*)(rp + 4) = xv[m][bj][1] + g[bj][1] * acc[ai][bj][m][1];
                }
        }
    }
};
struct PEpiGate {
    static constexpr bool PERM = true, AFTER_DRAIN = false;
    bf16_t* G; int ldc;
    __device__ __forceinline__ void operator()(const pg8::f32x4 (&acc)[2][2][4][2], const pg8::Unit& u, int wr, int wc, int fr, int fq) const {
        const int row0 = u.pm * 256 + wr * 64 + fr, col0 = u.pn * 256 + wc * 32 + 8 * fq;
#pragma unroll
        for (int ai = 0; ai < 2; ++ai) {
            u32x4 gv[4][2];
#pragma unroll
            for (int m = 0; m < 4; ++m)
#pragma unroll
                for (int bj = 0; bj < 2; ++bj) gv[m][bj] = *(const u32x4*)(G + (size_t)(row0 + ai * 128 + m * 16) * ldc + col0 + bj * 128);
#pragma unroll
            for (int m = 0; m < 4; ++m)
#pragma unroll
                for (int bj = 0; bj < 2; ++bj) {
                    const u32x4 g = gv[m][bj];
                    const pg8::f32x4 v0 = acc[ai][bj][m][0], v1 = acc[ai][bj][m][1];
                    u32x4 w; w.x = pk2(bflo(g.x) * v0.x, bfhi(g.x) * v0.y); w.y = pk2(bflo(g.y) * v0.z, bfhi(g.y) * v0.w);
                    w.z = pk2(bflo(g.z) * v1.x, bfhi(g.z) * v1.y); w.w = pk2(bflo(g.w) * v1.z, bfhi(g.w) * v1.w);
                    *(u32x4*)(G + (size_t)(row0 + ai * 128 + m * 16) * ldc + col0 + bj * 128) = w;
                }
        }
    }
};
__device__ __forceinline__ void sum3_phase(const Params& p) {
    const bf16_t* Y = (const bf16_t*)(p.ws + WS_PROJ); bf16_t* merged = (bf16_t*)(p.ws + WS_ST);
    for (size_t i = (size_t)blockIdx.x * 512 + otid(); i < (size_t)NTOK * (D / 8); i += (size_t)gridDim.x * 512) {
        const size_t row = i >> 7; const int c8 = (int)(i & 127) * 8;
        const bf16_t* yr = Y + row * NGATE + c8;
        const u32x4 a = *(const u32x4*)yr, b = *(const u32x4*)(yr + 1024), c = *(const u32x4*)(yr + 2048);
        u32x4 w; w.x = pk2(bflo(a.x) + bflo(b.x) + bflo(c.x), bfhi(a.x) + bfhi(b.x) + bfhi(c.x)); w.y = pk2(bflo(a.y) + bflo(b.y) + bflo(c.y), bfhi(a.y) + bfhi(b.y) + bfhi(c.y));
        w.z = pk2(bflo(a.z) + bflo(b.z) + bflo(c.z), bfhi(a.z) + bfhi(b.z) + bfhi(c.z)); w.w = pk2(bflo(a.w) + bflo(b.w) + bflo(c.w), bfhi(a.w) + bfhi(b.w) + bfhi(c.w));
        *(u32x4*)(merged + row * D + c8) = w;
    }
}
template <class Epi>
__device__ __forceinline__ void pg8_gemm(LAS unsigned char* lds, const bf16_t* A, const bf16_t* Bt, int M, int N, int K, const Epi& e, size_t agrp = 0) {
    pg8::Gemm g{A, Bt, M, N, K, agrp};
    pg8::StaticOrder so; so.init(M, N, (int)gridDim.x, (int)blockIdx.x);
    pg8::gemm_phase<Epi, pg8::StaticOrder, false>(lds, g, so, e, nullptr);
    __syncthreads();
}

__device__ __forceinline__ void grid_barrier(unsigned* bar, unsigned k) {
    asm volatile("s_waitcnt vmcnt(0)" ::: "memory");
    __syncthreads();
    if (otid() == 0) {
        const unsigned g = blockIdx.x & 7u, ng = (gridDim.x + 7u - g) >> 3;
        __builtin_amdgcn_fence(__ATOMIC_RELEASE, "agent");
        asm volatile("s_waitcnt vmcnt(0)" ::: "memory");
        const unsigned c = __hip_atomic_fetch_add(bar + 16 * g, 1u, __ATOMIC_RELAXED, __HIP_MEMORY_SCOPE_AGENT);
        if (c == ng * k - 1u) {
            const unsigned ngroups = gridDim.x < 8u ? gridDim.x : 8u;
            const unsigned t = __hip_atomic_fetch_add(bar + 128, 1u, __ATOMIC_RELAXED, __HIP_MEMORY_SCOPE_AGENT);
            if (t == ngroups * k - 1u)
                for (unsigned j = 0; j < ngroups; ++j) __hip_atomic_store(bar + 144 + 16 * j, k, __ATOMIC_RELAXED, __HIP_MEMORY_SCOPE_AGENT);
        }
        unsigned spins = 0;
        while (__hip_atomic_load(bar + 144 + 16 * g, __ATOMIC_RELAXED, __HIP_MEMORY_SCOPE_AGENT) < k && ++spins < (1u << 28)) __builtin_amdgcn_s_sleep(1);
        __builtin_amdgcn_fence(__ATOMIC_ACQUIRE, "agent");
        asm volatile("s_waitcnt vmcnt(0)" ::: "memory");
    }
    __syncthreads();
}

__device__ __forceinline__ void transpose_item(const float* __restrict__ W, int N, int K, int k0, int n0, bf16_t* __restrict__ dst  , LAS float* scr, int lane) {
    {
        const int kr = lane >> 3, c4 = (lane & 7) * 4;
        f32x4 v[8];
#pragma unroll
        for (int i = 0; i < 8; ++i) v[i] = *(const f32x4*)(W + (size_t)(k0 + i * 8 + kr) * N + n0 + c4);
#pragma unroll
        for (int i = 0; i < 8; ++i) { LAS float* d = scr + (i * 8 + kr) * 33 + c4; d[0] = v[i].x; d[1] = v[i].y; d[2] = v[i].z; d[3] = v[i].w; }
    }
    LDS_WAIT();
    const int c = lane & 7;
#pragma unroll
    for (int j = 0; j < 4; ++j) {
        const int n = (lane >> 3) + 8 * j; const LAS float* s = scr + (8 * c) * 33 + n;
        u32x4 o; o.x = pk2(s[0 * 33], s[1 * 33]); o.y = pk2(s[2 * 33], s[3 * 33]); o.z = pk2(s[4 * 33], s[5 * 33]); o.w = pk2(s[6 * 33], s[7 * 33]);
        *(u32x4*)(dst + (size_t)n * K + k0 + 8 * c) = o;
    }
    LDS_WAIT();
}

constexpr int CONV_NIT = 16 * 257 + 3 * 8 * 32 + 16 * 32 + 16 * 128 + 64 * 32, CONV_BLOCK_ITEMS = (CONV_NIT + 7) / 8;
constexpr int CONV_IN_P2 = 112 * 2, CONV_IN_P4 = 64 * 4, CONV_IN_GEMM = CONV_IN_P2 + CONV_IN_P4;
__device__ __forceinline__ void convert_weights(const Params& p, int l, LAS unsigned char* lds, int bitem = -1) {
    const int lane = otid() & 63, wid = otid() >> 6;
    LAS float* scr = (LAS float*)(lds + wid * 16384);
    unsigned char* wb = p.ws + WS_W + (size_t)(l & 1) * W_END;
    constexpr int I_IN = 16 * 257, I_BR = 8 * 32, I_OUT = 16 * 32, I_FF1 = 16 * 128, I_FF2 = 64 * 32;
    constexpr int NIT = I_IN + 3 * I_BR + I_OUT + I_FF1 + I_FF2;
    for (int it = (bitem < 0 ? blockIdx.x * 8 + wid : bitem * 8 + wid); it < NIT; it += (bitem < 0 ? gridDim.x * 8 : NIT)) {
        int r = it;
        if (r < I_IN) { const int kb = r / 257, nb = r % 257, n0 = nb * 32;
            bf16_t* dst = n0 < NPROJ ? (bf16_t*)(wb + W_IN) + (size_t)n0 * D : (bf16_t*)(wb + W_G) + (size_t)(n0 - NPROJ) * D;
            transpose_item(p.w_in + (size_t)l * D * DIN, DIN, D, kb * 64, n0, dst, scr, lane); continue; }
        r -= I_IN;
        if (r < 3 * I_BR) { const int b = r / I_BR, q = r % I_BR, kb = q / 32, nb = q % 32;
            const float* W = (b == 0 ? p.w_br_gla : b == 1 ? p.w_br_hg : p.w_br_gm) + (size_t)l * 512 * D;
            transpose_item(W, D, 512, kb * 64, nb * 32, (bf16_t*)(wb + W_BR) + (size_t)b * D * 512 + (size_t)nb * 32 * 512, scr, lane); continue; }
        r -= 3 * I_BR;
        if (r < I_OUT) { const int kb = r / 32, nb = r % 32;
            transpose_item(p.w_out + (size_t)l * D * D, D, D, kb * 64, nb * 32, (bf16_t*)(wb + W_OUT) + (size_t)nb * 32 * D, scr, lane); continue; }
        r -= I_OUT;
        if (r < I_FF1) { const int kb = r / 128, nb = r % 128;
            transpose_item(p.w_ff1 + (size_t)l * D * DFF, DFF, D, kb * 64, nb * 32, (bf16_t*)(wb + W_FF1) + (size_t)nb * 32 * D, scr, lane); continue; }
        r -= I_FF1;
        { const int kb = r / 32, nb = r % 32;
            transpose_item(p.w_ff2 + (size_t)l * DFF * D, D, DFF, kb * 64, nb * 32, (bf16_t*)(wb + W_FF2) + (size_t)nb * 32 * DFF, scr, lane); }
    }
}

__device__ __forceinline__ void phase0(const Params& p, LAS unsigned char* lds) {
    const int tid = otid();
    float* x = p.out;
    for (size_t i = (size_t)blockIdx.x * 512 + tid; i < (size_t)NTOK * (D / 4); i += (size_t)gridDim.x * 512) {
        const int tok = (int)(i >> 8), c4 = (int)(i & 255) * 4;
        f32x4 v;
        if (tok < NCTX) v = *(const f32x4*)(p.x_prompt + (size_t)tok * D + c4);
        else {
            const int lt = tok - NCTX; v = *(const f32x4*)(p.x_sample + (size_t)lt * D + c4);
            const int t = lt & 2047; const float rr = (float)(t >> 6), cc = (float)(t & 63);
            const int sec = c4 >> 8; const float pos = sec < 2 ? rr : cc;
#pragma unroll
            for (int j = 0; j < 4; ++j) {
                const int f = (c4 + j) & 255;
                const float omega = exp2f((float)f * (-13.287712379549449f / 256.0f));
                const float a = pos * omega;
                v[j] += (sec & 1) ? __cosf(a) : __sinf(a);
            }
        }
        *(f32x4*)(x + i * 4) = v;
    }
    if (blockIdx.x == 0) {
        float* lbs = (float*)(p.ws + WS_LBS);
        for (int i = tid; i < 1024; i += 512) {
            const int dir = i >> 9, ch = i & 511; float lg[4], mx = -1e30f;
            for (int l = 0; l < 4; ++l) { lg[l] = p.hg_lb_logits[(size_t)(dir * 4 + l) * 512 + ch]; mx = fmaxf(mx, lg[l]); }
            float s = 0.f; for (int l = 0; l < 4; ++l) { lg[l] = expf(lg[l] - mx); s += lg[l]; }
            float cum = 0.f, c0 = 0.f;
            for (int l = 0; l < 4; ++l) { cum += lg[l] / s; if (l == 0) c0 = cum; lbs[(size_t)(dir * 4 + l) * 512 + ch] = cum - c0; }
        }
        for (int i = tid; i < 1024; i += 512) ((unsigned*)(p.ws + WS_CTR))[i] = 0u;
    }
    LAS float* sc = (LAS float*)lds;
    LAS float* red = sc + 9 * 1024;
    for (int i = tid; i < 9 * 1024; i += 512) { const int r = i >> 10, k = i & 1023; const float v = r == 0 ? p.c_ctx[k] : p.c[(size_t)(r - 1) * D + k]; sc[i] = siluf_(v); }
    __syncthreads();
    float* mod = (float*)(p.ws + WS_MOD);
    for (int u = blockIdx.x; u < DEPTH * 48; u += gridDim.x) {
        const int l = u / 48, cb = u % 48, cl = tid & 127, kp = tid >> 7, n = cb * 128 + cl;
        const float* w = p.ada_w + (size_t)l * D * 6144 + n;
        float a[9];
#pragma unroll
        for (int r = 0; r < 9; ++r) a[r] = 0.f;
#pragma unroll 4
        for (int k = kp * 256; k < kp * 256 + 256; ++k) {
            const float wv = w[(size_t)k * 6144];
#pragma unroll
            for (int r = 0; r < 9; ++r) a[r] += sc[r * 1024 + k] * wv;
        }
#pragma unroll
        for (int r = 0; r < 9; ++r) red[(kp * 9 + r) * 128 + cl] = a[r];
        __syncthreads();
        for (int i = tid; i < 9 * 128; i += 512) {
            const int r = i >> 7, c2 = i & 127;
            const float s = red[(0 * 9 + r) * 128 + c2] + red[(1 * 9 + r) * 128 + c2] + red[(2 * 9 + r) * 128 + c2] + red[(3 * 9 + r) * 128 + c2];
            mod[((size_t)l * 9 + r) * 6144 + cb * 128 + c2] = s + p.ada_b[(size_t)l * 6144 + cb * 128 + c2];
        }
        __syncthreads();
    }
}

__device__ __forceinline__ void norm_phase(const Params& p, const float* g, const float* mod_l, int off_sh, int off_sc, bf16_t* hout, int mode) {
    const int lane = otid() & 63, wid = otid() >> 6;
    float* x = p.out;
    for (int row = blockIdx.x * 8 + wid; row < NTOK; row += gridDim.x * 8) {
        f32x4 v[4]; float s = 0.f;
        float* xr = x + (size_t)row * D;
#pragma unroll
        for (int j = 0; j < 4; ++j) { v[j] = *(const f32x4*)(xr + lane * 4 + 256 * j); s += v[j].x * v[j].x + v[j].y * v[j].y + v[j].z * v[j].z + v[j].w * v[j].w; }
        const float rstd = rsqrtf(wave_sum(s) * (1.0f / D) + EPS);
        if (mode == 0) {
            const float* mr = mod_l + (size_t)mod_row(row) * 6144;
#pragma unroll
            for (int j = 0; j < 4; ++j) {
                const int c = lane * 4 + 256 * j;
                const f32x4 gg = *(const f32x4*)(g + c), sh = *(const f32x4*)(mr + off_sh + c), scv = *(const f32x4*)(mr + off_sc + c);
                const f32x4 o = (v[j] * rstd) * gg * (scv + 1.0f) + sh;
                u32x2 w; w.x = pk2(o.x, o.y); w.y = pk2(o.z, o.w);
                *(u32x2*)(hout + (size_t)row * D + c) = w;
            }
        } else {
#pragma unroll
            for (int j = 0; j < 4; ++j) { const int c = lane * 4 + 256 * j; const f32x4 gg = *(const f32x4*)(g + c); *(f32x4*)(xr + c) = (v[j] * rstd) * gg; }
        }
    }
}

template <int MIX>
__device__ __forceinline__ void gate_eval(const bf16_t* row, int kcol, int zcol, const float (&lrw)[16], float lrb, float lb, float& gt, float& kt) {
    if (!MIX) {
        const bf16_t* zr = row + zcol;
        const u32x4 z0 = *(const u32x4*)zr, z1 = *(const u32x4*)(zr + 8);
        float z = lrb;
        z += bflo(z0.x) * lrw[0] + bfhi(z0.x) * lrw[1] + bflo(z0.y) * lrw[2] + bfhi(z0.y) * lrw[3] + bflo(z0.z) * lrw[4] + bfhi(z0.z) * lrw[5] + bflo(z0.w) * lrw[6] + bfhi(z0.w) * lrw[7];
        z += bflo(z1.x) * lrw[8] + bfhi(z1.x) * lrw[9] + bflo(z1.y) * lrw[10] + bfhi(z1.y) * lrw[11] + bflo(z1.z) * lrw[12] + bfhi(z1.z) * lrw[13] + bflo(z1.w) * lrw[14] + bfhi(z1.w) * lrw[15];
        gt = logsigmoidf_(z) * (1.0f / 16.0f);
        kt = bf2f(row[kcol]);
    } else {
        const float xf = bf2f(row[kcol]);
        const float sg = sigmoidf_(xf);
        gt = flog_(lb + (1.0f - lb) * sg);
        kt = (1.0f - lb) * (1.0f - sg);
    }
}

template <int MIX>
__device__ __forceinline__ void gate_raw(unsigned kraw, const u32x4& z0, const u32x4& z1, const float (&lrw)[16], float lrb, float lb, float& gt, float& kt) {
    if (!MIX) {
        float z = lrb;
        z += bflo(z0.x) * lrw[0] + bfhi(z0.x) * lrw[1] + bflo(z0.y) * lrw[2] + bfhi(z0.y) * lrw[3] + bflo(z0.z) * lrw[4] + bfhi(z0.z) * lrw[5] + bflo(z0.w) * lrw[6] + bfhi(z0.w) * lrw[7];
        z += bflo(z1.x) * lrw[8] + bfhi(z1.x) * lrw[9] + bflo(z1.y) * lrw[10] + bfhi(z1.y) * lrw[11] + bflo(z1.z) * lrw[12] + bfhi(z1.z) * lrw[13] + bflo(z1.w) * lrw[14] + bfhi(z1.w) * lrw[15];
        gt = logsigmoidf_(z) * (1.0f / 16.0f);
        kt = bflo(kraw);
    } else {
        const float xf = bflo(kraw);
        const float sg = sigmoidf_(xf);
        gt = flog_(lb + (1.0f - lb) * sg);
        kt = (1.0f - lb) * (1.0f - sg);
    }
}

template <int MIX>
__device__ __forceinline__ void scan_job(const Params& p, int l, int s, int dir, int hd, LAS unsigned char* lds) {
    constexpr int DK = MIX ? 128 : 64, WM = DK / 32, WN = 8 / WM, WTN = 128 / WN, NTL = WTN / 32, LDT = 72, LDG = DK + 1;
    LAS bf16_t* At = (LAS bf16_t*)lds;
    LAS bf16_t* Bt = At + 128 * LDT;
    LAS float* dec = (LAS float*)(lds + 2 * 128 * LDT * 2);
    LAS float* G = dec + 128;
    LAS float* KK = G + 64 * 129;
    const int tid = otid(), lane = tid & 63, wid = tid >> 6, wm = wid / WN, wn = wid % WN;
    const bool ctx = s < 16;
    const int T = ctx ? 256 : 2048, tok0 = ctx ? s * 256 : NCTX + (s - 16) * 2048, nch = T / 64;
    const bf16_t* proj = (const bf16_t*)(p.ws + WS_PROJ);
    const float* lbs = (const float*)(p.ws + WS_LBS);
    bf16_t* sbuf = (bf16_t*)(p.ws + WS_ST + (MIX ? ST_GLA_BYTES : 0));
    f32x16 S[1][NTL];
    {
        const float* st0 = ctx ? nullptr : (MIX ? p.state_hgrn + ((((size_t)(s - 16) * DEPTH + l) * 2 + dir) * 4 + hd) * 128 * 128
                                                : p.state_gla + ((((size_t)(s - 16) * DEPTH + l) * 2 + dir) * 4 + hd) * 64 * 128);
#pragma unroll
        for (int n = 0; n < NTL; ++n)
#pragma unroll
            for (int i = 0; i < 16; ++i) {
                const int d = wm * 32 + (i & 3) + 8 * (i >> 2) + 4 * (lane >> 5), v = wn * WTN + n * 32 + (lane & 31);
                S[0][n][i] = ctx ? 0.f : st0[(size_t)d * 128 + v];
            }
    }
    const int sd = tid & (DK - 1), t0 = tid / DK; constexpr int TS = 512 / DK;
    float lrw[16]; float lrb = 0.f, lb = 0.f;
    if (!MIX) {
#pragma unroll
        for (int r = 0; r < 16; ++r) lrw[r] = p.gla_lr_w[(((size_t)l * 2 + dir) * 16 + r) * 256 + hd * 64 + sd];
        lrb = p.gla_lr_b[((size_t)l * 2 + dir) * 256 + hd * 64 + sd];
    } else {
#pragma unroll
        for (int r = 0; r < 16; ++r) lrw[r] = 0.f;
        lb = lbs[(size_t)(dir * 4 + l) * 512 + hd * 128 + sd];
    }
    const int kcol = MIX ? (dir ? PJ_HFB : PJ_HFF) + hd * 128 + sd : PJ_GK + hd * 64 + sd;
    const int zcol = dir ? PJ_GZB : PJ_GZF;
    const int vv = tid & 127, vq = tid >> 7;
    const int vcol = (MIX ? PJ_HI : PJ_GV) + hd * 128 + vv;
    const int kd = tid >> 2, kq = tid & 3;
    const bool k2 = tid < 4 * DK;

    constexpr int NE = 64 / TS;
    unsigned kraw[NE]; unsigned vraw[8];
    const int widu = __builtin_amdgcn_readfirstlane(tid >> 6), gmt = (widu >> 1) & 1, gnt = widu & 1;
    bf16x8 gafr = {0, 0, 0, 0, 0, 0, 0, 0}; u32x4 gbw = {0u, 0u, 0u, 0u}; float gbias = 0.f;
    if (!MIX && widu < 4) {
        const float* lw = p.gla_lr_w + (((size_t)l * 2 + dir) * 16 + 8 * (lane >> 5)) * 256 + hd * 64 + gnt * 32 + (lane & 31);
        float wv[8];
#pragma unroll
        for (int j = 0; j < 8; ++j) wv[j] = lw[(size_t)j * 256];
        gbw.x = pk2(wv[0], wv[1]); gbw.y = pk2(wv[2], wv[3]); gbw.z = pk2(wv[4], wv[5]); gbw.w = pk2(wv[6], wv[7]);
        gbias = p.gla_lr_b[((size_t)l * 2 + dir) * 256 + hd * 64 + gnt * 32 + (lane & 31)];
    }
    auto load_chunk = [&](const bf16_t* prc) {
#pragma unroll
        for (int i = 0; i < NE; ++i) {
            const bf16_t* row = prc + (size_t)(t0 + TS * i) * NPROJ;
            kraw[i] = row[kcol];
        }
        if (!MIX && widu < 4) gafr = *(const bf16x8*)(prc + (size_t)(gmt * 32 + (lane & 31)) * NPROJ + zcol + 8 * (lane >> 5));
#pragma unroll
        for (int t = 0; t < 16; t += 2) {
            const unsigned a = prc[(size_t)(vq * 16 + t) * NPROJ + vcol], b = prc[(size_t)(vq * 16 + t + 1) * NPROJ + vcol];
            vraw[t >> 1] = a | (b << 16);
        }
    };
    auto store_state = [&](int gcs) {
        bf16_t* sb = sbuf + (((size_t)gcs * 2 + dir) * 4 + hd) * 128 * DK;
#pragma unroll
        for (int nn = 0; nn < NTL; ++nn)
#pragma unroll
            for (int q = 0; q < 4; ++q) {
                const int d0 = wm * 32 + 8 * q + 4 * (lane >> 5), v = wn * WTN + nn * 32 + (lane & 31);
                u32x2 w; w.x = pk2(S[0][nn][4 * q + 0], S[0][nn][4 * q + 1]); w.y = pk2(S[0][nn][4 * q + 2], S[0][nn][4 * q + 3]);
                *(u32x2*)(sb + (size_t)v * DK + d0) = w;
            }
    };
    load_chunk(proj + (size_t)(tok0 + (dir ? nch - 1 : 0) * 64) * NPROJ);
    store_state((tok0 >> 6) + (dir ? nch - 1 : 0));
    for (int n = 0; n < nch; ++n) {
        if (MIX) {
#pragma unroll
            for (int i = 0; i < NE; ++i) {
                const int t = t0 + TS * i; float gt, kt; const u32x4 zz = {0u, 0u, 0u, 0u};
                gate_raw<MIX>(kraw[i], zz, zz, lrw, lrb, lb, gt, kt);
                G[t * LDG + sd] = gt; KK[t * LDG + sd] = kt;
            }
        } else {
#pragma unroll
            for (int i = 0; i < NE; ++i) KK[(t0 + TS * i) * LDG + sd] = bflo(kraw[i]);
            if (widu < 4) {
                f32x16 zacc;
#pragma unroll
                for (int i = 0; i < 16; ++i) zacc[i] = 0.f;
                zacc = __builtin_amdgcn_mfma_f32_32x32x16_bf16(gafr, __builtin_bit_cast(bf16x8, gbw), zacc, 0, 0, 0);
#pragma unroll
                for (int i = 0; i < 16; ++i)
                    G[(gmt * 32 + (i & 3) + 8 * (i >> 2) + 4 * (lane >> 5)) * LDG + gnt * 32 + (lane & 31)] = logsigmoidf_(zacc[i] + gbias) * (1.0f / 16.0f);
            }
        }
#pragma unroll
        for (int q = 0; q < 2; ++q) { u32x4 w; w.x = vraw[4 * q]; w.y = vraw[4 * q + 1]; w.z = vraw[4 * q + 2]; w.w = vraw[4 * q + 3]; *(LAS u32x4*)(Bt + vv * LDT + vq * 16 + q * 8) = w; }
        if (n + 1 < nch) load_chunk(proj + (size_t)(tok0 + (dir ? nch - 2 - n : n + 1) * 64) * NPROJ);
        __syncthreads();
        if (k2) {
            float g[16]; float qs = 0.f;
#pragma unroll
            for (int t = 0; t < 16; ++t) { g[t] = G[(kq * 16 + t) * LDG + kd]; qs += g[t]; }
            const int lb4 = lane & ~3;
            const float s0 = __shfl(qs, lb4), s1 = __shfl(qs, lb4 + 1), s2 = __shfl(qs, lb4 + 2), s3 = __shfl(qs, lb4 + 3);
            const float total = (s0 + s1) + (s2 + s3);
            float pref = (kq > 0 ? s0 : 0.f) + (kq > 1 ? s1 : 0.f) + (kq > 2 ? s2 : 0.f);
            unsigned pkv[8];
#pragma unroll
            for (int t = 0; t < 16; ++t) {
                const float pe = pref; pref += g[t];
                const float w = dir ? pe : total - pref;
                const float kv = KK[(kq * 16 + t) * LDG + kd] * fexp_(w);
                if (t & 1) pkv[t >> 1] = pk2(__uint_as_float(pkv[t >> 1]), kv); else pkv[t >> 1] = __float_as_uint(kv);
            }
#pragma unroll
            for (int q = 0; q < 2; ++q) { u32x4 w; w.x = pkv[4 * q]; w.y = pkv[4 * q + 1]; w.z = pkv[4 * q + 2]; w.w = pkv[4 * q + 3]; *(LAS u32x4*)(At + kd * LDT + kq * 16 + q * 8) = w; }
            if (kq == 0) dec[kd] = fexp_(total);
        }
        __syncthreads();
#pragma unroll
        for (int nn = 0; nn < NTL; ++nn)
#pragma unroll
            for (int i = 0; i < 16; ++i) S[0][nn][i] *= dec[wm * 32 + (i & 3) + 8 * (i >> 2) + 4 * (lane >> 5)];
        mma_lds<1, NTL, 4>(S, At + wm * 32 * LDT, LDT, Bt + wn * WTN * LDT, LDT, lane);
        if (n + 1 < nch) store_state((tok0 >> 6) + (dir ? nch - 2 - n : n + 1));
        __syncthreads();
    }
    if (ctx) {
        float* o = MIX ? p.out + (size_t)NTOK * D + (size_t)16 * DEPTH * 2 * 4 * 64 * 128 + ((((size_t)s * DEPTH + l) * 2 + dir) * 4 + hd) * 128 * 128
                       : p.out + (size_t)NTOK * D + ((((size_t)s * DEPTH + l) * 2 + dir) * 4 + hd) * 64 * 128;
#pragma unroll
        for (int nn = 0; nn < NTL; ++nn)
#pragma unroll
            for (int i = 0; i < 16; ++i) {
                const int d = wm * 32 + (i & 3) + 8 * (i >> 2) + 4 * (lane >> 5), v = wn * WTN + nn * 32 + (lane & 31);
                o[(size_t)d * 128 + v] = S[0][nn][i];
            }
    }
}


__device__ __forceinline__ void gmlp_item(const Params& p, int l, int c2, int g, LAS unsigned char* lds) {
    constexpr int LDT = 136;
    LAS bf16_t* Aw = (LAS bf16_t*)lds;
    LAS bf16_t* Bt = Aw + 128 * LDT;
    const int tid = otid(), lane = tid & 63, wid = tid >> 6, wm = wid >> 2, wn = wid & 3;
    const bf16_t* proj = (const bf16_t*)(p.ws + WS_PROJ);
    const int tokb = c2 * 128;
    {
        const float* wsrc = p.gm_ws + ((size_t)l * 4 + g) * 128 * 128;
#pragma unroll
        for (int i = 0; i < 8; ++i) {
            const int e = (i * 512 + tid) * 4, pp = e >> 7, q = e & 127;
            const f32x4 v = *(const f32x4*)(wsrc + e);
            u32x2 w; w.x = pk2(v.x, v.y); w.y = pk2(v.z, v.w);
            *(LAS u32x2*)(Aw + pp * LDT + q) = w;
        }
    }
    {
        const int q = tid >> 2, part = tid & 3;
        const bf16_t* mv = proj + (size_t)(tokb + q) * NPROJ + PJ_MV;
        float ggv[32];
        {
            const float* ggp = p.gm_norm_g + (size_t)l * 512 + g * 128 + part * 32;
#pragma unroll
            for (int i = 0; i < 8; ++i) { const f32x4 t4 = *(const f32x4*)(ggp + 4 * i); ggv[4 * i] = t4.x; ggv[4 * i + 1] = t4.y; ggv[4 * i + 2] = t4.z; ggv[4 * i + 3] = t4.w; }
        }
        float s = 0.f, s2 = 0.f;
#pragma unroll
        for (int i = 0; i < 16; ++i) {
            const u32x4 u = *(const u32x4*)(mv + (i * 4 + part) * 8);
            const unsigned uu[4] = {u.x, u.y, u.z, u.w};
#pragma unroll
            for (int j = 0; j < 4; ++j) { const float a = geluf_(bflo(uu[j])), b = geluf_(bfhi(uu[j])); s += a + b; s2 += a * a + b * b; }
        }
        s += __shfl_xor(s, 1); s += __shfl_xor(s, 2); s2 += __shfl_xor(s2, 1); s2 += __shfl_xor(s2, 2);
        const float mean = s * (1.0f / 512.0f), var = fmaxf(s2 * (1.0f / 512.0f) - mean * mean, 0.f), rstd = rsqrtf(var + EPS);
        const bf16_t* mvg = mv + g * 128 + part * 32;
#pragma unroll
        for (int i = 0; i < 4; ++i) {
            const u32x4 u = *(const u32x4*)(mvg + i * 8);
            const unsigned uu[4] = {u.x, u.y, u.z, u.w};
#pragma unroll
            for (int j = 0; j < 4; ++j) {
                const int c = part * 32 + i * 8 + j * 2;
                const float a = (geluf_(bflo(uu[j])) - mean) * rstd * ggv[i * 8 + j * 2], b = (geluf_(bfhi(uu[j])) - mean) * rstd * ggv[i * 8 + j * 2 + 1];
                Bt[c * LDT + q] = f2bf(a); Bt[(c + 1) * LDT + q] = f2bf(b);
            }
        }
    }
    const float* bs = p.gm_bs + ((size_t)l * 4 + g) * 128;
    bf16_t muv[2][16]; float bsv[2][16];
#pragma unroll
    for (int m = 0; m < 2; ++m)
#pragma unroll
        for (int i = 0; i < 16; ++i) {
            const int pp = wm * 64 + m * 32 + (i & 3) + 8 * (i >> 2) + 4 * (lane >> 5), c = wn * 32 + (lane & 31);
            muv[m][i] = proj[(size_t)(tokb + pp) * NPROJ + PJ_MU + g * 128 + c]; bsv[m][i] = bs[pp];
        }
    __syncthreads();
    f32x16 acc[2][1]; acc_zero<1>(acc);
    mma_lds<2, 1, 8>(acc, Aw + wm * 64 * LDT, LDT, Bt + wn * 32 * LDT, LDT, lane);
    bf16_t* ocat = (bf16_t*)(p.ws + WS_OCAT);
#pragma unroll
    for (int m = 0; m < 2; ++m)
#pragma unroll
        for (int i = 0; i < 16; ++i) {
            const int pp = wm * 64 + m * 32 + (i & 3) + 8 * (i >> 2) + 4 * (lane >> 5), c = wn * 32 + (lane & 31);
            ocat[(size_t)2 * NTOK * 512 + (size_t)(tokb + pp) * 512 + g * 128 + c] = f2bf(geluf_(bf2f(muv[m][i])) * (acc[m][0][i] + bsv[m][i]));
        }
    __syncthreads();
}

__device__ __forceinline__ void phase_scan(const Params& p, int l, LAS unsigned char* lds) {
    LAS int* slot = (LAS int*)(lds + LDS_BYTES - 16);
    unsigned* ctr = (unsigned*)(p.ws + WS_CTR) + l;
    constexpr int NLAT = 8 * 2 * 4 * 2, NCX = 16 * 2 * 4 * 2, NGM = 160 * 4;
    for (;;) {
        if (otid() == 0) *slot = (int)atomicAdd(ctr, 1u);
        __syncthreads();
        const int j = *slot;
        __syncthreads();
        const int nconv = l + 1 < DEPTH ? CONV_BLOCK_ITEMS - CONV_IN_GEMM : 0;
        if (j >= NLAT + NCX + NGM + nconv) break;
        if (j >= NLAT + NCX + NGM) { convert_weights(p, l + 1, lds, CONV_IN_GEMM + j - (NLAT + NCX + NGM)); __syncthreads(); continue; }
        if (j < NLAT + NCX) {
            int r = j, s;
            if (r < NLAT) { s = 16 + (r >> 4); r &= 15; } else { r -= NLAT; s = r >> 4; r &= 15; }
            const int mix = r & 1, dir = (r >> 1) & 1, hd = r >> 2;
            if (mix) scan_job<1>(p, l, s, dir, hd, lds); else scan_job<0>(p, l, s, dir, hd, lds);
        } else { const int r = j - NLAT - NCX; gmlp_item(p, l, r >> 2, r & 3, lds); }
    }
}

template <int MIX>
__device__ __forceinline__ void out_item(const Params& p, int l, int gc, int hd, LAS unsigned char* lds) {
    constexpr int DK = MIX ? 128 : 64, LQ = DK + 8, LDV = 72, LDG = DK + 1;
    LAS bf16_t* QA = (LAS bf16_t*)lds;
    LAS bf16_t* KA = QA + 128 * LQ;
    LAS bf16_t* QS = KA + 128 * LQ;
    LAS bf16_t* VT = QS + 64 * LQ;
    LAS bf16_t* P = VT + 128 * LDV;
    LAS float* C = (LAS float*)(P + 64 * LDV);
    LAS float* BS = C + (MIX ? 64 : 128) * LDG;
    LAS bf16_t* ST = KA;
    LAS float* Of = (LAS float*)lds;
    const int tid = otid(), lane = tid & 63, wid = __builtin_amdgcn_readfirstlane(tid >> 6);
    const int tokb = gc * 64;
    const bf16_t* proj = (const bf16_t*)(p.ws + WS_PROJ);
    const bf16_t* pr = proj + (size_t)tokb * NPROJ;
    const float* lbs = (const float*)(p.ws + WS_LBS);
    const bf16_t* sbuf = (const bf16_t*)(p.ws + WS_ST + (MIX ? ST_GLA_BYTES : 0));
    constexpr int NPQ = 64 * (DK / 8), NRQ = NPQ / 512;
    u32x4 rq[NRQ], rk[NRQ];
    auto load_raw = [&](int dr) {
        const int kcol0 = MIX ? (dr ? PJ_HFB : PJ_HFF) + hd * 128 : PJ_GK + hd * 64;
        const int qcol0 = MIX ? PJ_HQ + hd * 128 : PJ_GQ + hd * 64;
#pragma unroll
        for (int k = 0; k < NRQ; ++k) { const int e = tid + 512 * k; const int t = e / (DK / 8), c8 = (e % (DK / 8)) * 8;
            rq[k] = *(const u32x4*)(pr + (size_t)t * NPROJ + qcol0 + c8); rk[k] = *(const u32x4*)(pr + (size_t)t * NPROJ + kcol0 + c8); }
    };
    load_raw(0);
    const int kdp = tid & (DK - 1);
    float gnv[16];
    {
        const float* gn = (MIX ? p.hg_norm_g : p.gla_norm_g) + (size_t)l * 512 + hd * 128 + (tid & 7) * 16;
#pragma unroll
        for (int j = 0; j < 16; j += 4) { const f32x4 t4 = *(const f32x4*)(gn + j); gnv[j] = t4.x; gnv[j + 1] = t4.y; gnv[j + 2] = t4.z; gnv[j + 3] = t4.w; }
    }
    const float lbd0 = MIX ? lbs[(size_t)(0 * 4 + l) * 512 + hd * 128 + kdp] : 0.f, lbd1 = MIX ? lbs[(size_t)(1 * 4 + l) * 512 + hd * 128 + kdp] : 0.f;
    typedef float f32x2p_t __attribute__((ext_vector_type(2)));
    const f32x2p_t zz2 = {0.f, 0.f};
    const f32x2p_t lbp0 = MIX ? *(const f32x2p_t*)(lbs + (size_t)(0 * 4 + l) * 512 + hd * 128 + 2 * (tid & 63)) : zz2, lbp1 = MIX ? *(const f32x2p_t*)(lbs + (size_t)(1 * 4 + l) * 512 + hd * 128 + 2 * (tid & 63)) : zz2;
    if (!MIX) {
        const int gd = wid >> 2, mt = (wid >> 1) & 1, nt = wid & 1, r = lane & 31, h = lane >> 5;
        const bf16x8 afr = *(const bf16x8*)(pr + (size_t)(mt * 32 + r) * NPROJ + (gd ? PJ_GZB : PJ_GZF) + 8 * h);
        const float* lw = p.gla_lr_w + (((size_t)l * 2 + gd) * 16 + 8 * h) * 256 + hd * 64 + nt * 32 + r;
        float wv[8];
#pragma unroll
        for (int j = 0; j < 8; ++j) wv[j] = lw[(size_t)j * 256];
        const float bias = p.gla_lr_b[((size_t)l * 2 + gd) * 256 + hd * 64 + nt * 32 + r];
        u32x4 bw; bw.x = pk2(wv[0], wv[1]); bw.y = pk2(wv[2], wv[3]); bw.z = pk2(wv[4], wv[5]); bw.w = pk2(wv[6], wv[7]);
        f32x16 zacc;
#pragma unroll
        for (int i = 0; i < 16; ++i) zacc[i] = 0.f;
        zacc = __builtin_amdgcn_mfma_f32_32x32x16_bf16(afr, __builtin_bit_cast(bf16x8, bw), zacc, 0, 0, 0);
#pragma unroll
        for (int i = 0; i < 16; ++i) {
            const int t = mt * 32 + (i & 3) + 8 * (i >> 2) + 4 * h;
            C[(gd * 64 + (gd ? 63 - t : t)) * LDG + nt * 32 + r] = logsigmoidf_(zacc[i] + bias) * (1.0f / 16.0f);
        }
    }
    const bf16_t* gatep = pr + (size_t)(tid >> 3) * NPROJ + (MIX ? PJ_HO : PJ_GO) + hd * 128 + (tid & 7) * 16;
    const u32x4 g0 = *(const u32x4*)gatep, g1 = *(const u32x4*)(gatep + 8);
    {
        const int vv = tid & 127, qt = tid >> 7;
        const int vcol = (MIX ? PJ_HI : PJ_GV) + hd * 128 + vv;
        unsigned pkv[8];
#pragma unroll
        for (int t = 0; t < 16; t += 2) {
            const unsigned a = pr[(size_t)(qt * 16 + t) * NPROJ + vcol], b = pr[(size_t)(qt * 16 + t + 1) * NPROJ + vcol];
            pkv[t >> 1] = a | (b << 16);
        }
#pragma unroll
        for (int q = 0; q < 2; ++q) { u32x4 w; w.x = pkv[4 * q]; w.y = pkv[4 * q + 1]; w.z = pkv[4 * q + 2]; w.w = pkv[4 * q + 3]; *(LAS u32x4*)(VT + vv * LDV + qt * 16 + q * 8) = w; }
    }
    const int wm = wid >> 2, wn = wid & 3;
    f32x16 o[1][1];
#pragma unroll
    for (int i = 0; i < 16; ++i) o[0][0][i] = 0.f;

#pragma unroll 1
    for (int dir = 0; dir < 2; ++dir) {
        const int kd = tid & (DK - 1), ba = tid / DK;
#pragma unroll
        for (int k = 0; k < NRQ; ++k) { const int e = tid + 512 * k; const int t = e / (DK / 8), c8 = (e % (DK / 8)) * 8;
            *(LAS u32x4*)(QS + t * LQ + c8) = rq[k]; *(LAS u32x4*)(KA + (64 + (dir ? 63 - t : t)) * LQ + c8) = rk[k]; }
        __syncthreads();
        if (MIX) {
            const int cp = tid & 63, bh = tid >> 6, bah = bh >> 1, u0 = (bh & 1) * 8;
            const float lbA = dir ? lbp1.x : lbp0.x, lbB = dir ? lbp1.y : lbp0.y;
            float gA[8], gB[8], kA[8], kB[8]; float thA = 0.f, thB = 0.f;
            {
                const LAS bf16_t* kzr = KA + (64 + bah * 16 + u0) * LQ + 2 * cp;
#pragma unroll
                for (int u = 0; u < 8; ++u) {
                    const unsigned raw = *(const LAS unsigned*)(kzr + u * LQ);
                    const float sa = sigmoidf_(bflo(raw)), sb = sigmoidf_(bfhi(raw));
                    gA[u] = flog_(lbA + (1.0f - lbA) * sa); kA[u] = (1.0f - lbA) * (1.0f - sa); thA += gA[u];
                    gB[u] = flog_(lbB + (1.0f - lbB) * sb); kB[u] = (1.0f - lbB) * (1.0f - sb); thB += gB[u];
                }
                typedef float f32x2_t __attribute__((ext_vector_type(2)));
                f32x2_t th; th.x = thA; th.y = thB;
                *(LAS f32x2_t*)(BS + bh * DK + 2 * cp) = th;
            }
            __syncthreads();
            {
                typedef float f32x2_t __attribute__((ext_vector_type(2)));
                f32x2_t hh[8];
#pragma unroll
                for (int j = 0; j < 8; ++j) hh[j] = *(const LAS f32x2_t*)(BS + j * DK + 2 * cp);
                const f32x2_t T0 = hh[0] + hh[1], T1 = hh[2] + hh[3], T2 = hh[4] + hh[5], T3 = hh[6] + hh[7];
                const f32x2_t Tb = bah == 0 ? T0 : bah == 1 ? T1 : bah == 2 ? T2 : T3;
                const f32x2_t l7 = bah == 0 ? hh[0] : bah == 1 ? hh[2] : bah == 2 ? hh[4] : hh[6];
                const f32x2_t zero2 = {0.f, 0.f};
                const f32x2_t base = bah == 0 ? zero2 : bah == 1 ? T0 : bah == 2 ? T0 + T1 : T0 + T1 + T2;
                const f32x2_t c31 = T0 + T1;
                float lpA = u0 ? l7.x : 0.f, lpB = u0 ? l7.y : 0.f;
                const float qscale = 0.08838834764831845f;
                LAS bf16_t* qz = QA + (64 + bah * 16 + u0) * LQ + 2 * cp;
                LAS bf16_t* kz = KA + (64 + bah * 16 + u0) * LQ + 2 * cp;
                LAS bf16_t* xrow = (bah < 2 ? KA + (bah * 16 + u0) * LQ : QA + (bah * 16 + u0 - 32) * LQ) + 2 * cp;
                LAS bf16_t* yrow = ((bah & 1) ? QA + (32 + (bah >> 1) * 16 + u0) * LQ : KA + (32 + (bah >> 1) * 16 + u0) * LQ) + 2 * cp;
                const bool xk = bah < 2, yq = (bah & 1) != 0;
#pragma unroll
                for (int u = 0; u < 8; ++u) {
                    const int pp = bah * 16 + u0 + u, t = dir ? 63 - pp : pp;
                    lpA += gA[u]; lpB += gB[u];
                    const float cA = base.x + lpA, cB = base.y + lpB;
                    const unsigned qraw = *(const LAS unsigned*)(QS + t * LQ + 2 * cp);
                    const float qa = bflo(qraw) * qscale, qb = bfhi(qraw) * qscale;
                    *(LAS unsigned*)(QS + t * LQ + 2 * cp) = pk2(qa * fexp_(cA), qb * fexp_(cB));
                    *(LAS unsigned*)(qz + u * LQ) = pk2(qa * fexp_(lpA - l7.x), qb * fexp_(lpB - l7.y));
                    *(LAS unsigned*)(kz + u * LQ) = pk2(kA[u] * fexp_(l7.x - lpA), kB[u] * fexp_(l7.y - lpB));
                    *(LAS unsigned*)(xrow + u * LQ) = pk2((xk ? kA[u] : qa) * fexp_(xk ? c31.x - cA : cA - c31.x), (xk ? kB[u] : qb) * fexp_(xk ? c31.y - cB : cB - c31.y));
                    *(LAS unsigned*)(yrow + u * LQ) = pk2((yq ? qa : kA[u]) * fexp_(yq ? lpA : Tb.x - lpA), (yq ? qb : kB[u]) * fexp_(yq ? lpB : Tb.y - lpB));
                }
            }
            __syncthreads();
        } else {
        float gk[16], kk[16]; float lp7 = 0.f, Ta = 0.f;
        if (MIX) {
            const float lb = dir ? lbd1 : lbd0;
            const LAS bf16_t* kz0 = KA + (64 + ba * 16) * LQ + kd;
#pragma unroll
            for (int u = 0; u < 16; ++u) {
                const float sg = sigmoidf_(bf2f(kz0[u * LQ]));
                gk[u] = flog_(lb + (1.0f - lb) * sg); kk[u] = (1.0f - lb) * (1.0f - sg);
                Ta += gk[u]; if (u == 7) lp7 = Ta;
            }
            BS[ba * DK + kd] = Ta;
        } else {
            if (ba < 4) {
#pragma unroll
                for (int u = 0; u < 16; ++u) { gk[u] = C[(dir * 64 + ba * 16 + u) * LDG + kd]; Ta += gk[u]; if (u == 7) lp7 = Ta; }
                BS[ba * DK + kd] = Ta;
            }
        }
        __syncthreads();
        if (ba < 4) {
            const float T0 = BS[kd], T1 = BS[DK + kd], T2 = BS[2 * DK + kd];
            const float base = ba == 0 ? 0.f : ba == 1 ? T0 : ba == 2 ? T0 + T1 : T0 + T1 + T2;
            const float c31 = T0 + T1;
            const float qscale = MIX ? 0.08838834764831845f : 0.125f;
            LAS bf16_t* qz = QA + (64 + ba * 16) * LQ + kd;
            LAS bf16_t* kz = KA + (64 + ba * 16) * LQ + kd;
            LAS bf16_t* xrow = (ba < 2 ? KA + (ba * 16) * LQ : QA + (ba * 16 - 32) * LQ) + kd;
            LAS bf16_t* yrow = ((ba & 1) ? QA + (32 + (ba >> 1) * 16) * LQ : KA + (32 + (ba >> 1) * 16) * LQ) + kd;
            float lp = 0.f;
#pragma unroll
            for (int u = 0; u < 16; ++u) {
                const int pp = ba * 16 + u, t = dir ? 63 - pp : pp;
                lp += gk[u];
                const float c = base + lp;
                const float qv = bf2f(QS[t * LQ + kd]) * qscale;
                const float kt = MIX ? kk[u] : bf2f(kz[u * LQ]);
                QS[t * LQ + kd] = f2bf(qv * fexp_(c));
                qz[u * LQ] = f2bf(qv * fexp_(lp - lp7));
                kz[u * LQ] = f2bf(kt * fexp_(lp7 - lp));
                xrow[u * LQ] = f2bf(ba < 2 ? kt * fexp_(c31 - c) : qv * fexp_(c - c31));
                yrow[u * LQ] = f2bf((ba & 1) ? qv * fexp_(lp) : kt * fexp_(Ta - lp));
            }
        }
        __syncthreads();
        }
        if (dir == 0) load_raw(1);
        constexpr int PIECES = 128 * DK / 8, NPC = PIECES / 512;
        u32x4 stv[NPC];
        {
            const bf16_t* sb = sbuf + (((size_t)gc * 2 + dir) * 4 + hd) * 128 * DK;
#pragma unroll
            for (int k = 0; k < NPC; ++k) { const int e = tid + 512 * k; const int v = e / (DK / 8), d0 = (e % (DK / 8)) * 8; stv[k] = *(const u32x4*)(sb + (size_t)v * DK + d0); }
        }
        if (wid < 4) {
            f32x16 sc[1][1];
#pragma unroll
            for (int i = 0; i < 16; ++i) sc[0][0][i] = 0.f;
            mma_lds<1, 1, DK / 16>(sc, KA + wid * 32 * LQ, LQ, QA + wid * 32 * LQ, LQ, lane);
            const int cc = lane & 31;
#pragma unroll
            for (int q = 0; q < 4; ++q) {
                const int r0 = 8 * q + 4 * (lane >> 5);
                int pi, pj0; bool wr = true, zero = false, tri = false;
                if (wid == 0) { pi = 32 + cc; pj0 = r0; }
                else if (wid == 1) { pi = cc < 16 ? 16 + cc : 32 + cc; pj0 = r0 < 16 ? r0 : r0 + 16; wr = (r0 < 16) == (cc < 16); }
                else { const int off = (wid - 2) * 32; pi = off + cc; pj0 = off + r0; const bool same = (r0 >> 4) == (cc >> 4); tri = same; zero = !same && r0 >= 16; wr = same || zero; }
                float v[4];
#pragma unroll
                for (int e = 0; e < 4; ++e) { float x = sc[0][0][4 * q + e]; if (tri && (r0 + e > cc)) x = 0.f; if (zero) x = 0.f; v[e] = x; }
                if (wr) {
                    u32x2 w;
                    if (dir == 0) { w.x = pk2(v[0], v[1]); w.y = pk2(v[2], v[3]); *(LAS u32x2*)(P + pi * LDV + pj0) = w; }
                    else { w.x = pk2(v[3], v[2]); w.y = pk2(v[1], v[0]); *(LAS u32x2*)(P + (63 - pi) * LDV + (60 - pj0)) = w; }
                }
            }
        } else if (wid == 4) {
#pragma unroll
            for (int k = 0; k < 2; ++k) {
                const int idx = lane * 2 + k, row = idx >> 2, piece = idx & 3;
                const int ti = dir ? 32 + row : row, tj = (dir ? 0 : 32) + piece * 8;
                u32x4 z; z.x = 0; z.y = 0; z.z = 0; z.w = 0;
                *(LAS u32x4*)(P + ti * LDV + tj) = z;
            }
        }
        __syncthreads();
#pragma unroll
        for (int k = 0; k < NPC; ++k) { const int e = tid + 512 * k; const int v = e / (DK / 8), d0 = (e % (DK / 8)) * 8; *(LAS u32x4*)(ST + v * LQ + d0) = stv[k]; }
        mma_lds<1, 1, 4>(o, P + wm * 32 * LDV, LDV, VT + wn * 32 * LDV, LDV, lane);
        __syncthreads();
        mma_lds<1, 1, DK / 16>(o, QS + wm * 32 * LQ, LQ, ST + wn * 32 * LQ, LQ, lane);
        __syncthreads();
    }
#pragma unroll
    for (int i = 0; i < 16; ++i) Of[(wm * 32 + (i & 3) + 8 * (i >> 2) + 4 * (lane >> 5)) * 132 + wn * 32 + (lane & 31)] = o[0][0][i];
    __syncthreads();
    {
        const int i_ = tid >> 3, seg = tid & 7;
        const LAS float* orow = Of + i_ * 132 + seg * 16;
        float v[16]; float ss = 0.f;
#pragma unroll
        for (int j = 0; j < 16; ++j) { v[j] = orow[j]; ss += v[j] * v[j]; }
        ss += __shfl_xor(ss, 1); ss += __shfl_xor(ss, 2); ss += __shfl_xor(ss, 4);
        const float r = rsqrtf(ss * (1.0f / 128.0f) + EPS);
        const unsigned gu[8] = {g0.x, g0.y, g0.z, g0.w, g1.x, g1.y, g1.z, g1.w};
        unsigned ow[8];
#pragma unroll
        for (int j = 0; j < 8; ++j) {
            const float a = v[2 * j] * r * gnv[2 * j] * siluf_(bflo(gu[j])), b = v[2 * j + 1] * r * gnv[2 * j + 1] * siluf_(bfhi(gu[j]));
            ow[j] = pk2(a, b);
        }
        bf16_t* dst = (bf16_t*)(p.ws + WS_OCAT) + (size_t)(MIX ? 1 : 0) * NTOK * 512 + (size_t)(tokb + i_) * 512 + hd * 128 + seg * 16;
        u32x4 w0, w1; w0.x = ow[0]; w0.y = ow[1]; w0.z = ow[2]; w0.w = ow[3]; w1.x = ow[4]; w1.y = ow[5]; w1.z = ow[6]; w1.w = ow[7];
        *(u32x4*)dst = w0; *(u32x4*)(dst + 8) = w1;
    }
    __syncthreads();
}


__device__ __forceinline__ void phase_out(const Params& p, int l, LAS unsigned char* lds) {
    constexpr int NIT = NCHUNK * 4 * 2;
    for (int it = blockIdx.x; it < NIT; it += gridDim.x) {
        const int mix = (it >> 8) & 1, rem = (it & 255) | ((it >> 9) << 8), hd = rem & 3, gc = rem >> 2;
        if (mix) out_item<1>(p, l, gc, hd, lds); else out_item<0>(p, l, gc, hd, lds);
    }
}

__device__ __forceinline__ void phase_merge(const Params& p, int l, LAS unsigned char* lds) {
    const bf16_t* ocat = (const bf16_t*)(p.ws + WS_OCAT);
    const bf16_t* G3 = (const bf16_t*)(p.ws + WS_PROJ);
    const bf16_t* WbrT = (const bf16_t*)(p.ws + WS_W + (size_t)(l & 1) * W_END + W_BR);
    bf16_t* merged = (bf16_t*)(p.ws + WS_ST);
    const int lane = otid() & 63, wid = otid() >> 6, wm = wid >> 2, wn = wid & 3;
    constexpr int nM = NTOK / 128, nN = 8;
    for (int t = blockIdx.x; t < nM * nN; t += gridDim.x) {
        int tm, tn; tile_coords(t, nN, tm, tn);
        const int row0 = tm * 128, col0 = tn * 128;
        f32x16 tot[2][1]; acc_zero<1>(tot);
#pragma unroll 1
        for (int b = 0; b < 3; ++b) {
            f32x16 ba[2][1]; acc_zero<1>(ba);
            gemm_kloop<128>(lds, ocat + (size_t)row0 * 1536 + b * 512, 1536, WbrT + ((size_t)b * D + col0) * 512, 512, 128, 512, ba);
#pragma unroll
            for (int m = 0; m < 2; ++m)
#pragma unroll
                for (int i = 0; i < 16; ++i) {
                    const int row = row0 + wm * 64 + m * 32 + (i & 3) + 8 * (i >> 2) + 4 * (lane >> 5), col = col0 + wn * 32 + (lane & 31);
                    tot[m][0][i] += bf2f(G3[(size_t)row * NGATE + b * 1024 + col]) * ba[m][0][i];
                }
        }
#pragma unroll
        for (int m = 0; m < 2; ++m)
#pragma unroll
            for (int i = 0; i < 16; ++i) {
                const int row = row0 + wm * 64 + m * 32 + (i & 3) + 8 * (i >> 2) + 4 * (lane >> 5), col = col0 + wn * 32 + (lane & 31);
                merged[(size_t)row * D + col] = f2bf(tot[m][0][i]);
            }
    }
}

__device__ __forceinline__ void run_phase(const Params& p, int ph, LAS unsigned char* lds) {
    if (ph == 0) { phase0(p, lds); return; }
    if (ph == NPHASE - 1) { norm_phase(p, p.final_norm_g, nullptr, 0, 0, nullptr, 1); return; }
    const int l = (ph - 1) / 10, sp = (ph - 1) % 10;
    const float* mod_l = (const float*)(p.ws + WS_MOD) + (size_t)l * 9 * 6144;
    bf16_t* hbuf = (bf16_t*)(p.ws + WS_H);
    bf16_t* proj = (bf16_t*)(p.ws + WS_PROJ);
    const unsigned char* wl = p.ws + WS_W + (size_t)(l & 1) * W_END;
    switch (sp) {
        case 0: if (l == 0) convert_weights(p, l, lds); norm_phase(p, p.norm_mix_g + (size_t)l * D, mod_l, 0, 1024, hbuf, 0); break;
        case 1: { PEpiBf16 e{proj, NPROJ, NPROJ, 0}; pg8_gemm(lds, hbuf, (const bf16_t*)(wl + W_IN), NTOK, 5376, D, e);
            if (l + 1 < DEPTH && blockIdx.x >= 144) { for (int k = 0; k < 2; ++k) convert_weights(p, l + 1, lds, ((int)blockIdx.x - 144) * 2 + k); } } break;
        case 2: phase_scan(p, l, lds); break;
        case 3: phase_out(p, l, lds); break;
        case 4: {
            PEpiBf16 e{proj, NGATE, NGATE, 2}; pg8_gemm(lds, hbuf, (const bf16_t*)(wl + W_G), NTOK, NGATE, D, e);
            PEpiGate e2{proj, NGATE}; pg8_gemm(lds, (const bf16_t*)(p.ws + WS_OCAT), (const bf16_t*)(wl + W_BR), NTOK, NGATE, 512, e2, (size_t)NTOK * 512 * 2);
            if (l + 1 < DEPTH && blockIdx.x >= 192) { for (int k = 0; k < 4; ++k) convert_weights(p, l + 1, lds, CONV_IN_P2 + ((int)blockIdx.x - 192) * 4 + k); } } break;
        case 5: sum3_phase(p); break;
        case 6: {
            PEpiResid e{p.out, mod_l + 2048}; pg8_gemm(lds, (const bf16_t*)(p.ws + WS_ST), (const bf16_t*)(wl + W_OUT), 16384, D, D, e);
            gemm_resid_tiles(lds, (const bf16_t*)(p.ws + WS_ST) + (size_t)16384 * D, D, (const bf16_t*)(wl + W_OUT), D, NTOK - 16384, D, p.out, mod_l + 2048, 16384); } break;
        case 7: norm_phase(p, p.norm_ffn_g + (size_t)l * D, mod_l, 3072, 4096, hbuf, 0); break;
        case 8: { PEpiBf16 e{proj, DFF, DFF, 1}; pg8_gemm(lds, hbuf, (const bf16_t*)(wl + W_FF1), NTOK, DFF, D, e); } break;
        case 9: { PEpiResid e{p.out, mod_l + 5120}; pg8_gemm(lds, proj, (const bf16_t*)(wl + W_FF2), 16384, D, DFF, e);
            gemm_resid_tiles(lds, proj + (size_t)16384 * DFF, DFF, (const bf16_t*)(wl + W_FF2), DFF, NTOK - 16384, DFF, p.out, mod_l + 5120, 16384); } break;
    }
}

__global__ void __launch_bounds__(512) fwd_megakernel(Params p) {
    extern __shared__ __attribute__((aligned(16))) unsigned char smem[];
    LAS unsigned char* lds = (LAS unsigned char*)smem;
    cg::grid_group grid = cg::this_grid();
    unsigned nbar = 0;
    for (int ph = p.ph_lo; ph < p.ph_hi; ++ph) {
        run_phase(p, ph, lds);
        if (ph + 1 < p.ph_hi) {
            if (ph == 0) grid.sync();
            else { ++nbar; grid_barrier((unsigned*)(p.ws + WS_CTR) + 64, nbar); }
        }
    }
}

extern "C" void kernel_launch(void* const* d_in, const int* in_sizes, int n_in, void* d_out, int out_size, void* d_ws, size_t ws_size, hipStream_t stream) {
    static int grid_blocks = 0;
    if (!grid_blocks) {
        int dev = 0, cus = 0, per_cu = 0;
        hipGetDevice(&dev);
        hipDeviceGetAttribute(&cus, hipDeviceAttributeMultiprocessorCount, dev);
        if (hipFuncSetAttribute((const void*)fwd_megakernel, hipFuncAttributeMaxDynamicSharedMemorySize, LDS_BYTES) != hipSuccess) fprintf(stderr, "hipFuncSetAttribute failed\n");
        hipOccupancyMaxActiveBlocksPerMultiprocessor(&per_cu, (const void*)fwd_megakernel, 512, LDS_BYTES);
        if (per_cu < 1) { fprintf(stderr, "occupancy query says %d blocks/CU\n", per_cu); per_cu = 1; }
        grid_blocks = cus * 1;
        (void)hipGetLastError();
        if (n_in != 26 || ws_size < WS_END) fprintf(stderr, "kernel_launch: unexpected n_in %d or ws_size %zu (need %zu)\n", n_in, ws_size, (size_t)WS_END);
    }
    Params p{};
    const float** pp = (const float**)&p;
    for (int i = 0; i < 26; ++i) pp[i] = (const float*)d_in[i];
    p.out = (float*)d_out; p.ws = (unsigned char*)d_ws; p.ph_lo = 0; p.ph_hi = NPHASE;
    void* args[] = {&p};
    hipError_t e = hipLaunchCooperativeKernel((const void*)fwd_megakernel, dim3(grid_blocks), dim3(512), args, LDS_BYTES, stream);
    if (e != hipSuccess) fprintf(stderr, "cooperative launch failed: %s (grid %d)\n", hipGetErrorString(e), grid_blocks);
}
```

```cpp
#include <hip/hip_runtime.h>
#include <hip/hip_cooperative_groups.h>
#include <cstdio>
namespace cg = cooperative_groups;

#define LAS __attribute__((address_space(3)))
typedef unsigned short bf16_t;
typedef short bf16x8 __attribute__((ext_vector_type(8)));
typedef float f32x16 __attribute__((ext_vector_type(16)));
typedef float f32x4 __attribute__((ext_vector_type(4)));
typedef unsigned u32x4 __attribute__((ext_vector_type(4)));
typedef unsigned u32x2 __attribute__((ext_vector_type(2)));

constexpr int D = 1024, DEPTH = 4, NTOK = 20480, NCTX = 4096, DFF = 4096;
constexpr int DIN = 8224, NPROJ = 5152, NGATE = 3072;
constexpr int PJ_GQ = 0, PJ_GK = 256, PJ_GV = 512, PJ_GO = 1024, PJ_GZF = 1536, PJ_GZB = 1552, PJ_HQ = 1568, PJ_HFF = 2080,
              PJ_HFB = 2592, PJ_HI = 3104, PJ_HO = 3616, PJ_MU = 4128, PJ_MV = 4640;
constexpr int NCHUNK = NTOK / 64;
constexpr float EPS = 1e-6f;
constexpr int LDS_BYTES = 160 * 1024;
constexpr int NPHASE = 2 + DEPTH * 10;

constexpr size_t WS_PROJ = 0;
constexpr size_t WS_ST   = WS_PROJ + (size_t)NTOK * NPROJ * 2;
constexpr size_t ST_GLA_BYTES = (size_t)NCHUNK * 2 * 4 * 128 * 64 * 2, ST_HG_BYTES = (size_t)NCHUNK * 2 * 4 * 128 * 128 * 2;
constexpr size_t WS_OCAT = WS_ST + ST_GLA_BYTES + ST_HG_BYTES;
constexpr size_t WS_H    = WS_OCAT + (size_t)NTOK * 1536 * 2;
constexpr size_t WS_W    = WS_H + (size_t)NTOK * D * 2;
constexpr size_t W_IN = 0, W_G = W_IN + (size_t)NPROJ * D * 2, W_BR = W_G + (size_t)NGATE * D * 2, W_OUT = W_BR + (size_t)3 * D * 512 * 2,
                 W_FF1 = W_OUT + (size_t)D * D * 2, W_FF2 = W_FF1 + (size_t)DFF * D * 2, W_END = W_FF2 + (size_t)D * DFF * 2;
constexpr size_t WS_MOD  = WS_W + 2 * W_END;
constexpr size_t WS_LBS  = WS_MOD + (size_t)DEPTH * 9 * 6144 * 4;
constexpr size_t WS_CTR  = WS_LBS + 2 * 4 * 512 * 4;
constexpr size_t WS_END  = WS_CTR + 4096;

struct Params {
    const float *x_prompt, *x_sample, *c, *state_gla, *state_hgrn, *c_ctx, *ada_w, *ada_b, *norm_mix_g, *norm_ffn_g, *w_in, *gla_lr_w,
        *gla_lr_b, *gla_norm_g, *hg_lb_logits, *hg_norm_g, *gm_norm_g, *gm_ws, *gm_bs, *w_br_gla, *w_br_hg, *w_br_gm, *w_out, *w_ff1, *w_ff2,
        *final_norm_g;
    float* out; unsigned char* ws; int ph_lo, ph_hi;
};

typedef __bf16 bf16x2_t __attribute__((ext_vector_type(2)));
__device__ __forceinline__ unsigned pk2(float lo, float hi) { bf16x2_t v; v.x = (__bf16)lo; v.y = (__bf16)hi; return __builtin_bit_cast(unsigned, v); }
__device__ __forceinline__ bf16_t f2bf(float f) { return (bf16_t)(pk2(f, 0.f) & 0xffffu); }
__device__ __forceinline__ float bf2f(bf16_t h) { return __uint_as_float(((unsigned)h) << 16); }
__device__ __forceinline__ float bflo(unsigned u) { return __uint_as_float(u << 16); }
__device__ __forceinline__ float bfhi(unsigned u) { return __uint_as_float(u & 0xffff0000u); }
__device__ __forceinline__ float fexp_(float x) { return __builtin_amdgcn_exp2f(x * 1.4426950408889634f); }
__device__ __forceinline__ float flog_(float x) { return __builtin_amdgcn_logf(x) * 0.6931471805599453f; }
__device__ __forceinline__ float sigmoidf_(float x) { return __builtin_amdgcn_rcpf(1.0f + fexp_(-x)); }
__device__ __forceinline__ float siluf_(float x) { return x * sigmoidf_(x); }
__device__ __forceinline__ float geluf_(float x) { const float y = 0.7978845608028654f * (x + 0.044715f * x * x * x); const float t = 1.0f - 2.0f * __builtin_amdgcn_rcpf(1.0f + fexp_(2.0f * y)); return 0.5f * x * (1.0f + t); }
__device__ __forceinline__ float logsigmoidf_(float x) { return fminf(x, 0.f) - flog_(1.0f + fexp_(-fabsf(x))); }
__device__ __forceinline__ float wave_sum(float v) {
#pragma unroll
    for (int o = 1; o < 64; o <<= 1) v += __shfl_xor(v, o);
    return v;
}
__device__ __forceinline__ int mod_row(int tok) { return tok < NCTX ? 0 : 1 + ((tok - NCTX) >> 11); }
__device__ __forceinline__ int otid() { int t = (int)__builtin_amdgcn_workitem_id_x(); asm volatile("" : "+v"(t)); return t; }
#define LDS_WAIT() asm volatile("s_waitcnt lgkmcnt(0)" ::: "memory")

template <int MT, int NTL, int KS>
__device__ __forceinline__ void mma_lds(f32x16 (&acc)[MT][NTL], const LAS bf16_t* As, int lda, const LAS bf16_t* Bs, int ldb, int lane) {
    const int r = lane & 31, h = lane >> 5;
    const LAS bf16_t* ap = As + r * lda + h * 8;
    const LAS bf16_t* bp = Bs + r * ldb + h * 8;
#pragma unroll
    for (int ks = 0; ks < KS; ++ks) {
        bf16x8 a[MT], b[NTL];
#pragma unroll
        for (int m = 0; m < MT; ++m) a[m] = *(const LAS bf16x8*)(ap + m * 32 * lda + ks * 16);
#pragma unroll
        for (int n = 0; n < NTL; ++n) b[n] = *(const LAS bf16x8*)(bp + n * 32 * ldb + ks * 16);
#pragma unroll
        for (int m = 0; m < MT; ++m)
#pragma unroll
            for (int n = 0; n < NTL; ++n) acc[m][n] = __builtin_amdgcn_mfma_f32_32x32x16_bf16(a[m], b[n], acc[m][n], 0, 0, 0);
    }
}

template <int BM>
__device__ __forceinline__ void gemm_kloop(LAS unsigned char* lds, const bf16_t* __restrict__ Ag, int lda, const bf16_t* __restrict__ Bg, int ldb, int brows,
                                           int K, f32x16 (&acc)[2][(128 / (8 / (BM / 64))) / 32]) {
    static_assert(BM == 128, "128-row tiles only");
    constexpr int WN = 4, WTN = 32, NTL = 1, LDT = 136, NP = 4;
    LAS bf16_t* As = (LAS bf16_t*)lds;
    LAS bf16_t* Bs = As + 2 * 128 * LDT;
    const int tid = otid(), lane = tid & 63, wid = tid >> 6, wm = wid / WN, wn = wid % WN;
    const int lrow = tid >> 4, lc = (tid & 15) * 8;
    const bf16_t* ap[NP]; const bf16_t* bp[NP];
#pragma unroll
    for (int p = 0; p < NP; ++p) ap[p] = Ag + (size_t)(lrow + p * 32) * lda + lc;
#pragma unroll
    for (int p = 0; p < NP; ++p) { int br = lrow + p * 32; br = br < brows ? br : brows - 1; bp[p] = Bg + (size_t)br * ldb + lc; }
    u32x4 ra[3][NP], rb[3][NP];
    const int nk = K / 128;
#define KL_ISSUE(S, step) do { _Pragma("unroll") for (int p = 0; p < NP; ++p) ra[S][p] = *(const u32x4*)(ap[p] + (step) * 128); \
                               _Pragma("unroll") for (int p = 0; p < NP; ++p) rb[S][p] = *(const u32x4*)(bp[p] + (step) * 128); } while (0)
#define KL_WRITE(S, stage) do { _Pragma("unroll") for (int p = 0; p < NP; ++p) *(LAS u32x4*)(As + (stage) * 128 * LDT + (lrow + p * 32) * LDT + lc) = ra[S][p]; \
                                _Pragma("unroll") for (int p = 0; p < NP; ++p) *(LAS u32x4*)(Bs + (stage) * 128 * LDT + (lrow + p * 32) * LDT + lc) = rb[S][p]; } while (0)
#define KL_STEP(J, JN) if (kt + J < nk) { const int s_ = kt + J; if (s_ + 3 < nk) KL_ISSUE(J, s_ + 3); \
        mma_lds<2, NTL, 8>(acc, As + (s_ & 1) * 128 * LDT + wm * 64 * LDT, LDT, Bs + (s_ & 1) * 128 * LDT + wn * WTN * LDT, LDT, lane); \
        if (s_ + 1 < nk) KL_WRITE(JN, (s_ + 1) & 1); __syncthreads(); }
    KL_ISSUE(0, 0); if (nk > 1) KL_ISSUE(1, 1); if (nk > 2) KL_ISSUE(2, 2);
    KL_WRITE(0, 0);
    __syncthreads();
    for (int kt = 0; kt < nk; kt += 3) { KL_STEP(0, 1) KL_STEP(1, 2) KL_STEP(2, 0) }
#undef KL_ISSUE
#undef KL_WRITE
#undef KL_STEP
}

template <int NTL>
__device__ __forceinline__ void acc_zero(f32x16 (&acc)[2][NTL]) {
#pragma unroll
    for (int m = 0; m < 2; ++m)
#pragma unroll
        for (int n = 0; n < NTL; ++n)
#pragma unroll
            for (int i = 0; i < 16; ++i) acc[m][n][i] = 0.f;
}

__device__ __forceinline__ void tile_coords(int t, int nN, int& tm, int& tn) { const int q = t >> 3; tn = q % nN; tm = (q / nN) * 8 + (t & 7); }

template <int BM, class Epi>
__device__ __forceinline__ void gemm_phase(LAS unsigned char* lds, const bf16_t* A, int lda, const bf16_t* Bt, int ldb, int M, int N, int K, const Epi& epi) {
    constexpr int WM = BM / 64, WN = 8 / WM, WTN = 128 / WN, NTL = WTN / 32;
    const int nM = M / BM, nN = (N + 127) / 128, ntiles = nM * nN;
    const int lane = otid() & 63, wid = otid() >> 6, wm = wid / WN, wn = wid % WN;
    for (int t = blockIdx.x; t < ntiles; t += gridDim.x) {
        int tm, tn; tile_coords(t, nN, tm, tn);
        const int row0 = tm * BM, col0 = tn * 128;
        f32x16 acc[2][NTL]; acc_zero<NTL>(acc);
        gemm_kloop<BM>(lds, A + (size_t)row0 * lda, lda, Bt + (size_t)col0 * ldb, ldb, min(128, N - col0), K, acc);
#pragma unroll
        for (int m = 0; m < 2; ++m)
#pragma unroll
            for (int n = 0; n < NTL; ++n) {
                const int col = col0 + wn * WTN + n * 32 + (lane & 31);
#pragma unroll
                for (int i = 0; i < 16; ++i) {
                    const int row = row0 + wm * 64 + m * 32 + (i & 3) + 8 * (i >> 2) + 4 * (lane >> 5);
                    epi(row, col, acc[m][n][i]);
                }
            }
    }
}

__device__ __forceinline__ void gemm_resid_tiles(LAS unsigned char* lds, const bf16_t* A, int lda, const bf16_t* Bt, int ldb, int M, int K, float* x, const float* gate, int roff) {
    const int nM = M / 128, nN = 8, ntiles = nM * nN;
    const int lane = otid() & 63, wid = otid() >> 6, wm = wid >> 2, wn = wid & 3;
    for (int t = blockIdx.x; t < ntiles; t += gridDim.x) {
        int tm, tn; tile_coords(t, nN, tm, tn);
        const int row0 = tm * 128, col0 = tn * 128;
        f32x16 acc[2][1]; acc_zero<1>(acc);
        gemm_kloop<128>(lds, A + (size_t)row0 * lda, lda, Bt + (size_t)col0 * ldb, ldb, 128, K, acc);
        const int col = col0 + wn * 32 + (lane & 31), rbase = roff + row0 + wm * 64 + 4 * (lane >> 5);
        const float g = gate[(size_t)mod_row(roff + row0) * 6144 + col];
        float xv[2][16];
#pragma unroll
        for (int m = 0; m < 2; ++m)
#pragma unroll
            for (int i = 0; i < 16; ++i) xv[m][i] = x[(size_t)(rbase + m * 32 + (i & 3) + 8 * (i >> 2)) * D + col];
#pragma unroll
        for (int m = 0; m < 2; ++m)
#pragma unroll
            for (int i = 0; i < 16; ++i) x[(size_t)(rbase + m * 32 + (i & 3) + 8 * (i >> 2)) * D + col] = xv[m][i] + g * acc[m][0][i];
    }
}

struct EpiBf16 { bf16_t* C; int ldc, N; __device__ __forceinline__ void operator()(int row, int col, float v) const { if (col < N) C[(size_t)row * ldc + col] = f2bf(v); } };
struct EpiRelu2 { bf16_t* C; int ldc; __device__ __forceinline__ void operator()(int row, int col, float v) const { v = fmaxf(v, 0.f); C[(size_t)row * ldc + col] = f2bf(v * v); } };
struct EpiResidOff { float* x; const float* gate; int roff; __device__ __forceinline__ void operator()(int row, int col, float v) const {
    const int r = row + roff; const float g = gate[mod_row(r) * 6144 + col]; float* p = x + (size_t)r * D + col; *p = *p + g * v; } };
struct EpiResid { float* x; const float* gate;   __device__ __forceinline__ void operator()(int row, int col, float v) const {
    const float g = gate[mod_row(row) * 6144 + col]; float* p = x + (size_t)row * D + col; *p = *p + g * v; } };

namespace pg8 {
#define PG8_LAS __attribute__((address_space(3)))
typedef unsigned short bf16_t;
typedef short bf16x8 __attribute__((ext_vector_type(8)));
typedef float f32x4 __attribute__((ext_vector_type(4)));
typedef unsigned u32x4 __attribute__((ext_vector_type(4)));
constexpr int BM = 256, BK = 64, HALF = 128, HTB = HALF * BK * 2  , STAGE_BYTES = 8 * HTB, NXCD = 8, WGM = 8;

__host__ __device__ __forceinline__ int lds_byte(int r, int c) { const int st = (r >> 4) * 2 + (c >> 5), rr = r & 15, cc = c & 31, ob = rr * 64 + cc * 2; return st * 1024 + (ob ^ (((ob >> 9) & 1) << 5)); }
__host__ __device__ __forceinline__ void stage_rc(int b, int& R, int& C) { const int st = b / 1024, sb = b % 1024, swz = sb ^ (((sb >> 9) & 1) << 5); R = (st >> 1) * 16 + swz / 64; C = (st & 1) * 32 + (swz % 64) / 2; }
__host__ __device__ __forceinline__ int perm32(int rho) { const int n = rho >> 4, i = rho & 15; return 8 * (i >> 2) + 4 * n + (i & 3); }

struct Unit { int pm, pn; };
struct Gemm { const bf16_t* A; const bf16_t* Bt; int M, N, K; size_t agrp; };

struct StaticOrder {
    int nM, nN, nwg, G, c;
    __host__ __device__ void init(int M, int N, int G_, int c_) { nM = M / BM; nN = N / BM; nwg = nM * nN; G = G_; c = c_; }
    __host__ __device__ bool next(int i, Unit& u) const {
        const long L = (long)i * G + c; if (L >= nwg) return false;
        int wgid = (int)L; { const int q = nwg / NXCD, r = nwg % NXCD, xcd = wgid % NXCD, off = wgid / NXCD; wgid = (xcd < r ? xcd * (q + 1) : r * (q + 1) + (xcd - r) * q) + off; }
        const int nig = WGM * nN, gid = wgid / nig, fm = gid * WGM, gsz = (nM - fm) < WGM ? (nM - fm) : WGM;
        u.pm = fm + ((wgid % nig) % gsz); u.pn = (wgid % nig) / gsz; return true;
    }
    __device__ __forceinline__ void a_ready(const Unit&) const {}
    __device__ __forceinline__ void done(const Unit&) const {}
};
__device__ __forceinline__ unsigned cvt_pk_bf16(float lo, float hi) { unsigned r; asm volatile("v_cvt_pk_bf16_f32 %0, %1, %2" : "=v"(r) : "v"(lo), "v"(hi)); return r; }
template <class Epi, class Sched, bool STAMP = false>
__device__ __forceinline__ void gemm_phase(PG8_LAS unsigned char* lds, const Gemm g, const Sched& S, const Epi& E, unsigned long long* stamps) {
    const int tid = otid(), wid = __builtin_amdgcn_readfirstlane(tid >> 6), lane = tid & 63, wr = wid >> 2, wc = wid & 3, fr = lane & 15, fq = lane >> 4;
    const int K = g.K, nt = K / BK;
    int ts_lo = 0, ts_hi = 0, nts = 0; const unsigned long long rt_entry = STAMP ? (unsigned long long)wall_clock64() : 0ull;
#define PG8_STAMP() do { if (STAMP && wid == 0 && nts < 64) { const unsigned long long _c = (unsigned long long)clock64(); \
        ts_lo = (lane == nts) ? (int)(unsigned)_c : ts_lo; ts_hi = (lane == nts) ? (int)(unsigned)(_c >> 32) : ts_hi; ++nts; } } while (0)
    PG8_STAMP();
    unsigned voffA[2], voffB[2];
#pragma unroll
    for (int i = 0; i < 2; ++i) { int R, C; stage_rc(tid * 16 + i * 8192, R, C); const int Rb = Epi::PERM ? ((R & ~31) + perm32(R & 31)) : R;
        voffA[i] = (unsigned)(R * K + C) * 2u; voffB[i] = (unsigned)(Rb * K + C) * 2u; }
    const size_t kstep = (size_t)(BK * 2);
    const size_t hstep = (size_t)HALF * K * 2;
    const size_t tstep = 2 * hstep;
    const unsigned ldsw = (unsigned)wid * 1024u;
    const int aoff = lds_byte(wr * 64 + fr, fq * 8), boff = lds_byte(wc * 32 + fr, fq * 8);
#define PG8_SA(b, h) (((b) * 2 + (h)) * HTB)
#define PG8_SB(b, h) ((4 + (b) * 2 + (h)) * HTB)
#define PG8_STAGE(bufoff, gbase, voff) do { _Pragma("unroll") for (int _i = 0; _i < 2; ++_i) \
        __builtin_amdgcn_global_load_lds((const unsigned*)((const char*)(gbase) + (voff)[_i]), (PG8_LAS unsigned*)(lds + (bufoff) + ldsw + _i * 8192), 16, 0, 0); } while (0)
#define PG8_LDA(dst, b, h) do { _Pragma("unroll") for (int m = 0; m < 4; ++m) _Pragma("unroll") for (int k = 0; k < 2; ++k) dst[m][k] = *(const PG8_LAS bf16x8*)(lds + PG8_SA(b, h) + aoff + m * 2048 + k * 1024); } while (0)
#define PG8_LDB(dst, b, h) do { _Pragma("unroll") for (int n = 0; n < 2; ++n) _Pragma("unroll") for (int k = 0; k < 2; ++k) dst[n][k] = *(const PG8_LAS bf16x8*)(lds + PG8_SB(b, h) + boff + n * 2048 + k * 1024); } while (0)
#define PG8_MMA(ai, bj, At, Bt) do { __builtin_amdgcn_s_setprio(1); _Pragma("unroll") for (int m = 0; m < 4; ++m) _Pragma("unroll") for (int n = 0; n < 2; ++n) _Pragma("unroll") for (int k = 0; k < 2; ++k) \
        acc[ai][bj][m][n] = __builtin_amdgcn_mfma_f32_16x16x32_bf16(Bt[n][k], At[m][k], acc[ai][bj][m][n], 0, 0, 0); __builtin_amdgcn_s_setprio(0); } while (0)
#define PG8_WAIT_V(n) asm volatile("s_waitcnt vmcnt(" #n ")" ::: "memory")
#define PG8_WAIT_L(n) asm volatile("s_waitcnt lgkmcnt(" #n ")" ::: "memory")
#define PG8_BAR __builtin_amdgcn_s_barrier()
#define PG8_SCHED __builtin_amdgcn_sched_barrier(0)
    Unit cur, nxt; int ui = 0;
    if (!S.next(0, cur)) return;
    f32x4 acc[2][2][4][2];
#pragma unroll
    for (int a = 0; a < 2; ++a)
#pragma unroll
        for (int b = 0; b < 2; ++b)
#pragma unroll
            for (int m = 0; m < 4; ++m)
#pragma unroll
                for (int n = 0; n < 2; ++n) acc[a][b][m][n] = (f32x4){0.f, 0.f, 0.f, 0.f};
    bf16x8 At[4][2], B0[2][2], B1[2][2];
    const char* cA = (const char*)g.A + (size_t)cur.pm * tstep + (size_t)(cur.pn >> 2) * g.agrp; const char* cB = (const char*)g.Bt + (size_t)cur.pn * tstep;
    S.a_ready(cur);
    PG8_STAGE(PG8_SB(0, 0), cB, voffB); PG8_STAGE(PG8_SA(0, 0), cA, voffA); PG8_STAGE(PG8_SB(0, 1), cB + hstep, voffB); PG8_STAGE(PG8_SA(0, 1), cA + hstep, voffA);
    if (wr == 1) PG8_BAR;
    PG8_WAIT_V(4); PG8_BAR;
    PG8_STAGE(PG8_SB(1, 0), cB + kstep, voffB); PG8_STAGE(PG8_SA(1, 0), cA + kstep, voffA); PG8_STAGE(PG8_SB(1, 1), cB + hstep + kstep, voffB);
    PG8_WAIT_V(6); PG8_BAR;
    PG8_STAMP();
    for (;;) {
        const bool has_next = S.next(ui + 1, nxt);
        const char* nA = has_next ? (const char*)g.A + (size_t)nxt.pm * tstep + (size_t)(nxt.pn >> 2) * g.agrp : cA; const char* nB = has_next ? (const char*)g.Bt + (size_t)nxt.pn * tstep : cB;
        for (int t = 0; t < nt; t += 2) {
            const bool last = (t == nt - 2);
            const char* a1 = cA + (size_t)(t + 1) * kstep;
            const char* a2 = last ? nA : cA + (size_t)(t + 2) * kstep; const char* b2 = last ? nB : cB + (size_t)(t + 2) * kstep;
            const char* a3 = a2 + kstep; const char* b3 = b2 + kstep;
            if (last && has_next) S.a_ready(nxt);
            PG8_LDB(B0, 0, 0); PG8_SCHED; PG8_LDA(At, 0, 0); PG8_STAGE(PG8_SA(1, 1), a1 + hstep, voffA);
            PG8_WAIT_L(8); PG8_BAR; PG8_WAIT_L(0); PG8_MMA(0, 0, At, B0); PG8_BAR; PG8_SCHED;
            PG8_LDB(B1, 0, 1); PG8_STAGE(PG8_SB(0, 0), b2, voffB);
            PG8_BAR; PG8_WAIT_L(0); PG8_MMA(0, 1, At, B1); PG8_BAR;
            PG8_LDA(At, 0, 1); PG8_STAGE(PG8_SA(0, 0), a2, voffA);
            PG8_BAR; PG8_WAIT_L(0); PG8_MMA(1, 0, At, B0); PG8_BAR; PG8_SCHED;
            PG8_STAGE(PG8_SB(0, 1), b2 + hstep, voffB);
            PG8_WAIT_V(6); PG8_BAR; PG8_MMA(1, 1, At, B1); PG8_BAR;
            PG8_LDB(B0, 1, 0); PG8_SCHED; PG8_LDA(At, 1, 0); PG8_STAGE(PG8_SA(0, 1), a2 + hstep, voffA);
            PG8_WAIT_L(8); PG8_BAR; PG8_WAIT_L(0); PG8_MMA(0, 0, At, B0); PG8_BAR; PG8_SCHED;
            PG8_LDB(B1, 1, 1); PG8_STAGE(PG8_SB(1, 0), b3, voffB);
            PG8_BAR; PG8_WAIT_L(0); PG8_MMA(0, 1, At, B1); PG8_BAR;
            PG8_LDA(At, 1, 1); PG8_STAGE(PG8_SA(1, 0), a3, voffA);
            PG8_BAR; PG8_WAIT_L(0); PG8_MMA(1, 0, At, B0); PG8_BAR; PG8_SCHED;
            PG8_STAGE(PG8_SB(1, 1), b3 + hstep, voffB);
            PG8_WAIT_V(6); PG8_BAR; PG8_MMA(1, 1, At, B1); PG8_BAR;
        }
        PG8_STAMP();
        if constexpr (!Epi::AFTER_DRAIN) { E(acc, cur, wr, wc, fr, fq); S.done(cur); }
        PG8_STAMP();
        if (!has_next) break;
#pragma unroll
        for (int a = 0; a < 2; ++a)
#pragma unroll
            for (int b = 0; b < 2; ++b)
#pragma unroll
                for (int m = 0; m < 4; ++m)
#pragma unroll
                    for (int n = 0; n < 2; ++n) acc[a][b][m][n] = (f32x4){0.f, 0.f, 0.f, 0.f};
        cur = nxt; cA = nA; cB = nB; ++ui;
    }
    PG8_WAIT_V(0);
    if (wr == 0) PG8_BAR;
    PG8_BAR;
    if constexpr (Epi::AFTER_DRAIN) { E.fused(acc, cur, wr, wc, fr, fq, lds, wid, lane); S.done(cur); }
    PG8_STAMP();
    if (STAMP && wid == 0) { stamps[lane] = lane < nts ? (((unsigned long long)(unsigned)ts_hi << 32) | (unsigned)ts_lo) : 0ull;
        if (lane == 62) stamps[62] = rt_entry; if (lane == 63) stamps[63] = (unsigned long long)wall_clock64(); }
#undef PG8_STAMP
#undef PG8_SA
#undef PG8_SB
#undef PG8_STAGE
#undef PG8_LDA
#undef PG8_LDB
#undef PG8_MMA
#undef PG8_WAIT_V
#undef PG8_WAIT_L
#undef PG8_BAR
#undef PG8_SCHED
}
}

struct PEpiBf16 {
    static constexpr bool PERM = true, AFTER_DRAIN = false;
    bf16_t* C; int ldc, N, act;
    __device__ __forceinline__ void operator()(const pg8::f32x4 (&acc)[2][2][4][2], const pg8::Unit& u, int wr, int wc, int fr, int fq) const {
        const int row0 = u.pm * 256 + wr * 64 + fr, col0 = u.pn * 256 + wc * 32 + 8 * fq;
#pragma unroll
        for (int ai = 0; ai < 2; ++ai)
#pragma unroll
            for (int m = 0; m < 4; ++m) {
                bf16_t* rowp = C + (size_t)(row0 + ai * 128 + m * 16) * ldc;
#pragma unroll
                for (int bj = 0; bj < 2; ++bj) {
                    const int col = col0 + bj * 128;
                    pg8::f32x4 v0 = acc[ai][bj][m][0], v1 = acc[ai][bj][m][1];
                    if (act == 1) { v0.x = fmaxf(v0.x, 0.f); v0.y = fmaxf(v0.y, 0.f); v0.z = fmaxf(v0.z, 0.f); v0.w = fmaxf(v0.w, 0.f); v0 = v0 * v0;
                                    v1.x = fmaxf(v1.x, 0.f); v1.y = fmaxf(v1.y, 0.f); v1.z = fmaxf(v1.z, 0.f); v1.w = fmaxf(v1.w, 0.f); v1 = v1 * v1; }
                    if (act == 2) { v0.x = sigmoidf_(v0.x); v0.y = sigmoidf_(v0.y); v0.z = sigmoidf_(v0.z); v0.w = sigmoidf_(v0.w);
                                    v1.x = sigmoidf_(v1.x); v1.y = sigmoidf_(v1.y); v1.z = sigmoidf_(v1.z); v1.w = sigmoidf_(v1.w); }
                    u32x4 w; w.x = pk2(v0.x, v0.y); w.y = pk2(v0.z, v0.w); w.z = pk2(v1.x, v1.y); w.w = pk2(v1.z, v1.w);
                    if (col < N) *(u32x4*)(rowp + col) = w;
                }
            }
    }
};
struct PEpiResid {
    static constexpr bool PERM = true, AFTER_DRAIN = false;
    float* x; const float* gate;
    __device__ __forceinline__ void operator()(const pg8::f32x4 (&acc)[2][2][4][2], const pg8::Unit& u, int wr, int wc, int fr, int fq) const {
        const int row0 = u.pm * 256 + wr * 64 + fr, col0 = u.pn * 256 + wc * 32 + 8 * fq;
        const float* gp = gate + (size_t)mod_row(u.pm * 256) * 6144 + col0;
        f32x4 g[2][2];
#pragma unroll
        for (int bj = 0; bj < 2; ++bj) { g[bj][0] = *(const f32x4*)(gp + bj * 128); g[bj][1] = *(const f32x4*)(gp + bj * 128 + 4); }
#pragma unroll
        for (int ai = 0; ai < 2; ++ai) {
            f32x4 xv[4][2][2];
#pragma unroll
            for (int m = 0; m < 4; ++m)
#pragma unroll
                for (int bj = 0; bj < 2; ++bj) {
                    const float* rp = x + (size_t)(row0 + ai * 128 + m * 16) * D + col0 + bj * 128;
                    xv[m][bj][0] = *(const f32x4*)rp; xv[m][bj][1] = *(const f32x4*)(rp + 4);
                }
#pragma unroll
            for (int m = 0; m < 4; ++m)
#pragma unroll
                for (int bj = 0; bj < 2; ++bj) {
                    float* rp = x + (size_t)(row0 + ai * 128 + m * 16) * D + col0 + bj * 128;
                    *(f32x4*)rp = xv[m][bj][0] + g[bj][0] * acc[ai][bj][m][0]; *(f32x4*)(rp + 4) = xv[m][bj][1] + g[bj][1] * acc[ai][bj][m][1];
                }
        }
    }
};
struct PEpiGate {
    static constexpr bool PERM = true, AFTER_DRAIN = false;
    bf16_t* G; int ldc;
    __device__ __forceinline__ void operator()(const pg8::f32x4 (&acc)[2][2][4][2], const pg8::Unit& u, int wr, int wc, int fr, int fq) const {
        const int row0 = u.pm * 256 + wr * 64 + fr, col0 = u.pn * 256 + wc * 32 + 8 * fq;
#pragma unroll
        for (int ai = 0; ai < 2; ++ai) {
            u32x4 gv[4][2];
#pragma unroll
            for (int m = 0; m < 4; ++m)
#pragma unroll
                for (int bj = 0; bj < 2; ++bj) gv[m][bj] = *(const u32x4*)(G + (size_t)(row0 + ai * 128 + m * 16) * ldc + col0 + bj * 128);
#pragma unroll
            for (int m = 0; m < 4; ++m)
#pragma unroll
                for (int bj = 0; bj < 2; ++bj) {
                    const u32x4 g = gv[m][bj];
                    const pg8::f32x4 v0 = acc[ai][bj][m][0], v1 = acc[ai][bj][m][1];
                    u32x4 w; w.x = pk2(bflo(g.x) * v0.x, bfhi(g.x) * v0.y); w.y = pk2(bflo(g.y) * v0.z, bfhi(g.y) * v0.w);
                    w.z = pk2(bflo(g.z) * v1.x, bfhi(g.z) * v1.y); w.w = pk2(bflo(g.w) * v1.z, bfhi(g.w) * v1.w);
                    *(u32x4*)(G + (size_t)(row0 + ai * 128 + m * 16) * ldc + col0 + bj * 128) = w;
                }
        }
    }
};
__device__ __forceinline__ void sum3_phase(const Params& p) {
    const bf16_t* Y = (const bf16_t*)(p.ws + WS_PROJ); bf16_t* merged = (bf16_t*)(p.ws + WS_ST);
    for (size_t i = (size_t)blockIdx.x * 512 + otid(); i < (size_t)NTOK * (D / 8); i += (size_t)gridDim.x * 512) {
        const size_t row = i >> 7; const int c8 = (int)(i & 127) * 8;
        const bf16_t* yr = Y + row * NGATE + c8;
        const u32x4 a = *(const u32x4*)yr, b = *(const u32x4*)(yr + 1024), c = *(const u32x4*)(yr + 2048);
        u32x4 w; w.x = pk2(bflo(a.x) + bflo(b.x) + bflo(c.x), bfhi(a.x) + bfhi(b.x) + bfhi(c.x)); w.y = pk2(bflo(a.y) + bflo(b.y) + bflo(c.y), bfhi(a.y) + bfhi(b.y) + bfhi(c.y));
        w.z = pk2(bflo(a.z) + bflo(b.z) + bflo(c.z), bfhi(a.z) + bfhi(b.z) + bfhi(c.z)); w.w = pk2(bflo(a.w) + bflo(b.w) + bflo(c.w), bfhi(a.w) + bfhi(b.w) + bfhi(c.w));
        *(u32x4*)(merged + row * D + c8) = w;
    }
}
template <class Epi>
__device__ __forceinline__ void pg8_gemm(LAS unsigned char* lds, const bf16_t* A, const bf16_t* Bt, int M, int N, int K, const Epi& e, size_t agrp = 0) {
    pg8::Gemm g{A, Bt, M, N, K, agrp};
    pg8::StaticOrder so; so.init(M, N, (int)gridDim.x, (int)blockIdx.x);
    pg8::gemm_phase<Epi, pg8::StaticOrder, false>(lds, g, so, e, nullptr);
    __syncthreads();
}

__device__ __forceinline__ void grid_barrier(unsigned* bar, unsigned k) {
    asm volatile("s_waitcnt vmcnt(0)" ::: "memory");
    __syncthreads();
    if (otid() == 0) {
        const unsigned g = blockIdx.x & 7u, ng = (gridDim.x + 7u - g) >> 3;
        __builtin_amdgcn_fence(__ATOMIC_RELEASE, "agent");
        asm volatile("s_waitcnt vmcnt(0)" ::: "memory");
        const unsigned c = __hip_atomic_fetch_add(bar + 16 * g, 1u, __ATOMIC_RELAXED, __HIP_MEMORY_SCOPE_AGENT);
        if (c == ng * k - 1u) {
            const unsigned ngroups = gridDim.x < 8u ? gridDim.x : 8u;
            const unsigned t = __hip_atomic_fetch_add(bar + 128, 1u, __ATOMIC_RELAXED, __HIP_MEMORY_SCOPE_AGENT);
            if (t == ngroups * k - 1u)
                for (unsigned j = 0; j < ngroups; ++j) __hip_atomic_store(bar + 144 + 16 * j, k, __ATOMIC_RELAXED, __HIP_MEMORY_SCOPE_AGENT);
        }
        unsigned spins = 0;
        while (__hip_atomic_load(bar + 144 + 16 * g, __ATOMIC_RELAXED, __HIP_MEMORY_SCOPE_AGENT) < k && ++spins < (1u << 28)) __builtin_amdgcn_s_sleep(1);
        __builtin_amdgcn_fence(__ATOMIC_ACQUIRE, "agent");
        asm volatile("s_waitcnt vmcnt(0)" ::: "memory");
    }
    __syncthreads();
}

__device__ __forceinline__ void transpose_item(const float* __restrict__ W, int N, int K, int k0, int n0, bf16_t* __restrict__ dst  , LAS float* scr, int lane) {
    {
        const int kr = lane >> 3, c4 = (lane & 7) * 4;
        f32x4 v[8];
#pragma unroll
        for (int i = 0; i < 8; ++i) v[i] = *(const f32x4*)(W + (size_t)(k0 + i * 8 + kr) * N + n0 + c4);
#pragma unroll
        for (int i = 0; i < 8; ++i) { LAS float* d = scr + (i * 8 + kr) * 33 + c4; d[0] = v[i].x; d[1] = v[i].y; d[2] = v[i].z; d[3] = v[i].w; }
    }
    LDS_WAIT();
    const int c = lane & 7;
#pragma unroll
    for (int j = 0; j < 4; ++j) {
        const int n = (lane >> 3) + 8 * j; const LAS float* s = scr + (8 * c) * 33 + n;
        u32x4 o; o.x = pk2(s[0 * 33], s[1 * 33]); o.y = pk2(s[2 * 33], s[3 * 33]); o.z = pk2(s[4 * 33], s[5 * 33]); o.w = pk2(s[6 * 33], s[7 * 33]);
        *(u32x4*)(dst + (size_t)n * K + k0 + 8 * c) = o;
    }
    LDS_WAIT();
}

constexpr int CONV_NIT = 16 * 257 + 3 * 8 * 32 + 16 * 32 + 16 * 128 + 64 * 32, CONV_BLOCK_ITEMS = (CONV_NIT + 7) / 8;
constexpr int CONV_IN_P2 = 112 * 2, CONV_IN_P4 = 64 * 4, CONV_IN_GEMM = CONV_IN_P2 + CONV_IN_P4;
__device__ __forceinline__ void convert_weights(const Params& p, int l, LAS unsigned char* lds, int bitem = -1) {
    const int lane = otid() & 63, wid = otid() >> 6;
    LAS float* scr = (LAS float*)(lds + wid * 16384);
    unsigned char* wb = p.ws + WS_W + (size_t)(l & 1) * W_END;
    constexpr int I_IN = 16 * 257, I_BR = 8 * 32, I_OUT = 16 * 32, I_FF1 = 16 * 128, I_FF2 = 64 * 32;
    constexpr int NIT = I_IN + 3 * I_BR + I_OUT + I_FF1 + I_FF2;
    for (int it = (bitem < 0 ? blockIdx.x * 8 + wid : bitem * 8 + wid); it < NIT; it += (bitem < 0 ? gridDim.x * 8 : NIT)) {
        int r = it;
        if (r < I_IN) { const int kb = r / 257, nb = r % 257, n0 = nb * 32;
            bf16_t* dst = n0 < NPROJ ? (bf16_t*)(wb + W_IN) + (size_t)n0 * D : (bf16_t*)(wb + W_G) + (size_t)(n0 - NPROJ) * D;
            transpose_item(p.w_in + (size_t)l * D * DIN, DIN, D, kb * 64, n0, dst, scr, lane); continue; }
        r -= I_IN;
        if (r < 3 * I_BR) { const int b = r / I_BR, q = r % I_BR, kb = q / 32, nb = q % 32;
            const float* W = (b == 0 ? p.w_br_gla : b == 1 ? p.w_br_hg : p.w_br_gm) + (size_t)l * 512 * D;
            transpose_item(W, D, 512, kb * 64, nb * 32, (bf16_t*)(wb + W_BR) + (size_t)b * D * 512 + (size_t)nb * 32 * 512, scr, lane); continue; }
        r -= 3 * I_BR;
        if (r < I_OUT) { const int kb = r / 32, nb = r % 32;
            transpose_item(p.w_out + (size_t)l * D * D, D, D, kb * 64, nb * 32, (bf16_t*)(wb + W_OUT) + (size_t)nb * 32 * D, scr, lane); continue; }
        r -= I_OUT;
        if (r < I_FF1) { const int kb = r / 128, nb = r % 128;
            transpose_item(p.w_ff1 + (size_t)l * D * DFF, DFF, D, kb * 64, nb * 32, (bf16_t*)(wb + W_FF1) + (size_t)nb * 32 * D, scr, lane); continue; }
        r -= I_FF1;
        { const int kb = r / 32, nb = r % 32;
            transpose_item(p.w_ff2 + (size_t)l * DFF * D, D, DFF, kb * 64, nb * 32, (bf16_t*)(wb + W_FF2) + (size_t)nb * 32 * DFF, scr, lane); }
    }
}

__device__ __forceinline__ void phase0(const Params& p, LAS unsigned char* lds) {
    const int tid = otid();
    float* x = p.out;
    for (size_t i = (size_t)blockIdx.x * 512 + tid; i < (size_t)NTOK * (D / 4); i += (size_t)gridDim.x * 512) {
        const int tok = (int)(i >> 8), c4 = (int)(i & 255) * 4;
        f32x4 v;
        if (tok < NCTX) v = *(const f32x4*)(p.x_prompt + (size_t)tok * D + c4);
        else {
            const int lt = tok - NCTX; v = *(const f32x4*)(p.x_sample + (size_t)lt * D + c4);
            const int t = lt & 2047; const float rr = (float)(t >> 6), cc = (float)(t & 63);
            const int sec = c4 >> 8; const float pos = sec < 2 ? rr : cc;
#pragma unroll
            for (int j = 0; j < 4; ++j) {
                const int f = (c4 + j) & 255;
                const float omega = exp2f((float)f * (-13.287712379549449f / 256.0f));
                const float a = pos * omega;
                v[j] += (sec & 1) ? __cosf(a) : __sinf(a);
            }
        }
        *(f32x4*)(x + i * 4) = v;
    }
    if (blockIdx.x == 0) {
        float* lbs = (float*)(p.ws + WS_LBS);
        for (int i = tid; i < 1024; i += 512) {
            const int dir = i >> 9, ch = i & 511; float lg[4], mx = -1e30f;
            for (int l = 0; l < 4; ++l) { lg[l] = p.hg_lb_logits[(size_t)(dir * 4 + l) * 512 + ch]; mx = fmaxf(mx, lg[l]); }
            float s = 0.f; for (int l = 0; l < 4; ++l) { lg[l] = expf(lg[l] - mx); s += lg[l]; }
            float cum = 0.f, c0 = 0.f;
            for (int l = 0; l < 4; ++l) { cum += lg[l] / s; if (l == 0) c0 = cum; lbs[(size_t)(dir * 4 + l) * 512 + ch] = cum - c0; }
        }
        for (int i = tid; i < 1024; i += 512) ((unsigned*)(p.ws + WS_CTR))[i] = 0u;
    }
    LAS float* sc = (LAS float*)lds;
    LAS float* red = sc + 9 * 1024;
    for (int i = tid; i < 9 * 1024; i += 512) { const int r = i >> 10, k = i & 1023; const float v = r == 0 ? p.c_ctx[k] : p.c[(size_t)(r - 1) * D + k]; sc[i] = siluf_(v); }
    __syncthreads();
    float* mod = (float*)(p.ws + WS_MOD);
    for (int u = blockIdx.x; u < DEPTH * 48; u += gridDim.x) {
        const int l = u / 48, cb = u % 48, cl = tid & 127, kp = tid >> 7, n = cb * 128 + cl;
        const float* w = p.ada_w + (size_t)l * D * 6144 + n;
        float a[9];
#pragma unroll
        for (int r = 0; r < 9; ++r) a[r] = 0.f;
#pragma unroll 4
        for (int k = kp * 256; k < kp * 256 + 256; ++k) {
            const float wv = w[(size_t)k * 6144];
#pragma unroll
            for (int r = 0; r < 9; ++r) a[r] += sc[r * 1024 + k] * wv;
        }
#pragma unroll
        for (int r = 0; r < 9; ++r) red[(kp * 9 + r) * 128 + cl] = a[r];
        __syncthreads();
        for (int i = tid; i < 9 * 128; i += 512) {
            const int r = i >> 7, c2 = i & 127;
            const float s = red[(0 * 9 + r) * 128 + c2] + red[(1 * 9 + r) * 128 + c2] + red[(2 * 9 + r) * 128 + c2] + red[(3 * 9 + r) * 128 + c2];
            mod[((size_t)l * 9 + r) * 6144 + cb * 128 + c2] = s + p.ada_b[(size_t)l * 6144 + cb * 128 + c2];
        }
        __syncthreads();
    }
}

__device__ __forceinline__ void norm_phase(const Params& p, const float* g, const float* mod_l, int off_sh, int off_sc, bf16_t* hout, int mode) {
    const int lane = otid() & 63, wid = otid() >> 6;
    float* x = p.out;
    for (int row = blockIdx.x * 8 + wid; row < NTOK; row += gridDim.x * 8) {
        f32x4 v[4]; float s = 0.f;
        float* xr = x + (size_t)row * D;
#pragma unroll
        for (int j = 0; j < 4; ++j) { v[j] = *(const f32x4*)(xr + lane * 4 + 256 * j); s += v[j].x * v[j].x + v[j].y * v[j].y + v[j].z * v[j].z + v[j].w * v[j].w; }
        f32x4 ggv[4], shv[4], scvv[4];
        if (mode == 0) {
            const float* mr = mod_l + (size_t)mod_row(row) * 6144;
#pragma unroll
            for (int j = 0; j < 4; ++j) { const int c = lane * 4 + 256 * j; ggv[j] = *(const f32x4*)(g + c); shv[j] = *(const f32x4*)(mr + off_sh + c); scvv[j] = *(const f32x4*)(mr + off_sc + c); }
        }
        const float rstd = rsqrtf(wave_sum(s) * (1.0f / D) + EPS);
        if (mode == 0) {
#pragma unroll
            for (int j = 0; j < 4; ++j) {
                const int c = lane * 4 + 256 * j;
                const f32x4 gg = ggv[j], sh = shv[j], scv = scvv[j];
                const f32x4 o = (v[j] * rstd) * gg * (scv + 1.0f) + sh;
                u32x2 w; w.x = pk2(o.x, o.y); w.y = pk2(o.z, o.w);
                *(u32x2*)(hout + (size_t)row * D + c) = w;
            }
        } else {
#pragma unroll
            for (int j = 0; j < 4; ++j) { const int c = lane * 4 + 256 * j; const f32x4 gg = *(const f32x4*)(g + c); *(f32x4*)(xr + c) = (v[j] * rstd) * gg; }
        }
    }
}

template <int MIX>
__device__ __forceinline__ void gate_eval(const bf16_t* row, int kcol, int zcol, const float (&lrw)[16], float lrb, float lb, float& gt, float& kt) {
    if (!MIX) {
        const bf16_t* zr = row + zcol;
        const u32x4 z0 = *(const u32x4*)zr, z1 = *(const u32x4*)(zr + 8);
        float z = lrb;
        z += bflo(z0.x) * lrw[0] + bfhi(z0.x) * lrw[1] + bflo(z0.y) * lrw[2] + bfhi(z0.y) * lrw[3] + bflo(z0.z) * lrw[4] + bfhi(z0.z) * lrw[5] + bflo(z0.w) * lrw[6] + bfhi(z0.w) * lrw[7];
        z += bflo(z1.x) * lrw[8] + bfhi(z1.x) * lrw[9] + bflo(z1.y) * lrw[10] + bfhi(z1.y) * lrw[11] + bflo(z1.z) * lrw[12] + bfhi(z1.z) * lrw[13] + bflo(z1.w) * lrw[14] + bfhi(z1.w) * lrw[15];
        gt = logsigmoidf_(z) * (1.0f / 16.0f);
        kt = bf2f(row[kcol]);
    } else {
        const float xf = bf2f(row[kcol]);
        const float sg = sigmoidf_(xf);
        gt = flog_(lb + (1.0f - lb) * sg);
        kt = (1.0f - lb) * (1.0f - sg);
    }
}

template <int MIX>
__device__ __forceinline__ void gate_raw(unsigned kraw, const u32x4& z0, const u32x4& z1, const float (&lrw)[16], float lrb, float lb, float& gt, float& kt) {
    if (!MIX) {
        float z = lrb;
        z += bflo(z0.x) * lrw[0] + bfhi(z0.x) * lrw[1] + bflo(z0.y) * lrw[2] + bfhi(z0.y) * lrw[3] + bflo(z0.z) * lrw[4] + bfhi(z0.z) * lrw[5] + bflo(z0.w) * lrw[6] + bfhi(z0.w) * lrw[7];
        z += bflo(z1.x) * lrw[8] + bfhi(z1.x) * lrw[9] + bflo(z1.y) * lrw[10] + bfhi(z1.y) * lrw[11] + bflo(z1.z) * lrw[12] + bfhi(z1.z) * lrw[13] + bflo(z1.w) * lrw[14] + bfhi(z1.w) * lrw[15];
        gt = logsigmoidf_(z) * (1.0f / 16.0f);
        kt = bflo(kraw);
    } else {
        const float xf = bflo(kraw);
        const float sg = sigmoidf_(xf);
        gt = flog_(lb + (1.0f - lb) * sg);
        kt = (1.0f - lb) * (1.0f - sg);
    }
}

template <int MIX>
__device__ __forceinline__ void scan_job(const Params& p, int l, int s, int dir, int hd, LAS unsigned char* lds) {
    constexpr int DK = MIX ? 128 : 64, WM = DK / 32, WN = 8 / WM, WTN = 128 / WN, NTL = WTN / 32, LDT = 72, LDG = DK + 1;
    LAS bf16_t* At = (LAS bf16_t*)lds;
    LAS bf16_t* Bt = At + 128 * LDT;
    LAS float* dec = (LAS float*)(lds + 2 * 128 * LDT * 2);
    LAS float* G = dec + 128;
    LAS float* KK = G + 64 * 129;
    const int tid = otid(), lane = tid & 63, wid = tid >> 6, wm = wid / WN, wn = wid % WN;
    const bool ctx = s < 16;
    const int T = ctx ? 256 : 2048, tok0 = ctx ? s * 256 : NCTX + (s - 16) * 2048, nch = T / 64;
    const bf16_t* proj = (const bf16_t*)(p.ws + WS_PROJ);
    const float* lbs = (const float*)(p.ws + WS_LBS);
    bf16_t* sbuf = (bf16_t*)(p.ws + WS_ST + (MIX ? ST_GLA_BYTES : 0));
    f32x16 S[1][NTL];
    {
        const float* st0 = ctx ? nullptr : (MIX ? p.state_hgrn + ((((size_t)(s - 16) * DEPTH + l) * 2 + dir) * 4 + hd) * 128 * 128
                                                : p.state_gla + ((((size_t)(s - 16) * DEPTH + l) * 2 + dir) * 4 + hd) * 64 * 128);
#pragma unroll
        for (int n = 0; n < NTL; ++n)
#pragma unroll
            for (int i = 0; i < 16; ++i) {
                const int d = wm * 32 + (i & 3) + 8 * (i >> 2) + 4 * (lane >> 5), v = wn * WTN + n * 32 + (lane & 31);
                S[0][n][i] = ctx ? 0.f : st0[(size_t)d * 128 + v];
            }
    }
    const int sd = tid & (DK - 1), t0 = tid / DK; constexpr int TS = 512 / DK;
    float lrw[16]; float lrb = 0.f, lb = 0.f;
    if (!MIX) {
#pragma unroll
        for (int r = 0; r < 16; ++r) lrw[r] = p.gla_lr_w[(((size_t)l * 2 + dir) * 16 + r) * 256 + hd * 64 + sd];
        lrb = p.gla_lr_b[((size_t)l * 2 + dir) * 256 + hd * 64 + sd];
    } else {
#pragma unroll
        for (int r = 0; r < 16; ++r) lrw[r] = 0.f;
        lb = lbs[(size_t)(dir * 4 + l) * 512 + hd * 128 + sd];
    }
    const int kcol = MIX ? (dir ? PJ_HFB : PJ_HFF) + hd * 128 + sd : PJ_GK + hd * 64 + sd;
    const int zcol = dir ? PJ_GZB : PJ_GZF;
    const int vv = tid & 127, vq = tid >> 7;
    const int vcol = (MIX ? PJ_HI : PJ_GV) + hd * 128 + vv;
    const int kd = tid >> 2, kq = tid & 3;
    const bool k2 = tid < 4 * DK;

    constexpr int NE = 64 / TS;
    unsigned kraw[NE]; unsigned vraw[8];
    const int widu = __builtin_amdgcn_readfirstlane(tid >> 6), gmt = (widu >> 1) & 1, gnt = widu & 1;
    bf16x8 gafr = {0, 0, 0, 0, 0, 0, 0, 0}; u32x4 gbw = {0u, 0u, 0u, 0u}; float gbias = 0.f;
    if (!MIX && widu < 4) {
        const float* lw = p.gla_lr_w + (((size_t)l * 2 + dir) * 16 + 8 * (lane >> 5)) * 256 + hd * 64 + gnt * 32 + (lane & 31);
        float wv[8];
#pragma unroll
        for (int j = 0; j < 8; ++j) wv[j] = lw[(size_t)j * 256];
        gbw.x = pk2(wv[0], wv[1]); gbw.y = pk2(wv[2], wv[3]); gbw.z = pk2(wv[4], wv[5]); gbw.w = pk2(wv[6], wv[7]);
        gbias = p.gla_lr_b[((size_t)l * 2 + dir) * 256 + hd * 64 + gnt * 32 + (lane & 31)];
    }
    auto load_chunk = [&](const bf16_t* prc) {
#pragma unroll
        for (int i = 0; i < NE; ++i) {
            const bf16_t* row = prc + (size_t)(t0 + TS * i) * NPROJ;
            kraw[i] = row[kcol];
        }
        if (!MIX && widu < 4) gafr = *(const bf16x8*)(prc + (size_t)(gmt * 32 + (lane & 31)) * NPROJ + zcol + 8 * (lane >> 5));
#pragma unroll
        for (int t = 0; t < 16; t += 2) {
            const unsigned a = prc[(size_t)(vq * 16 + t) * NPROJ + vcol], b = prc[(size_t)(vq * 16 + t + 1) * NPROJ + vcol];
            vraw[t >> 1] = a | (b << 16);
        }
    };
    auto store_state = [&](int gcs) {
        bf16_t* sb = sbuf + (((size_t)gcs * 2 + dir) * 4 + hd) * 128 * DK;
#pragma unroll
        for (int nn = 0; nn < NTL; ++nn)
#pragma unroll
            for (int q = 0; q < 4; ++q) {
                const int d0 = wm * 32 + 8 * q + 4 * (lane >> 5), v = wn * WTN + nn * 32 + (lane & 31);
                u32x2 w; w.x = pk2(S[0][nn][4 * q + 0], S[0][nn][4 * q + 1]); w.y = pk2(S[0][nn][4 * q + 2], S[0][nn][4 * q + 3]);
                *(u32x2*)(sb + (size_t)v * DK + d0) = w;
            }
    };
    load_chunk(proj + (size_t)(tok0 + (dir ? nch - 1 : 0) * 64) * NPROJ);
    store_state((tok0 >> 6) + (dir ? nch - 1 : 0));
    for (int n = 0; n < nch; ++n) {
        if (MIX) {
#pragma unroll
            for (int i = 0; i < NE; ++i) {
                const int t = t0 + TS * i; float gt, kt; const u32x4 zz = {0u, 0u, 0u, 0u};
                gate_raw<MIX>(kraw[i], zz, zz, lrw, lrb, lb, gt, kt);
                G[t * LDG + sd] = gt; KK[t * LDG + sd] = kt;
            }
        } else {
#pragma unroll
            for (int i = 0; i < NE; ++i) KK[(t0 + TS * i) * LDG + sd] = bflo(kraw[i]);
            if (widu < 4) {
                f32x16 zacc;
#pragma unroll
                for (int i = 0; i < 16; ++i) zacc[i] = 0.f;
                zacc = __builtin_amdgcn_mfma_f32_32x32x16_bf16(gafr, __builtin_bit_cast(bf16x8, gbw), zacc, 0, 0, 0);
#pragma unroll
                for (int i = 0; i < 16; ++i)
                    G[(gmt * 32 + (i & 3) + 8 * (i >> 2) + 4 * (lane >> 5)) * LDG + gnt * 32 + (lane & 31)] = logsigmoidf_(zacc[i] + gbias) * (1.0f / 16.0f);
            }
        }
#pragma unroll
        for (int q = 0; q < 2; ++q) { u32x4 w; w.x = vraw[4 * q]; w.y = vraw[4 * q + 1]; w.z = vraw[4 * q + 2]; w.w = vraw[4 * q + 3]; *(LAS u32x4*)(Bt + vv * LDT + vq * 16 + q * 8) = w; }
        if (n + 1 < nch) load_chunk(proj + (size_t)(tok0 + (dir ? nch - 2 - n : n + 1) * 64) * NPROJ);
        __syncthreads();
        if (k2) {
            float g[16]; float qs = 0.f;
#pragma unroll
            for (int t = 0; t < 16; ++t) { g[t] = G[(kq * 16 + t) * LDG + kd]; qs += g[t]; }
            const int lb4 = lane & ~3;
            const float s0 = __shfl(qs, lb4), s1 = __shfl(qs, lb4 + 1), s2 = __shfl(qs, lb4 + 2), s3 = __shfl(qs, lb4 + 3);
            const float total = (s0 + s1) + (s2 + s3);
            float pref = (kq > 0 ? s0 : 0.f) + (kq > 1 ? s1 : 0.f) + (kq > 2 ? s2 : 0.f);
            unsigned pkv[8];
#pragma unroll
            for (int t = 0; t < 16; ++t) {
                const float pe = pref; pref += g[t];
                const float w = dir ? pe : total - pref;
                const float kv = KK[(kq * 16 + t) * LDG + kd] * fexp_(w);
                if (t & 1) pkv[t >> 1] = pk2(__uint_as_float(pkv[t >> 1]), kv); else pkv[t >> 1] = __float_as_uint(kv);
            }
#pragma unroll
            for (int q = 0; q < 2; ++q) { u32x4 w; w.x = pkv[4 * q]; w.y = pkv[4 * q + 1]; w.z = pkv[4 * q + 2]; w.w = pkv[4 * q + 3]; *(LAS u32x4*)(At + kd * LDT + kq * 16 + q * 8) = w; }
            if (kq == 0) dec[kd] = fexp_(total);
        }
        __syncthreads();
#pragma unroll
        for (int nn = 0; nn < NTL; ++nn)
#pragma unroll
            for (int i = 0; i < 16; ++i) S[0][nn][i] *= dec[wm * 32 + (i & 3) + 8 * (i >> 2) + 4 * (lane >> 5)];
        mma_lds<1, NTL, 4>(S, At + wm * 32 * LDT, LDT, Bt + wn * WTN * LDT, LDT, lane);
        if (n + 1 < nch) store_state((tok0 >> 6) + (dir ? nch - 2 - n : n + 1));
        __syncthreads();
    }
    if (ctx) {
        float* o = MIX ? p.out + (size_t)NTOK * D + (size_t)16 * DEPTH * 2 * 4 * 64 * 128 + ((((size_t)s * DEPTH + l) * 2 + dir) * 4 + hd) * 128 * 128
                       : p.out + (size_t)NTOK * D + ((((size_t)s * DEPTH + l) * 2 + dir) * 4 + hd) * 64 * 128;
#pragma unroll
        for (int nn = 0; nn < NTL; ++nn)
#pragma unroll
            for (int i = 0; i < 16; ++i) {
                const int d = wm * 32 + (i & 3) + 8 * (i >> 2) + 4 * (lane >> 5), v = wn * WTN + nn * 32 + (lane & 31);
                o[(size_t)d * 128 + v] = S[0][nn][i];
            }
    }
}


__device__ __forceinline__ void gmlp_item(const Params& p, int l, int c2, int g, LAS unsigned char* lds) {
    constexpr int LDT = 136;
    LAS bf16_t* Aw = (LAS bf16_t*)lds;
    LAS bf16_t* Bt = Aw + 128 * LDT;
    const int tid = otid(), lane = tid & 63, wid = tid >> 6, wm = wid >> 2, wn = wid & 3;
    const bf16_t* proj = (const bf16_t*)(p.ws + WS_PROJ);
    const int tokb = c2 * 128;
    {
        const float* wsrc = p.gm_ws + ((size_t)l * 4 + g) * 128 * 128;
#pragma unroll
        for (int i = 0; i < 8; ++i) {
            const int e = (i * 512 + tid) * 4, pp = e >> 7, q = e & 127;
            const f32x4 v = *(const f32x4*)(wsrc + e);
            u32x2 w; w.x = pk2(v.x, v.y); w.y = pk2(v.z, v.w);
            *(LAS u32x2*)(Aw + pp * LDT + q) = w;
        }
    }
    {
        const int q = tid >> 2, part = tid & 3;
        const bf16_t* mv = proj + (size_t)(tokb + q) * NPROJ + PJ_MV;
        float ggv[32];
        {
            const float* ggp = p.gm_norm_g + (size_t)l * 512 + g * 128 + part * 32;
#pragma unroll
            for (int i = 0; i < 8; ++i) { const f32x4 t4 = *(const f32x4*)(ggp + 4 * i); ggv[4 * i] = t4.x; ggv[4 * i + 1] = t4.y; ggv[4 * i + 2] = t4.z; ggv[4 * i + 3] = t4.w; }
        }
        float s = 0.f, s2 = 0.f;
#pragma unroll
        for (int i = 0; i < 16; ++i) {
            const u32x4 u = *(const u32x4*)(mv + (i * 4 + part) * 8);
            const unsigned uu[4] = {u.x, u.y, u.z, u.w};
#pragma unroll
            for (int j = 0; j < 4; ++j) { const float a = geluf_(bflo(uu[j])), b = geluf_(bfhi(uu[j])); s += a + b; s2 += a * a + b * b; }
        }
        s += __shfl_xor(s, 1); s += __shfl_xor(s, 2); s2 += __shfl_xor(s2, 1); s2 += __shfl_xor(s2, 2);
        const float mean = s * (1.0f / 512.0f), var = fmaxf(s2 * (1.0f / 512.0f) - mean * mean, 0.f), rstd = rsqrtf(var + EPS);
        const bf16_t* mvg = mv + g * 128 + part * 32;
#pragma unroll
        for (int i = 0; i < 4; ++i) {
            const u32x4 u = *(const u32x4*)(mvg + i * 8);
            const unsigned uu[4] = {u.x, u.y, u.z, u.w};
#pragma unroll
            for (int j = 0; j < 4; ++j) {
                const int c = part * 32 + i * 8 + j * 2;
                const float a = (geluf_(bflo(uu[j])) - mean) * rstd * ggv[i * 8 + j * 2], b = (geluf_(bfhi(uu[j])) - mean) * rstd * ggv[i * 8 + j * 2 + 1];
                Bt[c * LDT + q] = f2bf(a); Bt[(c + 1) * LDT + q] = f2bf(b);
            }
        }
    }
    const float* bs = p.gm_bs + ((size_t)l * 4 + g) * 128;
    bf16_t muv[2][16]; float bsv[2][16];
#pragma unroll
    for (int m = 0; m < 2; ++m)
#pragma unroll
        for (int i = 0; i < 16; ++i) {
            const int pp = wm * 64 + m * 32 + (i & 3) + 8 * (i >> 2) + 4 * (lane >> 5), c = wn * 32 + (lane & 31);
            muv[m][i] = proj[(size_t)(tokb + pp) * NPROJ + PJ_MU + g * 128 + c]; bsv[m][i] = bs[pp];
        }
    __syncthreads();
    f32x16 acc[2][1]; acc_zero<1>(acc);
    mma_lds<2, 1, 8>(acc, Aw + wm * 64 * LDT, LDT, Bt + wn * 32 * LDT, LDT, lane);
    bf16_t* ocat = (bf16_t*)(p.ws + WS_OCAT);
#pragma unroll
    for (int m = 0; m < 2; ++m)
#pragma unroll
        for (int i = 0; i < 16; ++i) {
            const int pp = wm * 64 + m * 32 + (i & 3) + 8 * (i >> 2) + 4 * (lane >> 5), c = wn * 32 + (lane & 31);
            ocat[(size_t)2 * NTOK * 512 + (size_t)(tokb + pp) * 512 + g * 128 + c] = f2bf(geluf_(bf2f(muv[m][i])) * (acc[m][0][i] + bsv[m][i]));
        }
    __syncthreads();
}

__device__ __forceinline__ void phase_scan(const Params& p, int l, LAS unsigned char* lds) {
    LAS int* slot = (LAS int*)(lds + LDS_BYTES - 16);
    unsigned* ctr = (unsigned*)(p.ws + WS_CTR) + l;
    constexpr int NLAT = 8 * 2 * 4 * 2, NCX = 16 * 2 * 4 * 2, NGM = 160 * 4;
    for (;;) {
        if (otid() == 0) *slot = (int)atomicAdd(ctr, 1u);
        __syncthreads();
        const int j = *slot;
        __syncthreads();
        const int nconv = l + 1 < DEPTH ? CONV_BLOCK_ITEMS - CONV_IN_GEMM : 0;
        if (j >= NLAT + NCX + NGM + nconv) break;
        if (j >= NLAT + NCX + NGM) { convert_weights(p, l + 1, lds, CONV_IN_GEMM + j - (NLAT + NCX + NGM)); __syncthreads(); continue; }
        if (j < NLAT + NCX) {
            int r = j, s;
            if (r < NLAT) { s = 16 + (r >> 4); r &= 15; } else { r -= NLAT; s = r >> 4; r &= 15; }
            const int mix = r & 1, dir = (r >> 1) & 1, hd = r >> 2;
            if (mix) scan_job<1>(p, l, s, dir, hd, lds); else scan_job<0>(p, l, s, dir, hd, lds);
        } else { const int r = j - NLAT - NCX; gmlp_item(p, l, r >> 2, r & 3, lds); }
    }
}

template <int MIX>
__device__ __forceinline__ void out_item(const Params& p, int l, int gc, int hd, LAS unsigned char* lds) {
    constexpr int DK = MIX ? 128 : 64, LQ = DK + 8, LDV = 72, LDG = DK + 1;
    LAS bf16_t* QA = (LAS bf16_t*)lds;
    LAS bf16_t* KA = QA + 128 * LQ;
    LAS bf16_t* QS = KA + 128 * LQ;
    LAS bf16_t* VT = QS + 64 * LQ;
    LAS bf16_t* P = VT + 128 * LDV;
    LAS float* C = (LAS float*)(P + 64 * LDV);
    LAS float* BS = C + (MIX ? 64 : 128) * LDG;
    LAS bf16_t* ST = KA;
    LAS float* Of = (LAS float*)lds;
    const int tid = otid(), lane = tid & 63, wid = __builtin_amdgcn_readfirstlane(tid >> 6);
    const int tokb = gc * 64;
    const bf16_t* proj = (const bf16_t*)(p.ws + WS_PROJ);
    const bf16_t* pr = proj + (size_t)tokb * NPROJ;
    const float* lbs = (const float*)(p.ws + WS_LBS);
    const bf16_t* sbuf = (const bf16_t*)(p.ws + WS_ST + (MIX ? ST_GLA_BYTES : 0));
    constexpr int NPQ = 64 * (DK / 8), NRQ = NPQ / 512;
    u32x4 rq[NRQ], rk[NRQ];
    auto load_raw = [&](int dr) {
        const int kcol0 = MIX ? (dr ? PJ_HFB : PJ_HFF) + hd * 128 : PJ_GK + hd * 64;
        const int qcol0 = MIX ? PJ_HQ + hd * 128 : PJ_GQ + hd * 64;
#pragma unroll
        for (int k = 0; k < NRQ; ++k) { const int e = tid + 512 * k; const int t = e / (DK / 8), c8 = (e % (DK / 8)) * 8;
            rq[k] = *(const u32x4*)(pr + (size_t)t * NPROJ + qcol0 + c8); rk[k] = *(const u32x4*)(pr + (size_t)t * NPROJ + kcol0 + c8); }
    };
    load_raw(0);
    const int kdp = tid & (DK - 1);
    float gnv[16];
    {
        const float* gn = (MIX ? p.hg_norm_g : p.gla_norm_g) + (size_t)l * 512 + hd * 128 + (tid & 7) * 16;
#pragma unroll
        for (int j = 0; j < 16; j += 4) { const f32x4 t4 = *(const f32x4*)(gn + j); gnv[j] = t4.x; gnv[j + 1] = t4.y; gnv[j + 2] = t4.z; gnv[j + 3] = t4.w; }
    }
    const float lbd0 = MIX ? lbs[(size_t)(0 * 4 + l) * 512 + hd * 128 + kdp] : 0.f, lbd1 = MIX ? lbs[(size_t)(1 * 4 + l) * 512 + hd * 128 + kdp] : 0.f;
    typedef float f32x2p_t __attribute__((ext_vector_type(2)));
    const f32x2p_t zz2 = {0.f, 0.f};
    const f32x2p_t lbp0 = MIX ? *(const f32x2p_t*)(lbs + (size_t)(0 * 4 + l) * 512 + hd * 128 + 2 * (tid & 63)) : zz2, lbp1 = MIX ? *(const f32x2p_t*)(lbs + (size_t)(1 * 4 + l) * 512 + hd * 128 + 2 * (tid & 63)) : zz2;
    if (!MIX) {
        const int gd = wid >> 2, mt = (wid >> 1) & 1, nt = wid & 1, r = lane & 31, h = lane >> 5;
        const bf16x8 afr = *(const bf16x8*)(pr + (size_t)(mt * 32 + r) * NPROJ + (gd ? PJ_GZB : PJ_GZF) + 8 * h);
        const float* lw = p.gla_lr_w + (((size_t)l * 2 + gd) * 16 + 8 * h) * 256 + hd * 64 + nt * 32 + r;
        float wv[8];
#pragma unroll
        for (int j = 0; j < 8; ++j) wv[j] = lw[(size_t)j * 256];
        const float bias = p.gla_lr_b[((size_t)l * 2 + gd) * 256 + hd * 64 + nt * 32 + r];
        u32x4 bw; bw.x = pk2(wv[0], wv[1]); bw.y = pk2(wv[2], wv[3]); bw.z = pk2(wv[4], wv[5]); bw.w = pk2(wv[6], wv[7]);
        f32x16 zacc;
#pragma unroll
        for (int i = 0; i < 16; ++i) zacc[i] = 0.f;
        zacc = __builtin_amdgcn_mfma_f32_32x32x16_bf16(afr, __builtin_bit_cast(bf16x8, bw), zacc, 0, 0, 0);
#pragma unroll
        for (int i = 0; i < 16; ++i) {
            const int t = mt * 32 + (i & 3) + 8 * (i >> 2) + 4 * h;
            C[(gd * 64 + (gd ? 63 - t : t)) * LDG + nt * 32 + r] = logsigmoidf_(zacc[i] + bias) * (1.0f / 16.0f);
        }
    }
    const bf16_t* gatep = pr + (size_t)(tid >> 3) * NPROJ + (MIX ? PJ_HO : PJ_GO) + hd * 128 + (tid & 7) * 16;
    const u32x4 g0 = *(const u32x4*)gatep, g1 = *(const u32x4*)(gatep + 8);
    {
        const int vv = tid & 127, qt = tid >> 7;
        const int vcol = (MIX ? PJ_HI : PJ_GV) + hd * 128 + vv;
        unsigned pkv[8];
#pragma unroll
        for (int t = 0; t < 16; t += 2) {
            const unsigned a = pr[(size_t)(qt * 16 + t) * NPROJ + vcol], b = pr[(size_t)(qt * 16 + t + 1) * NPROJ + vcol];
            pkv[t >> 1] = a | (b << 16);
        }
#pragma unroll
        for (int q = 0; q < 2; ++q) { u32x4 w; w.x = pkv[4 * q]; w.y = pkv[4 * q + 1]; w.z = pkv[4 * q + 2]; w.w = pkv[4 * q + 3]; *(LAS u32x4*)(VT + vv * LDV + qt * 16 + q * 8) = w; }
    }
    const int wm = wid >> 2, wn = wid & 3;
    f32x16 o[1][1];
#pragma unroll
    for (int i = 0; i < 16; ++i) o[0][0][i] = 0.f;

#pragma unroll 1
    for (int dir = 0; dir < 2; ++dir) {
        const int kd = tid & (DK - 1), ba = tid / DK;
#pragma unroll
        for (int k = 0; k < NRQ; ++k) { const int e = tid + 512 * k; const int t = e / (DK / 8), c8 = (e % (DK / 8)) * 8;
            *(LAS u32x4*)(QS + t * LQ + c8) = rq[k]; *(LAS u32x4*)(KA + (64 + (dir ? 63 - t : t)) * LQ + c8) = rk[k]; }
        __syncthreads();
        if (MIX) {
            const int cp = tid & 63, bh = tid >> 6, bah = bh >> 1, u0 = (bh & 1) * 8;
            const float lbA = dir ? lbp1.x : lbp0.x, lbB = dir ? lbp1.y : lbp0.y;
            float gA[8], gB[8], kA[8], kB[8]; float thA = 0.f, thB = 0.f;
            {
                const LAS bf16_t* kzr = KA + (64 + bah * 16 + u0) * LQ + 2 * cp;
#pragma unroll
                for (int u = 0; u < 8; ++u) {
                    const unsigned raw = *(const LAS unsigned*)(kzr + u * LQ);
                    const float sa = sigmoidf_(bflo(raw)), sb = sigmoidf_(bfhi(raw));
                    gA[u] = flog_(lbA + (1.0f - lbA) * sa); kA[u] = (1.0f - lbA) * (1.0f - sa); thA += gA[u];
                    gB[u] = flog_(lbB + (1.0f - lbB) * sb); kB[u] = (1.0f - lbB) * (1.0f - sb); thB += gB[u];
                }
                typedef float f32x2_t __attribute__((ext_vector_type(2)));
                f32x2_t th; th.x = thA; th.y = thB;
                *(LAS f32x2_t*)(BS + bh * DK + 2 * cp) = th;
            }
            __syncthreads();
            {
                typedef float f32x2_t __attribute__((ext_vector_type(2)));
                f32x2_t hh[8];
#pragma unroll
                for (int j = 0; j < 8; ++j) hh[j] = *(const LAS f32x2_t*)(BS + j * DK + 2 * cp);
                const f32x2_t T0 = hh[0] + hh[1], T1 = hh[2] + hh[3], T2 = hh[4] + hh[5], T3 = hh[6] + hh[7];
                const f32x2_t Tb = bah == 0 ? T0 : bah == 1 ? T1 : bah == 2 ? T2 : T3;
                const f32x2_t l7 = bah == 0 ? hh[0] : bah == 1 ? hh[2] : bah == 2 ? hh[4] : hh[6];
                const f32x2_t zero2 = {0.f, 0.f};
                const f32x2_t base = bah == 0 ? zero2 : bah == 1 ? T0 : bah == 2 ? T0 + T1 : T0 + T1 + T2;
                const f32x2_t c31 = T0 + T1;
                float lpA = u0 ? l7.x : 0.f, lpB = u0 ? l7.y : 0.f;
                const float qscale = 0.08838834764831845f;
                LAS bf16_t* qz = QA + (64 + bah * 16 + u0) * LQ + 2 * cp;
                LAS bf16_t* kz = KA + (64 + bah * 16 + u0) * LQ + 2 * cp;
                LAS bf16_t* xrow = (bah < 2 ? KA + (bah * 16 + u0) * LQ : QA + (bah * 16 + u0 - 32) * LQ) + 2 * cp;
                LAS bf16_t* yrow = ((bah & 1) ? QA + (32 + (bah >> 1) * 16 + u0) * LQ : KA + (32 + (bah >> 1) * 16 + u0) * LQ) + 2 * cp;
                const bool xk = bah < 2, yq = (bah & 1) != 0;
#pragma unroll
                for (int u = 0; u < 8; ++u) {
                    const int pp = bah * 16 + u0 + u, t = dir ? 63 - pp : pp;
                    lpA += gA[u]; lpB += gB[u];
                    const float cA = base.x + lpA, cB = base.y + lpB;
                    const unsigned qraw = *(const LAS unsigned*)(QS + t * LQ + 2 * cp);
                    const float qa = bflo(qraw) * qscale, qb = bfhi(qraw) * qscale;
                    *(LAS unsigned*)(QS + t * LQ + 2 * cp) = pk2(qa * fexp_(cA), qb * fexp_(cB));
                    *(LAS unsigned*)(qz + u * LQ) = pk2(qa * fexp_(lpA - l7.x), qb * fexp_(lpB - l7.y));
                    *(LAS unsigned*)(kz + u * LQ) = pk2(kA[u] * fexp_(l7.x - lpA), kB[u] * fexp_(l7.y - lpB));
                    *(LAS unsigned*)(xrow + u * LQ) = pk2((xk ? kA[u] : qa) * fexp_(xk ? c31.x - cA : cA - c31.x), (xk ? kB[u] : qb) * fexp_(xk ? c31.y - cB : cB - c31.y));
                    *(LAS unsigned*)(yrow + u * LQ) = pk2((yq ? qa : kA[u]) * fexp_(yq ? lpA : Tb.x - lpA), (yq ? qb : kB[u]) * fexp_(yq ? lpB : Tb.y - lpB));
                }
            }
            __syncthreads();
        } else {
        float gk[16], kk[16]; float lp7 = 0.f, Ta = 0.f;
        if (MIX) {
            const float lb = dir ? lbd1 : lbd0;
            const LAS bf16_t* kz0 = KA + (64 + ba * 16) * LQ + kd;
#pragma unroll
            for (int u = 0; u < 16; ++u) {
                const float sg = sigmoidf_(bf2f(kz0[u * LQ]));
                gk[u] = flog_(lb + (1.0f - lb) * sg); kk[u] = (1.0f - lb) * (1.0f - sg);
                Ta += gk[u]; if (u == 7) lp7 = Ta;
            }
            BS[ba * DK + kd] = Ta;
        } else {
            if (ba < 4) {
#pragma unroll
                for (int u = 0; u < 16; ++u) { gk[u] = C[(dir * 64 + ba * 16 + u) * LDG + kd]; Ta += gk[u]; if (u == 7) lp7 = Ta; }
                BS[ba * DK + kd] = Ta;
            }
        }
        __syncthreads();
        if (ba < 4) {
            const float T0 = BS[kd], T1 = BS[DK + kd], T2 = BS[2 * DK + kd];
            const float base = ba == 0 ? 0.f : ba == 1 ? T0 : ba == 2 ? T0 + T1 : T0 + T1 + T2;
            const float c31 = T0 + T1;
            const float qscale = MIX ? 0.08838834764831845f : 0.125f;
            LAS bf16_t* qz = QA + (64 + ba * 16) * LQ + kd;
            LAS bf16_t* kz = KA + (64 + ba * 16) * LQ + kd;
            LAS bf16_t* xrow = (ba < 2 ? KA + (ba * 16) * LQ : QA + (ba * 16 - 32) * LQ) + kd;
            LAS bf16_t* yrow = ((ba & 1) ? QA + (32 + (ba >> 1) * 16) * LQ : KA + (32 + (ba >> 1) * 16) * LQ) + kd;
            float lp = 0.f;
#pragma unroll
            for (int u = 0; u < 16; ++u) {
                const int pp = ba * 16 + u, t = dir ? 63 - pp : pp;
                lp += gk[u];
                const float c = base + lp;
                const float qv = bf2f(QS[t * LQ + kd]) * qscale;
                const float kt = MIX ? kk[u] : bf2f(kz[u * LQ]);
                QS[t * LQ + kd] = f2bf(qv * fexp_(c));
                qz[u * LQ] = f2bf(qv * fexp_(lp - lp7));
                kz[u * LQ] = f2bf(kt * fexp_(lp7 - lp));
                xrow[u * LQ] = f2bf(ba < 2 ? kt * fexp_(c31 - c) : qv * fexp_(c - c31));
                yrow[u * LQ] = f2bf((ba & 1) ? qv * fexp_(lp) : kt * fexp_(Ta - lp));
            }
        }
        __syncthreads();
        }
        if (dir == 0) load_raw(1);
        constexpr int PIECES = 128 * DK / 8, NPC = PIECES / 512;
        u32x4 stv[NPC];
        {
            const bf16_t* sb = sbuf + (((size_t)gc * 2 + dir) * 4 + hd) * 128 * DK;
#pragma unroll
            for (int k = 0; k < NPC; ++k) { const int e = tid + 512 * k; const int v = e / (DK / 8), d0 = (e % (DK / 8)) * 8; stv[k] = *(const u32x4*)(sb + (size_t)v * DK + d0); }
        }
        if (wid < 4) {
            f32x16 sc[1][1];
#pragma unroll
            for (int i = 0; i < 16; ++i) sc[0][0][i] = 0.f;
            mma_lds<1, 1, DK / 16>(sc, KA + wid * 32 * LQ, LQ, QA + wid * 32 * LQ, LQ, lane);
            const int cc = lane & 31;
#pragma unroll
            for (int q = 0; q < 4; ++q) {
                const int r0 = 8 * q + 4 * (lane >> 5);
                int pi, pj0; bool wr = true, zero = false, tri = false;
                if (wid == 0) { pi = 32 + cc; pj0 = r0; }
                else if (wid == 1) { pi = cc < 16 ? 16 + cc : 32 + cc; pj0 = r0 < 16 ? r0 : r0 + 16; wr = (r0 < 16) == (cc < 16); }
                else { const int off = (wid - 2) * 32; pi = off + cc; pj0 = off + r0; const bool same = (r0 >> 4) == (cc >> 4); tri = same; zero = !same && r0 >= 16; wr = same || zero; }
                float v[4];
#pragma unroll
                for (int e = 0; e < 4; ++e) { float x = sc[0][0][4 * q + e]; if (tri && (r0 + e > cc)) x = 0.f; if (zero) x = 0.f; v[e] = x; }
                if (wr) {
                    u32x2 w;
                    if (dir == 0) { w.x = pk2(v[0], v[1]); w.y = pk2(v[2], v[3]); *(LAS u32x2*)(P + pi * LDV + pj0) = w; }
                    else { w.x = pk2(v[3], v[2]); w.y = pk2(v[1], v[0]); *(LAS u32x2*)(P + (63 - pi) * LDV + (60 - pj0)) = w; }
                }
            }
        } else if (wid == 4) {
#pragma unroll
            for (int k = 0; k < 2; ++k) {
                const int idx = lane * 2 + k, row = idx >> 2, piece = idx & 3;
                const int ti = dir ? 32 + row : row, tj = (dir ? 0 : 32) + piece * 8;
                u32x4 z; z.x = 0; z.y = 0; z.z = 0; z.w = 0;
                *(LAS u32x4*)(P + ti * LDV + tj) = z;
            }
        }
        __syncthreads();
#pragma unroll
        for (int k = 0; k < NPC; ++k) { const int e = tid + 512 * k; const int v = e / (DK / 8), d0 = (e % (DK / 8)) * 8; *(LAS u32x4*)(ST + v * LQ + d0) = stv[k]; }
        mma_lds<1, 1, 4>(o, P + wm * 32 * LDV, LDV, VT + wn * 32 * LDV, LDV, lane);
        __syncthreads();
        mma_lds<1, 1, DK / 16>(o, QS + wm * 32 * LQ, LQ, ST + wn * 32 * LQ, LQ, lane);
        __syncthreads();
    }
#pragma unroll
    for (int i = 0; i < 16; ++i) Of[(wm * 32 + (i & 3) + 8 * (i >> 2) + 4 * (lane >> 5)) * 132 + wn * 32 + (lane & 31)] = o[0][0][i];
    __syncthreads();
    {
        const int i_ = tid >> 3, seg = tid & 7;
        const LAS float* orow = Of + i_ * 132 + seg * 16;
        float v[16]; float ss = 0.f;
#pragma unroll
        for (int j = 0; j < 16; ++j) { v[j] = orow[j]; ss += v[j] * v[j]; }
        ss += __shfl_xor(ss, 1); ss += __shfl_xor(ss, 2); ss += __shfl_xor(ss, 4);
        const float r = rsqrtf(ss * (1.0f / 128.0f) + EPS);
        const unsigned gu[8] = {g0.x, g0.y, g0.z, g0.w, g1.x, g1.y, g1.z, g1.w};
        unsigned ow[8];
#pragma unroll
        for (int j = 0; j < 8; ++j) {
            const float a = v[2 * j] * r * gnv[2 * j] * siluf_(bflo(gu[j])), b = v[2 * j + 1] * r * gnv[2 * j + 1] * siluf_(bfhi(gu[j]));
            ow[j] = pk2(a, b);
        }
        bf16_t* dst = (bf16_t*)(p.ws + WS_OCAT) + (size_t)(MIX ? 1 : 0) * NTOK * 512 + (size_t)(tokb + i_) * 512 + hd * 128 + seg * 16;
        u32x4 w0, w1; w0.x = ow[0]; w0.y = ow[1]; w0.z = ow[2]; w0.w = ow[3]; w1.x = ow[4]; w1.y = ow[5]; w1.z = ow[6]; w1.w = ow[7];
        *(u32x4*)dst = w0; *(u32x4*)(dst + 8) = w1;
    }
    __syncthreads();
}


__device__ __forceinline__ void phase_out(const Params& p, int l, LAS unsigned char* lds) {
    constexpr int NIT = NCHUNK * 4 * 2;
    for (int it = blockIdx.x; it < NIT; it += gridDim.x) {
        const int mix = (it >> 8) & 1, rem = (it & 255) | ((it >> 9) << 8), hd = rem & 3, gc = rem >> 2;
        if (mix) out_item<1>(p, l, gc, hd, lds); else out_item<0>(p, l, gc, hd, lds);
    }
}

__device__ __forceinline__ void phase_merge(const Params& p, int l, LAS unsigned char* lds) {
    const bf16_t* ocat = (const bf16_t*)(p.ws + WS_OCAT);
    const bf16_t* G3 = (const bf16_t*)(p.ws + WS_PROJ);
    const bf16_t* WbrT = (const bf16_t*)(p.ws + WS_W + (size_t)(l & 1) * W_END + W_BR);
    bf16_t* merged = (bf16_t*)(p.ws + WS_ST);
    const int lane = otid() & 63, wid = otid() >> 6, wm = wid >> 2, wn = wid & 3;
    constexpr int nM = NTOK / 128, nN = 8;
    for (int t = blockIdx.x; t < nM * nN; t += gridDim.x) {
        int tm, tn; tile_coords(t, nN, tm, tn);
        const int row0 = tm * 128, col0 = tn * 128;
        f32x16 tot[2][1]; acc_zero<1>(tot);
#pragma unroll 1
        for (int b = 0; b < 3; ++b) {
            f32x16 ba[2][1]; acc_zero<1>(ba);
            gemm_kloop<128>(lds, ocat + (size_t)row0 * 1536 + b * 512, 1536, WbrT + ((size_t)b * D + col0) * 512, 512, 128, 512, ba);
#pragma unroll
            for (int m = 0; m < 2; ++m)
#pragma unroll
                for (int i = 0; i < 16; ++i) {
                    const int row = row0 + wm * 64 + m * 32 + (i & 3) + 8 * (i >> 2) + 4 * (lane >> 5), col = col0 + wn * 32 + (lane & 31);
                    tot[m][0][i] += bf2f(G3[(size_t)row * NGATE + b * 1024 + col]) * ba[m][0][i];
                }
        }
#pragma unroll
        for (int m = 0; m < 2; ++m)
#pragma unroll
            for (int i = 0; i < 16; ++i) {
                const int row = row0 + wm * 64 + m * 32 + (i & 3) + 8 * (i >> 2) + 4 * (lane >> 5), col = col0 + wn * 32 + (lane & 31);
                merged[(size_t)row * D + col] = f2bf(tot[m][0][i]);
            }
    }
}

__device__ __forceinline__ void run_phase(const Params& p, int ph, LAS unsigned char* lds) {
    if (ph == 0) { phase0(p, lds); return; }
    if (ph == NPHASE - 1) { norm_phase(p, p.final_norm_g, nullptr, 0, 0, nullptr, 1); return; }
    const int l = (ph - 1) / 10, sp = (ph - 1) % 10;
    const float* mod_l = (const float*)(p.ws + WS_MOD) + (size_t)l * 9 * 6144;
    bf16_t* hbuf = (bf16_t*)(p.ws + WS_H);
    bf16_t* proj = (bf16_t*)(p.ws + WS_PROJ);
    const unsigned char* wl = p.ws + WS_W + (size_t)(l & 1) * W_END;
    switch (sp) {
        case 0: if (l == 0) convert_weights(p, l, lds); norm_phase(p, p.norm_mix_g + (size_t)l * D, mod_l, 0, 1024, hbuf, 0); break;
        case 1: { PEpiBf16 e{proj, NPROJ, NPROJ, 0}; pg8_gemm(lds, hbuf, (const bf16_t*)(wl + W_IN), NTOK, 5376, D, e);
            if (l + 1 < DEPTH && blockIdx.x >= 144) { for (int k = 0; k < 2; ++k) convert_weights(p, l + 1, lds, ((int)blockIdx.x - 144) * 2 + k); } } break;
        case 2: phase_scan(p, l, lds); break;
        case 3: phase_out(p, l, lds); break;
        case 4: {
            PEpiBf16 e{proj, NGATE, NGATE, 2}; pg8_gemm(lds, hbuf, (const bf16_t*)(wl + W_G), NTOK, NGATE, D, e);
            PEpiGate e2{proj, NGATE}; pg8_gemm(lds, (const bf16_t*)(p.ws + WS_OCAT), (const bf16_t*)(wl + W_BR), NTOK, NGATE, 512, e2, (size_t)NTOK * 512 * 2);
            if (l + 1 < DEPTH && blockIdx.x >= 192) { for (int k = 0; k < 4; ++k) convert_weights(p, l + 1, lds, CONV_IN_P2 + ((int)blockIdx.x - 192) * 4 + k); } } break;
        case 5: sum3_phase(p); break;
        case 6: {
            PEpiResid e{p.out, mod_l + 2048}; pg8_gemm(lds, (const bf16_t*)(p.ws + WS_ST), (const bf16_t*)(wl + W_OUT), 16384, D, D, e);
            gemm_resid_tiles(lds, (const bf16_t*)(p.ws + WS_ST) + (size_t)16384 * D, D, (const bf16_t*)(wl + W_OUT), D, NTOK - 16384, D, p.out, mod_l + 2048, 16384); } break;
        case 7: norm_phase(p, p.norm_ffn_g + (size_t)l * D, mod_l, 3072, 4096, hbuf, 0); break;
        case 8: { PEpiBf16 e{proj, DFF, DFF, 1}; pg8_gemm(lds, hbuf, (const bf16_t*)(wl + W_FF1), NTOK, DFF, D, e); } break;
        case 9: { PEpiResid e{p.out, mod_l + 5120}; pg8_gemm(lds, proj, (const bf16_t*)(wl + W_FF2), 16384, D, DFF, e);
            gemm_resid_tiles(lds, proj + (size_t)16384 * DFF, DFF, (const bf16_t*)(wl + W_FF2), DFF, NTOK - 16384, DFF, p.out, mod_l + 5120, 16384); } break;
    }
}

__global__ void __launch_bounds__(512) fwd_megakernel(Params p) {
    extern __shared__ __attribute__((aligned(16))) unsigned char smem[];
    LAS unsigned char* lds = (LAS unsigned char*)smem;
    cg::grid_group grid = cg::this_grid();
    unsigned nbar = 0;
    for (int ph = p.ph_lo; ph < p.ph_hi; ++ph) {
        run_phase(p, ph, lds);
        if (ph + 1 < p.ph_hi) {
            if (ph == 0) grid.sync();
            else { ++nbar; grid_barrier((unsigned*)(p.ws + WS_CTR) + 64, nbar); }
        }
    }
}

extern "C" void kernel_launch(void* const* d_in, const int* in_sizes, int n_in, void* d_out, int out_size, void* d_ws, size_t ws_size, hipStream_t stream) {
    static int grid_blocks = 0;
    if (!grid_blocks) {
        int dev = 0, cus = 0, per_cu = 0;
        hipGetDevice(&dev);
        hipDeviceGetAttribute(&cus, hipDeviceAttributeMultiprocessorCount, dev);
        if (hipFuncSetAttribute((const void*)fwd_megakernel, hipFuncAttributeMaxDynamicSharedMemorySize, LDS_BYTES) != hipSuccess) fprintf(stderr, "hipFuncSetAttribute failed\n");
        hipOccupancyMaxActiveBlocksPerMultiprocessor(&per_cu, (const void*)fwd_megakernel, 512, LDS_BYTES);
        if (per_cu < 1) { fprintf(stderr, "occupancy query says %d blocks/CU\n", per_cu); per_cu = 1; }
        grid_blocks = cus * 1;
        (void)hipGetLastError();
        if (n_in != 26 || ws_size < WS_END) fprintf(stderr, "kernel_launch: unexpected n_in %d or ws_size %zu (need %zu)\n", n_in, ws_size, (size_t)WS_END);
    }
    Params p{};
    const float** pp = (const float**)&p;
    for (int i = 0; i < 26; ++i) pp[i] = (const float*)d_in[i];
    p.out = (float*)d_out; p.ws = (unsigned char*)d_ws; p.ph_lo = 0; p.ph_hi = NPHASE;
    void* args[] = {&p};
    hipError_t e = hipLaunchCooperativeKernel((const void*)fwd_megakernel, dim3(grid_blocks), dim3(512), args, LDS_BYTES, stream);
    if (e != hipSuccess) fprintf(stderr, "cooperative launch failed: %s (grid %d)\n", hipGetErrorString(e), grid_blocks);
}
```
